# Optimizing an MI355X kernel written in HIP

```python
import math
import jax
import jax.numpy as jnp
from jax import lax
import numpy as np


D_MODEL = 1024
BATCH = 4
SEQ = 4096
DEPTH = 4

GRID_W = 64
CTX_LEN = 256
QBLOCK = 128

DIFF_HEADS = 4
DIFF_QK_DIM = 64
DIFF_V_DIM = 2 * DIFF_QK_DIM
DIFF_WIDTH = DIFF_HEADS * DIFF_V_DIM

S5_WIDTH = 512
S5_GROUP = 16
S5_GROUPS = S5_WIDTH // S5_GROUP
S5_STATE = 64

WIN_Q_HEADS = 8
WIN_KV_HEADS = 2
WIN_HEAD_DIM = 64
WIN_GROUP = WIN_Q_HEADS // WIN_KV_HEADS
WIN_WIDTH = WIN_Q_HEADS * WIN_HEAD_DIM
WINDOW = 128

ROPE_DIM = 64
N_BRANCHES = 3
D_FF = 4 * D_MODEL
ROPE_BASE = 10000.0
EPS = 1e-6
NEG_INF = -1e30

IN_WIDTHS = (2 * DIFF_HEADS * DIFF_QK_DIM, 2 * DIFF_HEADS * DIFF_QK_DIM, DIFF_WIDTH, S5_WIDTH,
             WIN_WIDTH, WIN_KV_HEADS * WIN_HEAD_DIM, WIN_KV_HEADS * WIN_HEAD_DIM, N_BRANCHES * D_MODEL)
D_IN = sum(IN_WIDTHS)

kernel_name = 'hybrid_diffattn_s5_swa_prefix_dit'


def _in_offsets():
    offs, acc = [], 0
    for w in IN_WIDTHS[:-1]:
        acc += w
        offs.append(acc)
    return offs


def rms_norm(x, g):
    xf = x.astype(jnp.float32)
    y = xf * lax.rsqrt(jnp.mean(jnp.square(xf), -1, keepdims=True) + EPS)
    return (y * g.astype(jnp.float32)).astype(x.dtype)


def axial_rope(rows, head_dim):
    n_freq = head_dim // 4
    inv = ROPE_BASE ** (-jnp.arange(n_freq, dtype=jnp.float32) / n_freq)
    r = jnp.repeat(jnp.arange(rows, dtype=jnp.float32), GRID_W)
    col = jnp.tile(jnp.arange(GRID_W, dtype=jnp.float32), rows)
    ang = jnp.concatenate([r[:, None] * inv, col[:, None] * inv], -1)
    return jnp.cos(ang), jnp.sin(ang)


def apply_rope(x, cos, sin):
    bshape = (1, x.shape[1]) + (1,) * (x.ndim - 3) + (cos.shape[-1],)
    cos = cos.reshape(bshape)
    sin = sin.reshape(bshape)
    x1, x2 = jnp.split(x.astype(jnp.float32), 2, -1)
    return jnp.concatenate([x1 * cos - x2 * sin, x2 * cos + x1 * sin], -1).astype(x.dtype)


def diff_attention(q_lat, k_lat, v_lat, q_ctx, k_ctx, v_ctx, cos, sin, q_g, k_g, lam, lam_init, out_g, need_ctx):
    b, n, _ = q_lat.shape
    nc = q_ctx.shape[1]
    sh = (2, DIFF_HEADS, DIFF_QK_DIM)
    scale = DIFF_QK_DIM ** -0.5
    ql = apply_rope(rms_norm(q_lat.reshape((b, n) + sh), q_g), cos, sin)
    kl = apply_rope(rms_norm(k_lat.reshape((b, n) + sh), k_g), cos, sin)
    kc = rms_norm(k_ctx.reshape((b, nc) + sh), k_g)
    vl = v_lat.reshape(b, n, DIFF_HEADS, DIFF_V_DIM)
    vc = v_ctx.reshape(b, nc, DIFF_HEADS, DIFF_V_DIM)
    k_all = jnp.concatenate([kc, kl], 1)
    v_all = jnp.concatenate([vc, vl], 1)

    def attend(q, k, v):
        s = jnp.einsum('bqmhd,bkmhd->bmhqk', q, k).astype(jnp.float32) * scale
        p = jax.nn.softmax(s, -1)
        p = p[:, 0] - lam * p[:, 1]
        return jnp.einsum('bhqk,bkhe->bqhe', p.astype(v.dtype), v)

    def post(o, length):
        o = rms_norm(o, out_g) * (1.0 - lam_init)
        return o.reshape(b, length, DIFF_WIDTH)

    nb = n // QBLOCK
    q_blocks = ql.reshape((b, nb, QBLOCK) + sh).swapaxes(0, 1)
    o = lax.map(lambda qb: attend(qb, k_all, v_all), q_blocks)
    y_lat = post(o.swapaxes(0, 1).reshape(b, n, DIFF_HEADS, DIFF_V_DIM), n)
    y_ctx = None
    if need_ctx:
        qc = rms_norm(q_ctx.reshape((b, nc) + sh), q_g)
        y_ctx = post(attend(qc, kc, vc), nc)
    return y_lat, y_ctx


def window_gqa(q_lat, k_lat, v_lat, q_ctx, k_ctx, v_ctx, cos, sin, q_g, k_g, sink, need_ctx):
    b, n, _ = q_lat.shape
    nc = q_ctx.shape[1]
    scale = WIN_HEAD_DIM ** -0.5
    ql = apply_rope(rms_norm(q_lat.reshape(b, n, WIN_KV_HEADS, WIN_GROUP, WIN_HEAD_DIM), q_g), cos, sin)
    kl = apply_rope(rms_norm(k_lat.reshape(b, n, WIN_KV_HEADS, WIN_HEAD_DIM), k_g), cos, sin)
    vl = v_lat.reshape(b, n, WIN_KV_HEADS, WIN_HEAD_DIM)
    kc = rms_norm(k_ctx.reshape(b, nc, WIN_KV_HEADS, WIN_HEAD_DIM), k_g)
    vc = v_ctx.reshape(b, nc, WIN_KV_HEADS, WIN_HEAD_DIM)
    sink_l = sink.astype(jnp.float32).reshape(WIN_KV_HEADS, WIN_GROUP)

    nb = n // QBLOCK
    qb = ql.reshape(b, nb, QBLOCK, WIN_KV_HEADS, WIN_GROUP, WIN_HEAD_DIM)
    pad = ((0, 0), (QBLOCK, QBLOCK), (0, 0), (0, 0))
    kp = jnp.pad(kl, pad).reshape(b, nb + 2, QBLOCK, WIN_KV_HEADS, WIN_HEAD_DIM)
    vp = jnp.pad(vl, pad).reshape(b, nb + 2, QBLOCK, WIN_KV_HEADS, WIN_HEAD_DIM)
    k_band = jnp.concatenate([kp[:, :-2], kp[:, 1:-1], kp[:, 2:]], 2)
    v_band = jnp.concatenate([vp[:, :-2], vp[:, 1:-1], vp[:, 2:]], 2)
    qi = jnp.arange(QBLOCK)
    sj = jnp.arange(3 * QBLOCK)
    key_pos = jnp.arange(nb)[:, None] * QBLOCK - QBLOCK + sj[None, :]
    rel = sj[None, :] - QBLOCK - qi[:, None]
    valid = (jnp.abs(rel) <= WINDOW)[None] & ((key_pos >= 0) & (key_pos < n))[:, None, :]

    s_band = jnp.einsum('bnqkgd,bnskd->bnkgqs', qb, k_band).astype(jnp.float32) * scale
    s_band = jnp.where(valid[None, :, None, None], s_band, NEG_INF)
    s_ctx = jnp.einsum('bnqkgd,bskd->bnkgqs', qb, kc).astype(jnp.float32) * scale
    s_sink = jnp.broadcast_to(sink_l[None, None, :, :, None, None], s_ctx.shape[:-1] + (1,))
    p = jax.nn.softmax(jnp.concatenate([s_ctx, s_band, s_sink], -1), -1).astype(vl.dtype)
    o = (jnp.einsum('bnkgqs,bskd->bnqkgd', p[..., :nc], vc)
         + jnp.einsum('bnkgqs,bnskd->bnqkgd', p[..., nc:nc + 3 * QBLOCK], v_band))
    y_lat = o.reshape(b, n, WIN_WIDTH)
    y_ctx = None
    if need_ctx:
        qc = rms_norm(q_ctx.reshape(b, nc, WIN_KV_HEADS, WIN_GROUP, WIN_HEAD_DIM), q_g)
        s = jnp.einsum('bqkgd,bskd->bkgqs', qc, kc).astype(jnp.float32) * scale
        s_sk = jnp.broadcast_to(sink_l[None, :, :, None, None], s.shape[:-1] + (1,))
        pc = jax.nn.softmax(jnp.concatenate([s, s_sk], -1), -1).astype(vc.dtype)
        y_ctx = jnp.einsum('bkgqs,bskd->bqkgd', pc[..., :nc], vc).reshape(b, nc, WIN_WIDTH)
    return y_lat, y_ctx


def s5_discretize(lam_re, lam_im, log_dt, b_re, b_im):
    dt = jnp.exp(log_dt)[:, None]
    mag = jnp.exp(lam_re * dt)
    ang = lam_im * dt
    a_re = mag * jnp.cos(ang)
    a_im = mag * jnp.sin(ang)
    den = jnp.square(lam_re) + jnp.square(lam_im)
    n_re = a_re - 1.0
    f_re = (n_re * lam_re + a_im * lam_im) / den
    f_im = (a_im * lam_re - n_re * lam_im) / den
    bb_re = f_re[..., None] * b_re - f_im[..., None] * b_im
    bb_im = f_re[..., None] * b_im + f_im[..., None] * b_re
    return a_re, a_im, bb_re, bb_im


def _ssm_combine(left, right):
    a1r, a1i, b1r, b1i = left
    a2r, a2i, b2r, b2i = right
    return (a2r * a1r - a2i * a1i, a2r * a1i + a2i * a1r,
            a2r * b1r - a2i * b1i + b2r, a2r * b1i + a2i * b1r + b2i)


def s5_scan(a_re, a_im, bu_re, bu_im, reverse, init=None):
    if init is not None:
        idx = bu_re.shape[1] - 1 if reverse else 0
        s_re, s_im = init
        bu_re = bu_re.at[:, idx].add(a_re * s_re - a_im * s_im)
        bu_im = bu_im.at[:, idx].add(a_re * s_im + a_im * s_re)
    ar = jnp.broadcast_to(a_re, bu_re.shape)
    ai = jnp.broadcast_to(a_im, bu_re.shape)
    _, _, s_re, s_im = lax.associative_scan(_ssm_combine, (ar, ai, bu_re, bu_im), reverse=reverse, axis=1)
    return s_re, s_im


def s5_readout(c_re, c_im, s_re, s_im):
    y = jnp.einsum('ghp,blgp->blgh', c_re, s_re) - jnp.einsum('ghp,blgp->blgh', c_im, s_im)
    return y.reshape(y.shape[0], y.shape[1], S5_WIDTH)


def s5_mixer(u_lat, u_ctx, lam_re, lam_im, log_dt, b_re, b_im, c_re, c_im, d_skip, w_glu, need_ctx):
    f32 = jnp.float32
    b, n, _ = u_lat.shape
    nc = u_ctx.shape[1]
    ul = u_lat.astype(f32).reshape(b, n, S5_GROUPS, S5_GROUP)
    uc = u_ctx.astype(f32).reshape(b, nc, S5_GROUPS, S5_GROUP)
    dsk = d_skip.astype(f32)
    y_lat = u_lat.astype(f32) * dsk
    y_ctx = u_ctx.astype(f32) * dsk if need_ctx else None
    for direction, reverse in ((0, False), (1, True)):
        a_re, a_im, bb_re, bb_im = s5_discretize(lam_re[direction].astype(f32), lam_im[direction].astype(f32),
                                                 log_dt[direction].astype(f32), b_re[direction].astype(f32),
                                                 b_im[direction].astype(f32))
        cr = c_re[direction].astype(f32)
        ci = c_im[direction].astype(f32)
        cs_re, cs_im = s5_scan(a_re, a_im, jnp.einsum('gph,blgh->blgp', bb_re, uc),
                               jnp.einsum('gph,blgh->blgp', bb_im, uc), reverse)
        edge = 0 if reverse else nc - 1
        ls_re, ls_im = s5_scan(a_re, a_im, jnp.einsum('gph,blgh->blgp', bb_re, ul),
                               jnp.einsum('gph,blgh->blgp', bb_im, ul), reverse,
                               init=(cs_re[:, edge], cs_im[:, edge]))
        y_lat = y_lat + s5_readout(cr, ci, ls_re, ls_im)
        if need_ctx:
            y_ctx = y_ctx + s5_readout(cr, ci, cs_re, cs_im)

    def glu(y):
        g = jax.nn.gelu(y.astype(u_lat.dtype))
        return g * jax.nn.sigmoid(g @ w_glu)

    return glu(y_lat), (glu(y_ctx) if need_ctx else None)


def setup_inputs(seed: int = 0) -> dict:
    key = jax.random.key(seed)
    ks = iter(jax.random.split(key, 48))
    f32 = jnp.float32

    def nrm(shape, scale):
        return jax.random.normal(next(ks), shape, f32) * scale

    def gain(shape):
        return 1.0 + nrm(shape, 0.02)

    L, D = DEPTH, D_MODEL
    G, P, HG = S5_GROUPS, S5_STATE, S5_GROUP
    n_idx = jnp.arange(P, dtype=f32)
    return {
        'x': nrm((BATCH, SEQ, D), 1.0),
        'c': nrm((BATCH, D), 1.0),
        'ctx': nrm((BATCH, CTX_LEN, D), 1.0),
        'c_ctx': nrm((D,), 1.0),
        'w_mod': nrm((L, D, 6 * D), 0.5 * D ** -0.5),
        'b_mod': nrm((L, 6 * D), 0.02),
        'norm1_g': gain((L, D)),
        'norm2_g': gain((L, D)),
        'w_in': nrm((L, D, D_IN), D ** -0.5),
        'diff_q_norm_g': gain((L, DIFF_QK_DIM)),
        'diff_k_norm_g': gain((L, DIFF_QK_DIM)),
        'diff_lam_q1': nrm((L, DIFF_QK_DIM), 0.1),
        'diff_lam_k1': nrm((L, DIFF_QK_DIM), 0.1),
        'diff_lam_q2': nrm((L, DIFF_QK_DIM), 0.1),
        'diff_lam_k2': nrm((L, DIFF_QK_DIM), 0.1),
        'diff_out_norm_g': gain((L, DIFF_V_DIM)),
        's5_lambda_re': -0.5 + nrm((L, 2, G, P), 0.01),
        's5_lambda_im': math.pi * n_idx + nrm((L, 2, G, P), 0.01),
        's5_log_dt': jax.random.uniform(next(ks), (L, 2, G), f32, math.log(1e-3), math.log(1e-1)),
        's5_b_re': nrm((L, 2, G, P, HG), (2 * HG) ** -0.5),
        's5_b_im': nrm((L, 2, G, P, HG), (2 * HG) ** -0.5),
        's5_c_re': nrm((L, 2, G, HG, P), (2 * P) ** -0.5 * 4.0),
        's5_c_im': nrm((L, 2, G, HG, P), (2 * P) ** -0.5 * 4.0),
        's5_d': nrm((L, S5_WIDTH), 1.0),
        's5_w_glu': nrm((L, S5_WIDTH, S5_WIDTH), S5_WIDTH ** -0.5),
        'win_q_norm_g': gain((L, WIN_HEAD_DIM)),
        'win_k_norm_g': gain((L, WIN_HEAD_DIM)),
        'win_sink': nrm((L, WIN_Q_HEADS), 1.0),
        'w_proj_diff': nrm((L, DIFF_WIDTH, D), DIFF_WIDTH ** -0.5),
        'w_proj_s5': nrm((L, S5_WIDTH, D), S5_WIDTH ** -0.5),
        'w_proj_win': nrm((L, WIN_WIDTH, D), WIN_WIDTH ** -0.5),
        'w_out': nrm((L, D, D), D ** -0.5),
        'w_ff1': nrm((L, D, D_FF), D ** -0.5),
        'w_ff2': nrm((L, D_FF, D), D_FF ** -0.5),
    }


def reference(x, c, ctx, c_ctx, w_mod, b_mod, norm1_g, norm2_g, w_in,
              diff_q_norm_g, diff_k_norm_g, diff_lam_q1, diff_lam_k1, diff_lam_q2, diff_lam_k2, diff_out_norm_g,
              s5_lambda_re, s5_lambda_im, s5_log_dt, s5_b_re, s5_b_im, s5_c_re, s5_c_im, s5_d, s5_w_glu,
              win_q_norm_g, win_k_norm_g, win_sink,
              w_proj_diff, w_proj_s5, w_proj_win, w_out, w_ff1, w_ff2):
    n_lat = x.shape[1]
    ROWS = n_lat // GRID_W
    cos, sin = axial_rope(ROWS, ROPE_DIM)
    offs = _in_offsets()
    silu_c = jax.nn.silu(c)
    silu_cc = jax.nn.silu(c_ctx)
    h_lat, h_ctx = x, ctx
    for l in range(DEPTH):
        need_ctx = l < DEPTH - 1
        lam_init = 0.8 - 0.6 * math.exp(-0.3 * l)
        mod_l = (silu_c @ w_mod[l] + b_mod[l])[:, None, :]
        mod_c = (silu_cc @ w_mod[l] + b_mod[l])[None, None, :]
        sh1, sc1, g1, sh2, sc2, g2 = jnp.split(mod_l, 6, -1)
        csh1, csc1, cg1, csh2, csc2, cg2 = jnp.split(mod_c, 6, -1)

        a_lat = rms_norm(h_lat, norm1_g[l]) * (1.0 + sc1) + sh1
        a_ctx = rms_norm(h_ctx, norm1_g[l]) * (1.0 + csc1) + csh1
        dq_l, dk_l, dv_l, su_l, wq_l, wk_l, wv_l, gt_l = jnp.split(a_lat @ w_in[l], offs, -1)
        dq_c, dk_c, dv_c, su_c, wq_c, wk_c, wv_c, gt_c = jnp.split(a_ctx @ w_in[l], offs, -1)

        lam = (jnp.exp(jnp.sum(diff_lam_q1[l] * diff_lam_k1[l]).astype(jnp.float32))
               - jnp.exp(jnp.sum(diff_lam_q2[l] * diff_lam_k2[l]).astype(jnp.float32)) + lam_init)
        yd_l, yd_c = diff_attention(dq_l, dk_l, dv_l, dq_c, dk_c, dv_c, cos, sin, diff_q_norm_g[l],
                                    diff_k_norm_g[l], lam, lam_init, diff_out_norm_g[l], need_ctx)
        ys_l, ys_c = s5_mixer(su_l, su_c, s5_lambda_re[l], s5_lambda_im[l], s5_log_dt[l], s5_b_re[l],
                              s5_b_im[l], s5_c_re[l], s5_c_im[l], s5_d[l], s5_w_glu[l], need_ctx)
        yw_l, yw_c = window_gqa(wq_l, wk_l, wv_l, wq_c, wk_c, wv_c, cos, sin, win_q_norm_g[l],
                                win_k_norm_g[l], win_sink[l], need_ctx)

        def merge(yd, ys, yw, gates):
            ga, gb, gc = jnp.split(jax.nn.sigmoid(gates), N_BRANCHES, -1)
            m = ga * (yd @ w_proj_diff[l]) + gb * (ys @ w_proj_s5[l]) + gc * (yw @ w_proj_win[l])
            return m @ w_out[l]

        h_lat = h_lat + g1 * merge(yd_l, ys_l, yw_l, gt_l)
        f_lat = rms_norm(h_lat, norm2_g[l]) * (1.0 + sc2) + sh2
        h_lat = h_lat + g2 * (jnp.square(jax.nn.relu(f_lat @ w_ff1[l])) @ w_ff2[l])
        if need_ctx:
            h_ctx = h_ctx + cg1 * merge(yd_c, ys_c, yw_c, gt_c)
            f_ctx = rms_norm(h_ctx, norm2_g[l]) * (1.0 + csc2) + csh2
            h_ctx = h_ctx + cg2 * (jnp.square(jax.nn.relu(f_ctx @ w_ff1[l])) @ w_ff2[l])
    return h_lat
```

```cpp
#include <hip/hip_runtime.h>
#include <hip/hip_cooperative_groups.h>
#include <cstdio>
#include <cstdint>
namespace cg = cooperative_groups;

typedef unsigned short bf16_t;
typedef short bf16x8 __attribute__((ext_vector_type(8)));
typedef short bf16x4 __attribute__((ext_vector_type(4)));
typedef float f32x4 __attribute__((ext_vector_type(4)));
typedef float f32x2 __attribute__((ext_vector_type(2)));
typedef unsigned u32x4 __attribute__((ext_vector_type(4)));
typedef unsigned u32x2 __attribute__((ext_vector_type(2)));
typedef __bf16 bf2_t __attribute__((ext_vector_type(2)));

#define DI __device__ __forceinline__
#define MFMA16(a, b, c) __builtin_amdgcn_mfma_f32_16x16x32_bf16((a), (b), (c), 0, 0, 0)

constexpr int D = 1024, NB = 4, SEQ = 4096, DEPTH = 4, CTX = 256, POS = CTX + SEQ  ;
constexpr int NLAT = NB * SEQ  , NCTX = NB * CTX  , NTOK = NLAT + NCTX  ;
constexpr int DIN = 5888, DFF = 4096;
constexpr float EPS = 1e-6f;
constexpr float LOG2E = 1.4426950408889634f;
constexpr int NCH = POS / 32;

constexpr size_t SZ_W_IN = (size_t)DIN * D * 2, SZ_W_GLU = 512 * 512 * 2, SZ_W_P = 1024 * 512 * 2, SZ_W_OUT = (size_t)D * D * 2, SZ_W_FF = (size_t)D * DFF * 2;
constexpr size_t OFF_W_IN = 0;
constexpr size_t OFF_W_GLU = OFF_W_IN + SZ_W_IN;
constexpr size_t OFF_W_PD = OFF_W_GLU + SZ_W_GLU;
constexpr size_t OFF_W_PS = OFF_W_PD + SZ_W_P;
constexpr size_t OFF_W_PW = OFF_W_PS + SZ_W_P;
constexpr size_t OFF_W_OUT = OFF_W_PW + SZ_W_P;
constexpr size_t OFF_W_FF1 = OFF_W_OUT + SZ_W_OUT;
constexpr size_t OFF_W_FF2 = OFF_W_FF1 + SZ_W_FF;
constexpr size_t OFF_MODV = OFF_W_FF2 + SZ_W_FF;
constexpr size_t OFF_ROPE = OFF_MODV + (size_t)DEPTH * 5 * 6144 * 4;
constexpr size_t OFF_LAM = OFF_ROPE + 8192;
constexpr size_t OFF_H = OFF_LAM + 256;
constexpr size_t OFF_ABUF = OFF_H + (size_t)NTOK * D * 4;
constexpr size_t OFF_R1 = OFF_ABUF + (size_t)NTOK * D * 2;
constexpr size_t SZ_HEADBUF = (size_t)NB * 8 * POS * 64 * 2;
constexpr size_t OFF_QD = OFF_R1;
constexpr size_t OFF_KD = OFF_QD + SZ_HEADBUF;
constexpr size_t OFF_VDT = OFF_KD + SZ_HEADBUF;
constexpr size_t OFF_SU = OFF_VDT + SZ_HEADBUF;
constexpr size_t OFF_QW = OFF_SU + (size_t)NTOK * 512 * 2;
constexpr size_t OFF_KW = OFF_QW + SZ_HEADBUF;
constexpr size_t OFF_VWT = OFF_KW + SZ_HEADBUF / 4;
constexpr size_t OFF_GATES = OFF_VWT + SZ_HEADBUF / 4;
constexpr size_t OFF_YD = OFF_GATES + (size_t)NTOK * 3072 * 2;
constexpr size_t OFF_YS = OFF_YD + (size_t)NTOK * 512 * 2;
constexpr size_t OFF_YW = OFF_YS + (size_t)NTOK * 512 * 2;
constexpr size_t OFF_GB = OFF_YW + (size_t)NTOK * 512 * 2;
constexpr size_t OFF_EB = OFF_GB + (size_t)NTOK * 512 * 2;
constexpr size_t OFF_END = OFF_EB + (size_t)NB * 32 * 2 * (NCH + 8) * 64 * 8;
constexpr size_t OFF_M = OFF_QD;
constexpr size_t OFF_U = OFF_R1;
static_assert((size_t)NTOK * DFF * 2 <= OFF_END - OFF_R1, "u alias");

struct Params {
  const float *x, *c, *ctx, *c_ctx, *w_mod, *b_mod, *norm1_g, *norm2_g, *w_in;
  const float *dq_g, *dk_g, *lq1, *lk1, *lq2, *lk2, *dout_g;
  const float *s5_lre, *s5_lim, *s5_ldt, *s5_bre, *s5_bim, *s5_cre, *s5_cim, *s5_d, *s5_wglu;
  const float *wq_g, *wk_g, *w_sink;
  const float *w_pd, *w_ps, *w_pw, *w_out, *w_ff1, *w_ff2;
  float* out;
  unsigned char* ws;
};

DI int get_tid() { int t = threadIdx.x; asm volatile("" : "+v"(t)); return t; }
DI int get_bid() { int b = blockIdx.x; asm volatile("" : "+s"(b)); return b; }
DI unsigned pack2(float lo, float hi) { f32x2 v = {lo, hi}; bf2_t r = __builtin_convertvector(v, bf2_t); return __builtin_bit_cast(unsigned, r); }
DI float sigmoidf_(float x) { return 1.0f / (1.0f + __expf(-x)); }
DI float gelu_tanh(float x) { const float z = 0.7978845608028654f * (x + 0.044715f * x * x * x); const float e = __expf(2.0f * z); const float t = 1.0f - 2.0f / (e + 1.0f); return 0.5f * x * (1.0f + t); }
DI f32x4 ld_bf4(const bf16_t* p_) { const u32x2 r = *(const u32x2*)p_; f32x4 v; v[0] = __uint_as_float(r[0] << 16); v[1] = __uint_as_float(r[0] & 0xffff0000u); v[2] = __uint_as_float(r[1] << 16); v[3] = __uint_as_float(r[1] & 0xffff0000u); return v; }
DI float xshfl(float v, int m) { return __shfl_xor(v, m, 64); }

constexpr int SMEM_BYTES = 65552;
constexpr int LDT = 72;

DI u32x4 gload_async(const void* ptr) { u32x4 r; asm volatile("global_load_dwordx4 %0, %1, off" : "=v"(r) : "v"(ptr) : "memory"); return r; }
#define VM_WAIT8(N, R, Q) asm volatile("s_waitcnt vmcnt(" #N ")" : "+v"(R[0]), "+v"(R[1]), "+v"(R[2]), "+v"(R[3]), "+v"(Q[0]), "+v"(Q[1]), "+v"(Q[2]), "+v"(Q[3]) :: "memory")
DI void gemm_mainloop(f32x4 (&acc)[4][4], const bf16_t* __restrict__ A, int lda, const bf16_t* __restrict__ B, int ldb, int K, bf16_t* As, bf16_t* Bs) {
  const int tid = get_tid(), lane = tid & 63, wid = tid >> 6, wr = wid >> 1, wc = wid & 1, lr = lane & 15, lg = lane >> 4;
  const int crow = tid >> 3, ckc = (tid & 7) * 8;
  constexpr int TB = 128 * 64;
  const int swc = (((tid & 7) ^ (crow & 7)) * 8);
  u32x4 ra0[4], rb0[4], ra1[4], rb1[4];
  const bf16_t* Ap = A + (size_t)crow * lda + ckc; const bf16_t* Bp = B + (size_t)crow * ldb + ckc;
#define GM_LOAD(RA, RB, KOFF) do { _Pragma("unroll") for (int i = 0; i < 4; ++i) { RA[i] = gload_async(Ap + (size_t)(i * 32) * lda + (KOFF)); RB[i] = gload_async(Bp + (size_t)(i * 32) * ldb + (KOFF)); } } while (0)
#define GM_STORE(RA, RB, BUF) do { _Pragma("unroll") for (int i = 0; i < 4; ++i) { *(u32x4*)(As + (BUF) * 2 * TB + (crow + i * 32) * 64 + swc) = RA[i]; *(u32x4*)(As + (BUF) * 2 * TB + TB + (crow + i * 32) * 64 + swc) = RB[i]; } } while (0)
#define GM_COMPUTE(BUF) do { const bf16_t* as_ = As + (BUF) * 2 * TB; const bf16_t* bs_ = as_ + TB; \
    _Pragma("unroll") for (int ks = 0; ks < 2; ++ks) { bf16x8 af[4], bfr[4]; const int co_ = ((ks * 4 + lg) ^ (lr & 7)) * 8; \
      _Pragma("unroll") for (int mi = 0; mi < 4; ++mi) af[mi] = *(const bf16x8*)(as_ + (wr * 64 + mi * 16 + lr) * 64 + co_); \
      _Pragma("unroll") for (int ni = 0; ni < 4; ++ni) bfr[ni] = *(const bf16x8*)(bs_ + (wc * 64 + ni * 16 + lr) * 64 + co_); \
      _Pragma("unroll") for (int mi = 0; mi < 4; ++mi) _Pragma("unroll") for (int ni = 0; ni < 4; ++ni) acc[mi][ni] = MFMA16(bfr[ni], af[mi], acc[mi][ni]); } } while (0)
  asm volatile("s_waitcnt vmcnt(0)" ::: "memory");
  GM_LOAD(ra0, rb0, 0); GM_LOAD(ra1, rb1, 64);
  __syncthreads();
  for (int k0 = 0; k0 < K; k0 += 128) {
    const int kn0 = k0 + 128 < K ? k0 + 128 : 0, kn1 = k0 + 192 < K ? k0 + 192 : 64;
    VM_WAIT8(8, ra0, rb0);
    GM_STORE(ra0, rb0, 0); __syncthreads();
    GM_LOAD(ra0, rb0, kn0);
    GM_COMPUTE(0);
    VM_WAIT8(8, ra1, rb1);
    GM_STORE(ra1, rb1, 1); __syncthreads();
    GM_LOAD(ra1, rb1, kn1);
    GM_COMPUTE(1);
  }
  VM_WAIT8(0, ra0, rb0); VM_WAIT8(0, ra1, rb1);
#undef GM_LOAD
#undef GM_STORE
#undef GM_COMPUTE
}
DI void zero_acc(f32x4 (&acc)[4][4]) {
#pragma unroll
  for (int mi = 0; mi < 4; ++mi)
#pragma unroll
    for (int ni = 0; ni < 4; ++ni) acc[mi][ni] = (f32x4){0.f, 0.f, 0.f, 0.f};
}

DI void convert_tile(const float* __restrict__ src, int K, int N, bf16_t* __restrict__ dst, int kt, int nt, float* tile) {
  const int tid = get_tid();
  { const int r = tid >> 4, c4 = (tid & 15) * 4;
#pragma unroll
    for (int i = 0; i < 4; ++i) { const int k = r + i * 16; const f32x4 v = *(const f32x4*)(src + (size_t)(kt * 64 + k) * N + nt * 64 + c4);
      tile[k * 65 + c4 + 0] = v[0]; tile[k * 65 + c4 + 1] = v[1]; tile[k * 65 + c4 + 2] = v[2]; tile[k * 65 + c4 + 3] = v[3]; } }
  __syncthreads();
  { const int n = tid >> 2, kc = (tid & 3) * 16; u32x4 o0, o1;
#pragma unroll
    for (int q = 0; q < 4; ++q) { o0[q] = pack2(tile[(kc + 2 * q) * 65 + n], tile[(kc + 2 * q + 1) * 65 + n]); o1[q] = pack2(tile[(kc + 8 + 2 * q) * 65 + n], tile[(kc + 8 + 2 * q + 1) * 65 + n]); }
    bf16_t* d = dst + (size_t)(nt * 64 + n) * K + kt * 64 + kc; *(u32x4*)d = o0; *(u32x4*)(d + 8) = o1; }
  __syncthreads();
}
DI void convert_layer(const Params& p, int l, unsigned char* smem) {
  float* tile = (float*)smem;
  unsigned char* ws = p.ws;
  for (int t = get_bid(); t < 4224; t += gridDim.x) {
    const float* src; bf16_t* dst; int K, N, idx;
    if (t < 1472) { idx = t; src = p.w_in + (size_t)l * D * DIN; K = D; N = DIN; dst = (bf16_t*)(ws + OFF_W_IN); }
    else if (t < 1536) { idx = t - 1472; src = p.s5_wglu + (size_t)l * 512 * 512; K = 512; N = 512; dst = (bf16_t*)(ws + OFF_W_GLU); }
    else if (t < 1664) { idx = t - 1536; src = p.w_pd + (size_t)l * 512 * D; K = 512; N = D; dst = (bf16_t*)(ws + OFF_W_PD); }
    else if (t < 1792) { idx = t - 1664; src = p.w_ps + (size_t)l * 512 * D; K = 512; N = D; dst = (bf16_t*)(ws + OFF_W_PS); }
    else if (t < 1920) { idx = t - 1792; src = p.w_pw + (size_t)l * 512 * D; K = 512; N = D; dst = (bf16_t*)(ws + OFF_W_PW); }
    else if (t < 2176) { idx = t - 1920; src = p.w_out + (size_t)l * D * D; K = D; N = D; dst = (bf16_t*)(ws + OFF_W_OUT); }
    else if (t < 3200) { idx = t - 2176; src = p.w_ff1 + (size_t)l * D * DFF; K = D; N = DFF; dst = (bf16_t*)(ws + OFF_W_FF1); }
    else { idx = t - 3200; src = p.w_ff2 + (size_t)l * DFF * D; K = DFF; N = D; dst = (bf16_t*)(ws + OFF_W_FF2); }
    const int nts = N / 64; convert_tile(src, K, N, dst, idx / nts, idx % nts, tile);
  }
}

DI void phase0_misc(const Params& p, unsigned char* smem) {
  unsigned char* ws = p.ws;
  const int tid = get_tid();
  { f32x4* h4 = (f32x4*)(ws + OFF_H); const f32x4* x4 = (const f32x4*)p.x; const f32x4* c4 = (const f32x4*)p.ctx;
    const size_t nx = (size_t)NLAT * D / 4, nc = (size_t)NCTX * D / 4;
    for (size_t i = (size_t)get_bid() * 256 + tid; i < nx + nc; i += (size_t)gridDim.x * 256) h4[i] = i < nx ? x4[i] : c4[i - nx]; }
  if (get_bid() == 0) {
    float* rope = (float*)(ws + OFF_ROPE);
    for (int i = tid; i < 1024; i += 256) { const int pos = i >> 4, f = i & 15; const float inv = powf(10000.0f, -(float)f / 16.0f); const float ang = (float)pos * inv; rope[i] = cosf(ang); rope[1024 + i] = sinf(ang); }
    if (tid < DEPTH) { const int l = tid; float s1 = 0.f, s2 = 0.f;
      for (int i = 0; i < 64; ++i) { s1 += p.lq1[l * 64 + i] * p.lk1[l * 64 + i]; s2 += p.lq2[l * 64 + i] * p.lk2[l * 64 + i]; }
      const float lam_init = 0.8f - 0.6f * expf(-0.3f * (float)l);
      ((float*)(ws + OFF_LAM))[l] = expf(s1) - expf(s2) + lam_init; }
    if (tid >= 64 && tid < 64 + DEPTH) { const int l = tid - 64; float a = 0.f, b2 = 0.f, c2 = 0.f, d2 = 0.f;
      for (int i = 0; i < 64; ++i) { a = fmaxf(a, fabsf(p.dq_g[l * 64 + i])); b2 = fmaxf(b2, fabsf(p.dk_g[l * 64 + i])); c2 = fmaxf(c2, fabsf(p.wq_g[l * 64 + i])); d2 = fmaxf(d2, fabsf(p.wk_g[l * 64 + i])); }
      ((float*)(ws + OFF_LAM))[4 + l] = 8.0f * LOG2E * 1.02f * a * b2;
      ((float*)(ws + OFF_LAM))[8 + l] = 8.0f * LOG2E * 1.02f * c2 * d2;
      for (int i = 0; i < 8; ++i) ((unsigned*)(ws + OFF_LAM))[16 + l * 8 + i] = 0u; }
  }
  float* sc = (float*)smem;
  float* red = sc + 5 * 1024;
  for (int i = tid; i < 5 * 1024; i += 256) { const int bb = i >> 10, k = i & 1023; const float v = bb < 4 ? p.c[bb * 1024 + k] : p.c_ctx[k]; sc[i] = v / (1.0f + __expf(-v)); }
  __syncthreads();
  float* modv = (float*)(ws + OFF_MODV);
  for (int t = get_bid(); t < DEPTH * 96; t += gridDim.x) {
    const int l = t / 96, cb = t % 96, kq = tid >> 6, cl = tid & 63, col = cb * 64 + cl;
    const float* w = p.w_mod + (size_t)l * D * 6144 + col;
    float s[5] = {0.f, 0.f, 0.f, 0.f, 0.f};
    for (int k = kq * 256; k < kq * 256 + 256; ++k) { const float wv = w[(size_t)k * 6144];
#pragma unroll
      for (int bb = 0; bb < 5; ++bb) s[bb] += sc[bb * 1024 + k] * wv; }
#pragma unroll
    for (int bb = 0; bb < 5; ++bb) red[(kq * 5 + bb) * 64 + cl] = s[bb];
    __syncthreads();
    for (int i = tid; i < 5 * 64; i += 256) { const int bb = i >> 6, c2 = i & 63; const float v = red[(0 * 5 + bb) * 64 + c2] + red[(1 * 5 + bb) * 64 + c2] + red[(2 * 5 + bb) * 64 + c2] + red[(3 * 5 + bb) * 64 + c2];
      modv[((size_t)l * 5 + bb) * 6144 + cb * 64 + c2] = v + p.b_mod[l * 6144 + cb * 64 + c2]; }
    __syncthreads();
  }
}

DI void norm_phase(const Params& p, int l, const float* gvec, int sh_off, int sc_off, int nrows) {
  const int tid = get_tid(), lane = tid & 63, wid = tid >> 6;
  const float* h = (const float*)(p.ws + OFF_H); bf16_t* out = (bf16_t*)(p.ws + OFF_ABUF);
  const float* modv = (const float*)(p.ws + OFF_MODV) + (size_t)l * 5 * 6144;
  for (int t = get_bid(); t < nrows / 4; t += gridDim.x) {
    const int row = t * 4 + wid; const int bb = row < NLAT ? row / SEQ : 4;
    const float* hr = h + (size_t)row * D; const float* mv = modv + bb * 6144;
    f32x4 v[4]; float ss = 0.f;
#pragma unroll
    for (int it = 0; it < 4; ++it) { v[it] = *(const f32x4*)(hr + it * 256 + lane * 4); ss += v[it][0] * v[it][0] + v[it][1] * v[it][1] + v[it][2] * v[it][2] + v[it][3] * v[it][3]; }
#pragma unroll
    for (int m = 1; m < 64; m <<= 1) ss += xshfl(ss, m);
    const float rstd = rsqrtf(ss * (1.0f / 1024.0f) + EPS);
#pragma unroll
    for (int it = 0; it < 4; ++it) { const int idx = it * 256 + lane * 4;
      const f32x4 g = *(const f32x4*)(gvec + idx), s1 = *(const f32x4*)(mv + sc_off + idx), s0 = *(const f32x4*)(mv + sh_off + idx);
      float y[4];
#pragma unroll
      for (int j = 0; j < 4; ++j) y[j] = v[it][j] * rstd * g[j] * (1.0f + s1[j]) + s0[j];
      u32x2 o; o[0] = pack2(y[0], y[1]); o[1] = pack2(y[2], y[3]); *(u32x2*)(out + (size_t)row * D + idx) = o; }
  }
}

DI void inproj_epilogue(const Params& p, int l, const f32x4 (&acc)[4][4], int m0, int n0) {
  unsigned char* ws = p.ws;
  const int tid = get_tid(), lane = tid & 63, wid = tid >> 6, wr = wid >> 1, wc = wid & 1, lr = lane & 15, lg = lane >> 4;
  const bool is_lat = m0 < NLAT;
  int b, i0; if (is_lat) { b = m0 / SEQ; i0 = m0 % SEQ; } else { const int c0 = m0 - NLAT; b = c0 / CTX; i0 = c0 % CTX; }
  const int pos0 = is_lat ? CTX + i0 : i0;
  const int hc = n0 + wc * 64;
  int seg;
  if (n0 < 512) seg = 0; else if (n0 < 1024) seg = 1; else if (n0 < 1536) seg = 2; else if (n0 < 2048) seg = 3; else if (n0 < 2560) seg = 4; else if (n0 < 2688) seg = 5; else if (n0 < 2816) seg = 6; else seg = 7;
  if (seg == 0 || seg == 1 || seg == 4 || seg == 5) {
    const float* gv; bf16_t* dst; float qs = 1.0f;
    if (seg == 0) { const int c = hc; gv = p.dq_g + l * 64; dst = (bf16_t*)(ws + OFF_QD) + ((size_t)((b * 2 + c / 256) * 4 + (c % 256) / 64) * POS) * 64; qs = 0.125f * LOG2E; }
    else if (seg == 1) { const int c = hc - 512; gv = p.dk_g + l * 64; dst = (bf16_t*)(ws + OFF_KD) + ((size_t)((b * 2 + c / 256) * 4 + (c % 256) / 64) * POS) * 64; }
    else if (seg == 4) { const int c = hc - 2048; gv = p.wq_g + l * 64; dst = (bf16_t*)(ws + OFF_QW) + ((size_t)(b * 8 + c / 64) * POS) * 64; qs = 0.125f * LOG2E; }
    else { const int c = hc - 2560; gv = p.wk_g + l * 64; dst = (bf16_t*)(ws + OFF_KW) + ((size_t)(b * 2 + c / 64) * POS) * 64; }
    const float* rope = (const float*)(ws + OFF_ROPE);
    f32x4 gq[4];
#pragma unroll
    for (int ni = 0; ni < 4; ++ni) gq[ni] = *(const f32x4*)(gv + ni * 16 + lg * 4);
#pragma unroll
    for (int mi = 0; mi < 4; ++mi) {
      const int r = wr * 64 + mi * 16 + lr;
      float ss = 0.f;
#pragma unroll
      for (int ni = 0; ni < 4; ++ni)
#pragma unroll
        for (int j = 0; j < 4; ++j) ss += acc[mi][ni][j] * acc[mi][ni][j];
      ss += xshfl(ss, 16); ss += xshfl(ss, 32);
      const float rstd = rsqrtf(ss * (1.0f / 64.0f) + EPS);
      f32x4 v[4];
#pragma unroll
      for (int ni = 0; ni < 4; ++ni) v[ni] = acc[mi][ni] * rstd * gq[ni];
      if (is_lat) {
        const int li = i0 + r, gr = li >> 6, gc = li & 63;
#pragma unroll
        for (int ni = 0; ni < 2; ++ni) {
          const int pi = ni == 0 ? gr : gc;
          const f32x4 cs = *(const f32x4*)(rope + pi * 16 + lg * 4), sn = *(const f32x4*)(rope + 1024 + pi * 16 + lg * 4);
          const f32x4 x1 = v[ni], x2 = v[ni + 2];
          v[ni] = x1 * cs - x2 * sn; v[ni + 2] = x2 * cs + x1 * sn;
        }
      }
      bf16_t* drow = dst + (size_t)(pos0 + r) * 64 + lg * 4;
#pragma unroll
      for (int ni = 0; ni < 4; ++ni) { u32x2 o; o[0] = pack2(v[ni][0] * qs, v[ni][1] * qs); o[1] = pack2(v[ni][2] * qs, v[ni][3] * qs); *(u32x2*)(drow + ni * 16) = o; }
    }
  } else if (seg == 2 || seg == 6) {
#pragma unroll
    for (int mi = 0; mi < 4; ++mi) {
      const int pos = pos0 + wr * 64 + mi * 16 + lr;
#pragma unroll
      for (int ni = 0; ni < 4; ++ni)
#pragma unroll
        for (int j = 0; j < 4; ++j) {
          const int col = hc + ni * 16 + lg * 4 + j; bf16_t* dst;
          if (seg == 2) { const int c = col - 1024; dst = (bf16_t*)(ws + OFF_VDT) + ((size_t)(b * 4 + c / 128) * 128 + (c % 128)) * POS + pos; }
          else { const int c = col - 2688; dst = (bf16_t*)(ws + OFF_VWT) + ((size_t)(b * 2 + c / 64) * 64 + (c % 64)) * POS + pos; }
          *dst = (bf16_t)(pack2(acc[mi][ni][j], 0.f) & 0xffffu);
        }
    }
  } else if (seg == 3) {
    bf16_t* su = (bf16_t*)(ws + OFF_SU);
#pragma unroll
    for (int mi = 0; mi < 4; ++mi) { const int pos = pos0 + wr * 64 + mi * 16 + lr;
#pragma unroll
      for (int ni = 0; ni < 4; ++ni) { u32x2 o; o[0] = pack2(acc[mi][ni][0], acc[mi][ni][1]); o[1] = pack2(acc[mi][ni][2], acc[mi][ni][3]);
        *(u32x2*)(su + ((size_t)(b * 32 + (hc - 1536) / 16 + ni) * POS + pos) * 16 + lg * 4) = o; } }
  } else {
    bf16_t* gt = (bf16_t*)(ws + OFF_GATES);
#pragma unroll
    for (int mi = 0; mi < 4; ++mi) { const int row = m0 + wr * 64 + mi * 16 + lr;
#pragma unroll
      for (int ni = 0; ni < 4; ++ni) { u32x2 o; o[0] = pack2(sigmoidf_(acc[mi][ni][0]), sigmoidf_(acc[mi][ni][1])); o[1] = pack2(sigmoidf_(acc[mi][ni][2]), sigmoidf_(acc[mi][ni][3]));
        *(u32x2*)(gt + (size_t)row * 3072 + (hc - 2816) + ni * 16 + lg * 4) = o; } }
  }
}
DI void inproj_phase(const Params& p, int l, unsigned char* smem) {
  bf16_t* As = (bf16_t*)smem; bf16_t* Bs = As + 128 * LDT;
  const bf16_t* A = (const bf16_t*)(p.ws + OFF_ABUF); const bf16_t* W = (const bf16_t*)(p.ws + OFF_W_IN);
  constexpr int NT = DIN / 128, MT = NTOK / 128;
  for (int t = get_bid(); t < MT * NT; t += gridDim.x) {
    const int mt = t / NT, nt = t % NT;
    f32x4 acc[4][4]; zero_acc(acc);
    gemm_mainloop(acc, A + (size_t)mt * 128 * D, D, W + (size_t)nt * 128 * D, D, D, As, Bs);
    inproj_epilogue(p, l, acc, mt * 128, nt * 128);
  }
}

constexpr int NW = 4;
constexpr int NTHR = NW * 64;
constexpr int QU = NW * 32;
template <int DV, bool TWOK>
DI void attn_core(f32x4 (&O)[2][DV / 16], float (&lsum)[2], const bf16x8 (&Qf)[2][2], float negm,
                  const bf16_t* __restrict__ Kp0, const bf16_t* __restrict__ Kp1, const bf16_t* __restrict__ Vt, int t0, int t1, int tm0, int tm1, int qlat0, unsigned char* smem) {
  constexpr int KB = TWOK ? 16384 : 8192, BUFB = KB + DV * 128;
  constexpr int NKL = (TWOK ? 16 : 8) / NW, NVL = DV / 8 / NW;
  const int tid = get_tid(), lane = tid & 63, wid = __builtin_amdgcn_readfirstlane(tid >> 6), lr = lane & 15, lg = lane >> 4;
  const int rl = lane >> 3, lc = (lane & 7) ^ rl;
  const int n0 = t1 - t0, ntl = n0 + (tm1 - tm0);
  u32x4 rk[NKL], rv[NVL];
#define ATTN_GLOAD(KEY0) do { const int key0_ = (KEY0); \
    _Pragma("unroll") for (int i = 0; i < NKL; ++i) { const int L = wid + i * NW; const bf16_t* kp_ = (i * NW >= 8) ? Kp1 : Kp0; rk[i] = *(const u32x4*)(kp_ + (size_t)(key0_ + (L & 7) * 8 + rl) * 64 + lc * 8); } \
    _Pragma("unroll") for (int i = 0; i < NVL; ++i) { const int L = wid + i * NW; rv[i] = *(const u32x4*)(Vt + (size_t)(L * 8 + rl) * POS + key0_ + lc * 8); } } while (0)
#define ATTN_LSTORE(BUF) do { unsigned char* buf_ = (BUF); \
    _Pragma("unroll") for (int i = 0; i < NKL; ++i) *(u32x4*)(buf_ + (wid + i * NW) * 1024 + lane * 16) = rk[i]; \
    _Pragma("unroll") for (int i = 0; i < NVL; ++i) *(u32x4*)(buf_ + KB + (wid + i * NW) * 1024 + lane * 16) = rv[i]; } while (0)
  ATTN_GLOAD((n0 > 0 ? t0 : tm0) * 64);
  __syncthreads();
  ATTN_LSTORE(smem);
  const int sw = lr & 7;
  for (int it = 0; it < ntl; ++it) {
    const bool masked = it >= n0;
    const int key0 = (masked ? tm0 + (it - n0) : t0 + it) * 64;
    const unsigned char* Kb = smem + (it & 1) * BUFB; const unsigned char* Vb = Kb + KB;
    __syncthreads();
    if (it + 1 < ntl) ATTN_GLOAD(((it + 1) >= n0 ? tm0 + (it + 1 - n0) : t0 + it + 1) * 64);
    f32x4 s[4][2];
#pragma unroll
    for (int kt = 0; kt < 4; ++kt) {
      const unsigned char* kr = Kb + (kt * 16 + lr) * 128;
      if (!TWOK) {
        const bf16x8 k0f = *(const bf16x8*)(kr + ((lg ^ sw) << 4)), k1f = *(const bf16x8*)(kr + (((4 + lg) ^ sw) << 4));
#pragma unroll
        for (int qt = 0; qt < 2; ++qt) { f32x4 z = {negm, negm, negm, negm}; z = MFMA16(k0f, Qf[qt][0], z); s[kt][qt] = MFMA16(k1f, Qf[qt][1], z); }
      } else {
#pragma unroll
        for (int qt = 0; qt < 2; ++qt) {
          const bf16x8 k0f = *(const bf16x8*)(kr + qt * 8192 + ((lg ^ sw) << 4)), k1f = *(const bf16x8*)(kr + qt * 8192 + (((4 + lg) ^ sw) << 4));
          f32x4 z = {negm, negm, negm, negm}; z = MFMA16(k0f, Qf[qt][0], z); s[kt][qt] = MFMA16(k1f, Qf[qt][1], z); }
      }
    }
    if (masked) {
#pragma unroll
      for (int kt = 0; kt < 4; ++kt)
#pragma unroll
        for (int qt = 0; qt < 2; ++qt)
#pragma unroll
          for (int j = 0; j < 4; ++j) { const int kl = key0 - CTX + kt * 16 + lg * 4 + j, ql = qlat0 + qt * 16 + lr; const int rel = kl - ql; if (rel > 128 || rel < -128) s[kt][qt][j] = -INFINITY; }
    }
    bf16x8 pf[2][2];
#pragma unroll
    for (int qt = 0; qt < 2; ++qt) {
      float rs = 0.f;
#pragma unroll
      for (int kt = 0; kt < 4; ++kt)
#pragma unroll
        for (int j = 0; j < 4; ++j) { const float e = __builtin_amdgcn_exp2f(s[kt][qt][j]); s[kt][qt][j] = e; rs += e; }
      lsum[qt] += rs;
#pragma unroll
      for (int kk = 0; kk < 2; ++kk) {
        u32x4 w; w[0] = pack2(s[2 * kk][qt][0], s[2 * kk][qt][1]); w[1] = pack2(s[2 * kk][qt][2], s[2 * kk][qt][3]);
        w[2] = pack2(s[2 * kk + 1][qt][0], s[2 * kk + 1][qt][1]); w[3] = pack2(s[2 * kk + 1][qt][2], s[2 * kk + 1][qt][3]);
        pf[qt][kk] = __builtin_bit_cast(bf16x8, w);
      }
    }
#pragma unroll
    for (int et = 0; et < DV / 16; ++et)
#pragma unroll
      for (int kk = 0; kk < 2; ++kk) {
        const unsigned char* vr = Vb + (et * 16 + lr) * 128 + (lg & 1) * 8;
        const int c0 = kk * 4 + (lg >> 1);
        const bf16x4 lo = *(const bf16x4*)(vr + ((c0 ^ sw) << 4)), hi = *(const bf16x4*)(vr + (((c0 + 2) ^ sw) << 4));
        const bf16x8 vf = __builtin_shufflevector(lo, hi, 0, 1, 2, 3, 4, 5, 6, 7);
        O[0][et] = MFMA16(vf, pf[0][kk], O[0][et]);
        O[1][et] = MFMA16(vf, pf[1][kk], O[1][et]);
      }
    if (it + 1 < ntl) ATTN_LSTORE(smem + ((it + 1) & 1) * BUFB);
  }
#undef ATTN_GLOAD
#undef ATTN_LSTORE
}

constexpr int QUD = NW * 16;
DI void diff_unit(const Params& p, int l, int b, int hd, bool is_lat, int qi, unsigned char* smem) {
  unsigned char* ws = p.ws;
  const int tid = get_tid(), lane = tid & 63, wid = __builtin_amdgcn_readfirstlane(tid >> 6), lr = lane & 15, lg = lane >> 4;
  const int qpos0 = (is_lat ? CTX + qi * QUD : qi * QUD) + wid * 16;
  const int ntile = is_lat ? POS / 64 : CTX / 64;
  const float lam = ((const float*)(ws + OFF_LAM))[l];
  const float negm = -((const float*)(ws + OFF_LAM))[4 + l];
  const float lam_init = 0.8f - 0.6f * expf(-0.3f * (float)l);
  const size_t hoff0 = (size_t)((b * 2 + 0) * 4 + hd) * POS * 64, hoff1 = (size_t)((b * 2 + 1) * 4 + hd) * POS * 64;
  const bf16_t* Qd = (const bf16_t*)(ws + OFF_QD); const bf16_t* Kd = (const bf16_t*)(ws + OFF_KD);
  bf16x8 Qf[2][2];
#pragma unroll
  for (int ks = 0; ks < 2; ++ks) { Qf[0][ks] = *(const bf16x8*)(Qd + hoff0 + (size_t)(qpos0 + lr) * 64 + ks * 32 + lg * 8); Qf[1][ks] = *(const bf16x8*)(Qd + hoff1 + (size_t)(qpos0 + lr) * 64 + ks * 32 + lg * 8); }
  float lsum[2] = {0.f, 0.f};
  f32x4 O[2][8];
#pragma unroll
  for (int m = 0; m < 2; ++m)
#pragma unroll
    for (int et = 0; et < 8; ++et) O[m][et] = (f32x4){0.f, 0.f, 0.f, 0.f};
  attn_core<128, true>(O, lsum, Qf, negm, Kd + hoff0, Kd + hoff1, (const bf16_t*)(ws + OFF_VDT) + (size_t)(b * 4 + hd) * 128 * POS, 0, ntile, 0, 0, 0, smem);
  float l0 = lsum[0], l1 = lsum[1];
  l0 += xshfl(l0, 16); l0 += xshfl(l0, 32); l1 += xshfl(l1, 16); l1 += xshfl(l1, 32);
  const float i0 = 1.0f / l0, i1 = lam / l1;
  float ss = 0.f;
#pragma unroll
  for (int et = 0; et < 8; ++et) { O[0][et] = O[0][et] * i0 - O[1][et] * i1;
#pragma unroll
    for (int j = 0; j < 4; ++j) ss += O[0][et][j] * O[0][et][j]; }
  ss += xshfl(ss, 16); ss += xshfl(ss, 32);
  const float rs = rsqrtf(ss * (1.0f / 128.0f) + EPS) * (1.0f - lam_init);
  const float* og = p.dout_g + l * 128; bf16_t* yd = (bf16_t*)(ws + OFF_YD);
  const int qpos = qpos0 + lr;
  const int row = is_lat ? b * SEQ + (qpos - CTX) : NLAT + b * CTX + qpos;
#pragma unroll
  for (int et = 0; et < 8; ++et) { const f32x4 g = *(const f32x4*)(og + et * 16 + lg * 4); const f32x4 y = O[0][et] * rs * g;
    u32x2 o; o[0] = pack2(y[0], y[1]); o[1] = pack2(y[2], y[3]); *(u32x2*)(yd + (size_t)row * 512 + hd * 128 + et * 16 + lg * 4) = o; }
}

DI void win_unit(const Params& p, int l, int b, int qh, bool is_lat, int qi, unsigned char* smem) {
  unsigned char* ws = p.ws;
  const int tid = get_tid(), lane = tid & 63, wid = __builtin_amdgcn_readfirstlane(tid >> 6), lr = lane & 15, lg = lane >> 4;
  const int qpos0 = (is_lat ? CTX + qi * QU : qi * QU) + wid * 32;
  const int kv = qh >> 2;
  const bf16_t* Qp = (const bf16_t*)(ws + OFF_QW) + ((size_t)(b * 8 + qh) * POS + qpos0) * 64;
  bf16x8 Qf[2][2];
#pragma unroll
  for (int qt = 0; qt < 2; ++qt)
#pragma unroll
    for (int ks = 0; ks < 2; ++ks) Qf[qt][ks] = *(const bf16x8*)(Qp + (qt * 16 + lr) * 64 + ks * 32 + lg * 8);
  const float sk = p.w_sink[l * 8 + qh] * LOG2E;
  const float mfix = fmaxf(((const float*)(ws + OFF_LAM))[8 + l], sk);
  const float l0 = lg == 0 ? __builtin_amdgcn_exp2f(sk - mfix) : 0.f;
  float lsum[2] = {l0, l0};
  f32x4 O[2][4];
#pragma unroll
  for (int qt = 0; qt < 2; ++qt)
#pragma unroll
    for (int et = 0; et < 4; ++et) O[qt][et] = (f32x4){0.f, 0.f, 0.f, 0.f};
  int tm0 = 0, tm1 = 0;
  if (is_lat) { const int q0 = qi * QU; tm0 = (q0 + 128) / 64; if (tm0 < 4) tm0 = 4; tm1 = (q0 + QU + 384) / 64; if (tm1 > POS / 64) tm1 = POS / 64; }
  attn_core<64, false>(O, lsum, Qf, -mfix, (const bf16_t*)(ws + OFF_KW) + (size_t)(b * 2 + kv) * POS * 64, nullptr, (const bf16_t*)(ws + OFF_VWT) + (size_t)(b * 2 + kv) * 64 * POS, 0, 4, tm0, tm1, qpos0 - CTX, smem);
  bf16_t* yw = (bf16_t*)(ws + OFF_YW);
#pragma unroll
  for (int qt = 0; qt < 2; ++qt) {
    float ls = lsum[qt]; ls += xshfl(ls, 16); ls += xshfl(ls, 32);
    const float inv = 1.0f / ls;
    const int qpos = qpos0 + qt * 16 + lr;
    const int row = is_lat ? b * SEQ + (qpos - CTX) : NLAT + b * CTX + qpos;
#pragma unroll
    for (int et = 0; et < 4; ++et) { const f32x4 y = O[qt][et] * inv; u32x2 o; o[0] = pack2(y[0], y[1]); o[1] = pack2(y[2], y[3]);
      *(u32x2*)(yw + (size_t)row * 512 + qh * 64 + et * 16 + lg * 4) = o; }
  }
}

constexpr int NR = NW / 2, CR = NCH / NR;
constexpr int BST = 132, SST = 136;
constexpr int S5_WAVE_LDS = 16 * BST * 4 + 16 * SST * 2;
constexpr int EB_PER_UNIT = 2 * (NCH + 8) * 64 * 2;
DI int s5_row(int b, int k, int t) { return k < 8 ? NLAT + b * CTX + k * 32 + t : b * SEQ + (k - 8) * 32 + t; }
DI int s5_cmap(int d, int k) { return d == 0 ? k : (k < 8 ? 7 - k : 143 - k); }
DI void s5_make_bf(const Params& p, int l, int d, int g, float fre, float fim, bf16x8 (&Bf)[8], int lr, int lg) {
#pragma unroll
  for (int q = 0; q < 8; ++q) {
    const int pp = 16 * (q & 3) + lr;
    const float fr = __shfl(fre, pp, 64), fi = __shfl(fim, pp, 64);
    u32x4 w = {0u, 0u, 0u, 0u};
    if (lg < 2) {
      const size_t bo = ((size_t)((l * 2 + d) * 32 + g) * 64 + pp) * 16 + lg * 8;
      const f32x4 br0 = *(const f32x4*)(p.s5_bre + bo), br1 = *(const f32x4*)(p.s5_bre + bo + 4), bi0 = *(const f32x4*)(p.s5_bim + bo), bi1 = *(const f32x4*)(p.s5_bim + bo + 4);
      f32x4 v0, v1;
      if (q < 4) { v0 = fr * br0 - fi * bi0; v1 = fr * br1 - fi * bi1; } else { v0 = fr * bi0 + fi * br0; v1 = fr * bi1 + fi * br1; }
      w[0] = pack2(v0[0], v0[1]); w[1] = pack2(v0[2], v0[3]); w[2] = pack2(v1[0], v1[1]); w[3] = pack2(v1[2], v1[3]);
    }
    Bf[q] = __builtin_bit_cast(bf16x8, w);
  }
}
DI u32x4 s5_load_uf(const bf16_t* sug, int k, int tt, int lr, int lg) { u32x4 uw = {0u, 0u, 0u, 0u}; if (lg < 2) uw = *(const u32x4*)(sug + (size_t)(k * 32 + tt * 16 + lr) * 16 + lg * 8); return uw; }
DI void s5_bu_tile(u32x4 uw, const bf16x8 (&Bf)[8], float* Bsm, int lr, int lg) {
  const bf16x8 uf = __builtin_bit_cast(bf16x8, uw);
#pragma unroll
  for (int q = 0; q < 8; ++q) { f32x4 z = {0.f, 0.f, 0.f, 0.f}; z = MFMA16(Bf[q], uf, z); *(f32x4*)(Bsm + lr * BST + q * 16 + lg * 4) = z; }
}
DI void s5_unit(const Params& p, int l, int b, int g, unsigned char* smem) {
  unsigned char* ws = p.ws;
  const int tid = get_tid(), lane = tid & 63, wid = __builtin_amdgcn_readfirstlane(tid >> 6), lr = lane & 15, lg = lane >> 4;
  float* Bsm = (float*)(smem + wid * S5_WAVE_LDS);
  bf16_t* Ssm = (bf16_t*)(smem + wid * S5_WAVE_LDS + 16 * BST * 4);
  const bf16_t* sug = (const bf16_t*)(ws + OFF_SU) + (size_t)(b * 32 + g) * POS * 16;
  float* Eb = (float*)(ws + OFF_EB) + (size_t)(b * 32 + g) * EB_PER_UNIT;
  float are[2], aim[2], fre[2], fim[2];
#pragma unroll
  for (int d = 0; d < 2; ++d) {
    const int pi = ((l * 2 + d) * 32 + g) * 64 + lane;
    const float lre = p.s5_lre[pi], lim = p.s5_lim[pi], dt = expf(p.s5_ldt[(l * 2 + d) * 32 + g]);
    const float mag = expf(lre * dt), ang = lim * dt;
    are[d] = mag * cosf(ang); aim[d] = mag * sinf(ang);
    const float den = lre * lre + lim * lim, nre = are[d] - 1.0f;
    fre[d] = (nre * lre + aim[d] * lim) / den; fim[d] = (aim[d] * lre - nre * lim) / den;
  }
  bf16x8 Bf[2][8];
  s5_make_bf(p, l, 0, g, fre[0], fim[0], Bf[0], lr, lg);
  s5_make_bf(p, l, 1, g, fre[1], fim[1], Bf[1], lr, lg);
  {
    const int d = wid & 1, r = wid >> 1;
    const float ar = d ? are[1] : are[0], ai = d ? aim[1] : aim[0];
    float sr = 0.f, si = 0.f;
    for (int ci = 0; ci < CR; ++ci) {
      const int c = r * CR + ci, k = s5_cmap(d, c);
      *(f32x2*)(Eb + ((size_t)(d * (NCH + 8) + c) * 64 + lane) * 2) = (f32x2){sr, si};
      const u32x4 ua = s5_load_uf(sug, k, d ? 1 : 0, lr, lg), ub = s5_load_uf(sug, k, d ? 0 : 1, lr, lg);
#pragma unroll
      for (int hh = 0; hh < 2; ++hh) {
        const u32x4 uw = hh ? ub : ua;
        __builtin_amdgcn_wave_barrier();
        if (d) s5_bu_tile(uw, Bf[1], Bsm, lr, lg); else s5_bu_tile(uw, Bf[0], Bsm, lr, lg);
        __builtin_amdgcn_wave_barrier();
#pragma unroll
        for (int st = 0; st < 16; ++st) { const int tl = d ? 15 - st : st; const float br = Bsm[tl * BST + lane], bi = Bsm[tl * BST + 64 + lane];
          const float nr = ar * sr - ai * si + br, ni = ar * si + ai * sr + bi; sr = nr; si = ni; }
      }
    }
    *(f32x2*)(Eb + ((size_t)(d * (NCH + 8) + NCH + r) * 64 + lane) * 2) = (f32x2){sr, si};
  }
  __threadfence(); __syncthreads();
  bf16x8 Cf[2][4];
  float a32r[2], a32i[2], aCRr[2], aCRi[2];
#pragma unroll
  for (int d = 0; d < 2; ++d) {
#pragma unroll
    for (int ks = 0; ks < 4; ++ks) {
      const float* src = (ks < 2 ? p.s5_cre : p.s5_cim) + ((size_t)((l * 2 + d) * 32 + g) * 16 + lr) * 64 + (ks & 1) * 32 + lg * 8;
      const f32x4 v0 = *(const f32x4*)src, v1 = *(const f32x4*)(src + 4); const float sg = ks < 2 ? 1.0f : -1.0f;
      u32x4 w; w[0] = pack2(sg * v0[0], sg * v0[1]); w[1] = pack2(sg * v0[2], sg * v0[3]); w[2] = pack2(sg * v1[0], sg * v1[1]); w[3] = pack2(sg * v1[2], sg * v1[3]);
      Cf[d][ks] = __builtin_bit_cast(bf16x8, w);
    }
    float pr = are[d], pi_ = aim[d];
#pragma unroll
    for (int q = 0; q < 5; ++q) { const float nr = pr * pr - pi_ * pi_, ni = 2.0f * pr * pi_; pr = nr; pi_ = ni; }
    a32r[d] = pr; a32i[d] = pi_;
    float rr = 1.f, ri = 0.f, br_ = pr, bi_ = pi_;
#pragma unroll
    for (int bit = 0; bit < 7; ++bit) { if ((CR >> bit) & 1) { const float nr = rr * br_ - ri * bi_, ni = rr * bi_ + ri * br_; rr = nr; ri = ni; } const float nr = br_ * br_ - bi_ * bi_, ni = 2.0f * br_ * bi_; br_ = nr; bi_ = ni; }
    aCRr[d] = rr; aCRi[d] = ri;
  }
  const f32x4 dsk = *(const f32x4*)(p.s5_d + l * 512 + g * 16 + lg * 4);
  bf16_t* gb = (bf16_t*)(ws + OFF_GB);
  for (int k = wid; k < NCH; k += NW) {
    f32x4 acc[2] = {{0.f, 0.f, 0.f, 0.f}, {0.f, 0.f, 0.f, 0.f}};
    u32x4 uq[2]; uq[0] = s5_load_uf(sug, k, 0, lr, lg); uq[1] = s5_load_uf(sug, k, 1, lr, lg);
    u32x2 us[2]; us[0] = *(const u32x2*)(sug + (size_t)(k * 32 + lr) * 16 + lg * 4); us[1] = *(const u32x2*)(sug + (size_t)(k * 32 + 16 + lr) * 16 + lg * 4);
    float s0[2][2];
#pragma unroll
    for (int d = 0; d < 2; ++d) { const float* e_ = Eb + ((size_t)(d * (NCH + 8) + s5_cmap(d, k)) * 64 + lane) * 2;
      s0[d][0] = __hip_atomic_load(e_, __ATOMIC_RELAXED, __HIP_MEMORY_SCOPE_AGENT); s0[d][1] = __hip_atomic_load(e_ + 1, __ATOMIC_RELAXED, __HIP_MEMORY_SCOPE_AGENT); }
#pragma unroll
    for (int d = 0; d < 2; ++d) {
      const int c = s5_cmap(d, k), r = c / CR, j = c - r * CR;
      const float* Ed = Eb + (size_t)d * (NCH + 8) * 128 + lane * 2;
      float tr = 0.f, ti = 0.f;
#pragma unroll
      for (int r2 = 0; r2 < NR - 1; ++r2) if (r2 < r) {
        const float er = __hip_atomic_load(Ed + (size_t)(NCH + r2) * 128, __ATOMIC_RELAXED, __HIP_MEMORY_SCOPE_AGENT), ei = __hip_atomic_load(Ed + (size_t)(NCH + r2) * 128 + 1, __ATOMIC_RELAXED, __HIP_MEMORY_SCOPE_AGENT);
        const float nr = aCRr[d] * tr - aCRi[d] * ti + er, ni = aCRr[d] * ti + aCRi[d] * tr + ei; tr = nr; ti = ni; }
      float pr = 1.f, pi_ = 0.f, br_ = a32r[d], bi_ = a32i[d];
      for (int bit = 0; bit < 7; ++bit) { if ((j >> bit) & 1) { const float nr = pr * br_ - pi_ * bi_, ni = pr * bi_ + pi_ * br_; pr = nr; pi_ = ni; } const float nr = br_ * br_ - bi_ * bi_, ni = 2.0f * br_ * bi_; br_ = nr; bi_ = ni; }
      float sr = s0[d][0] + (pr * tr - pi_ * ti), si = s0[d][1] + (pr * ti + pi_ * tr);
#pragma unroll
      for (int hh = 0; hh < 2; ++hh) {
        const int tt = d ? 1 - hh : hh;
        __builtin_amdgcn_wave_barrier();
        s5_bu_tile(uq[tt], Bf[d], Bsm, lr, lg);
        __builtin_amdgcn_wave_barrier();
#pragma unroll
        for (int st = 0; st < 16; ++st) { const int tl = d ? 15 - st : st; const float br = Bsm[tl * BST + lane], bi = Bsm[tl * BST + 64 + lane];
          const float nr = are[d] * sr - aim[d] * si + br, ni = are[d] * si + aim[d] * sr + bi; sr = nr; si = ni;
          const unsigned pk = pack2(sr, si);
          Ssm[tl * SST + lane] = (bf16_t)(pk & 0xffffu); Ssm[tl * SST + 64 + lane] = (bf16_t)(pk >> 16); }
        __builtin_amdgcn_wave_barrier();
#pragma unroll
        for (int ks = 0; ks < 4; ++ks) { const bf16x8 sf = *(const bf16x8*)(Ssm + lr * SST + ks * 32 + lg * 8); acc[tt] = MFMA16(Cf[d][ks], sf, acc[tt]); }
      }
    }
#pragma unroll
    for (int tt = 0; tt < 2; ++tt) { const int row = s5_row(b, k, tt * 16 + lr);
      f32x4 u; u[0] = __uint_as_float(us[tt][0] << 16); u[1] = __uint_as_float(us[tt][0] & 0xffff0000u); u[2] = __uint_as_float(us[tt][1] << 16); u[3] = __uint_as_float(us[tt][1] & 0xffff0000u);
      float y[4];
#pragma unroll
      for (int j = 0; j < 4; ++j) y[j] = gelu_tanh(acc[tt][j] + u[j] * dsk[j]);
      u32x2 o; o[0] = pack2(y[0], y[1]); o[1] = pack2(y[2], y[3]); *(u32x2*)(gb + (size_t)row * 512 + g * 16 + lg * 4) = o; }
  }
}

DI void mixer_phase(const Params& p, int l, unsigned char* smem) {
  const bool need_ctx = l < DEPTH - 1;
  volatile int* smw = (volatile int*)(smem + SMEM_BYTES - 16);
  constexpr int QL = SEQ / QU, QC = CTX / QU, QLD = SEQ / QUD, QCD = CTX / QUD;
  const int n_s5 = 16, n_dl = 2 * QLD, n_dc = need_ctx ? 2 * QCD : 0, n_wl = 4 * QL, n_wc = need_ctx ? 4 * QC : 0;
  const int total = n_dl + n_s5 + n_dc + n_wl + n_wc;
  const int x0 = get_bid() & 7;
  for (int dx = 0; dx < 8; ++dx) {
    const int xq = (x0 + dx) & 7;
    unsigned* ctr = (unsigned*)(p.ws + OFF_LAM) + 16 + l * 8 + xq;
    for (;;) {
      __syncthreads();
      if (get_tid() == 0) *smw = (int)atomicAdd(ctr, 1u);
      __syncthreads();
      int u = *smw;
      u = __builtin_amdgcn_readfirstlane(u);
      if (u >= total) break;
      int type, bq, hd, qi; bool is_lat = true;
      if (u < n_s5) { const int idx = xq * 16 + u; type = 1; bq = idx >> 5; hd = idx & 31; qi = 0; }
      else if ((u -= n_s5) < n_dl) { const int gidx = xq + 8 * (u / QLD); type = 0; bq = gidx >> 2; hd = gidx & 3; qi = u % QLD; }
      else if ((u -= n_dl) < n_dc) { const int gidx = xq + 8 * (u / QCD); type = 0; is_lat = false; bq = gidx >> 2; hd = gidx & 3; qi = u % QCD; }
      else if ((u -= n_dc) < n_wl) { type = 2; bq = xq >> 1; hd = (xq & 1) * 4 + (u & 3); qi = u >> 2; }
      else { u -= n_wl; type = 2; is_lat = false; bq = xq >> 1; hd = (xq & 1) * 4 + (u & 3); qi = u >> 2; }
      if (type == 0) diff_unit(p, l, bq, hd, is_lat, qi, smem);
      else if (type == 1) s5_unit(p, l, bq, hd, smem);
      else win_unit(p, l, bq, hd, is_lat, qi, smem);
    }
  }
}

#define EPI_LOOP_BEGIN { const int tid_ = get_tid(), lane_ = tid_ & 63, wid_ = tid_ >> 6, wr_ = wid_ >> 1, wc_ = wid_ & 1, lr_ = lane_ & 15, lg_ = lane_ >> 4; \
  _Pragma("unroll") for (int mi = 0; mi < 4; ++mi) { const int row = m0 + wr_ * 64 + mi * 16 + lr_; \
  _Pragma("unroll") for (int ni = 0; ni < 4; ++ni) { const int col = n0 + wc_ * 64 + ni * 16 + lg_ * 4;
#define EPI_LOOP_END } } }

DI void glu_phase(const Params& p, int MT, unsigned char* smem) {
  bf16_t* As = (bf16_t*)smem; bf16_t* Bs = As + 128 * LDT;
  const bf16_t* G = (const bf16_t*)(p.ws + OFF_GB); const bf16_t* W = (const bf16_t*)(p.ws + OFF_W_GLU); bf16_t* ys = (bf16_t*)(p.ws + OFF_YS);
  constexpr int NT = 4;
  for (int t = get_bid(); t < MT * NT; t += gridDim.x) {
    const int m0 = (t / NT) * 128, n0 = (t % NT) * 128;
    f32x4 acc[4][4]; zero_acc(acc);
    gemm_mainloop(acc, G + (size_t)m0 * 512, 512, W + (size_t)n0 * 512, 512, 512, As, Bs);
    EPI_LOOP_BEGIN
      const u32x2 gr = *(const u32x2*)(G + (size_t)row * 512 + col);
      const float g0 = __uint_as_float(gr[0] << 16), g1 = __uint_as_float(gr[0] & 0xffff0000u), g2 = __uint_as_float(gr[1] << 16), g3 = __uint_as_float(gr[1] & 0xffff0000u);
      u32x2 o; o[0] = pack2(g0 * sigmoidf_(acc[mi][ni][0]), g1 * sigmoidf_(acc[mi][ni][1])); o[1] = pack2(g2 * sigmoidf_(acc[mi][ni][2]), g3 * sigmoidf_(acc[mi][ni][3]));
      *(u32x2*)(ys + (size_t)row * 512 + col) = o;
    EPI_LOOP_END
  }
}
DI void merge_phase(const Params& p, int MT, unsigned char* smem) {
  bf16_t* As = (bf16_t*)smem; bf16_t* Bs = As + 128 * LDT;
  const bf16_t* gt = (const bf16_t*)(p.ws + OFF_GATES); bf16_t* mo = (bf16_t*)(p.ws + OFF_M);
  constexpr int NT = 8;
  for (int t = get_bid(); t < MT * NT; t += gridDim.x) {
    const int m0 = (t / NT) * 128, n0 = (t % NT) * 128;
    f32x4 acc[4][4]; zero_acc(acc);
#pragma unroll 1
    for (int br = 0; br < 3; ++br) {
      const bf16_t* Y = (const bf16_t*)(p.ws + (br == 0 ? OFF_YD : br == 1 ? OFF_YS : OFF_YW));
      const bf16_t* W = (const bf16_t*)(p.ws + (br == 0 ? OFF_W_PD : br == 1 ? OFF_W_PS : OFF_W_PW));
      gemm_mainloop(acc, Y + (size_t)m0 * 512, 512, W + (size_t)n0 * 512, 512, 512, As, Bs);
      if (br < 2) {
        EPI_LOOP_BEGIN
          const f32x4 g0 = ld_bf4(gt + (size_t)row * 3072 + br * 1024 + col), g1 = ld_bf4(gt + (size_t)row * 3072 + (br + 1) * 1024 + col);
#pragma unroll
          for (int j = 0; j < 4; ++j) acc[mi][ni][j] *= fmaxf(g0[j], 1e-30f) / fmaxf(g1[j], 1e-30f);
        EPI_LOOP_END
      } else {
        EPI_LOOP_BEGIN
          const f32x4 g2 = ld_bf4(gt + (size_t)row * 3072 + 2048 + col);
          u32x2 o; o[0] = pack2(acc[mi][ni][0] * fmaxf(g2[0], 1e-30f), acc[mi][ni][1] * fmaxf(g2[1], 1e-30f)); o[1] = pack2(acc[mi][ni][2] * fmaxf(g2[2], 1e-30f), acc[mi][ni][3] * fmaxf(g2[3], 1e-30f));
          *(u32x2*)(mo + (size_t)row * D + col) = o;
        EPI_LOOP_END
      }
    }
  }
}
DI void resid_phase(const Params& p, int l, const bf16_t* A, int K, const bf16_t* W, int gate_off, float* dst, int MT, unsigned char* smem) {
  bf16_t* As = (bf16_t*)smem; bf16_t* Bs = As + 128 * LDT;
  const float* h = (const float*)(p.ws + OFF_H);
  const float* modv = (const float*)(p.ws + OFF_MODV) + (size_t)l * 5 * 6144;
  constexpr int NT = 8;
  for (int t = get_bid(); t < MT * NT; t += gridDim.x) {
    const int m0 = (t / NT) * 128, n0 = (t % NT) * 128;
    f32x4 acc[4][4]; zero_acc(acc);
    gemm_mainloop(acc, A + (size_t)m0 * K, K, W + (size_t)n0 * K, K, K, As, Bs);
    const int bb = m0 < NLAT ? m0 / SEQ : 4;
    EPI_LOOP_BEGIN
      const f32x4 gv = *(const f32x4*)(modv + bb * 6144 + gate_off + col);
      const f32x4 hv = *(const f32x4*)(h + (size_t)row * D + col);
      *(f32x4*)(dst + (size_t)row * D + col) = hv + gv * acc[mi][ni];
    EPI_LOOP_END
  }
}
DI void ff1_phase(const Params& p, int MT, unsigned char* smem) {
  bf16_t* As = (bf16_t*)smem; bf16_t* Bs = As + 128 * LDT;
  const bf16_t* A = (const bf16_t*)(p.ws + OFF_ABUF); const bf16_t* W = (const bf16_t*)(p.ws + OFF_W_FF1); bf16_t* uo = (bf16_t*)(p.ws + OFF_U);
  constexpr int NT = DFF / 128;
  for (int t = get_bid(); t < MT * NT; t += gridDim.x) {
    const int m0 = (t / NT) * 128, n0 = (t % NT) * 128;
    f32x4 acc[4][4]; zero_acc(acc);
    gemm_mainloop(acc, A + (size_t)m0 * D, D, W + (size_t)n0 * D, D, D, As, Bs);
    EPI_LOOP_BEGIN
      float r[4];
#pragma unroll
      for (int j = 0; j < 4; ++j) { const float v = fmaxf(acc[mi][ni][j], 0.f); r[j] = v * v; }
      u32x2 o; o[0] = pack2(r[0], r[1]); o[1] = pack2(r[2], r[3]); *(u32x2*)(uo + (size_t)row * DFF + col) = o;
    EPI_LOOP_END
  }
}

__global__ void __launch_bounds__(256, 2) fwd_megakernel(Params p) {
  __shared__ __attribute__((aligned(16))) unsigned char smem[SMEM_BYTES];
  cg::grid_group grid = cg::this_grid();
  unsigned char* ws = p.ws;
  phase0_misc(p, smem);
  __syncthreads();
  convert_layer(p, 0, smem);
  grid.sync();
  for (int l = 0; l < DEPTH; ++l) {
    const bool need_ctx = l < DEPTH - 1;
    const int MT = need_ctx ? NTOK / 128 : NLAT / 128;
    if (l > 0) convert_layer(p, l, smem);
    norm_phase(p, l, p.norm1_g + l * D, 0, 1024, NTOK);
    grid.sync();
    inproj_phase(p, l, smem);
    grid.sync();
    mixer_phase(p, l, smem);
    grid.sync();
    glu_phase(p, MT, smem);
    grid.sync();
    merge_phase(p, MT, smem);
    grid.sync();
    resid_phase(p, l, (const bf16_t*)(ws + OFF_M), D, (const bf16_t*)(ws + OFF_W_OUT), 2048, (float*)(ws + OFF_H), MT, smem);
    grid.sync();
    norm_phase(p, l, p.norm2_g + l * D, 3072, 4096, MT * 128);
    grid.sync();
    ff1_phase(p, MT, smem);
    grid.sync();
    resid_phase(p, l, (const bf16_t*)(ws + OFF_U), DFF, (const bf16_t*)(ws + OFF_W_FF2), 5120, need_ctx ? (float*)(ws + OFF_H) : p.out, MT, smem);
    if (need_ctx) grid.sync();
  }
}

extern "C" void kernel_launch(void* const* d_in, const int* in_sizes, int n_in, void* d_out, int out_size, void* d_ws, size_t ws_size, hipStream_t stream) {
  static int grid_blocks = 0;
  if (!grid_blocks) {
    int dev = 0, cus = 0, per_cu = 0;
    (void)hipGetDevice(&dev);
    (void)hipDeviceGetAttribute(&cus, hipDeviceAttributeMultiprocessorCount, dev);
    (void)hipOccupancyMaxActiveBlocksPerMultiprocessor(&per_cu, fwd_megakernel, 256, 0);
    if (per_cu > 2) per_cu = 2;
    if (per_cu < 1) per_cu = 1;
    grid_blocks = cus * per_cu;
  }
  if (ws_size < OFF_END) { fprintf(stderr, "workspace too small: %zu < %zu\n", ws_size, (size_t)OFF_END); return; }
  Params p{};
  const float* const* in = (const float* const*)d_in;
  p.x = in[0]; p.c = in[1]; p.ctx = in[2]; p.c_ctx = in[3]; p.w_mod = in[4]; p.b_mod = in[5]; p.norm1_g = in[6]; p.norm2_g = in[7]; p.w_in = in[8];
  p.dq_g = in[9]; p.dk_g = in[10]; p.lq1 = in[11]; p.lk1 = in[12]; p.lq2 = in[13]; p.lk2 = in[14]; p.dout_g = in[15];
  p.s5_lre = in[16]; p.s5_lim = in[17]; p.s5_ldt = in[18]; p.s5_bre = in[19]; p.s5_bim = in[20]; p.s5_cre = in[21]; p.s5_cim = in[22]; p.s5_d = in[23]; p.s5_wglu = in[24];
  p.wq_g = in[25]; p.wk_g = in[26]; p.w_sink = in[27];
  p.w_pd = in[28]; p.w_ps = in[29]; p.w_pw = in[30]; p.w_out = in[31]; p.w_ff1 = in[32]; p.w_ff2 = in[33];
  p.out = (float*)d_out; p.ws = (unsigned char*)d_ws;
  void* args[] = {&p};
  hipError_t e = hipLaunchCooperativeKernel((void*)fwd_megakernel, dim3(grid_blocks), dim3(256), args, 0, stream);
  if (e != hipSuccess) fprintf(stderr, "cooperative launch failed: %s (grid %d)\n", hipGetErrorString(e), grid_blocks);
}
```

```cpp
#include <hip/hip_runtime.h>
#include <hip/hip_cooperative_groups.h>
#include <cstdio>
#include <cstdint>
namespace cg = cooperative_groups;

typedef unsigned short bf16_t;
typedef short bf16x8 __attribute__((ext_vector_type(8)));
typedef short bf16x4 __attribute__((ext_vector_type(4)));
typedef float f32x4 __attribute__((ext_vector_type(4)));
typedef float f32x2 __attribute__((ext_vector_type(2)));
typedef unsigned u32x4 __attribute__((ext_vector_type(4)));
typedef unsigned u32x2 __attribute__((ext_vector_type(2)));
typedef __bf16 bf2_t __attribute__((ext_vector_type(2)));

#define DI __device__ __forceinline__
#define MFMA16(a, b, c) __builtin_amdgcn_mfma_f32_16x16x32_bf16((a), (b), (c), 0, 0, 0)

constexpr int D = 1024, NB = 4, SEQ = 4096, DEPTH = 4, CTX = 256, POS = CTX + SEQ  ;
constexpr int NLAT = NB * SEQ  , NCTX = NB * CTX  , NTOK = NLAT + NCTX  ;
constexpr int DIN = 5888, DFF = 4096;
constexpr float EPS = 1e-6f;
constexpr float LOG2E = 1.4426950408889634f;
constexpr int NCH = POS / 32;

constexpr size_t SZ_W_IN = (size_t)DIN * D * 2, SZ_W_GLU = 512 * 512 * 2, SZ_W_P = 1024 * 512 * 2, SZ_W_OUT = (size_t)D * D * 2, SZ_W_FF = (size_t)D * DFF * 2;
constexpr size_t OFF_W_IN = 0;
constexpr size_t OFF_W_GLU = OFF_W_IN + SZ_W_IN;
constexpr size_t OFF_W_PD = OFF_W_GLU + SZ_W_GLU;
constexpr size_t OFF_W_PS = OFF_W_PD + SZ_W_P;
constexpr size_t OFF_W_PW = OFF_W_PS + SZ_W_P;
constexpr size_t OFF_W_OUT = OFF_W_PW + SZ_W_P;
constexpr size_t OFF_W_FF1 = OFF_W_OUT + SZ_W_OUT;
constexpr size_t OFF_W_FF2 = OFF_W_FF1 + SZ_W_FF;
constexpr size_t OFF_MODV = OFF_W_FF2 + SZ_W_FF;
constexpr size_t OFF_ROPE = OFF_MODV + (size_t)DEPTH * 5 * 6144 * 4;
constexpr size_t OFF_LAM = OFF_ROPE + 8192;
constexpr size_t OFF_H = OFF_LAM + 256;
constexpr size_t OFF_ABUF = OFF_H + (size_t)NTOK * D * 4;
constexpr size_t OFF_R1 = OFF_ABUF + (size_t)NTOK * D * 2;
constexpr size_t SZ_HEADBUF = (size_t)NB * 8 * POS * 64 * 2;
constexpr size_t OFF_QD = OFF_R1;
constexpr size_t OFF_KD = OFF_QD + SZ_HEADBUF;
constexpr size_t OFF_VDT = OFF_KD + SZ_HEADBUF;
constexpr size_t OFF_SU = OFF_VDT + SZ_HEADBUF;
constexpr size_t OFF_QW = OFF_SU + (size_t)NTOK * 512 * 2;
constexpr size_t OFF_KW = OFF_QW + SZ_HEADBUF;
constexpr size_t OFF_VWT = OFF_KW + SZ_HEADBUF / 4;
constexpr size_t OFF_GATES = OFF_VWT + SZ_HEADBUF / 4;
constexpr size_t OFF_YD = OFF_GATES + (size_t)NTOK * 3072 * 2;
constexpr size_t OFF_YS = OFF_YD + (size_t)NTOK * 512 * 2;
constexpr size_t OFF_YW = OFF_YS + (size_t)NTOK * 512 * 2;
constexpr size_t OFF_GB = OFF_YW + (size_t)NTOK * 512 * 2;
constexpr size_t OFF_EB = OFF_GB + (size_t)NTOK * 512 * 2;
constexpr size_t OFF_END = OFF_EB + (size_t)NB * 32 * 2 * (NCH + 8) * 64 * 8;
constexpr size_t OFF_BAR = OFF_END;
constexpr size_t BAR_BYTES = 16384;
constexpr size_t WS_NEED = OFF_BAR + BAR_BYTES;
constexpr size_t OFF_M = OFF_QD;
constexpr size_t OFF_U = OFF_R1;
static_assert((size_t)NTOK * DFF * 2 <= OFF_END - OFF_R1, "u alias");

struct Params {
  const float *x, *c, *ctx, *c_ctx, *w_mod, *b_mod, *norm1_g, *norm2_g, *w_in;
  const float *dq_g, *dk_g, *lq1, *lk1, *lq2, *lk2, *dout_g;
  const float *s5_lre, *s5_lim, *s5_ldt, *s5_bre, *s5_bim, *s5_cre, *s5_cim, *s5_d, *s5_wglu;
  const float *wq_g, *wk_g, *w_sink;
  const float *w_pd, *w_ps, *w_pw, *w_out, *w_ff1, *w_ff2;
  float* out;
  unsigned char* ws;
};

DI int get_tid() { int t = threadIdx.x; asm volatile("" : "+v"(t)); return t; }
DI int get_bid() { int b = blockIdx.x; asm volatile("" : "+s"(b)); return b; }
DI unsigned pack2(float lo, float hi) { f32x2 v = {lo, hi}; bf2_t r = __builtin_convertvector(v, bf2_t); return __builtin_bit_cast(unsigned, r); }
DI float sigmoidf_(float x) { return 1.0f / (1.0f + __expf(-x)); }
DI float gelu_tanh(float x) { const float z = 0.7978845608028654f * (x + 0.044715f * x * x * x); const float e = __expf(2.0f * z); const float t = 1.0f - 2.0f / (e + 1.0f); return 0.5f * x * (1.0f + t); }
DI f32x4 ld_bf4(const bf16_t* p_) { const u32x2 r = *(const u32x2*)p_; f32x4 v; v[0] = __uint_as_float(r[0] << 16); v[1] = __uint_as_float(r[0] & 0xffff0000u); v[2] = __uint_as_float(r[1] << 16); v[3] = __uint_as_float(r[1] & 0xffff0000u); return v; }
DI float xshfl(float v, int m) { return __shfl_xor(v, m, 64); }

constexpr int SMEM_BYTES = 65552;
constexpr int LDT = 72;

DI u32x4 gload_async(const void* ptr) { u32x4 r; asm volatile("global_load_dwordx4 %0, %1, off" : "=v"(r) : "v"(ptr) : "memory"); return r; }
#define VM_WAIT8(N, R, Q) asm volatile("s_waitcnt vmcnt(" #N ")" : "+v"(R[0]), "+v"(R[1]), "+v"(R[2]), "+v"(R[3]), "+v"(Q[0]), "+v"(Q[1]), "+v"(Q[2]), "+v"(Q[3]) :: "memory")
DI void gemm_mainloop(f32x4 (&acc)[4][4], const bf16_t* __restrict__ A, int lda, const bf16_t* __restrict__ B, int ldb, int K, bf16_t* As, bf16_t* Bs) {
  const int tid = get_tid(), lane = tid & 63, wid = tid >> 6, wr = wid >> 1, wc = wid & 1, lr = lane & 15, lg = lane >> 4;
  const int crow = tid >> 3, ckc = (tid & 7) * 8;
  constexpr int TB = 128 * 64;
  const int swc = (((tid & 7) ^ (crow & 7)) * 8);
  u32x4 ra0[4], rb0[4], ra1[4], rb1[4];
  const bf16_t* Ap = A + (size_t)crow * lda + ckc; const bf16_t* Bp = B + (size_t)crow * ldb + ckc;
#define GM_LOAD(RA, RB, KOFF) do { _Pragma("unroll") for (int i = 0; i < 4; ++i) { RA[i] = gload_async(Ap + (size_t)(i * 32) * lda + (KOFF)); RB[i] = gload_async(Bp + (size_t)(i * 32) * ldb + (KOFF)); } } while (0)
#define GM_STORE(RA, RB, BUF) do { _Pragma("unroll") for (int i = 0; i < 4; ++i) { *(u32x4*)(As + (BUF) * 2 * TB + (crow + i * 32) * 64 + swc) = RA[i]; *(u32x4*)(As + (BUF) * 2 * TB + TB + (crow + i * 32) * 64 + swc) = RB[i]; } } while (0)
#define GM_COMPUTE(BUF) do { const bf16_t* as_ = As + (BUF) * 2 * TB; const bf16_t* bs_ = as_ + TB; \
    _Pragma("unroll") for (int ks = 0; ks < 2; ++ks) { bf16x8 af[4], bfr[4]; const int co_ = ((ks * 4 + lg) ^ (lr & 7)) * 8; \
      _Pragma("unroll") for (int mi = 0; mi < 4; ++mi) af[mi] = *(const bf16x8*)(as_ + (wr * 64 + mi * 16 + lr) * 64 + co_); \
      _Pragma("unroll") for (int ni = 0; ni < 4; ++ni) bfr[ni] = *(const bf16x8*)(bs_ + (wc * 64 + ni * 16 + lr) * 64 + co_); \
      _Pragma("unroll") for (int mi = 0; mi < 4; ++mi) _Pragma("unroll") for (int ni = 0; ni < 4; ++ni) acc[mi][ni] = MFMA16(bfr[ni], af[mi], acc[mi][ni]); } } while (0)
  asm volatile("s_waitcnt vmcnt(0)" ::: "memory");
  GM_LOAD(ra0, rb0, 0); GM_LOAD(ra1, rb1, 64);
  __syncthreads();
  VM_WAIT8(8, ra0, rb0); GM_STORE(ra0, rb0, 0); GM_LOAD(ra0, rb0, (128 < K ? 128 : 0));
  __syncthreads();
  for (int k0 = 0; k0 < K; k0 += 128) {
    const int kn1 = k0 + 192 < K ? k0 + 192 : 0, kn0 = k0 + 256 < K ? k0 + 256 : 0;
    VM_WAIT8(8, ra1, rb1); GM_STORE(ra1, rb1, 1); GM_LOAD(ra1, rb1, kn1);
    GM_COMPUTE(0); __syncthreads();
    VM_WAIT8(8, ra0, rb0); GM_STORE(ra0, rb0, 0); GM_LOAD(ra0, rb0, kn0);
    GM_COMPUTE(1); __syncthreads();
  }
  VM_WAIT8(0, ra0, rb0); VM_WAIT8(0, ra1, rb1);
#undef GM_LOAD
#undef GM_STORE
#undef GM_COMPUTE
}
DI void zero_acc(f32x4 (&acc)[4][4]) {
#pragma unroll
  for (int mi = 0; mi < 4; ++mi)
#pragma unroll
    for (int ni = 0; ni < 4; ++ni) acc[mi][ni] = (f32x4){0.f, 0.f, 0.f, 0.f};
}

DI void convert_tile(const float* __restrict__ src, int K, int N, bf16_t* __restrict__ dst, int kt, int nt, float* tile) {
  const int tid = get_tid();
  { const int r = tid >> 4, c4 = (tid & 15) * 4;
#pragma unroll
    for (int i = 0; i < 4; ++i) { const int k = r + i * 16; const f32x4 v = *(const f32x4*)(src + (size_t)(kt * 64 + k) * N + nt * 64 + c4);
      tile[k * 65 + c4 + 0] = v[0]; tile[k * 65 + c4 + 1] = v[1]; tile[k * 65 + c4 + 2] = v[2]; tile[k * 65 + c4 + 3] = v[3]; } }
  __syncthreads();
  { const int n = tid >> 2, kc = (tid & 3) * 16; u32x4 o0, o1;
#pragma unroll
    for (int q = 0; q < 4; ++q) { o0[q] = pack2(tile[(kc + 2 * q) * 65 + n], tile[(kc + 2 * q + 1) * 65 + n]); o1[q] = pack2(tile[(kc + 8 + 2 * q) * 65 + n], tile[(kc + 8 + 2 * q + 1) * 65 + n]); }
    bf16_t* d = dst + (size_t)(nt * 64 + n) * K + kt * 64 + kc; *(u32x4*)d = o0; *(u32x4*)(d + 8) = o1; }
  __syncthreads();
}
DI void convert_layer(const Params& p, int l, unsigned char* smem) {
  float* tile = (float*)smem;
  unsigned char* ws = p.ws;
  for (int t = get_bid(); t < 4224; t += gridDim.x) {
    const float* src; bf16_t* dst; int K, N, idx;
    if (t < 1472) { idx = t; src = p.w_in + (size_t)l * D * DIN; K = D; N = DIN; dst = (bf16_t*)(ws + OFF_W_IN); }
    else if (t < 1536) { idx = t - 1472; src = p.s5_wglu + (size_t)l * 512 * 512; K = 512; N = 512; dst = (bf16_t*)(ws + OFF_W_GLU); }
    else if (t < 1664) { idx = t - 1536; src = p.w_pd + (size_t)l * 512 * D; K = 512; N = D; dst = (bf16_t*)(ws + OFF_W_PD); }
    else if (t < 1792) { idx = t - 1664; src = p.w_ps + (size_t)l * 512 * D; K = 512; N = D; dst = (bf16_t*)(ws + OFF_W_PS); }
    else if (t < 1920) { idx = t - 1792; src = p.w_pw + (size_t)l * 512 * D; K = 512; N = D; dst = (bf16_t*)(ws + OFF_W_PW); }
    else if (t < 2176) { idx = t - 1920; src = p.w_out + (size_t)l * D * D; K = D; N = D; dst = (bf16_t*)(ws + OFF_W_OUT); }
    else if (t < 3200) { idx = t - 2176; src = p.w_ff1 + (size_t)l * D * DFF; K = D; N = DFF; dst = (bf16_t*)(ws + OFF_W_FF1); }
    else { idx = t - 3200; src = p.w_ff2 + (size_t)l * DFF * D; K = DFF; N = D; dst = (bf16_t*)(ws + OFF_W_FF2); }
    const int nts = N / 64; convert_tile(src, K, N, dst, idx / nts, idx % nts, tile);
  }
}

DI void phase0_misc(const Params& p, unsigned char* smem) {
  unsigned char* ws = p.ws;
  const int tid = get_tid();
  { f32x4* h4 = (f32x4*)(ws + OFF_H); const f32x4* x4 = (const f32x4*)p.x; const f32x4* c4 = (const f32x4*)p.ctx;
    const size_t nx = (size_t)NLAT * D / 4, nc = (size_t)NCTX * D / 4;
    for (size_t i = (size_t)get_bid() * 256 + tid; i < nx + nc; i += (size_t)gridDim.x * 256) h4[i] = i < nx ? x4[i] : c4[i - nx]; }
  if (get_bid() == 0) {
    float* rope = (float*)(ws + OFF_ROPE);
    for (int i = tid; i < 1024; i += 256) { const int pos = i >> 4, f = i & 15; const float inv = powf(10000.0f, -(float)f / 16.0f); const float ang = (float)pos * inv; rope[i] = cosf(ang); rope[1024 + i] = sinf(ang); }
    if (tid < DEPTH) { const int l = tid; float s1 = 0.f, s2 = 0.f;
      for (int i = 0; i < 64; ++i) { s1 += p.lq1[l * 64 + i] * p.lk1[l * 64 + i]; s2 += p.lq2[l * 64 + i] * p.lk2[l * 64 + i]; }
      const float lam_init = 0.8f - 0.6f * expf(-0.3f * (float)l);
      ((float*)(ws + OFF_LAM))[l] = expf(s1) - expf(s2) + lam_init; }
    if (tid >= 64 && tid < 64 + DEPTH) { const int l = tid - 64; float a = 0.f, b2 = 0.f, c2 = 0.f, d2 = 0.f;
      for (int i = 0; i < 64; ++i) { a = fmaxf(a, fabsf(p.dq_g[l * 64 + i])); b2 = fmaxf(b2, fabsf(p.dk_g[l * 64 + i])); c2 = fmaxf(c2, fabsf(p.wq_g[l * 64 + i])); d2 = fmaxf(d2, fabsf(p.wk_g[l * 64 + i])); }
      ((float*)(ws + OFF_LAM))[4 + l] = 8.0f * LOG2E * 1.02f * a * b2;
      ((float*)(ws + OFF_LAM))[8 + l] = 8.0f * LOG2E * 1.02f * c2 * d2;
      for (int i = 0; i < 8; ++i) ((unsigned*)(ws + OFF_LAM))[16 + l * 8 + i] = 0u; }
  }
  float* sc = (float*)smem;
  float* red = sc + 5 * 1024;
  for (int i = tid; i < 5 * 1024; i += 256) { const int bb = i >> 10, k = i & 1023; const float v = bb < 4 ? p.c[bb * 1024 + k] : p.c_ctx[k]; sc[i] = v / (1.0f + __expf(-v)); }
  __syncthreads();
  float* modv = (float*)(ws + OFF_MODV);
  for (int t = get_bid(); t < DEPTH * 96; t += gridDim.x) {
    const int l = t / 96, cb = t % 96, kq = tid >> 6, cl = tid & 63, col = cb * 64 + cl;
    const float* w = p.w_mod + (size_t)l * D * 6144 + col;
    float s[5] = {0.f, 0.f, 0.f, 0.f, 0.f};
    for (int k = kq * 256; k < kq * 256 + 256; ++k) { const float wv = w[(size_t)k * 6144];
#pragma unroll
      for (int bb = 0; bb < 5; ++bb) s[bb] += sc[bb * 1024 + k] * wv; }
#pragma unroll
    for (int bb = 0; bb < 5; ++bb) red[(kq * 5 + bb) * 64 + cl] = s[bb];
    __syncthreads();
    for (int i = tid; i < 5 * 64; i += 256) { const int bb = i >> 6, c2 = i & 63; const float v = red[(0 * 5 + bb) * 64 + c2] + red[(1 * 5 + bb) * 64 + c2] + red[(2 * 5 + bb) * 64 + c2] + red[(3 * 5 + bb) * 64 + c2];
      modv[((size_t)l * 5 + bb) * 6144 + cb * 64 + c2] = v + p.b_mod[l * 6144 + cb * 64 + c2]; }
    __syncthreads();
  }
}

DI void norm_phase(const Params& p, int l, const float* gvec, int sh_off, int sc_off, int nrows) {
  const int tid = get_tid(), lane = tid & 63, wid = tid >> 6;
  const float* h = (const float*)(p.ws + OFF_H); bf16_t* out = (bf16_t*)(p.ws + OFF_ABUF);
  const float* modv = (const float*)(p.ws + OFF_MODV) + (size_t)l * 5 * 6144;
  for (int t = get_bid(); t < nrows / 4; t += gridDim.x) {
    const int row = t * 4 + wid; const int bb = row < NLAT ? row / SEQ : 4;
    const float* hr = h + (size_t)row * D; const float* mv = modv + bb * 6144;
    f32x4 v[4]; float ss = 0.f;
#pragma unroll
    for (int it = 0; it < 4; ++it) { v[it] = *(const f32x4*)(hr + it * 256 + lane * 4); ss += v[it][0] * v[it][0] + v[it][1] * v[it][1] + v[it][2] * v[it][2] + v[it][3] * v[it][3]; }
#pragma unroll
    for (int m = 1; m < 64; m <<= 1) ss += xshfl(ss, m);
    const float rstd = rsqrtf(ss * (1.0f / 1024.0f) + EPS);
#pragma unroll
    for (int it = 0; it < 4; ++it) { const int idx = it * 256 + lane * 4;
      const f32x4 g = *(const f32x4*)(gvec + idx), s1 = *(const f32x4*)(mv + sc_off + idx), s0 = *(const f32x4*)(mv + sh_off + idx);
      float y[4];
#pragma unroll
      for (int j = 0; j < 4; ++j) y[j] = v[it][j] * rstd * g[j] * (1.0f + s1[j]) + s0[j];
      u32x2 o; o[0] = pack2(y[0], y[1]); o[1] = pack2(y[2], y[3]); *(u32x2*)(out + (size_t)row * D + idx) = o; }
  }
}

DI void inproj_epilogue(const Params& p, int l, const f32x4 (&acc)[4][4], int m0, int n0) {
  unsigned char* ws = p.ws;
  const int tid = get_tid(), lane = tid & 63, wid = tid >> 6, wr = wid >> 1, wc = wid & 1, lr = lane & 15, lg = lane >> 4;
  const bool is_lat = m0 < NLAT;
  int b, i0; if (is_lat) { b = m0 / SEQ; i0 = m0 % SEQ; } else { const int c0 = m0 - NLAT; b = c0 / CTX; i0 = c0 % CTX; }
  const int pos0 = is_lat ? CTX + i0 : i0;
  const int hc = n0 + wc * 64;
  int seg;
  if (n0 < 512) seg = 0; else if (n0 < 1024) seg = 1; else if (n0 < 1536) seg = 2; else if (n0 < 2048) seg = 3; else if (n0 < 2560) seg = 4; else if (n0 < 2688) seg = 5; else if (n0 < 2816) seg = 6; else seg = 7;
  if (seg == 0 || seg == 1 || seg == 4 || seg == 5) {
    const float* gv; bf16_t* dst; float qs = 1.0f;
    if (seg == 0) { const int c = hc; gv = p.dq_g + l * 64; dst = (bf16_t*)(ws + OFF_QD) + ((size_t)((b * 2 + c / 256) * 4 + (c % 256) / 64) * POS) * 64; qs = 0.125f * LOG2E; }
    else if (seg == 1) { const int c = hc - 512; gv = p.dk_g + l * 64; dst = (bf16_t*)(ws + OFF_KD) + ((size_t)((b * 2 + c / 256) * 4 + (c % 256) / 64) * POS) * 64; }
    else if (seg == 4) { const int c = hc - 2048; gv = p.wq_g + l * 64; dst = (bf16_t*)(ws + OFF_QW) + ((size_t)(b * 8 + c / 64) * POS) * 64; qs = 0.125f * LOG2E; }
    else { const int c = hc - 2560; gv = p.wk_g + l * 64; dst = (bf16_t*)(ws + OFF_KW) + ((size_t)(b * 2 + c / 64) * POS) * 64; }
    const float* rope = (const float*)(ws + OFF_ROPE);
    f32x4 gq[4];
#pragma unroll
    for (int ni = 0; ni < 4; ++ni) gq[ni] = *(const f32x4*)(gv + ni * 16 + lg * 4);
#pragma unroll
    for (int mi = 0; mi < 4; ++mi) {
      const int r = wr * 64 + mi * 16 + lr;
      float ss = 0.f;
#pragma unroll
      for (int ni = 0; ni < 4; ++ni)
#pragma unroll
        for (int j = 0; j < 4; ++j) ss += acc[mi][ni][j] * acc[mi][ni][j];
      ss += xshfl(ss, 16); ss += xshfl(ss, 32);
      const float rstd = rsqrtf(ss * (1.0f / 64.0f) + EPS);
      f32x4 v[4];
#pragma unroll
      for (int ni = 0; ni < 4; ++ni) v[ni] = acc[mi][ni] * rstd * gq[ni];
      if (is_lat) {
        const int li = i0 + r, gr = li >> 6, gc = li & 63;
#pragma unroll
        for (int ni = 0; ni < 2; ++ni) {
          const int pi = ni == 0 ? gr : gc;
          const f32x4 cs = *(const f32x4*)(rope + pi * 16 + lg * 4), sn = *(const f32x4*)(rope + 1024 + pi * 16 + lg * 4);
          const f32x4 x1 = v[ni], x2 = v[ni + 2];
          v[ni] = x1 * cs - x2 * sn; v[ni + 2] = x2 * cs + x1 * sn;
        }
      }
      bf16_t* drow = dst + (size_t)(pos0 + r) * 64 + lg * 4;
#pragma unroll
      for (int ni = 0; ni < 4; ++ni) { u32x2 o; o[0] = pack2(v[ni][0] * qs, v[ni][1] * qs); o[1] = pack2(v[ni][2] * qs, v[ni][3] * qs); *(u32x2*)(drow + ni * 16) = o; }
    }
  } else if (seg == 2 || seg == 6) {
#pragma unroll
    for (int mi = 0; mi < 4; ++mi) {
      const int pos = pos0 + wr * 64 + mi * 16 + lr;
#pragma unroll
      for (int ni = 0; ni < 4; ++ni)
#pragma unroll
        for (int j = 0; j < 4; ++j) {
          const int col = hc + ni * 16 + lg * 4 + j; bf16_t* dst;
          if (seg == 2) { const int c = col - 1024; dst = (bf16_t*)(ws + OFF_VDT) + ((size_t)(b * 4 + c / 128) * 128 + (c % 128)) * POS + pos; }
          else { const int c = col - 2688; dst = (bf16_t*)(ws + OFF_VWT) + ((size_t)(b * 2 + c / 64) * 64 + (c % 64)) * POS + pos; }
          *dst = (bf16_t)(pack2(acc[mi][ni][j], 0.f) & 0xffffu);
        }
    }
  } else if (seg == 3) {
    bf16_t* su = (bf16_t*)(ws + OFF_SU);
#pragma unroll
    for (int mi = 0; mi < 4; ++mi) { const int pos = pos0 + wr * 64 + mi * 16 + lr;
#pragma unroll
      for (int ni = 0; ni < 4; ++ni) { u32x2 o; o[0] = pack2(acc[mi][ni][0], acc[mi][ni][1]); o[1] = pack2(acc[mi][ni][2], acc[mi][ni][3]);
        *(u32x2*)(su + ((size_t)(b * 32 + (hc - 1536) / 16 + ni) * POS + pos) * 16 + lg * 4) = o; } }
  } else {
    bf16_t* gt = (bf16_t*)(ws + OFF_GATES);
#pragma unroll
    for (int mi = 0; mi < 4; ++mi) { const int row = m0 + wr * 64 + mi * 16 + lr;
#pragma unroll
      for (int ni = 0; ni < 4; ++ni) { u32x2 o; o[0] = pack2(sigmoidf_(acc[mi][ni][0]), sigmoidf_(acc[mi][ni][1])); o[1] = pack2(sigmoidf_(acc[mi][ni][2]), sigmoidf_(acc[mi][ni][3]));
        *(u32x2*)(gt + (size_t)row * 3072 + (hc - 2816) + ni * 16 + lg * 4) = o; } }
  }
}
DI void inproj_phase(const Params& p, int l, unsigned char* smem) {
  bf16_t* As = (bf16_t*)smem; bf16_t* Bs = As + 128 * LDT;
  const bf16_t* A = (const bf16_t*)(p.ws + OFF_ABUF); const bf16_t* W = (const bf16_t*)(p.ws + OFF_W_IN);
  constexpr int NT = DIN / 128, MT = NTOK / 128;
  for (int t = get_bid(); t < MT * NT; t += gridDim.x) {
    const int mt = t / NT, nt = t % NT;
    f32x4 acc[4][4]; zero_acc(acc);
    gemm_mainloop(acc, A + (size_t)mt * 128 * D, D, W + (size_t)nt * 128 * D, D, D, As, Bs);
    inproj_epilogue(p, l, acc, mt * 128, nt * 128);
  }
}

constexpr int NW = 4;
constexpr int NTHR = NW * 64;
constexpr int QU = NW * 32;
template <int DV, bool TWOK>
DI void attn_core_d1(f32x4 (&O)[2][DV / 16], float (&lsum)[2], const bf16x8 (&Qf)[2][2], float negm,
                  const bf16_t* __restrict__ Kp0, const bf16_t* __restrict__ Kp1, const bf16_t* __restrict__ Vt, int t0, int t1, int tm0, int tm1, int qlat0, unsigned char* smem) {
  constexpr int KB = TWOK ? 16384 : 8192, BUFB = KB + DV * 128;
  constexpr int NKL = (TWOK ? 16 : 8) / NW, NVL = DV / 8 / NW;
  const int tid = get_tid(), lane = tid & 63, wid = __builtin_amdgcn_readfirstlane(tid >> 6), lr = lane & 15, lg = lane >> 4;
  const int rl = lane >> 3, lc = (lane & 7) ^ rl;
  const int n0 = t1 - t0, ntl = n0 + (tm1 - tm0);
  u32x4 rk[NKL], rv[NVL];
#define ATTN_GLOAD(KEY0) do { const int key0_ = (KEY0); \
    _Pragma("unroll") for (int i = 0; i < NKL; ++i) { const int L = wid + i * NW; const bf16_t* kp_ = (i * NW >= 8) ? Kp1 : Kp0; rk[i] = *(const u32x4*)(kp_ + (size_t)(key0_ + (L & 7) * 8 + rl) * 64 + lc * 8); } \
    _Pragma("unroll") for (int i = 0; i < NVL; ++i) { const int L = wid + i * NW; rv[i] = *(const u32x4*)(Vt + (size_t)(L * 8 + rl) * POS + key0_ + lc * 8); } } while (0)
#define ATTN_LSTORE(BUF) do { unsigned char* buf_ = (BUF); \
    _Pragma("unroll") for (int i = 0; i < NKL; ++i) *(u32x4*)(buf_ + (wid + i * NW) * 1024 + lane * 16) = rk[i]; \
    _Pragma("unroll") for (int i = 0; i < NVL; ++i) *(u32x4*)(buf_ + KB + (wid + i * NW) * 1024 + lane * 16) = rv[i]; } while (0)
  ATTN_GLOAD((n0 > 0 ? t0 : tm0) * 64);
  __syncthreads();
  ATTN_LSTORE(smem);
  const int sw = lr & 7;
  for (int it = 0; it < ntl; ++it) {
    const bool masked = it >= n0;
    const int key0 = (masked ? tm0 + (it - n0) : t0 + it) * 64;
    const unsigned char* Kb = smem + (it & 1) * BUFB; const unsigned char* Vb = Kb + KB;
    __syncthreads();
    if (it + 1 < ntl) ATTN_GLOAD(((it + 1) >= n0 ? tm0 + (it + 1 - n0) : t0 + it + 1) * 64);
    f32x4 s[4][2];
#pragma unroll
    for (int kt = 0; kt < 4; ++kt) {
      const unsigned char* kr = Kb + (kt * 16 + lr) * 128;
      if (!TWOK) {
        const bf16x8 k0f = *(const bf16x8*)(kr + ((lg ^ sw) << 4)), k1f = *(const bf16x8*)(kr + (((4 + lg) ^ sw) << 4));
#pragma unroll
        for (int qt = 0; qt < 2; ++qt) { f32x4 z = {negm, negm, negm, negm}; z = MFMA16(k0f, Qf[qt][0], z); s[kt][qt] = MFMA16(k1f, Qf[qt][1], z); }
      } else {
#pragma unroll
        for (int qt = 0; qt < 2; ++qt) {
          const bf16x8 k0f = *(const bf16x8*)(kr + qt * 8192 + ((lg ^ sw) << 4)), k1f = *(const bf16x8*)(kr + qt * 8192 + (((4 + lg) ^ sw) << 4));
          f32x4 z = {negm, negm, negm, negm}; z = MFMA16(k0f, Qf[qt][0], z); s[kt][qt] = MFMA16(k1f, Qf[qt][1], z); }
      }
    }
    if (masked) {
#pragma unroll
      for (int kt = 0; kt < 4; ++kt)
#pragma unroll
        for (int qt = 0; qt < 2; ++qt)
#pragma unroll
          for (int j = 0; j < 4; ++j) { const int kl = key0 - CTX + kt * 16 + lg * 4 + j, ql = qlat0 + qt * 16 + lr; const int rel = kl - ql; if (rel > 128 || rel < -128) s[kt][qt][j] = -INFINITY; }
    }
    bf16x8 pf[2][2];
#pragma unroll
    for (int qt = 0; qt < 2; ++qt) {
      float rs = 0.f;
#pragma unroll
      for (int kt = 0; kt < 4; ++kt)
#pragma unroll
        for (int j = 0; j < 4; ++j) { const float e = __builtin_amdgcn_exp2f(s[kt][qt][j]); s[kt][qt][j] = e; rs += e; }
      lsum[qt] += rs;
#pragma unroll
      for (int kk = 0; kk < 2; ++kk) {
        u32x4 w; w[0] = pack2(s[2 * kk][qt][0], s[2 * kk][qt][1]); w[1] = pack2(s[2 * kk][qt][2], s[2 * kk][qt][3]);
        w[2] = pack2(s[2 * kk + 1][qt][0], s[2 * kk + 1][qt][1]); w[3] = pack2(s[2 * kk + 1][qt][2], s[2 * kk + 1][qt][3]);
        pf[qt][kk] = __builtin_bit_cast(bf16x8, w);
      }
    }
#pragma unroll
    for (int et = 0; et < DV / 16; ++et)
#pragma unroll
      for (int kk = 0; kk < 2; ++kk) {
        const unsigned char* vr = Vb + (et * 16 + lr) * 128 + (lg & 1) * 8;
        const int c0 = kk * 4 + (lg >> 1);
        const bf16x4 lo = *(const bf16x4*)(vr + ((c0 ^ sw) << 4)), hi = *(const bf16x4*)(vr + (((c0 + 2) ^ sw) << 4));
        const bf16x8 vf = __builtin_shufflevector(lo, hi, 0, 1, 2, 3, 4, 5, 6, 7);
        O[0][et] = MFMA16(vf, pf[0][kk], O[0][et]);
        O[1][et] = MFMA16(vf, pf[1][kk], O[1][et]);
      }
    if (it + 1 < ntl) ATTN_LSTORE(smem + ((it + 1) & 1) * BUFB);
  }
#undef ATTN_GLOAD
#undef ATTN_LSTORE
}

#define VM_WAIT4(N, R, Q) asm volatile("s_waitcnt vmcnt(" #N ")" : "+v"(R[0]), "+v"(R[1]), "+v"(Q[0]), "+v"(Q[1]) :: "memory")
template <int DV, bool TWOK>
DI void attn_core(f32x4 (&O)[2][DV / 16], float (&lsum)[2], const bf16x8 (&Qf)[2][2], float negm,
                  const bf16_t* __restrict__ Kp0, const bf16_t* __restrict__ Kp1, const bf16_t* __restrict__ Vt, int t0, int t1, int tm0, int tm1, int qlat0, unsigned char* smem) {
  constexpr int KB = TWOK ? 16384 : 8192, BUFB = KB + DV * 128;
  constexpr int NKL = (TWOK ? 16 : 8) / NW, NVL = DV / 8 / NW;
  static_assert((NKL == 4 && NVL == 4) || (NKL == 2 && NVL == 2), "wait macros are written for 8 or 4 loads per set");
  const int tid = get_tid(), lane = tid & 63, wid = __builtin_amdgcn_readfirstlane(tid >> 6), lr = lane & 15, lg = lane >> 4;
  const int rl = lane >> 3, lc = (lane & 7) ^ rl;
  const int n0 = t1 - t0, ntl = n0 + (tm1 - tm0);
  u32x4 rk0[NKL], rv0[NVL], rk1[NKL], rv1[NVL];
#define ATTN_TILE(I) ({ int i_ = (I); i_ = i_ < ntl ? i_ : ntl - 1; (i_ < n0 ? t0 + i_ : tm0 + (i_ - n0)) * 64; })
#define ATTN_GLOAD(RK, RV, KEY0) do { const int key0_ = (KEY0); \
    _Pragma("unroll") for (int i = 0; i < NKL; ++i) { const int L = wid + i * NW; const bf16_t* kp_ = (i * NW >= 8) ? Kp1 : Kp0; RK[i] = gload_async(kp_ + (size_t)(key0_ + (L & 7) * 8 + rl) * 64 + lc * 8); } \
    _Pragma("unroll") for (int i = 0; i < NVL; ++i) { const int L = wid + i * NW; RV[i] = gload_async(Vt + (size_t)(L * 8 + rl) * POS + key0_ + lc * 8); } } while (0)
#define ATTN_LSTORE(RK, RV, BUF) do { unsigned char* buf_ = (BUF); \
    _Pragma("unroll") for (int i = 0; i < NKL; ++i) *(u32x4*)(buf_ + (wid + i * NW) * 1024 + lane * 16) = RK[i]; \
    _Pragma("unroll") for (int i = 0; i < NVL; ++i) *(u32x4*)(buf_ + KB + (wid + i * NW) * 1024 + lane * 16) = RV[i]; } while (0)
#define ATTN_WAIT(RK, RV) do { if constexpr (NKL == 4) VM_WAIT8(8, RK, RV); else VM_WAIT4(4, RK, RV); } while (0)
#define ATTN_DRAIN(RK, RV) do { if constexpr (NKL == 4) VM_WAIT8(0, RK, RV); else VM_WAIT4(0, RK, RV); } while (0)
  const int sw = lr & 7;
#define ATTN_COMPUTE(IT, BUFP) do { const int it_ = (IT); const bool masked = it_ >= n0; const int key0 = (masked ? tm0 + (it_ - n0) : t0 + it_) * 64; \
    const unsigned char* Kb = (BUFP); const unsigned char* Vb = Kb + KB; \
    bf16x8 pf[2][2]; \
    _Pragma("unroll") for (int qt = 0; qt < 2; ++qt) { f32x4 s4[4]; \
      _Pragma("unroll") for (int kt = 0; kt < 4; ++kt) { const unsigned char* kq = Kb + (kt * 16 + lr) * 128 + (TWOK ? qt * 8192 : 0); \
        const bf16x8 k0f = *(const bf16x8*)(kq + ((lg ^ sw) << 4)), k1f = *(const bf16x8*)(kq + (((4 + lg) ^ sw) << 4)); \
        f32x4 z = {negm, negm, negm, negm}; z = MFMA16(k0f, Qf[qt][0], z); s4[kt] = MFMA16(k1f, Qf[qt][1], z); } \
      if (masked) { \
        _Pragma("unroll") for (int kt = 0; kt < 4; ++kt) _Pragma("unroll") for (int j = 0; j < 4; ++j) { \
          const int kl = key0 - CTX + kt * 16 + lg * 4 + j, ql = qlat0 + qt * 16 + lr; const int rel = kl - ql; if (rel > 128 || rel < -128) s4[kt][j] = -INFINITY; } } \
      float rs = 0.f; \
      _Pragma("unroll") for (int kt = 0; kt < 4; ++kt) _Pragma("unroll") for (int j = 0; j < 4; ++j) { const float e = __builtin_amdgcn_exp2f(s4[kt][j]); s4[kt][j] = e; rs += e; } \
      lsum[qt] += rs; \
      _Pragma("unroll") for (int kk = 0; kk < 2; ++kk) { u32x4 w; w[0] = pack2(s4[2 * kk][0], s4[2 * kk][1]); w[1] = pack2(s4[2 * kk][2], s4[2 * kk][3]); \
        w[2] = pack2(s4[2 * kk + 1][0], s4[2 * kk + 1][1]); w[3] = pack2(s4[2 * kk + 1][2], s4[2 * kk + 1][3]); pf[qt][kk] = __builtin_bit_cast(bf16x8, w); } } \
    _Pragma("unroll") for (int et = 0; et < DV / 16; ++et) _Pragma("unroll") for (int kk = 0; kk < 2; ++kk) { \
        const unsigned char* vr = Vb + (et * 16 + lr) * 128 + (lg & 1) * 8; const int c0 = kk * 4 + (lg >> 1); \
        const bf16x4 lo = *(const bf16x4*)(vr + ((c0 ^ sw) << 4)), hi = *(const bf16x4*)(vr + (((c0 + 2) ^ sw) << 4)); \
        const bf16x8 vf = __builtin_shufflevector(lo, hi, 0, 1, 2, 3, 4, 5, 6, 7); \
        O[0][et] = MFMA16(vf, pf[0][kk], O[0][et]); O[1][et] = MFMA16(vf, pf[1][kk], O[1][et]); } } while (0)
  asm volatile("s_waitcnt vmcnt(0)" ::: "memory");
  ATTN_GLOAD(rk0, rv0, ATTN_TILE(0)); ATTN_GLOAD(rk1, rv1, ATTN_TILE(1));
  __syncthreads();
  ATTN_WAIT(rk0, rv0); ATTN_LSTORE(rk0, rv0, smem); ATTN_GLOAD(rk0, rv0, ATTN_TILE(2));
  for (int it = 0; it < ntl; it += 2) {
    __syncthreads();
    ATTN_COMPUTE(it, smem);
    ATTN_WAIT(rk1, rv1); ATTN_LSTORE(rk1, rv1, smem + BUFB); ATTN_GLOAD(rk1, rv1, ATTN_TILE(it + 3));
    __syncthreads();
    ATTN_COMPUTE(it + 1, smem + BUFB);
    ATTN_WAIT(rk0, rv0); ATTN_LSTORE(rk0, rv0, smem); ATTN_GLOAD(rk0, rv0, ATTN_TILE(it + 4));
  }
  ATTN_DRAIN(rk0, rv0); ATTN_DRAIN(rk1, rv1);
#undef ATTN_TILE
#undef ATTN_GLOAD
#undef ATTN_LSTORE
#undef ATTN_WAIT
#undef ATTN_DRAIN
#undef ATTN_COMPUTE
}

constexpr int QUD = NW * 16;
DI void diff_unit(const Params& p, int l, int b, int hd, bool is_lat, int qi, unsigned char* smem) {
  unsigned char* ws = p.ws;
  const int tid = get_tid(), lane = tid & 63, wid = __builtin_amdgcn_readfirstlane(tid >> 6), lr = lane & 15, lg = lane >> 4;
  const int qpos0 = (is_lat ? CTX + qi * QUD : qi * QUD) + wid * 16;
  const int ntile = is_lat ? POS / 64 : CTX / 64;
  const float lam = ((const float*)(ws + OFF_LAM))[l];
  const float negm = -((const float*)(ws + OFF_LAM))[4 + l];
  const float lam_init = 0.8f - 0.6f * expf(-0.3f * (float)l);
  const size_t hoff0 = (size_t)((b * 2 + 0) * 4 + hd) * POS * 64, hoff1 = (size_t)((b * 2 + 1) * 4 + hd) * POS * 64;
  const bf16_t* Qd = (const bf16_t*)(ws + OFF_QD); const bf16_t* Kd = (const bf16_t*)(ws + OFF_KD);
  bf16x8 Qf[2][2];
#pragma unroll
  for (int ks = 0; ks < 2; ++ks) { Qf[0][ks] = *(const bf16x8*)(Qd + hoff0 + (size_t)(qpos0 + lr) * 64 + ks * 32 + lg * 8); Qf[1][ks] = *(const bf16x8*)(Qd + hoff1 + (size_t)(qpos0 + lr) * 64 + ks * 32 + lg * 8); }
  float lsum[2] = {0.f, 0.f};
  f32x4 O[2][8];
#pragma unroll
  for (int m = 0; m < 2; ++m)
#pragma unroll
    for (int et = 0; et < 8; ++et) O[m][et] = (f32x4){0.f, 0.f, 0.f, 0.f};
  attn_core_d1<128, true>(O, lsum, Qf, negm, Kd + hoff0, Kd + hoff1, (const bf16_t*)(ws + OFF_VDT) + (size_t)(b * 4 + hd) * 128 * POS, 0, ntile, 0, 0, 0, smem);
  float l0 = lsum[0], l1 = lsum[1];
  l0 += xshfl(l0, 16); l0 += xshfl(l0, 32); l1 += xshfl(l1, 16); l1 += xshfl(l1, 32);
  const float i0 = 1.0f / l0, i1 = lam / l1;
  float ss = 0.f;
#pragma unroll
  for (int et = 0; et < 8; ++et) { O[0][et] = O[0][et] * i0 - O[1][et] * i1;
#pragma unroll
    for (int j = 0; j < 4; ++j) ss += O[0][et][j] * O[0][et][j]; }
  ss += xshfl(ss, 16); ss += xshfl(ss, 32);
  const float rs = rsqrtf(ss * (1.0f / 128.0f) + EPS) * (1.0f - lam_init);
  const float* og = p.dout_g + l * 128; bf16_t* yd = (bf16_t*)(ws + OFF_YD);
  const int qpos = qpos0 + lr;
  const int row = is_lat ? b * SEQ + (qpos - CTX) : NLAT + b * CTX + qpos;
#pragma unroll
  for (int et = 0; et < 8; ++et) { const f32x4 g = *(const f32x4*)(og + et * 16 + lg * 4); const f32x4 y = O[0][et] * rs * g;
    u32x2 o; o[0] = pack2(y[0], y[1]); o[1] = pack2(y[2], y[3]); *(u32x2*)(yd + (size_t)row * 512 + hd * 128 + et * 16 + lg * 4) = o; }
}

DI void win_unit(const Params& p, int l, int b, int qh, bool is_lat, int qi, unsigned char* smem) {
  unsigned char* ws = p.ws;
  const int tid = get_tid(), lane = tid & 63, wid = __builtin_amdgcn_readfirstlane(tid >> 6), lr = lane & 15, lg = lane >> 4;
  const int qpos0 = (is_lat ? CTX + qi * QU : qi * QU) + wid * 32;
  const int kv = qh >> 2;
  const bf16_t* Qp = (const bf16_t*)(ws + OFF_QW) + ((size_t)(b * 8 + qh) * POS + qpos0) * 64;
  bf16x8 Qf[2][2];
#pragma unroll
  for (int qt = 0; qt < 2; ++qt)
#pragma unroll
    for (int ks = 0; ks < 2; ++ks) Qf[qt][ks] = *(const bf16x8*)(Qp + (qt * 16 + lr) * 64 + ks * 32 + lg * 8);
  const float sk = p.w_sink[l * 8 + qh] * LOG2E;
  const float mfix = fmaxf(((const float*)(ws + OFF_LAM))[8 + l], sk);
  const float l0 = lg == 0 ? __builtin_amdgcn_exp2f(sk - mfix) : 0.f;
  float lsum[2] = {l0, l0};
  f32x4 O[2][4];
#pragma unroll
  for (int qt = 0; qt < 2; ++qt)
#pragma unroll
    for (int et = 0; et < 4; ++et) O[qt][et] = (f32x4){0.f, 0.f, 0.f, 0.f};
  int tm0 = 0, tm1 = 0;
  if (is_lat) { const int q0 = qi * QU; tm0 = (q0 + 128) / 64; if (tm0 < 4) tm0 = 4; tm1 = (q0 + QU + 384) / 64; if (tm1 > POS / 64) tm1 = POS / 64; }
  attn_core<64, false>(O, lsum, Qf, -mfix, (const bf16_t*)(ws + OFF_KW) + (size_t)(b * 2 + kv) * POS * 64, nullptr, (const bf16_t*)(ws + OFF_VWT) + (size_t)(b * 2 + kv) * 64 * POS, 0, 4, tm0, tm1, qpos0 - CTX, smem);
  bf16_t* yw = (bf16_t*)(ws + OFF_YW);
#pragma unroll
  for (int qt = 0; qt < 2; ++qt) {
    float ls = lsum[qt]; ls += xshfl(ls, 16); ls += xshfl(ls, 32);
    const float inv = 1.0f / ls;
    const int qpos = qpos0 + qt * 16 + lr;
    const int row = is_lat ? b * SEQ + (qpos - CTX) : NLAT + b * CTX + qpos;
#pragma unroll
    for (int et = 0; et < 4; ++et) { const f32x4 y = O[qt][et] * inv; u32x2 o; o[0] = pack2(y[0], y[1]); o[1] = pack2(y[2], y[3]);
      *(u32x2*)(yw + (size_t)row * 512 + qh * 64 + et * 16 + lg * 4) = o; }
  }
}

constexpr int NR = NW / 2, CR = NCH / NR;
constexpr int BST = 20, SST = 136;
constexpr int S5_WAVE_LDS = 128 * BST * 4 + 16 * SST * 2;
constexpr int EB_PER_UNIT = 2 * (NCH + 8) * 64 * 2;
DI int s5_row(int b, int k, int t) { return k < 8 ? NLAT + b * CTX + k * 32 + t : b * SEQ + (k - 8) * 32 + t; }
DI int s5_cmap(int d, int k) { return d == 0 ? k : (k < 8 ? 7 - k : 143 - k); }
DI void s5_make_bf(const Params& p, int l, int d, int g, float fre, float fim, bf16x8 (&Bf)[8], int lr, int lg) {
#pragma unroll
  for (int q = 0; q < 8; ++q) {
    const int pp = 16 * (q & 3) + lr;
    const float fr = __shfl(fre, pp, 64), fi = __shfl(fim, pp, 64);
    u32x4 w = {0u, 0u, 0u, 0u};
    if (lg < 2) {
      const size_t bo = ((size_t)((l * 2 + d) * 32 + g) * 64 + pp) * 16 + lg * 8;
      const f32x4 br0 = *(const f32x4*)(p.s5_bre + bo), br1 = *(const f32x4*)(p.s5_bre + bo + 4), bi0 = *(const f32x4*)(p.s5_bim + bo), bi1 = *(const f32x4*)(p.s5_bim + bo + 4);
      f32x4 v0, v1;
      if (q < 4) { v0 = fr * br0 - fi * bi0; v1 = fr * br1 - fi * bi1; } else { v0 = fr * bi0 + fi * br0; v1 = fr * bi1 + fi * br1; }
      w[0] = pack2(v0[0], v0[1]); w[1] = pack2(v0[2], v0[3]); w[2] = pack2(v1[0], v1[1]); w[3] = pack2(v1[2], v1[3]);
    }
    Bf[q] = __builtin_bit_cast(bf16x8, w);
  }
}
DI u32x4 s5_load_uf(const bf16_t* sug, int k, int tt, int lr, int lg) { u32x4 uw = {0u, 0u, 0u, 0u}; if (lg < 2) uw = *(const u32x4*)(sug + (size_t)(k * 32 + tt * 16 + lr) * 16 + lg * 8); return uw; }
DI void s5_bu_tile(u32x4 uw, const bf16x8 (&Bf)[8], float* Bsm, int lr, int lg) {
  const bf16x8 uf = __builtin_bit_cast(bf16x8, uw);
#pragma unroll
  for (int q = 0; q < 8; ++q) { f32x4 z = {0.f, 0.f, 0.f, 0.f}; z = MFMA16(Bf[q], uf, z);
#pragma unroll
    for (int jj = 0; jj < 4; ++jj) Bsm[(q * 16 + lg * 4 + jj) * BST + lr] = z[jj]; }
}
#define S5_SCAN(D, AR, AI, WRITE) do { \
    _Pragma("unroll") for (int hb = 0; hb < 2; ++hb) { const int cb = ((D) ? 1 - hb : hb) * 2;     \
      const f32x4 br0_ = *(const f32x4*)(Bsm + lane * BST + cb * 4), br1_ = *(const f32x4*)(Bsm + lane * BST + cb * 4 + 4); \
      const f32x4 bi0_ = *(const f32x4*)(Bsm + (64 + lane) * BST + cb * 4), bi1_ = *(const f32x4*)(Bsm + (64 + lane) * BST + cb * 4 + 4); \
      _Pragma("unroll") for (int st = 0; st < 8; ++st) { const int t8 = (D) ? 7 - st : st; const int tl = cb * 4 + t8; \
        const float br = t8 < 4 ? br0_[t8 & 3] : br1_[t8 & 3], bi = t8 < 4 ? bi0_[t8 & 3] : bi1_[t8 & 3]; \
        const float nr = (AR) * sr - (AI) * si + br, ni = (AR) * si + (AI) * sr + bi; sr = nr; si = ni; \
        if (WRITE) { const unsigned pk = pack2(sr, si); Ssm[tl * SST + lane] = (bf16_t)(pk & 0xffffu); Ssm[tl * SST + 64 + lane] = (bf16_t)(pk >> 16); } } } } while (0)
DI void s5_unit(const Params& p, int l, int b, int g, unsigned char* smem) {
  unsigned char* ws = p.ws;
  const int tid = get_tid(), lane = tid & 63, wid = __builtin_amdgcn_readfirstlane(tid >> 6), lr = lane & 15, lg = lane >> 4;
  float* Bsm = (float*)(smem + wid * S5_WAVE_LDS);
  bf16_t* Ssm = (bf16_t*)(smem + wid * S5_WAVE_LDS + 128 * BST * 4);
  const bf16_t* sug = (const bf16_t*)(ws + OFF_SU) + (size_t)(b * 32 + g) * POS * 16;
  float* Eb = (float*)(ws + OFF_EB) + (size_t)(b * 32 + g) * EB_PER_UNIT;
  float are[2], aim[2], fre[2], fim[2];
#pragma unroll
  for (int d = 0; d < 2; ++d) {
    const int pi = ((l * 2 + d) * 32 + g) * 64 + lane;
    const float lre = p.s5_lre[pi], lim = p.s5_lim[pi], dt = expf(p.s5_ldt[(l * 2 + d) * 32 + g]);
    const float mag = expf(lre * dt), ang = lim * dt;
    are[d] = mag * cosf(ang); aim[d] = mag * sinf(ang);
    const float den = lre * lre + lim * lim, nre = are[d] - 1.0f;
    fre[d] = (nre * lre + aim[d] * lim) / den; fim[d] = (aim[d] * lre - nre * lim) / den;
  }
  bf16x8 Bf[2][8];
  s5_make_bf(p, l, 0, g, fre[0], fim[0], Bf[0], lr, lg);
  s5_make_bf(p, l, 1, g, fre[1], fim[1], Bf[1], lr, lg);
  {
    const int d = wid & 1, r = wid >> 1;
    const float ar = d ? are[1] : are[0], ai = d ? aim[1] : aim[0];
    float sr = 0.f, si = 0.f;
    for (int ci = 0; ci < CR; ++ci) {
      const int c = r * CR + ci, k = s5_cmap(d, c);
      { float* e_ = Eb + ((size_t)(d * (NCH + 8) + c) * 64 + lane) * 2; __hip_atomic_store(e_, sr, __ATOMIC_RELAXED, __HIP_MEMORY_SCOPE_AGENT); __hip_atomic_store(e_ + 1, si, __ATOMIC_RELAXED, __HIP_MEMORY_SCOPE_AGENT); }
      const u32x4 ua = s5_load_uf(sug, k, d ? 1 : 0, lr, lg), ub = s5_load_uf(sug, k, d ? 0 : 1, lr, lg);
#pragma unroll
      for (int hh = 0; hh < 2; ++hh) {
        const u32x4 uw = hh ? ub : ua;
        __builtin_amdgcn_wave_barrier();
        if (d) s5_bu_tile(uw, Bf[1], Bsm, lr, lg); else s5_bu_tile(uw, Bf[0], Bsm, lr, lg);
        __builtin_amdgcn_wave_barrier();
        if (d) S5_SCAN(1, ar, ai, false); else S5_SCAN(0, ar, ai, false);
      }
    }
    { float* e_ = Eb + ((size_t)(d * (NCH + 8) + NCH + r) * 64 + lane) * 2; __hip_atomic_store(e_, sr, __ATOMIC_RELAXED, __HIP_MEMORY_SCOPE_AGENT); __hip_atomic_store(e_ + 1, si, __ATOMIC_RELAXED, __HIP_MEMORY_SCOPE_AGENT); }
  }
  asm volatile("s_waitcnt vmcnt(0)" ::: "memory"); __syncthreads();
  bf16x8 Cf[2][4];
  float a32r[2], a32i[2], aCRr[2], aCRi[2];
#pragma unroll
  for (int d = 0; d < 2; ++d) {
#pragma unroll
    for (int ks = 0; ks < 4; ++ks) {
      const float* src = (ks < 2 ? p.s5_cre : p.s5_cim) + ((size_t)((l * 2 + d) * 32 + g) * 16 + lr) * 64 + (ks & 1) * 32 + lg * 8;
      const f32x4 v0 = *(const f32x4*)src, v1 = *(const f32x4*)(src + 4); const float sg = ks < 2 ? 1.0f : -1.0f;
      u32x4 w; w[0] = pack2(sg * v0[0], sg * v0[1]); w[1] = pack2(sg * v0[2], sg * v0[3]); w[2] = pack2(sg * v1[0], sg * v1[1]); w[3] = pack2(sg * v1[2], sg * v1[3]);
      Cf[d][ks] = __builtin_bit_cast(bf16x8, w);
    }
    float pr = are[d], pi_ = aim[d];
#pragma unroll
    for (int q = 0; q < 5; ++q) { const float nr = pr * pr - pi_ * pi_, ni = 2.0f * pr * pi_; pr = nr; pi_ = ni; }
    a32r[d] = pr; a32i[d] = pi_;
    float rr = 1.f, ri = 0.f, br_ = pr, bi_ = pi_;
#pragma unroll
    for (int bit = 0; bit < 7; ++bit) { if ((CR >> bit) & 1) { const float nr = rr * br_ - ri * bi_, ni = rr * bi_ + ri * br_; rr = nr; ri = ni; } const float nr = br_ * br_ - bi_ * bi_, ni = 2.0f * br_ * bi_; br_ = nr; bi_ = ni; }
    aCRr[d] = rr; aCRi[d] = ri;
  }
  const f32x4 dsk = *(const f32x4*)(p.s5_d + l * 512 + g * 16 + lg * 4);
  bf16_t* gb = (bf16_t*)(ws + OFF_GB);
  for (int k = wid; k < NCH; k += NW) {
    f32x4 acc[2] = {{0.f, 0.f, 0.f, 0.f}, {0.f, 0.f, 0.f, 0.f}};
    u32x4 uq[2]; uq[0] = s5_load_uf(sug, k, 0, lr, lg); uq[1] = s5_load_uf(sug, k, 1, lr, lg);
    u32x2 us[2]; us[0] = *(const u32x2*)(sug + (size_t)(k * 32 + lr) * 16 + lg * 4); us[1] = *(const u32x2*)(sug + (size_t)(k * 32 + 16 + lr) * 16 + lg * 4);
    float s0[2][2];
#pragma unroll
    for (int d = 0; d < 2; ++d) { const float* e_ = Eb + ((size_t)(d * (NCH + 8) + s5_cmap(d, k)) * 64 + lane) * 2;
      s0[d][0] = __hip_atomic_load(e_, __ATOMIC_RELAXED, __HIP_MEMORY_SCOPE_AGENT); s0[d][1] = __hip_atomic_load(e_ + 1, __ATOMIC_RELAXED, __HIP_MEMORY_SCOPE_AGENT); }
#pragma unroll
    for (int d = 0; d < 2; ++d) {
      const int c = s5_cmap(d, k), r = c / CR, j = c - r * CR;
      const float* Ed = Eb + (size_t)d * (NCH + 8) * 128 + lane * 2;
      float tr = 0.f, ti = 0.f;
#pragma unroll
      for (int r2 = 0; r2 < NR - 1; ++r2) if (r2 < r) {
        const float er = __hip_atomic_load(Ed + (size_t)(NCH + r2) * 128, __ATOMIC_RELAXED, __HIP_MEMORY_SCOPE_AGENT), ei = __hip_atomic_load(Ed + (size_t)(NCH + r2) * 128 + 1, __ATOMIC_RELAXED, __HIP_MEMORY_SCOPE_AGENT);
        const float nr = aCRr[d] * tr - aCRi[d] * ti + er, ni = aCRr[d] * ti + aCRi[d] * tr + ei; tr = nr; ti = ni; }
      float pr = 1.f, pi_ = 0.f, br_ = a32r[d], bi_ = a32i[d];
      for (int bit = 0; bit < 7; ++bit) { if ((j >> bit) & 1) { const float nr = pr * br_ - pi_ * bi_, ni = pr * bi_ + pi_ * br_; pr = nr; pi_ = ni; } const float nr = br_ * br_ - bi_ * bi_, ni = 2.0f * br_ * bi_; br_ = nr; bi_ = ni; }
      float sr = s0[d][0] + (pr * tr - pi_ * ti), si = s0[d][1] + (pr * ti + pi_ * tr);
#pragma unroll
      for (int hh = 0; hh < 2; ++hh) {
        const int tt = d ? 1 - hh : hh;
        __builtin_amdgcn_wave_barrier();
        s5_bu_tile(uq[tt], Bf[d], Bsm, lr, lg);
        __builtin_amdgcn_wave_barrier();
        if (d) S5_SCAN(1, are[1], aim[1], true); else S5_SCAN(0, are[0], aim[0], true);
        __builtin_amdgcn_wave_barrier();
#pragma unroll
        for (int ks = 0; ks < 4; ++ks) { const bf16x8 sf = *(const bf16x8*)(Ssm + lr * SST + ks * 32 + lg * 8); acc[tt] = MFMA16(Cf[d][ks], sf, acc[tt]); }
      }
    }
#pragma unroll
    for (int tt = 0; tt < 2; ++tt) { const int row = s5_row(b, k, tt * 16 + lr);
      f32x4 u; u[0] = __uint_as_float(us[tt][0] << 16); u[1] = __uint_as_float(us[tt][0] & 0xffff0000u); u[2] = __uint_as_float(us[tt][1] << 16); u[3] = __uint_as_float(us[tt][1] & 0xffff0000u);
      float y[4];
#pragma unroll
      for (int j = 0; j < 4; ++j) y[j] = gelu_tanh(acc[tt][j] + u[j] * dsk[j]);
      u32x2 o; o[0] = pack2(y[0], y[1]); o[1] = pack2(y[2], y[3]); *(u32x2*)(gb + (size_t)row * 512 + g * 16 + lg * 4) = o; }
  }
}

DI void mixer_phase(const Params& p, int l, unsigned char* smem) {
  const bool need_ctx = l < DEPTH - 1;
  volatile int* smw = (volatile int*)(smem + SMEM_BYTES - 16);
  constexpr int QL = SEQ / QU, QC = CTX / QU, QLD = SEQ / QUD, QCD = CTX / QUD;
  const int n_s5 = 16, n_dl = 2 * QLD, n_dc = need_ctx ? 2 * QCD : 0, n_wl = 4 * QL, n_wc = need_ctx ? 4 * QC : 0;
  const int total = n_dl + n_s5 + n_dc + n_wl + n_wc;
  const int x0 = get_bid() & 7;
  for (int dx = 0; dx < 8; ++dx) {
    const int xq = (x0 + dx) & 7;
    unsigned* ctr = (unsigned*)(p.ws + OFF_LAM) + 16 + l * 8 + xq;
    for (;;) {
      __syncthreads();
      if (get_tid() == 0) *smw = (int)atomicAdd(ctr, 1u);
      __syncthreads();
      int u = *smw;
      u = __builtin_amdgcn_readfirstlane(u);
      if (u >= total) break;
      int type, bq, hd, qi; bool is_lat = true;
      if (u < n_s5) { const int idx = xq * 16 + u; type = 1; bq = idx >> 5; hd = idx & 31; qi = 0; }
      else if ((u -= n_s5) < n_dl) { const int gidx = xq + 8 * (u / QLD); type = 0; bq = gidx >> 2; hd = gidx & 3; qi = u % QLD; }
      else if ((u -= n_dl) < n_dc) { const int gidx = xq + 8 * (u / QCD); type = 0; is_lat = false; bq = gidx >> 2; hd = gidx & 3; qi = u % QCD; }
      else if ((u -= n_dc) < n_wl) { type = 2; bq = xq >> 1; hd = (xq & 1) * 4 + (u & 3); qi = u >> 2; }
      else { u -= n_wl; type = 2; is_lat = false; bq = xq >> 1; hd = (xq & 1) * 4 + (u & 3); qi = u >> 2; }
      if (type == 0) diff_unit(p, l, bq, hd, is_lat, qi, smem);
      else if (type == 1) s5_unit(p, l, bq, hd, smem);
      else win_unit(p, l, bq, hd, is_lat, qi, smem);
    }
  }
}

#define EPI_LOOP_BEGIN { const int tid_ = get_tid(), lane_ = tid_ & 63, wid_ = tid_ >> 6, wr_ = wid_ >> 1, wc_ = wid_ & 1, lr_ = lane_ & 15, lg_ = lane_ >> 4; \
  _Pragma("unroll") for (int mi = 0; mi < 4; ++mi) { const int row = m0 + wr_ * 64 + mi * 16 + lr_; \
  _Pragma("unroll") for (int ni = 0; ni < 4; ++ni) { const int col = n0 + wc_ * 64 + ni * 16 + lg_ * 4;
#define EPI_LOOP_END } } }

DI void glu_phase(const Params& p, int MT, unsigned char* smem) {
  bf16_t* As = (bf16_t*)smem; bf16_t* Bs = As + 128 * LDT;
  const bf16_t* G = (const bf16_t*)(p.ws + OFF_GB); const bf16_t* W = (const bf16_t*)(p.ws + OFF_W_GLU); bf16_t* ys = (bf16_t*)(p.ws + OFF_YS);
  constexpr int NT = 4;
  for (int t = get_bid(); t < MT * NT; t += gridDim.x) {
    const int m0 = (t / NT) * 128, n0 = (t % NT) * 128;
    f32x4 acc[4][4]; zero_acc(acc);
    gemm_mainloop(acc, G + (size_t)m0 * 512, 512, W + (size_t)n0 * 512, 512, 512, As, Bs);
    EPI_LOOP_BEGIN
      const u32x2 gr = *(const u32x2*)(G + (size_t)row * 512 + col);
      const float g0 = __uint_as_float(gr[0] << 16), g1 = __uint_as_float(gr[0] & 0xffff0000u), g2 = __uint_as_float(gr[1] << 16), g3 = __uint_as_float(gr[1] & 0xffff0000u);
      u32x2 o; o[0] = pack2(g0 * sigmoidf_(acc[mi][ni][0]), g1 * sigmoidf_(acc[mi][ni][1])); o[1] = pack2(g2 * sigmoidf_(acc[mi][ni][2]), g3 * sigmoidf_(acc[mi][ni][3]));
      *(u32x2*)(ys + (size_t)row * 512 + col) = o;
    EPI_LOOP_END
  }
}
DI void merge_phase(const Params& p, int MT, unsigned char* smem) {
  bf16_t* As = (bf16_t*)smem; bf16_t* Bs = As + 128 * LDT;
  const bf16_t* gt = (const bf16_t*)(p.ws + OFF_GATES); bf16_t* mo = (bf16_t*)(p.ws + OFF_M);
  constexpr int NT = 8;
  for (int t = get_bid(); t < MT * NT; t += gridDim.x) {
    const int m0 = (t / NT) * 128, n0 = (t % NT) * 128;
    f32x4 acc[4][4]; zero_acc(acc);
#pragma unroll 1
    for (int br = 0; br < 3; ++br) {
      const bf16_t* Y = (const bf16_t*)(p.ws + (br == 0 ? OFF_YD : br == 1 ? OFF_YS : OFF_YW));
      const bf16_t* W = (const bf16_t*)(p.ws + (br == 0 ? OFF_W_PD : br == 1 ? OFF_W_PS : OFF_W_PW));
      gemm_mainloop(acc, Y + (size_t)m0 * 512, 512, W + (size_t)n0 * 512, 512, 512, As, Bs);
      if (br < 2) {
        EPI_LOOP_BEGIN
          const f32x4 g0 = ld_bf4(gt + (size_t)row * 3072 + br * 1024 + col), g1 = ld_bf4(gt + (size_t)row * 3072 + (br + 1) * 1024 + col);
#pragma unroll
          for (int j = 0; j < 4; ++j) acc[mi][ni][j] *= fmaxf(g0[j], 1e-30f) / fmaxf(g1[j], 1e-30f);
        EPI_LOOP_END
      } else {
        EPI_LOOP_BEGIN
          const f32x4 g2 = ld_bf4(gt + (size_t)row * 3072 + 2048 + col);
          u32x2 o; o[0] = pack2(acc[mi][ni][0] * fmaxf(g2[0], 1e-30f), acc[mi][ni][1] * fmaxf(g2[1], 1e-30f)); o[1] = pack2(acc[mi][ni][2] * fmaxf(g2[2], 1e-30f), acc[mi][ni][3] * fmaxf(g2[3], 1e-30f));
          *(u32x2*)(mo + (size_t)row * D + col) = o;
        EPI_LOOP_END
      }
    }
  }
}
DI void resid_phase(const Params& p, int l, const bf16_t* A, int K, const bf16_t* W, int gate_off, float* dst, int MT, unsigned char* smem) {
  bf16_t* As = (bf16_t*)smem; bf16_t* Bs = As + 128 * LDT;
  const float* h = (const float*)(p.ws + OFF_H);
  const float* modv = (const float*)(p.ws + OFF_MODV) + (size_t)l * 5 * 6144;
  constexpr int NT = 8;
  for (int t = get_bid(); t < MT * NT; t += gridDim.x) {
    const int m0 = (t / NT) * 128, n0 = (t % NT) * 128;
    f32x4 acc[4][4]; zero_acc(acc);
    gemm_mainloop(acc, A + (size_t)m0 * K, K, W + (size_t)n0 * K, K, K, As, Bs);
    const int bb = m0 < NLAT ? m0 / SEQ : 4;
    EPI_LOOP_BEGIN
      const f32x4 gv = *(const f32x4*)(modv + bb * 6144 + gate_off + col);
      const f32x4 hv = *(const f32x4*)(h + (size_t)row * D + col);
      *(f32x4*)(dst + (size_t)row * D + col) = hv + gv * acc[mi][ni];
    EPI_LOOP_END
  }
}
DI void ff1_phase(const Params& p, int MT, unsigned char* smem) {
  bf16_t* As = (bf16_t*)smem; bf16_t* Bs = As + 128 * LDT;
  const bf16_t* A = (const bf16_t*)(p.ws + OFF_ABUF); const bf16_t* W = (const bf16_t*)(p.ws + OFF_W_FF1); bf16_t* uo = (bf16_t*)(p.ws + OFF_U);
  constexpr int NT = DFF / 128;
  for (int t = get_bid(); t < MT * NT; t += gridDim.x) {
    const int m0 = (t / NT) * 128, n0 = (t % NT) * 128;
    f32x4 acc[4][4]; zero_acc(acc);
    gemm_mainloop(acc, A + (size_t)m0 * D, D, W + (size_t)n0 * D, D, D, As, Bs);
    EPI_LOOP_BEGIN
      float r[4];
#pragma unroll
      for (int j = 0; j < 4; ++j) { const float v = fmaxf(acc[mi][ni][j], 0.f); r[j] = v * v; }
      u32x2 o; o[0] = pack2(r[0], r[1]); o[1] = pack2(r[2], r[3]); *(u32x2*)(uo + (size_t)row * DFF + col) = o;
    EPI_LOOP_END
  }
}

#define XB_TMO      128
#define XB_XCNT(j)  (256  + 64 * (j))
#define XB_XSUB(j)  (1280 + 64 * (j))
#define XB_XGEN(j)  (2304 + 64 * (j))
#define XB_TOP      3328
#define XB_TOPGEN   3392
#define XCD_BAR_WORDS 3456
#define XB_SPIN_CAP (1u << 18)
#define XLAS __attribute__((address_space(3)))

__device__ __forceinline__ unsigned xb_ld(unsigned* p)              { return __hip_atomic_load(p, __ATOMIC_RELAXED, __HIP_MEMORY_SCOPE_AGENT); }
__device__ __forceinline__ unsigned xb_add(unsigned* p, unsigned v) { return __hip_atomic_fetch_add(p, v, __ATOMIC_RELAXED, __HIP_MEMORY_SCOPE_AGENT); }
__device__ __forceinline__ unsigned xb_xcc_id() { return (unsigned)__builtin_amdgcn_s_getreg((3 << 11) | 20) & 0xFu; }
#define XB_SPIN(cond, bar) do { unsigned _sp = 0; while (cond) { __builtin_amdgcn_s_sleep(1); \
    if ((++_sp & 255u) == 0u) { if (xb_ld(&(bar)[XB_TMO])) break; if (_sp > XB_SPIN_CAP) { atomicAdd(&(bar)[XB_TMO], 1u); break; } } } } while (0)

struct XcdBarrier {
    unsigned* bar; unsigned x;
    volatile XLAS unsigned* st;
};

__device__ __forceinline__ XcdBarrier xcd_barrier_post(unsigned* bar, volatile XLAS unsigned* st) {
    XcdBarrier b; b.bar = bar; b.x = xb_xcc_id(); b.st = st;
    if (threadIdx.x == 0) (void)xb_add(&bar[XB_XCNT(b.x)], 1u);
    return b;
}
__device__ __forceinline__ void xcd_barrier_complete(unsigned* bar, unsigned x, unsigned& nloc, unsigned& nx) {
    const unsigned G = gridDim.x * gridDim.y * gridDim.z;
    unsigned sum, cnt, mine, sp = 0u;
    for (;;) {
        sum = 0u; cnt = 0u; mine = 0u;
#pragma unroll
        for (unsigned j = 0; j < 16; ++j) { const unsigned c = xb_ld(&bar[XB_XCNT(j)]); sum += c; cnt += (c > 0u) ? 1u : 0u; mine = (j == x) ? c : mine; }
        if (sum == G) break;
        __builtin_amdgcn_s_sleep(1);
        if ((++sp & 255u) == 0u) { if (xb_ld(&bar[XB_TMO])) break; if (sp > XB_SPIN_CAP) { atomicAdd(&bar[XB_TMO], 1u); break; } }
    }
    nloc = mine > 0u ? mine : 1u; nx = cnt > 0u ? cnt : 1u;
}

__device__ __forceinline__ void xcd_barrier(const XcdBarrier& b) {
    asm volatile("s_waitcnt vmcnt(0)" ::: "memory");
    __syncthreads();
    if (threadIdx.x == 0) {
        unsigned* bar = b.bar;
        __builtin_amdgcn_s_waitcnt(0);
        unsigned nloc = b.st[0], nx = b.st[1];
        if (nloc == 0u) { xcd_barrier_complete(bar, b.x, nloc, nx); b.st[0] = nloc; b.st[1] = nx; }
        const unsigned old = xb_add(&bar[XB_XSUB(b.x)], 1u);
        const unsigned gen = old / nloc;
        if (old + 1u == (gen + 1u) * nloc) {
            __builtin_amdgcn_fence(__ATOMIC_RELEASE, "agent");
            asm volatile("s_waitcnt vmcnt(0)" ::: "memory");
            const unsigned og = xb_add(&bar[XB_TOP], 1u);
            const unsigned tg = og / nx;
            if (og + 1u == (tg + 1u) * nx) xb_add(&bar[XB_TOPGEN], 1u);
            else XB_SPIN(xb_ld(&bar[XB_TOPGEN]) == tg, bar);
            __builtin_amdgcn_fence(__ATOMIC_ACQUIRE, "agent");
            xb_add(&bar[XB_XGEN(b.x)], 1u);
            asm volatile("s_waitcnt vmcnt(0)" ::: "memory");
        } else {
            XB_SPIN(xb_ld(&bar[XB_XGEN(b.x)]) == gen, bar);
            __builtin_amdgcn_fence(__ATOMIC_ACQUIRE, "agent");
            asm volatile("s_waitcnt vmcnt(0)" ::: "memory");
        }
    }
    __syncthreads();
}


__global__ void __launch_bounds__(256, 2) fwd_megakernel(Params p) {
  __shared__ __attribute__((aligned(16))) unsigned char smem[SMEM_BYTES];
  __shared__ uint4 xb_words;
  cg::grid_group grid = cg::this_grid();
  unsigned char* ws = p.ws;
  if (threadIdx.x == 0) xb_words = make_uint4(0u, 0u, 0u, 0u);
  __syncthreads();
  const XcdBarrier xb = xcd_barrier_post((unsigned*)(ws + OFF_BAR), (volatile XLAS unsigned*)&xb_words);
  phase0_misc(p, smem);
  __syncthreads();
  convert_layer(p, 0, smem);
  grid.sync();
  for (int l = 0; l < DEPTH; ++l) {
    const bool need_ctx = l < DEPTH - 1;
    const int MT = need_ctx ? NTOK / 128 : NLAT / 128;
    if (l > 0) convert_layer(p, l, smem);
    norm_phase(p, l, p.norm1_g + l * D, 0, 1024, NTOK);
    xcd_barrier(xb);
    inproj_phase(p, l, smem);
    xcd_barrier(xb);
    mixer_phase(p, l, smem);
    xcd_barrier(xb);
    glu_phase(p, MT, smem);
    xcd_barrier(xb);
    merge_phase(p, MT, smem);
    xcd_barrier(xb);
    resid_phase(p, l, (const bf16_t*)(ws + OFF_M), D, (const bf16_t*)(ws + OFF_W_OUT), 2048, (float*)(ws + OFF_H), MT, smem);
    xcd_barrier(xb);
    norm_phase(p, l, p.norm2_g + l * D, 3072, 4096, MT * 128);
    xcd_barrier(xb);
    ff1_phase(p, MT, smem);
    xcd_barrier(xb);
    resid_phase(p, l, (const bf16_t*)(ws + OFF_U), DFF, (const bf16_t*)(ws + OFF_W_FF2), 5120, need_ctx ? (float*)(ws + OFF_H) : p.out, MT, smem);
    if (need_ctx) xcd_barrier(xb);
  }
}

extern "C" void kernel_launch(void* const* d_in, const int* in_sizes, int n_in, void* d_out, int out_size, void* d_ws, size_t ws_size, hipStream_t stream) {
  static int grid_blocks = 0;
  if (!grid_blocks) {
    int dev = 0, cus = 0, per_cu = 0;
    (void)hipGetDevice(&dev);
    (void)hipDeviceGetAttribute(&cus, hipDeviceAttributeMultiprocessorCount, dev);
    (void)hipOccupancyMaxActiveBlocksPerMultiprocessor(&per_cu, fwd_megakernel, 256, 0);
    if (per_cu > 2) per_cu = 2;
    if (per_cu < 1) per_cu = 1;
    grid_blocks = cus * per_cu;
  }
  if (ws_size < WS_NEED) { fprintf(stderr, "workspace too small: %zu < %zu\n", ws_size, (size_t)WS_NEED); return; }
  (void)hipMemsetAsync((unsigned char*)d_ws + OFF_BAR, 0, BAR_BYTES, stream);
  Params p{};
  const float* const* in = (const float* const*)d_in;
  p.x = in[0]; p.c = in[1]; p.ctx = in[2]; p.c_ctx = in[3]; p.w_mod = in[4]; p.b_mod = in[5]; p.norm1_g = in[6]; p.norm2_g = in[7]; p.w_in = in[8];
  p.dq_g = in[9]; p.dk_g = in[10]; p.lq1 = in[11]; p.lk1 = in[12]; p.lq2 = in[13]; p.lk2 = in[14]; p.dout_g = in[15];
  p.s5_lre = in[16]; p.s5_lim = in[17]; p.s5_ldt = in[18]; p.s5_bre = in[19]; p.s5_bim = in[20]; p.s5_cre = in[21]; p.s5_cim = in[22]; p.s5_d = in[23]; p.s5_wglu = in[24];
  p.wq_g = in[25]; p.wk_g = in[26]; p.w_sink = in[27];
  p.w_pd = in[28]; p.w_ps = in[29]; p.w_pw = in[30]; p.w_out = in[31]; p.w_ff1 = in[32]; p.w_ff2 = in[33];
  p.out = (float*)d_out; p.ws = (unsigned char*)d_ws;
  void* args[] = {&p};
  hipError_t e = hipLaunchCooperativeKernel((void*)fwd_megakernel, dim3(grid_blocks), dim3(256), args, 0, stream);
  if (e != hipSuccess) fprintf(stderr, "cooperative launch failed: %s (grid %d)\n", hipGetErrorString(e), grid_blocks);
}
```

```cpp
#include <hip/hip_runtime.h>
#include <hip/hip_cooperative_groups.h>
#include <cstdio>
#include <cstdint>
namespace cg = cooperative_groups;

typedef unsigned short bf16_t;
typedef short bf16x8 __attribute__((ext_vector_type(8)));
typedef short bf16x4 __attribute__((ext_vector_type(4)));
typedef float f32x4 __attribute__((ext_vector_type(4)));
typedef float f32x2 __attribute__((ext_vector_type(2)));
typedef unsigned u32x4 __attribute__((ext_vector_type(4)));
typedef unsigned u32x2 __attribute__((ext_vector_type(2)));
typedef __bf16 bf2_t __attribute__((ext_vector_type(2)));

#define DI __device__ __forceinline__
#define MFMA16(a, b, c) __builtin_amdgcn_mfma_f32_16x16x32_bf16((a), (b), (c), 0, 0, 0)

constexpr int D = 1024, NB = 4, SEQ = 4096, DEPTH = 4, CTX = 256, POS = CTX + SEQ  ;
constexpr int NLAT = NB * SEQ  , NCTX = NB * CTX  , NTOK = NLAT + NCTX  ;
constexpr int DIN = 5888, DFF = 4096;
constexpr float EPS = 1e-6f;
constexpr float LOG2E = 1.4426950408889634f;
constexpr int NCH = POS / 32;

constexpr size_t SZ_W_IN = (size_t)DIN * D * 2, SZ_W_GLU = 512 * 512 * 2, SZ_W_P = 1024 * 512 * 2, SZ_W_OUT = (size_t)D * D * 2, SZ_W_FF = (size_t)D * DFF * 2;
constexpr size_t OFF_W_IN = 0;
constexpr size_t OFF_W_GLU = OFF_W_IN + SZ_W_IN;
constexpr size_t OFF_W_PD = OFF_W_GLU + SZ_W_GLU;
constexpr size_t OFF_W_PS = OFF_W_PD + SZ_W_P;
constexpr size_t OFF_W_PW = OFF_W_PS + SZ_W_P;
constexpr size_t OFF_W_OUT = OFF_W_PW + SZ_W_P;
constexpr size_t OFF_W_FF1 = OFF_W_OUT + SZ_W_OUT;
constexpr size_t OFF_W_FF2 = OFF_W_FF1 + SZ_W_FF;
constexpr size_t OFF_MODV = OFF_W_FF2 + SZ_W_FF;
constexpr size_t OFF_ROPE = OFF_MODV + (size_t)DEPTH * 5 * 6144 * 4;
constexpr size_t OFF_LAM = OFF_ROPE + 8192;
constexpr size_t OFF_H = OFF_LAM + 256;
constexpr size_t OFF_ABUF = OFF_H + (size_t)NTOK * D * 4;
constexpr size_t OFF_R1 = OFF_ABUF + (size_t)NTOK * D * 2;
constexpr size_t SZ_HEADBUF = (size_t)NB * 8 * POS * 64 * 2;
constexpr size_t OFF_QD = OFF_R1;
constexpr size_t OFF_KD = OFF_QD + SZ_HEADBUF;
constexpr size_t OFF_VDT = OFF_KD + SZ_HEADBUF;
constexpr size_t OFF_SU = OFF_VDT + SZ_HEADBUF;
constexpr size_t OFF_QW = OFF_SU + (size_t)NTOK * 512 * 2;
constexpr size_t OFF_KW = OFF_QW + SZ_HEADBUF;
constexpr size_t OFF_VWT = OFF_KW + SZ_HEADBUF / 4;
constexpr size_t OFF_GATES = OFF_VWT + SZ_HEADBUF / 4;
constexpr size_t OFF_YD = OFF_GATES + (size_t)NTOK * 3072 * 2;
constexpr size_t OFF_YS = OFF_YD + (size_t)NTOK * 512 * 2;
constexpr size_t OFF_YW = OFF_YS + (size_t)NTOK * 512 * 2;
constexpr size_t OFF_GB = OFF_YW + (size_t)NTOK * 512 * 2;
constexpr size_t OFF_EB = OFF_GB + (size_t)NTOK * 512 * 2;
constexpr size_t OFF_END = OFF_EB + (size_t)NB * 32 * 2 * (NCH + 8) * 64 * 8;
constexpr size_t OFF_BAR = OFF_END;
constexpr size_t BAR_BYTES = 16384;
constexpr size_t WS_NEED = OFF_BAR + BAR_BYTES;
constexpr size_t OFF_M = OFF_QD;
constexpr size_t OFF_U = OFF_R1;
static_assert((size_t)NTOK * DFF * 2 <= OFF_END - OFF_R1, "u alias");

struct Params {
  const float *x, *c, *ctx, *c_ctx, *w_mod, *b_mod, *norm1_g, *norm2_g, *w_in;
  const float *dq_g, *dk_g, *lq1, *lk1, *lq2, *lk2, *dout_g;
  const float *s5_lre, *s5_lim, *s5_ldt, *s5_bre, *s5_bim, *s5_cre, *s5_cim, *s5_d, *s5_wglu;
  const float *wq_g, *wk_g, *w_sink;
  const float *w_pd, *w_ps, *w_pw, *w_out, *w_ff1, *w_ff2;
  float* out;
  unsigned char* ws;
};

DI int get_tid() { int t = threadIdx.x; asm volatile("" : "+v"(t)); return t; }
DI int get_bid() { int b = blockIdx.x; asm volatile("" : "+s"(b)); return b; }
DI unsigned pack2(float lo, float hi) { f32x2 v = {lo, hi}; bf2_t r = __builtin_convertvector(v, bf2_t); return __builtin_bit_cast(unsigned, r); }
DI float sigmoidf_(float x) { return 1.0f / (1.0f + __expf(-x)); }
DI float gelu_tanh(float x) { const float z = 0.7978845608028654f * (x + 0.044715f * x * x * x); const float e = __expf(2.0f * z); const float t = 1.0f - 2.0f / (e + 1.0f); return 0.5f * x * (1.0f + t); }
DI f32x4 ld_bf4(const bf16_t* p_) { const u32x2 r = *(const u32x2*)p_; f32x4 v; v[0] = __uint_as_float(r[0] << 16); v[1] = __uint_as_float(r[0] & 0xffff0000u); v[2] = __uint_as_float(r[1] << 16); v[3] = __uint_as_float(r[1] & 0xffff0000u); return v; }
DI float xshfl(float v, int m) { return __shfl_xor(v, m, 64); }

constexpr int SMEM_BYTES = 65552;
constexpr int LDT = 72;

DI u32x4 gload_async(const void* ptr) { u32x4 r; asm volatile("global_load_dwordx4 %0, %1, off" : "=v"(r) : "v"(ptr) : "memory"); return r; }
#define VM_WAIT8(N, R, Q) asm volatile("s_waitcnt vmcnt(" #N ")" : "+v"(R[0]), "+v"(R[1]), "+v"(R[2]), "+v"(R[3]), "+v"(Q[0]), "+v"(Q[1]), "+v"(Q[2]), "+v"(Q[3]) :: "memory")
DI void gemm_mainloop(f32x4 (&acc)[4][4], const bf16_t* __restrict__ A, int lda, const bf16_t* __restrict__ B, int ldb, int K, bf16_t* As, bf16_t* Bs) {
  const int tid = get_tid(), lane = tid & 63, wid = tid >> 6, wr = wid >> 1, wc = wid & 1, lr = lane & 15, lg = lane >> 4;
  const int crow = tid >> 3, ckc = (tid & 7) * 8;
  constexpr int TB = 128 * 64;
  const int swc = (((tid & 7) ^ (crow & 7)) * 8);
  u32x4 ra0[4], rb0[4], ra1[4], rb1[4];
  const bf16_t* Ap = A + (size_t)crow * lda + ckc; const bf16_t* Bp = B + (size_t)crow * ldb + ckc;
#define GM_LOAD(RA, RB, KOFF) do { _Pragma("unroll") for (int i = 0; i < 4; ++i) { RA[i] = gload_async(Ap + (size_t)(i * 32) * lda + (KOFF)); RB[i] = gload_async(Bp + (size_t)(i * 32) * ldb + (KOFF)); } } while (0)
#define GM_STORE(RA, RB, BUF) do { _Pragma("unroll") for (int i = 0; i < 4; ++i) { *(u32x4*)(As + (BUF) * 2 * TB + (crow + i * 32) * 64 + swc) = RA[i]; *(u32x4*)(As + (BUF) * 2 * TB + TB + (crow + i * 32) * 64 + swc) = RB[i]; } } while (0)
#define GM_COMPUTE(BUF) do { const bf16_t* as_ = As + (BUF) * 2 * TB; const bf16_t* bs_ = as_ + TB; \
    _Pragma("unroll") for (int ks = 0; ks < 2; ++ks) { bf16x8 af[4], bfr[4]; const int co_ = ((ks * 4 + lg) ^ (lr & 7)) * 8; \
      _Pragma("unroll") for (int mi = 0; mi < 4; ++mi) af[mi] = *(const bf16x8*)(as_ + (wr * 64 + mi * 16 + lr) * 64 + co_); \
      _Pragma("unroll") for (int ni = 0; ni < 4; ++ni) bfr[ni] = *(const bf16x8*)(bs_ + (wc * 64 + ni * 16 + lr) * 64 + co_); \
      _Pragma("unroll") for (int mi = 0; mi < 4; ++mi) _Pragma("unroll") for (int ni = 0; ni < 4; ++ni) acc[mi][ni] = MFMA16(bfr[ni], af[mi], acc[mi][ni]); } } while (0)
  asm volatile("s_waitcnt vmcnt(0)" ::: "memory");
  GM_LOAD(ra0, rb0, 0); GM_LOAD(ra1, rb1, 64);
  __syncthreads();
  VM_WAIT8(8, ra0, rb0); GM_STORE(ra0, rb0, 0); GM_LOAD(ra0, rb0, (128 < K ? 128 : 0));
  __syncthreads();
  for (int k0 = 0; k0 < K; k0 += 128) {
    const int kn1 = k0 + 192 < K ? k0 + 192 : 0, kn0 = k0 + 256 < K ? k0 + 256 : 0;
    VM_WAIT8(8, ra1, rb1); GM_STORE(ra1, rb1, 1); GM_LOAD(ra1, rb1, kn1);
    GM_COMPUTE(0); __syncthreads();
    VM_WAIT8(8, ra0, rb0); GM_STORE(ra0, rb0, 0); GM_LOAD(ra0, rb0, kn0);
    GM_COMPUTE(1); __syncthreads();
  }
  VM_WAIT8(0, ra0, rb0); VM_WAIT8(0, ra1, rb1);
#undef GM_LOAD
#undef GM_STORE
#undef GM_COMPUTE
}
DI void zero_acc(f32x4 (&acc)[4][4]) {
#pragma unroll
  for (int mi = 0; mi < 4; ++mi)
#pragma unroll
    for (int ni = 0; ni < 4; ++ni) acc[mi][ni] = (f32x4){0.f, 0.f, 0.f, 0.f};
}

DI void convert_tile(const float* __restrict__ src, int K, int N, bf16_t* __restrict__ dst, int kt, int nt, float* tile) {
  const int tid = get_tid();
  { const int r = tid >> 4, c4 = (tid & 15) * 4;
#pragma unroll
    for (int i = 0; i < 4; ++i) { const int k = r + i * 16; const f32x4 v = *(const f32x4*)(src + (size_t)(kt * 64 + k) * N + nt * 64 + c4);
      tile[k * 65 + c4 + 0] = v[0]; tile[k * 65 + c4 + 1] = v[1]; tile[k * 65 + c4 + 2] = v[2]; tile[k * 65 + c4 + 3] = v[3]; } }
  __syncthreads();
  { const int n = tid >> 2, kc = (tid & 3) * 16; u32x4 o0, o1;
#pragma unroll
    for (int q = 0; q < 4; ++q) { o0[q] = pack2(tile[(kc + 2 * q) * 65 + n], tile[(kc + 2 * q + 1) * 65 + n]); o1[q] = pack2(tile[(kc + 8 + 2 * q) * 65 + n], tile[(kc + 8 + 2 * q + 1) * 65 + n]); }
    bf16_t* d = dst + (size_t)(nt * 64 + n) * K + kt * 64 + kc; *(u32x4*)d = o0; *(u32x4*)(d + 8) = o1; }
  __syncthreads();
}
DI void convert_layer(const Params& p, int l, unsigned char* smem) {
  float* tile = (float*)smem;
  unsigned char* ws = p.ws;
  for (int t = get_bid(); t < 4224; t += gridDim.x) {
    const float* src; bf16_t* dst; int K, N, idx;
    if (t < 1472) { idx = t; src = p.w_in + (size_t)l * D * DIN; K = D; N = DIN; dst = (bf16_t*)(ws + OFF_W_IN); }
    else if (t < 1536) { idx = t - 1472; src = p.s5_wglu + (size_t)l * 512 * 512; K = 512; N = 512; dst = (bf16_t*)(ws + OFF_W_GLU); }
    else if (t < 1664) { idx = t - 1536; src = p.w_pd + (size_t)l * 512 * D; K = 512; N = D; dst = (bf16_t*)(ws + OFF_W_PD); }
    else if (t < 1792) { idx = t - 1664; src = p.w_ps + (size_t)l * 512 * D; K = 512; N = D; dst = (bf16_t*)(ws + OFF_W_PS); }
    else if (t < 1920) { idx = t - 1792; src = p.w_pw + (size_t)l * 512 * D; K = 512; N = D; dst = (bf16_t*)(ws + OFF_W_PW); }
    else if (t < 2176) { idx = t - 1920; src = p.w_out + (size_t)l * D * D; K = D; N = D; dst = (bf16_t*)(ws + OFF_W_OUT); }
    else if (t < 3200) { idx = t - 2176; src = p.w_ff1 + (size_t)l * D * DFF; K = D; N = DFF; dst = (bf16_t*)(ws + OFF_W_FF1); }
    else { idx = t - 3200; src = p.w_ff2 + (size_t)l * DFF * D; K = DFF; N = D; dst = (bf16_t*)(ws + OFF_W_FF2); }
    const int nts = N / 64; convert_tile(src, K, N, dst, idx / nts, idx % nts, tile);
  }
}

DI void phase0_misc(const Params& p, unsigned char* smem) {
  unsigned char* ws = p.ws;
  const int tid = get_tid();
  { f32x4* h4 = (f32x4*)(ws + OFF_H); const f32x4* x4 = (const f32x4*)p.x; const f32x4* c4 = (const f32x4*)p.ctx;
    const size_t nx = (size_t)NLAT * D / 4, nc = (size_t)NCTX * D / 4;
    for (size_t i = (size_t)get_bid() * 256 + tid; i < nx + nc; i += (size_t)gridDim.x * 256) h4[i] = i < nx ? x4[i] : c4[i - nx]; }
  if (get_bid() == 0) {
    float* rope = (float*)(ws + OFF_ROPE);
    for (int i = tid; i < 1024; i += 256) { const int pos = i >> 4, f = i & 15; const float inv = powf(10000.0f, -(float)f / 16.0f); const float ang = (float)pos * inv; rope[i] = cosf(ang); rope[1024 + i] = sinf(ang); }
    if (tid < DEPTH) { const int l = tid; float s1 = 0.f, s2 = 0.f;
      for (int i = 0; i < 64; ++i) { s1 += p.lq1[l * 64 + i] * p.lk1[l * 64 + i]; s2 += p.lq2[l * 64 + i] * p.lk2[l * 64 + i]; }
      const float lam_init = 0.8f - 0.6f * expf(-0.3f * (float)l);
      ((float*)(ws + OFF_LAM))[l] = expf(s1) - expf(s2) + lam_init; }
    if (tid >= 64 && tid < 64 + DEPTH) { const int l = tid - 64; float a = 0.f, b2 = 0.f, c2 = 0.f, d2 = 0.f;
      for (int i = 0; i < 64; ++i) { a = fmaxf(a, fabsf(p.dq_g[l * 64 + i])); b2 = fmaxf(b2, fabsf(p.dk_g[l * 64 + i])); c2 = fmaxf(c2, fabsf(p.wq_g[l * 64 + i])); d2 = fmaxf(d2, fabsf(p.wk_g[l * 64 + i])); }
      ((float*)(ws + OFF_LAM))[4 + l] = 8.0f * LOG2E * 1.02f * a * b2;
      ((float*)(ws + OFF_LAM))[8 + l] = 8.0f * LOG2E * 1.02f * c2 * d2;
      for (int i = 0; i < 8; ++i) ((unsigned*)(ws + OFF_LAM))[16 + l * 8 + i] = 0u; }
  }
  float* sc = (float*)smem;
  float* red = sc + 5 * 1024;
  for (int i = tid; i < 5 * 1024; i += 256) { const int bb = i >> 10, k = i & 1023; const float v = bb < 4 ? p.c[bb * 1024 + k] : p.c_ctx[k]; sc[i] = v / (1.0f + __expf(-v)); }
  __syncthreads();
  float* modv = (float*)(ws + OFF_MODV);
  for (int t = get_bid(); t < DEPTH * 96; t += gridDim.x) {
    const int l = t / 96, cb = t % 96, kq = tid >> 6, cl = tid & 63, col = cb * 64 + cl;
    const float* w = p.w_mod + (size_t)l * D * 6144 + col;
    float s[5] = {0.f, 0.f, 0.f, 0.f, 0.f};
    for (int k = kq * 256; k < kq * 256 + 256; ++k) { const float wv = w[(size_t)k * 6144];
#pragma unroll
      for (int bb = 0; bb < 5; ++bb) s[bb] += sc[bb * 1024 + k] * wv; }
#pragma unroll
    for (int bb = 0; bb < 5; ++bb) red[(kq * 5 + bb) * 64 + cl] = s[bb];
    __syncthreads();
    for (int i = tid; i < 5 * 64; i += 256) { const int bb = i >> 6, c2 = i & 63; const float v = red[(0 * 5 + bb) * 64 + c2] + red[(1 * 5 + bb) * 64 + c2] + red[(2 * 5 + bb) * 64 + c2] + red[(3 * 5 + bb) * 64 + c2];
      modv[((size_t)l * 5 + bb) * 6144 + cb * 64 + c2] = v + p.b_mod[l * 6144 + cb * 64 + c2]; }
    __syncthreads();
  }
}

DI void norm_phase(const Params& p, int l, const float* gvec, int sh_off, int sc_off, int nrows) {
  const int tid = get_tid(), lane = tid & 63, wid = tid >> 6;
  const float* h = (const float*)(p.ws + OFF_H); bf16_t* out = (bf16_t*)(p.ws + OFF_ABUF);
  const float* modv = (const float*)(p.ws + OFF_MODV) + (size_t)l * 5 * 6144;
  for (int t = get_bid(); t < nrows / 4; t += gridDim.x) {
    const int row = t * 4 + wid; const int bb = row < NLAT ? row / SEQ : 4;
    const float* hr = h + (size_t)row * D; const float* mv = modv + bb * 6144;
    f32x4 v[4]; float ss = 0.f;
#pragma unroll
    for (int it = 0; it < 4; ++it) { v[it] = *(const f32x4*)(hr + it * 256 + lane * 4); ss += v[it][0] * v[it][0] + v[it][1] * v[it][1] + v[it][2] * v[it][2] + v[it][3] * v[it][3]; }
#pragma unroll
    for (int m = 1; m < 64; m <<= 1) ss += xshfl(ss, m);
    const float rstd = rsqrtf(ss * (1.0f / 1024.0f) + EPS);
#pragma unroll
    for (int it = 0; it < 4; ++it) { const int idx = it * 256 + lane * 4;
      const f32x4 g = *(const f32x4*)(gvec + idx), s1 = *(const f32x4*)(mv + sc_off + idx), s0 = *(const f32x4*)(mv + sh_off + idx);
      float y[4];
#pragma unroll
      for (int j = 0; j < 4; ++j) y[j] = v[it][j] * rstd * g[j] * (1.0f + s1[j]) + s0[j];
      u32x2 o; o[0] = pack2(y[0], y[1]); o[1] = pack2(y[2], y[3]); *(u32x2*)(out + (size_t)row * D + idx) = o; }
  }
}

DI void inproj_epilogue(const Params& p, int l, const f32x4 (&acc)[4][4], int m0, int n0) {
  unsigned char* ws = p.ws;
  const int tid = get_tid(), lane = tid & 63, wid = tid >> 6, wr = wid >> 1, wc = wid & 1, lr = lane & 15, lg = lane >> 4;
  const bool is_lat = m0 < NLAT;
  int b, i0; if (is_lat) { b = m0 / SEQ; i0 = m0 % SEQ; } else { const int c0 = m0 - NLAT; b = c0 / CTX; i0 = c0 % CTX; }
  const int pos0 = is_lat ? CTX + i0 : i0;
  const int hc = n0 + wc * 64;
  int seg;
  if (n0 < 512) seg = 0; else if (n0 < 1024) seg = 1; else if (n0 < 1536) seg = 2; else if (n0 < 2048) seg = 3; else if (n0 < 2560) seg = 4; else if (n0 < 2688) seg = 5; else if (n0 < 2816) seg = 6; else seg = 7;
  if (seg == 0 || seg == 1 || seg == 4 || seg == 5) {
    const float* gv; bf16_t* dst; float qs = 1.0f;
    if (seg == 0) { const int c = hc; gv = p.dq_g + l * 64; dst = (bf16_t*)(ws + OFF_QD) + ((size_t)((b * 2 + c / 256) * 4 + (c % 256) / 64) * POS) * 64; qs = 0.125f * LOG2E; }
    else if (seg == 1) { const int c = hc - 512; gv = p.dk_g + l * 64; dst = (bf16_t*)(ws + OFF_KD) + ((size_t)((b * 2 + c / 256) * 4 + (c % 256) / 64) * POS) * 64; }
    else if (seg == 4) { const int c = hc - 2048; gv = p.wq_g + l * 64; dst = (bf16_t*)(ws + OFF_QW) + ((size_t)(b * 8 + c / 64) * POS) * 64; qs = 0.125f * LOG2E; }
    else { const int c = hc - 2560; gv = p.wk_g + l * 64; dst = (bf16_t*)(ws + OFF_KW) + ((size_t)(b * 2 + c / 64) * POS) * 64; }
    const float* rope = (const float*)(ws + OFF_ROPE);
    f32x4 gq[4];
#pragma unroll
    for (int ni = 0; ni < 4; ++ni) gq[ni] = *(const f32x4*)(gv + ni * 16 + lg * 4);
#pragma unroll
    for (int mi = 0; mi < 4; ++mi) {
      const int r = wr * 64 + mi * 16 + lr;
      float ss = 0.f;
#pragma unroll
      for (int ni = 0; ni < 4; ++ni)
#pragma unroll
        for (int j = 0; j < 4; ++j) ss += acc[mi][ni][j] * acc[mi][ni][j];
      ss += xshfl(ss, 16); ss += xshfl(ss, 32);
      const float rstd = rsqrtf(ss * (1.0f / 64.0f) + EPS);
      f32x4 v[4];
#pragma unroll
      for (int ni = 0; ni < 4; ++ni) v[ni] = acc[mi][ni] * rstd * gq[ni];
      if (is_lat) {
        const int li = i0 + r, gr = li >> 6, gc = li & 63;
#pragma unroll
        for (int ni = 0; ni < 2; ++ni) {
          const int pi = ni == 0 ? gr : gc;
          const f32x4 cs = *(const f32x4*)(rope + pi * 16 + lg * 4), sn = *(const f32x4*)(rope + 1024 + pi * 16 + lg * 4);
          const f32x4 x1 = v[ni], x2 = v[ni + 2];
          v[ni] = x1 * cs - x2 * sn; v[ni + 2] = x2 * cs + x1 * sn;
        }
      }
      bf16_t* drow = dst + (size_t)(pos0 + r) * 64 + lg * 4;
#pragma unroll
      for (int ni = 0; ni < 4; ++ni) { u32x2 o; o[0] = pack2(v[ni][0] * qs, v[ni][1] * qs); o[1] = pack2(v[ni][2] * qs, v[ni][3] * qs); *(u32x2*)(drow + ni * 16) = o; }
    }
  } else if (seg == 2 || seg == 6) {
#pragma unroll
    for (int mi = 0; mi < 4; ++mi) {
      const int pos = pos0 + wr * 64 + mi * 16 + lr;
#pragma unroll
      for (int ni = 0; ni < 4; ++ni)
#pragma unroll
        for (int j = 0; j < 4; ++j) {
          const int col = hc + ni * 16 + lg * 4 + j; bf16_t* dst;
          if (seg == 2) { const int c = col - 1024; dst = (bf16_t*)(ws + OFF_VDT) + ((size_t)(b * 4 + c / 128) * 128 + (c % 128)) * POS + pos; }
          else { const int c = col - 2688; dst = (bf16_t*)(ws + OFF_VWT) + ((size_t)(b * 2 + c / 64) * 64 + (c % 64)) * POS + pos; }
          *dst = (bf16_t)(pack2(acc[mi][ni][j], 0.f) & 0xffffu);
        }
    }
  } else if (seg == 3) {
    bf16_t* su = (bf16_t*)(ws + OFF_SU);
#pragma unroll
    for (int mi = 0; mi < 4; ++mi) { const int pos = pos0 + wr * 64 + mi * 16 + lr;
#pragma unroll
      for (int ni = 0; ni < 4; ++ni) { u32x2 o; o[0] = pack2(acc[mi][ni][0], acc[mi][ni][1]); o[1] = pack2(acc[mi][ni][2], acc[mi][ni][3]);
        *(u32x2*)(su + ((size_t)(b * 32 + (hc - 1536) / 16 + ni) * POS + pos) * 16 + lg * 4) = o; } }
  } else {
    bf16_t* gt = (bf16_t*)(ws + OFF_GATES);
#pragma unroll
    for (int mi = 0; mi < 4; ++mi) { const int row = m0 + wr * 64 + mi * 16 + lr;
#pragma unroll
      for (int ni = 0; ni < 4; ++ni) { u32x2 o; o[0] = pack2(sigmoidf_(acc[mi][ni][0]), sigmoidf_(acc[mi][ni][1])); o[1] = pack2(sigmoidf_(acc[mi][ni][2]), sigmoidf_(acc[mi][ni][3]));
        *(u32x2*)(gt + (size_t)row * 3072 + (hc - 2816) + ni * 16 + lg * 4) = o; } }
  }
}
DI void inproj_phase(const Params& p, int l, unsigned char* smem) {
  bf16_t* As = (bf16_t*)smem; bf16_t* Bs = As + 128 * LDT;
  const bf16_t* A = (const bf16_t*)(p.ws + OFF_ABUF); const bf16_t* W = (const bf16_t*)(p.ws + OFF_W_IN);
  constexpr int NT = DIN / 128, MT = NTOK / 128;
  for (int t = get_bid(); t < MT * NT; t += gridDim.x) {
    const int mt = t / NT, nt = t % NT;
    f32x4 acc[4][4]; zero_acc(acc);
    gemm_mainloop(acc, A + (size_t)mt * 128 * D, D, W + (size_t)nt * 128 * D, D, D, As, Bs);
    inproj_epilogue(p, l, acc, mt * 128, nt * 128);
  }
}

constexpr int NW = 4;
constexpr int NTHR = NW * 64;
constexpr int QU = NW * 32;
template <int DV, bool TWOK>
DI void attn_core_d1(f32x4 (&O)[2][DV / 16], float (&lsum)[2], const bf16x8 (&Qf)[2][2], float negm,
                  const bf16_t* __restrict__ Kp0, const bf16_t* __restrict__ Kp1, const bf16_t* __restrict__ Vt, int t0, int t1, int tm0, int tm1, int qlat0, unsigned char* smem) {
  constexpr int KB = TWOK ? 16384 : 8192, BUFB = KB + DV * 128;
  constexpr int NKL = (TWOK ? 16 : 8) / NW, NVL = DV / 8 / NW;
  const int tid = get_tid(), lane = tid & 63, wid = __builtin_amdgcn_readfirstlane(tid >> 6), lr = lane & 15, lg = lane >> 4;
  const int rl = lane >> 3, lc = (lane & 7) ^ rl;
  const int n0 = t1 - t0, ntl = n0 + (tm1 - tm0);
  u32x4 rk[NKL], rv[NVL];
#define ATTN_GLOAD(KEY0) do { const int key0_ = (KEY0); \
    _Pragma("unroll") for (int i = 0; i < NKL; ++i) { const int L = wid + i * NW; const bf16_t* kp_ = (i * NW >= 8) ? Kp1 : Kp0; rk[i] = *(const u32x4*)(kp_ + (size_t)(key0_ + (L & 7) * 8 + rl) * 64 + lc * 8); } \
    _Pragma("unroll") for (int i = 0; i < NVL; ++i) { const int L = wid + i * NW; rv[i] = *(const u32x4*)(Vt + (size_t)(L * 8 + rl) * POS + key0_ + lc * 8); } } while (0)
#define ATTN_LSTORE(BUF) do { unsigned char* buf_ = (BUF); \
    _Pragma("unroll") for (int i = 0; i < NKL; ++i) *(u32x4*)(buf_ + (wid + i * NW) * 1024 + lane * 16) = rk[i]; \
    _Pragma("unroll") for (int i = 0; i < NVL; ++i) *(u32x4*)(buf_ + KB + (wid + i * NW) * 1024 + lane * 16) = rv[i]; } while (0)
  ATTN_GLOAD((n0 > 0 ? t0 : tm0) * 64);
  __syncthreads();
  ATTN_LSTORE(smem);
  const int sw = lr & 7;
  for (int it = 0; it < ntl; ++it) {
    const bool masked = it >= n0;
    const int key0 = (masked ? tm0 + (it - n0) : t0 + it) * 64;
    const unsigned char* Kb = smem + (it & 1) * BUFB; const unsigned char* Vb = Kb + KB;
    __syncthreads();
    if (it + 1 < ntl) ATTN_GLOAD(((it + 1) >= n0 ? tm0 + (it + 1 - n0) : t0 + it + 1) * 64);
    f32x4 s[4][2];
#pragma unroll
    for (int kt = 0; kt < 4; ++kt) {
      const unsigned char* kr = Kb + (kt * 16 + lr) * 128;
      if (!TWOK) {
        const bf16x8 k0f = *(const bf16x8*)(kr + ((lg ^ sw) << 4)), k1f = *(const bf16x8*)(kr + (((4 + lg) ^ sw) << 4));
#pragma unroll
        for (int qt = 0; qt < 2; ++qt) { f32x4 z = {negm, negm, negm, negm}; z = MFMA16(k0f, Qf[qt][0], z); s[kt][qt] = MFMA16(k1f, Qf[qt][1], z); }
      } else {
#pragma unroll
        for (int qt = 0; qt < 2; ++qt) {
          const bf16x8 k0f = *(const bf16x8*)(kr + qt * 8192 + ((lg ^ sw) << 4)), k1f = *(const bf16x8*)(kr + qt * 8192 + (((4 + lg) ^ sw) << 4));
          f32x4 z = {negm, negm, negm, negm}; z = MFMA16(k0f, Qf[qt][0], z); s[kt][qt] = MFMA16(k1f, Qf[qt][1], z); }
      }
    }
    if (masked) {
#pragma unroll
      for (int kt = 0; kt < 4; ++kt)
#pragma unroll
        for (int qt = 0; qt < 2; ++qt)
#pragma unroll
          for (int j = 0; j < 4; ++j) { const int kl = key0 - CTX + kt * 16 + lg * 4 + j, ql = qlat0 + qt * 16 + lr; const int rel = kl - ql; if (rel > 128 || rel < -128) s[kt][qt][j] = -INFINITY; }
    }
    bf16x8 pf[2][2];
#pragma unroll
    for (int qt = 0; qt < 2; ++qt) {
      float rs = 0.f;
#pragma unroll
      for (int kt = 0; kt < 4; ++kt)
#pragma unroll
        for (int j = 0; j < 4; ++j) { const float e = __builtin_amdgcn_exp2f(s[kt][qt][j]); s[kt][qt][j] = e; rs += e; }
      lsum[qt] += rs;
#pragma unroll
      for (int kk = 0; kk < 2; ++kk) {
        u32x4 w; w[0] = pack2(s[2 * kk][qt][0], s[2 * kk][qt][1]); w[1] = pack2(s[2 * kk][qt][2], s[2 * kk][qt][3]);
        w[2] = pack2(s[2 * kk + 1][qt][0], s[2 * kk + 1][qt][1]); w[3] = pack2(s[2 * kk + 1][qt][2], s[2 * kk + 1][qt][3]);
        pf[qt][kk] = __builtin_bit_cast(bf16x8, w);
      }
    }
#pragma unroll
    for (int et = 0; et < DV / 16; ++et)
#pragma unroll
      for (int kk = 0; kk < 2; ++kk) {
        const unsigned char* vr = Vb + (et * 16 + lr) * 128 + (lg & 1) * 8;
        const int c0 = kk * 4 + (lg >> 1);
        const bf16x4 lo = *(const bf16x4*)(vr + ((c0 ^ sw) << 4)), hi = *(const bf16x4*)(vr + (((c0 + 2) ^ sw) << 4));
        const bf16x8 vf = __builtin_shufflevector(lo, hi, 0, 1, 2, 3, 4, 5, 6, 7);
        O[0][et] = MFMA16(vf, pf[0][kk], O[0][et]);
        O[1][et] = MFMA16(vf, pf[1][kk], O[1][et]);
      }
    if (it + 1 < ntl) ATTN_LSTORE(smem + ((it + 1) & 1) * BUFB);
  }
#undef ATTN_GLOAD
#undef ATTN_LSTORE
}

#define VM_WAIT4(N, R, Q) asm volatile("s_waitcnt vmcnt(" #N ")" : "+v"(R[0]), "+v"(R[1]), "+v"(Q[0]), "+v"(Q[1]) :: "memory")
template <int DV, bool TWOK>
DI void attn_core(f32x4 (&O)[2][DV / 16], float (&lsum)[2], const bf16x8 (&Qf)[2][2], float negm,
                  const bf16_t* __restrict__ Kp0, const bf16_t* __restrict__ Kp1, const bf16_t* __restrict__ Vt, int t0, int t1, int tm0, int tm1, int qlat0, unsigned char* smem) {
  constexpr int KB = TWOK ? 16384 : 8192, BUFB = KB + DV * 128;
  constexpr int NKL = (TWOK ? 16 : 8) / NW, NVL = DV / 8 / NW;
  static_assert((NKL == 4 && NVL == 4) || (NKL == 2 && NVL == 2), "wait macros are written for 8 or 4 loads per set");
  const int tid = get_tid(), lane = tid & 63, wid = __builtin_amdgcn_readfirstlane(tid >> 6), lr = lane & 15, lg = lane >> 4;
  const int rl = lane >> 3, lc = (lane & 7) ^ rl;
  const int n0 = t1 - t0, ntl = n0 + (tm1 - tm0);
  u32x4 rk0[NKL], rv0[NVL], rk1[NKL], rv1[NVL];
#define ATTN_TILE(I) ({ int i_ = (I); i_ = i_ < ntl ? i_ : ntl - 1; (i_ < n0 ? t0 + i_ : tm0 + (i_ - n0)) * 64; })
#define ATTN_GLOAD(RK, RV, KEY0) do { const int key0_ = (KEY0); \
    _Pragma("unroll") for (int i = 0; i < NKL; ++i) { const int L = wid + i * NW; const bf16_t* kp_ = (i * NW >= 8) ? Kp1 : Kp0; RK[i] = gload_async(kp_ + (size_t)(key0_ + (L & 7) * 8 + rl) * 64 + lc * 8); } \
    _Pragma("unroll") for (int i = 0; i < NVL; ++i) { const int L = wid + i * NW; RV[i] = gload_async(Vt + (size_t)(L * 8 + rl) * POS + key0_ + lc * 8); } } while (0)
#define ATTN_LSTORE(RK, RV, BUF) do { unsigned char* buf_ = (BUF); \
    _Pragma("unroll") for (int i = 0; i < NKL; ++i) *(u32x4*)(buf_ + (wid + i * NW) * 1024 + lane * 16) = RK[i]; \
    _Pragma("unroll") for (int i = 0; i < NVL; ++i) *(u32x4*)(buf_ + KB + (wid + i * NW) * 1024 + lane * 16) = RV[i]; } while (0)
#define ATTN_WAIT(RK, RV) do { if constexpr (NKL == 4) VM_WAIT8(8, RK, RV); else VM_WAIT4(4, RK, RV); } while (0)
#define ATTN_DRAIN(RK, RV) do { if constexpr (NKL == 4) VM_WAIT8(0, RK, RV); else VM_WAIT4(0, RK, RV); } while (0)
  const int sw = lr & 7;
#define ATTN_COMPUTE(IT, BUFP) do { const int it_ = (IT); const bool masked = it_ >= n0; const int key0 = (masked ? tm0 + (it_ - n0) : t0 + it_) * 64; \
    const unsigned char* Kb = (BUFP); const unsigned char* Vb = Kb + KB; \
    bf16x8 pf[2][2]; \
    _Pragma("unroll") for (int qt = 0; qt < 2; ++qt) { f32x4 s4[4]; \
      _Pragma("unroll") for (int kt = 0; kt < 4; ++kt) { const unsigned char* kq = Kb + (kt * 16 + lr) * 128 + (TWOK ? qt * 8192 : 0); \
        const bf16x8 k0f = *(const bf16x8*)(kq + ((lg ^ sw) << 4)), k1f = *(const bf16x8*)(kq + (((4 + lg) ^ sw) << 4)); \
        f32x4 z = {negm, negm, negm, negm}; z = MFMA16(k0f, Qf[qt][0], z); s4[kt] = MFMA16(k1f, Qf[qt][1], z); } \
      if (masked) { \
        _Pragma("unroll") for (int kt = 0; kt < 4; ++kt) _Pragma("unroll") for (int j = 0; j < 4; ++j) { \
          const int kl = key0 - CTX + kt * 16 + lg * 4 + j, ql = qlat0 + qt * 16 + lr; const int rel = kl - ql; if (rel > 128 || rel < -128) s4[kt][j] = -INFINITY; } } \
      float rs = 0.f; \
      _Pragma("unroll") for (int kt = 0; kt < 4; ++kt) _Pragma("unroll") for (int j = 0; j < 4; ++j) { const float e = __builtin_amdgcn_exp2f(s4[kt][j]); s4[kt][j] = e; rs += e; } \
      lsum[qt] += rs; \
      _Pragma("unroll") for (int kk = 0; kk < 2; ++kk) { u32x4 w; w[0] = pack2(s4[2 * kk][0], s4[2 * kk][1]); w[1] = pack2(s4[2 * kk][2], s4[2 * kk][3]); \
        w[2] = pack2(s4[2 * kk + 1][0], s4[2 * kk + 1][1]); w[3] = pack2(s4[2 * kk + 1][2], s4[2 * kk + 1][3]); pf[qt][kk] = __builtin_bit_cast(bf16x8, w); } } \
    _Pragma("unroll") for (int et = 0; et < DV / 16; ++et) _Pragma("unroll") for (int kk = 0; kk < 2; ++kk) { \
        const unsigned char* vr = Vb + (et * 16 + lr) * 128 + (lg & 1) * 8; const int c0 = kk * 4 + (lg >> 1); \
        const bf16x4 lo = *(const bf16x4*)(vr + ((c0 ^ sw) << 4)), hi = *(const bf16x4*)(vr + (((c0 + 2) ^ sw) << 4)); \
        const bf16x8 vf = __builtin_shufflevector(lo, hi, 0, 1, 2, 3, 4, 5, 6, 7); \
        O[0][et] = MFMA16(vf, pf[0][kk], O[0][et]); O[1][et] = MFMA16(vf, pf[1][kk], O[1][et]); } } while (0)
  asm volatile("s_waitcnt vmcnt(0)" ::: "memory");
  ATTN_GLOAD(rk0, rv0, ATTN_TILE(0)); ATTN_GLOAD(rk1, rv1, ATTN_TILE(1));
  __syncthreads();
  ATTN_WAIT(rk0, rv0); ATTN_LSTORE(rk0, rv0, smem); ATTN_GLOAD(rk0, rv0, ATTN_TILE(2));
  for (int it = 0; it < ntl; it += 2) {
    __syncthreads();
    ATTN_COMPUTE(it, smem);
    ATTN_WAIT(rk1, rv1); ATTN_LSTORE(rk1, rv1, smem + BUFB); ATTN_GLOAD(rk1, rv1, ATTN_TILE(it + 3));
    __syncthreads();
    ATTN_COMPUTE(it + 1, smem + BUFB);
    ATTN_WAIT(rk0, rv0); ATTN_LSTORE(rk0, rv0, smem); ATTN_GLOAD(rk0, rv0, ATTN_TILE(it + 4));
  }
  ATTN_DRAIN(rk0, rv0); ATTN_DRAIN(rk1, rv1);
#undef ATTN_TILE
#undef ATTN_GLOAD
#undef ATTN_LSTORE
#undef ATTN_WAIT
#undef ATTN_DRAIN
#undef ATTN_COMPUTE
}

constexpr int QUD = NW * 16;
DI void diff_unit(const Params& p, int l, int b, int hd, bool is_lat, int qi, unsigned char* smem) {
  unsigned char* ws = p.ws;
  const int tid = get_tid(), lane = tid & 63, wid = __builtin_amdgcn_readfirstlane(tid >> 6), lr = lane & 15, lg = lane >> 4;
  const int qpos0 = (is_lat ? CTX + qi * QUD : qi * QUD) + wid * 16;
  const int ntile = is_lat ? POS / 64 : CTX / 64;
  const float lam = ((const float*)(ws + OFF_LAM))[l];
  const float negm = -((const float*)(ws + OFF_LAM))[4 + l];
  const float lam_init = 0.8f - 0.6f * expf(-0.3f * (float)l);
  const size_t hoff0 = (size_t)((b * 2 + 0) * 4 + hd) * POS * 64, hoff1 = (size_t)((b * 2 + 1) * 4 + hd) * POS * 64;
  const bf16_t* Qd = (const bf16_t*)(ws + OFF_QD); const bf16_t* Kd = (const bf16_t*)(ws + OFF_KD);
  bf16x8 Qf[2][2];
#pragma unroll
  for (int ks = 0; ks < 2; ++ks) { Qf[0][ks] = *(const bf16x8*)(Qd + hoff0 + (size_t)(qpos0 + lr) * 64 + ks * 32 + lg * 8); Qf[1][ks] = *(const bf16x8*)(Qd + hoff1 + (size_t)(qpos0 + lr) * 64 + ks * 32 + lg * 8); }
  float lsum[2] = {0.f, 0.f};
  f32x4 O[2][8];
#pragma unroll
  for (int m = 0; m < 2; ++m)
#pragma unroll
    for (int et = 0; et < 8; ++et) O[m][et] = (f32x4){0.f, 0.f, 0.f, 0.f};
  attn_core_d1<128, true>(O, lsum, Qf, negm, Kd + hoff0, Kd + hoff1, (const bf16_t*)(ws + OFF_VDT) + (size_t)(b * 4 + hd) * 128 * POS, 0, ntile, 0, 0, 0, smem);
  float l0 = lsum[0], l1 = lsum[1];
  l0 += xshfl(l0, 16); l0 += xshfl(l0, 32); l1 += xshfl(l1, 16); l1 += xshfl(l1, 32);
  const float i0 = 1.0f / l0, i1 = lam / l1;
  float ss = 0.f;
#pragma unroll
  for (int et = 0; et < 8; ++et) { O[0][et] = O[0][et] * i0 - O[1][et] * i1;
#pragma unroll
    for (int j = 0; j < 4; ++j) ss += O[0][et][j] * O[0][et][j]; }
  ss += xshfl(ss, 16); ss += xshfl(ss, 32);
  const float rs = rsqrtf(ss * (1.0f / 128.0f) + EPS) * (1.0f - lam_init);
  const float* og = p.dout_g + l * 128; bf16_t* yd = (bf16_t*)(ws + OFF_YD);
  const int qpos = qpos0 + lr;
  const int row = is_lat ? b * SEQ + (qpos - CTX) : NLAT + b * CTX + qpos;
#pragma unroll
  for (int et = 0; et < 8; ++et) { const f32x4 g = *(const f32x4*)(og + et * 16 + lg * 4); const f32x4 y = O[0][et] * rs * g;
    u32x2 o; o[0] = pack2(y[0], y[1]); o[1] = pack2(y[2], y[3]); *(u32x2*)(yd + (size_t)row * 512 + hd * 128 + et * 16 + lg * 4) = o; }
}

DI void win_unit(const Params& p, int l, int b, int qh, bool is_lat, int qi, unsigned char* smem) {
  unsigned char* ws = p.ws;
  const int tid = get_tid(), lane = tid & 63, wid = __builtin_amdgcn_readfirstlane(tid >> 6), lr = lane & 15, lg = lane >> 4;
  const int qpos0 = (is_lat ? CTX + qi * QU : qi * QU) + wid * 32;
  const int kv = qh >> 2;
  const bf16_t* Qp = (const bf16_t*)(ws + OFF_QW) + ((size_t)(b * 8 + qh) * POS + qpos0) * 64;
  bf16x8 Qf[2][2];
#pragma unroll
  for (int qt = 0; qt < 2; ++qt)
#pragma unroll
    for (int ks = 0; ks < 2; ++ks) Qf[qt][ks] = *(const bf16x8*)(Qp + (qt * 16 + lr) * 64 + ks * 32 + lg * 8);
  const float sk = p.w_sink[l * 8 + qh] * LOG2E;
  const float mfix = fmaxf(((const float*)(ws + OFF_LAM))[8 + l], sk);
  const float l0 = lg == 0 ? __builtin_amdgcn_exp2f(sk - mfix) : 0.f;
  float lsum[2] = {l0, l0};
  f32x4 O[2][4];
#pragma unroll
  for (int qt = 0; qt < 2; ++qt)
#pragma unroll
    for (int et = 0; et < 4; ++et) O[qt][et] = (f32x4){0.f, 0.f, 0.f, 0.f};
  int tm0 = 0, tm1 = 0;
  if (is_lat) { const int q0 = qi * QU; tm0 = (q0 + 128) / 64; if (tm0 < 4) tm0 = 4; tm1 = (q0 + QU + 384) / 64; if (tm1 > POS / 64) tm1 = POS / 64; }
  attn_core<64, false>(O, lsum, Qf, -mfix, (const bf16_t*)(ws + OFF_KW) + (size_t)(b * 2 + kv) * POS * 64, nullptr, (const bf16_t*)(ws + OFF_VWT) + (size_t)(b * 2 + kv) * 64 * POS, 0, 4, tm0, tm1, qpos0 - CTX, smem);
  bf16_t* yw = (bf16_t*)(ws + OFF_YW);
#pragma unroll
  for (int qt = 0; qt < 2; ++qt) {
    float ls = lsum[qt]; ls += xshfl(ls, 16); ls += xshfl(ls, 32);
    const float inv = 1.0f / ls;
    const int qpos = qpos0 + qt * 16 + lr;
    const int row = is_lat ? b * SEQ + (qpos - CTX) : NLAT + b * CTX + qpos;
#pragma unroll
    for (int et = 0; et < 4; ++et) { const f32x4 y = O[qt][et] * inv; u32x2 o; o[0] = pack2(y[0], y[1]); o[1] = pack2(y[2], y[3]);
      *(u32x2*)(yw + (size_t)row * 512 + qh * 64 + et * 16 + lg * 4) = o; }
  }
}

constexpr int NR = NW / 2, CR = NCH / NR;
constexpr int BST = 20, SST = 136;
constexpr int S5_WAVE_LDS = 128 * BST * 4 + 16 * SST * 2;
constexpr int EB_PER_UNIT = 2 * (NCH + 8) * 64 * 2;
DI int s5_row(int b, int k, int t) { return k < 8 ? NLAT + b * CTX + k * 32 + t : b * SEQ + (k - 8) * 32 + t; }
DI int s5_cmap(int d, int k) { return d == 0 ? k : (k < 8 ? 7 - k : 143 - k); }
DI void s5_make_bf(const Params& p, int l, int d, int g, float fre, float fim, bf16x8 (&Bf)[8], int lr, int lg) {
#pragma unroll
  for (int q = 0; q < 8; ++q) {
    const int pp = 16 * (q & 3) + lr;
    const float fr = __shfl(fre, pp, 64), fi = __shfl(fim, pp, 64);
    u32x4 w = {0u, 0u, 0u, 0u};
    if (lg < 2) {
      const size_t bo = ((size_t)((l * 2 + d) * 32 + g) * 64 + pp) * 16 + lg * 8;
      const f32x4 br0 = *(const f32x4*)(p.s5_bre + bo), br1 = *(const f32x4*)(p.s5_bre + bo + 4), bi0 = *(const f32x4*)(p.s5_bim + bo), bi1 = *(const f32x4*)(p.s5_bim + bo + 4);
      f32x4 v0, v1;
      if (q < 4) { v0 = fr * br0 - fi * bi0; v1 = fr * br1 - fi * bi1; } else { v0 = fr * bi0 + fi * br0; v1 = fr * bi1 + fi * br1; }
      w[0] = pack2(v0[0], v0[1]); w[1] = pack2(v0[2], v0[3]); w[2] = pack2(v1[0], v1[1]); w[3] = pack2(v1[2], v1[3]);
    }
    Bf[q] = __builtin_bit_cast(bf16x8, w);
  }
}
DI u32x4 s5_load_uf(const bf16_t* sug, int k, int tt, int lr, int lg) { u32x4 uw = {0u, 0u, 0u, 0u}; if (lg < 2) uw = *(const u32x4*)(sug + (size_t)(k * 32 + tt * 16 + lr) * 16 + lg * 8); return uw; }
DI void s5_bu_tile(u32x4 uw, const bf16x8 (&Bf)[8], float* Bsm, int lr, int lg) {
  const bf16x8 uf = __builtin_bit_cast(bf16x8, uw);
#pragma unroll
  for (int q = 0; q < 8; ++q) { f32x4 z = {0.f, 0.f, 0.f, 0.f}; z = MFMA16(Bf[q], uf, z);
#pragma unroll
    for (int jj = 0; jj < 4; ++jj) Bsm[(q * 16 + lg * 4 + jj) * BST + lr] = z[jj]; }
}
#define S5_SCAN(D, AR, AI, WRITE) do { \
    _Pragma("unroll") for (int hb = 0; hb < 2; ++hb) { const int cb = ((D) ? 1 - hb : hb) * 2;     \
      const f32x4 br0_ = *(const f32x4*)(Bsm + lane * BST + cb * 4), br1_ = *(const f32x4*)(Bsm + lane * BST + cb * 4 + 4); \
      const f32x4 bi0_ = *(const f32x4*)(Bsm + (64 + lane) * BST + cb * 4), bi1_ = *(const f32x4*)(Bsm + (64 + lane) * BST + cb * 4 + 4); \
      _Pragma("unroll") for (int st = 0; st < 8; ++st) { const int t8 = (D) ? 7 - st : st; const int tl = cb * 4 + t8; \
        const float br = t8 < 4 ? br0_[t8 & 3] : br1_[t8 & 3], bi = t8 < 4 ? bi0_[t8 & 3] : bi1_[t8 & 3]; \
        const float nr = (AR) * sr - (AI) * si + br, ni = (AR) * si + (AI) * sr + bi; sr = nr; si = ni; \
        if (WRITE) { const unsigned pk = pack2(sr, si); Ssm[tl * SST + lane] = (bf16_t)(pk & 0xffffu); Ssm[tl * SST + 64 + lane] = (bf16_t)(pk >> 16); } } } } while (0)
DI void s5_unit(const Params& p, int l, int b, int g, unsigned char* smem) {
  unsigned char* ws = p.ws;
  const int tid = get_tid(), lane = tid & 63, wid = __builtin_amdgcn_readfirstlane(tid >> 6), lr = lane & 15, lg = lane >> 4;
  float* Bsm = (float*)(smem + wid * S5_WAVE_LDS);
  bf16_t* Ssm = (bf16_t*)(smem + wid * S5_WAVE_LDS + 128 * BST * 4);
  const bf16_t* sug = (const bf16_t*)(ws + OFF_SU) + (size_t)(b * 32 + g) * POS * 16;
  float* Eb = (float*)(ws + OFF_EB) + (size_t)(b * 32 + g) * EB_PER_UNIT;
  float are[2], aim[2], fre[2], fim[2];
#pragma unroll
  for (int d = 0; d < 2; ++d) {
    const int pi = ((l * 2 + d) * 32 + g) * 64 + lane;
    const float lre = p.s5_lre[pi], lim = p.s5_lim[pi], dt = expf(p.s5_ldt[(l * 2 + d) * 32 + g]);
    const float mag = expf(lre * dt), ang = lim * dt;
    are[d] = mag * cosf(ang); aim[d] = mag * sinf(ang);
    const float den = lre * lre + lim * lim, nre = are[d] - 1.0f;
    fre[d] = (nre * lre + aim[d] * lim) / den; fim[d] = (aim[d] * lre - nre * lim) / den;
  }
  bf16x8 Bf[2][8];
  s5_make_bf(p, l, 0, g, fre[0], fim[0], Bf[0], lr, lg);
  s5_make_bf(p, l, 1, g, fre[1], fim[1], Bf[1], lr, lg);
  {
    const int d = wid & 1, r = wid >> 1;
    const float ar = d ? are[1] : are[0], ai = d ? aim[1] : aim[0];
    float sr = 0.f, si = 0.f;
    for (int ci = 0; ci < CR; ++ci) {
      const int c = r * CR + ci, k = s5_cmap(d, c);
      { float* e_ = Eb + ((size_t)(d * (NCH + 8) + c) * 64 + lane) * 2; __hip_atomic_store(e_, sr, __ATOMIC_RELAXED, __HIP_MEMORY_SCOPE_AGENT); __hip_atomic_store(e_ + 1, si, __ATOMIC_RELAXED, __HIP_MEMORY_SCOPE_AGENT); }
      const u32x4 ua = s5_load_uf(sug, k, d ? 1 : 0, lr, lg), ub = s5_load_uf(sug, k, d ? 0 : 1, lr, lg);
#pragma unroll
      for (int hh = 0; hh < 2; ++hh) {
        const u32x4 uw = hh ? ub : ua;
        __builtin_amdgcn_wave_barrier();
        if (d) s5_bu_tile(uw, Bf[1], Bsm, lr, lg); else s5_bu_tile(uw, Bf[0], Bsm, lr, lg);
        __builtin_amdgcn_wave_barrier();
        if (d) S5_SCAN(1, ar, ai, false); else S5_SCAN(0, ar, ai, false);
      }
    }
    { float* e_ = Eb + ((size_t)(d * (NCH + 8) + NCH + r) * 64 + lane) * 2; __hip_atomic_store(e_, sr, __ATOMIC_RELAXED, __HIP_MEMORY_SCOPE_AGENT); __hip_atomic_store(e_ + 1, si, __ATOMIC_RELAXED, __HIP_MEMORY_SCOPE_AGENT); }
  }
  asm volatile("s_waitcnt vmcnt(0)" ::: "memory"); __syncthreads();
  bf16x8 Cf[2][4];
  float a32r[2], a32i[2], aCRr[2], aCRi[2];
#pragma unroll
  for (int d = 0; d < 2; ++d) {
#pragma unroll
    for (int ks = 0; ks < 4; ++ks) {
      const float* src = (ks < 2 ? p.s5_cre : p.s5_cim) + ((size_t)((l * 2 + d) * 32 + g) * 16 + lr) * 64 + (ks & 1) * 32 + lg * 8;
      const f32x4 v0 = *(const f32x4*)src, v1 = *(const f32x4*)(src + 4); const float sg = ks < 2 ? 1.0f : -1.0f;
      u32x4 w; w[0] = pack2(sg * v0[0], sg * v0[1]); w[1] = pack2(sg * v0[2], sg * v0[3]); w[2] = pack2(sg * v1[0], sg * v1[1]); w[3] = pack2(sg * v1[2], sg * v1[3]);
      Cf[d][ks] = __builtin_bit_cast(bf16x8, w);
    }
    float pr = are[d], pi_ = aim[d];
#pragma unroll
    for (int q = 0; q < 5; ++q) { const float nr = pr * pr - pi_ * pi_, ni = 2.0f * pr * pi_; pr = nr; pi_ = ni; }
    a32r[d] = pr; a32i[d] = pi_;
    float rr = 1.f, ri = 0.f, br_ = pr, bi_ = pi_;
#pragma unroll
    for (int bit = 0; bit < 7; ++bit) { if ((CR >> bit) & 1) { const float nr = rr * br_ - ri * bi_, ni = rr * bi_ + ri * br_; rr = nr; ri = ni; } const float nr = br_ * br_ - bi_ * bi_, ni = 2.0f * br_ * bi_; br_ = nr; bi_ = ni; }
    aCRr[d] = rr; aCRi[d] = ri;
  }
  const f32x4 dsk = *(const f32x4*)(p.s5_d + l * 512 + g * 16 + lg * 4);
  bf16_t* gb = (bf16_t*)(ws + OFF_GB);
  for (int k = wid; k < NCH; k += NW) {
    f32x4 acc[2] = {{0.f, 0.f, 0.f, 0.f}, {0.f, 0.f, 0.f, 0.f}};
    u32x4 uq[2]; uq[0] = s5_load_uf(sug, k, 0, lr, lg); uq[1] = s5_load_uf(sug, k, 1, lr, lg);
    u32x2 us[2]; us[0] = *(const u32x2*)(sug + (size_t)(k * 32 + lr) * 16 + lg * 4); us[1] = *(const u32x2*)(sug + (size_t)(k * 32 + 16 + lr) * 16 + lg * 4);
    float s0[2][2];
#pragma unroll
    for (int d = 0; d < 2; ++d) { const float* e_ = Eb + ((size_t)(d * (NCH + 8) + s5_cmap(d, k)) * 64 + lane) * 2;
      s0[d][0] = __hip_atomic_load(e_, __ATOMIC_RELAXED, __HIP_MEMORY_SCOPE_AGENT); s0[d][1] = __hip_atomic_load(e_ + 1, __ATOMIC_RELAXED, __HIP_MEMORY_SCOPE_AGENT); }
#pragma unroll
    for (int d = 0; d < 2; ++d) {
      const int c = s5_cmap(d, k), r = c / CR, j = c - r * CR;
      const float* Ed = Eb + (size_t)d * (NCH + 8) * 128 + lane * 2;
      float tr = 0.f, ti = 0.f;
#pragma unroll
      for (int r2 = 0; r2 < NR - 1; ++r2) if (r2 < r) {
        const float er = __hip_atomic_load(Ed + (size_t)(NCH + r2) * 128, __ATOMIC_RELAXED, __HIP_MEMORY_SCOPE_AGENT), ei = __hip_atomic_load(Ed + (size_t)(NCH + r2) * 128 + 1, __ATOMIC_RELAXED, __HIP_MEMORY_SCOPE_AGENT);
        const float nr = aCRr[d] * tr - aCRi[d] * ti + er, ni = aCRr[d] * ti + aCRi[d] * tr + ei; tr = nr; ti = ni; }
      float pr = 1.f, pi_ = 0.f, br_ = a32r[d], bi_ = a32i[d];
      for (int bit = 0; bit < 7; ++bit) { if ((j >> bit) & 1) { const float nr = pr * br_ - pi_ * bi_, ni = pr * bi_ + pi_ * br_; pr = nr; pi_ = ni; } const float nr = br_ * br_ - bi_ * bi_, ni = 2.0f * br_ * bi_; br_ = nr; bi_ = ni; }
      float sr = s0[d][0] + (pr * tr - pi_ * ti), si = s0[d][1] + (pr * ti + pi_ * tr);
#pragma unroll
      for (int hh = 0; hh < 2; ++hh) {
        const int tt = d ? 1 - hh : hh;
        __builtin_amdgcn_wave_barrier();
        s5_bu_tile(uq[tt], Bf[d], Bsm, lr, lg);
        __builtin_amdgcn_wave_barrier();
        if (d) S5_SCAN(1, are[1], aim[1], true); else S5_SCAN(0, are[0], aim[0], true);
        __builtin_amdgcn_wave_barrier();
#pragma unroll
        for (int ks = 0; ks < 4; ++ks) { const bf16x8 sf = *(const bf16x8*)(Ssm + lr * SST + ks * 32 + lg * 8); acc[tt] = MFMA16(Cf[d][ks], sf, acc[tt]); }
      }
    }
#pragma unroll
    for (int tt = 0; tt < 2; ++tt) { const int row = s5_row(b, k, tt * 16 + lr);
      f32x4 u; u[0] = __uint_as_float(us[tt][0] << 16); u[1] = __uint_as_float(us[tt][0] & 0xffff0000u); u[2] = __uint_as_float(us[tt][1] << 16); u[3] = __uint_as_float(us[tt][1] & 0xffff0000u);
      float y[4];
#pragma unroll
      for (int j = 0; j < 4; ++j) y[j] = gelu_tanh(acc[tt][j] + u[j] * dsk[j]);
      u32x2 o; o[0] = pack2(y[0], y[1]); o[1] = pack2(y[2], y[3]); *(u32x2*)(gb + (size_t)row * 512 + g * 16 + lg * 4) = o; }
  }
}

DI void mixer_phase(const Params& p, int l, unsigned char* smem) {
  const bool need_ctx = l < DEPTH - 1;
  volatile int* smw = (volatile int*)(smem + SMEM_BYTES - 16);
  constexpr int QL = SEQ / QU, QC = CTX / QU, QLD = SEQ / QUD, QCD = CTX / QUD;
  const int n_s5 = 16, n_dl = 2 * QLD, n_dc = need_ctx ? 2 * QCD : 0, n_wl = 4 * QL, n_wc = need_ctx ? 4 * QC : 0;
  const int total = n_dl + n_s5 + n_dc + n_wl + n_wc;
  const int x0 = get_bid() & 7;
  for (int dx = 0; dx < 8; ++dx) {
    const int xq = (x0 + dx) & 7;
    unsigned* ctr = (unsigned*)(p.ws + OFF_LAM) + 16 + l * 8 + xq;
    for (;;) {
      __syncthreads();
      if (get_tid() == 0) *smw = (int)atomicAdd(ctr, 1u);
      __syncthreads();
      int u = *smw;
      u = __builtin_amdgcn_readfirstlane(u);
      if (u >= total) break;
      int type, bq, hd, qi; bool is_lat = true;
      if (u < n_s5) { const int idx = xq * 16 + u; type = 1; bq = idx >> 5; hd = idx & 31; qi = 0; }
      else if ((u -= n_s5) < n_dl) { const int gidx = xq + 8 * (u / QLD); type = 0; bq = gidx >> 2; hd = gidx & 3; qi = u % QLD; }
      else if ((u -= n_dl) < n_dc) { const int gidx = xq + 8 * (u / QCD); type = 0; is_lat = false; bq = gidx >> 2; hd = gidx & 3; qi = u % QCD; }
      else if ((u -= n_dc) < n_wl) { type = 2; bq = xq >> 1; hd = (xq & 1) * 4 + (u & 3); qi = u >> 2; }
      else { u -= n_wl; type = 2; is_lat = false; bq = xq >> 1; hd = (xq & 1) * 4 + (u & 3); qi = u >> 2; }
      if (type == 0) diff_unit(p, l, bq, hd, is_lat, qi, smem);
      else if (type == 1) s5_unit(p, l, bq, hd, smem);
      else win_unit(p, l, bq, hd, is_lat, qi, smem);
    }
  }
}

#define EPI_LOOP_BEGIN { const int tid_ = get_tid(), lane_ = tid_ & 63, wid_ = tid_ >> 6, wr_ = wid_ >> 1, wc_ = wid_ & 1, lr_ = lane_ & 15, lg_ = lane_ >> 4; \
  _Pragma("unroll") for (int mi = 0; mi < 4; ++mi) { const int row = m0 + wr_ * 64 + mi * 16 + lr_; \
  _Pragma("unroll") for (int ni = 0; ni < 4; ++ni) { const int col = n0 + wc_ * 64 + ni * 16 + lg_ * 4;
#define EPI_LOOP_END } } }

DI void glu_phase(const Params& p, int MT, unsigned char* smem) {
  bf16_t* As = (bf16_t*)smem; bf16_t* Bs = As + 128 * LDT;
  const bf16_t* G = (const bf16_t*)(p.ws + OFF_GB); const bf16_t* W = (const bf16_t*)(p.ws + OFF_W_GLU); bf16_t* ys = (bf16_t*)(p.ws + OFF_YS);
  constexpr int NT = 4;
  for (int t = get_bid(); t < MT * NT; t += gridDim.x) {
    const int m0 = (t / NT) * 128, n0 = (t % NT) * 128;
    f32x4 acc[4][4]; zero_acc(acc);
    gemm_mainloop(acc, G + (size_t)m0 * 512, 512, W + (size_t)n0 * 512, 512, 512, As, Bs);
    EPI_LOOP_BEGIN
      const u32x2 gr = *(const u32x2*)(G + (size_t)row * 512 + col);
      const float g0 = __uint_as_float(gr[0] << 16), g1 = __uint_as_float(gr[0] & 0xffff0000u), g2 = __uint_as_float(gr[1] << 16), g3 = __uint_as_float(gr[1] & 0xffff0000u);
      u32x2 o; o[0] = pack2(g0 * sigmoidf_(acc[mi][ni][0]), g1 * sigmoidf_(acc[mi][ni][1])); o[1] = pack2(g2 * sigmoidf_(acc[mi][ni][2]), g3 * sigmoidf_(acc[mi][ni][3]));
      *(u32x2*)(ys + (size_t)row * 512 + col) = o;
    EPI_LOOP_END
  }
}
DI void merge_phase(const Params& p, int MT, unsigned char* smem) {
  bf16_t* As = (bf16_t*)smem; bf16_t* Bs = As + 128 * LDT;
  const bf16_t* gt = (const bf16_t*)(p.ws + OFF_GATES); bf16_t* mo = (bf16_t*)(p.ws + OFF_M);
  constexpr int NT = 8;
  for (int t = get_bid(); t < MT * NT; t += gridDim.x) {
    const int m0 = (t / NT) * 128, n0 = (t % NT) * 128;
    f32x4 acc[4][4]; zero_acc(acc);
#pragma unroll 1
    for (int br = 0; br < 3; ++br) {
      const bf16_t* Y = (const bf16_t*)(p.ws + (br == 0 ? OFF_YD : br == 1 ? OFF_YS : OFF_YW));
      const bf16_t* W = (const bf16_t*)(p.ws + (br == 0 ? OFF_W_PD : br == 1 ? OFF_W_PS : OFF_W_PW));
      gemm_mainloop(acc, Y + (size_t)m0 * 512, 512, W + (size_t)n0 * 512, 512, 512, As, Bs);
      if (br < 2) {
        EPI_LOOP_BEGIN
          const f32x4 g0 = ld_bf4(gt + (size_t)row * 3072 + br * 1024 + col), g1 = ld_bf4(gt + (size_t)row * 3072 + (br + 1) * 1024 + col);
#pragma unroll
          for (int j = 0; j < 4; ++j) acc[mi][ni][j] *= fmaxf(g0[j], 1e-30f) / fmaxf(g1[j], 1e-30f);
        EPI_LOOP_END
      } else {
        EPI_LOOP_BEGIN
          const f32x4 g2 = ld_bf4(gt + (size_t)row * 3072 + 2048 + col);
          u32x2 o; o[0] = pack2(acc[mi][ni][0] * fmaxf(g2[0], 1e-30f), acc[mi][ni][1] * fmaxf(g2[1], 1e-30f)); o[1] = pack2(acc[mi][ni][2] * fmaxf(g2[2], 1e-30f), acc[mi][ni][3] * fmaxf(g2[3], 1e-30f));
          *(u32x2*)(mo + (size_t)row * D + col) = o;
        EPI_LOOP_END
      }
    }
  }
}
DI void resid_phase(const Params& p, int l, const bf16_t* A, int K, const bf16_t* W, int gate_off, float* dst, int MT, unsigned char* smem) {
  bf16_t* As = (bf16_t*)smem; bf16_t* Bs = As + 128 * LDT;
  const float* h = (const float*)(p.ws + OFF_H);
  const float* modv = (const float*)(p.ws + OFF_MODV) + (size_t)l * 5 * 6144;
  constexpr int NT = 8;
  for (int t = get_bid(); t < MT * NT; t += gridDim.x) {
    const int m0 = (t / NT) * 128, n0 = (t % NT) * 128;
    f32x4 acc[4][4]; zero_acc(acc);
    gemm_mainloop(acc, A + (size_t)m0 * K, K, W + (size_t)n0 * K, K, K, As, Bs);
    const int bb = m0 < NLAT ? m0 / SEQ : 4;
    EPI_LOOP_BEGIN
      const f32x4 gv = *(const f32x4*)(modv + bb * 6144 + gate_off + col);
      const f32x4 hv = *(const f32x4*)(h + (size_t)row * D + col);
      *(f32x4*)(dst + (size_t)row * D + col) = hv + gv * acc[mi][ni];
    EPI_LOOP_END
  }
}
DI void ff1_phase(const Params& p, int MT, unsigned char* smem) {
  bf16_t* As = (bf16_t*)smem; bf16_t* Bs = As + 128 * LDT;
  const bf16_t* A = (const bf16_t*)(p.ws + OFF_ABUF); const bf16_t* W = (const bf16_t*)(p.ws + OFF_W_FF1); bf16_t* uo = (bf16_t*)(p.ws + OFF_U);
  constexpr int NT = DFF / 128;
  for (int t = get_bid(); t < MT * NT; t += gridDim.x) {
    const int m0 = (t / NT) * 128, n0 = (t % NT) * 128;
    f32x4 acc[4][4]; zero_acc(acc);
    gemm_mainloop(acc, A + (size_t)m0 * D, D, W + (size_t)n0 * D, D, D, As, Bs);
    EPI_LOOP_BEGIN
      float r[4];
#pragma unroll
      for (int j = 0; j < 4; ++j) { const float v = fmaxf(acc[mi][ni][j], 0.f); r[j] = v * v; }
      u32x2 o; o[0] = pack2(r[0], r[1]); o[1] = pack2(r[2], r[3]); *(u32x2*)(uo + (size_t)row * DFF + col) = o;
    EPI_LOOP_END
  }
}

#define XB_TMO      128
#define XB_XCNT(j)  (256  + 64 * (j))
#define XB_XSUB(j)  (1280 + 64 * (j))
#define XB_XGEN(j)  (2304 + 64 * (j))
#define XB_TOP      3328
#define XB_TOPGEN   3392
#define XCD_BAR_WORDS 3456
#define XB_SPIN_CAP (1u << 18)
#define XLAS __attribute__((address_space(3)))

__device__ __forceinline__ unsigned xb_ld(unsigned* p)              { return __hip_atomic_load(p, __ATOMIC_RELAXED, __HIP_MEMORY_SCOPE_AGENT); }
__device__ __forceinline__ unsigned xb_add(unsigned* p, unsigned v) { return __hip_atomic_fetch_add(p, v, __ATOMIC_RELAXED, __HIP_MEMORY_SCOPE_AGENT); }
__device__ __forceinline__ unsigned xb_xcc_id() { return (unsigned)__builtin_amdgcn_s_getreg((3 << 11) | 20) & 0xFu; }
#define XB_SPIN(cond, bar) do { unsigned _sp = 0; while (cond) { __builtin_amdgcn_s_sleep(1); \
    if ((++_sp & 255u) == 0u) { if (xb_ld(&(bar)[XB_TMO])) break; if (_sp > XB_SPIN_CAP) { atomicAdd(&(bar)[XB_TMO], 1u); break; } } } } while (0)

struct XcdBarrier {
    unsigned* bar; unsigned x;
    volatile XLAS unsigned* st;
};

__device__ __forceinline__ XcdBarrier xcd_barrier_post(unsigned* bar, volatile XLAS unsigned* st) {
    XcdBarrier b; b.bar = bar; b.x = xb_xcc_id(); b.st = st;
    if (threadIdx.x == 0) (void)xb_add(&bar[XB_XCNT(b.x)], 1u);
    return b;
}
__device__ __forceinline__ void xcd_barrier_complete(unsigned* bar, unsigned x, unsigned& nloc, unsigned& nx) {
    const unsigned G = gridDim.x * gridDim.y * gridDim.z;
    unsigned sum, cnt, mine, sp = 0u;
    for (;;) {
        sum = 0u; cnt = 0u; mine = 0u;
#pragma unroll
        for (unsigned j = 0; j < 16; ++j) { const unsigned c = xb_ld(&bar[XB_XCNT(j)]); sum += c; cnt += (c > 0u) ? 1u : 0u; mine = (j == x) ? c : mine; }
        if (sum == G) break;
        __builtin_amdgcn_s_sleep(1);
        if ((++sp & 255u) == 0u) { if (xb_ld(&bar[XB_TMO])) break; if (sp > XB_SPIN_CAP) { atomicAdd(&bar[XB_TMO], 1u); break; } }
    }
    nloc = mine > 0u ? mine : 1u; nx = cnt > 0u ? cnt : 1u;
}

__device__ __forceinline__ void xcd_barrier(const XcdBarrier& b) {
    asm volatile("s_waitcnt vmcnt(0)" ::: "memory");
    __syncthreads();
    if (threadIdx.x == 0) {
        unsigned* bar = b.bar;
        __builtin_amdgcn_s_waitcnt(0);
        unsigned nloc = b.st[0], nx = b.st[1];
        if (nloc == 0u) { xcd_barrier_complete(bar, b.x, nloc, nx); b.st[0] = nloc; b.st[1] = nx; }
        const unsigned old = xb_add(&bar[XB_XSUB(b.x)], 1u);
        const unsigned gen = old / nloc;
        if (old + 1u == (gen + 1u) * nloc) {
            __builtin_amdgcn_fence(__ATOMIC_RELEASE, "agent");
            asm volatile("s_waitcnt vmcnt(0)" ::: "memory");
            const unsigned og = xb_add(&bar[XB_TOP], 1u);
            const unsigned tg = og / nx;
            if (og + 1u == (tg + 1u) * nx) xb_add(&bar[XB_TOPGEN], 1u);
            else XB_SPIN(xb_ld(&bar[XB_TOPGEN]) == tg, bar);
            __builtin_amdgcn_fence(__ATOMIC_ACQUIRE, "agent");
            xb_add(&bar[XB_XGEN(b.x)], 1u);
            asm volatile("s_waitcnt vmcnt(0)" ::: "memory");
        } else {
            XB_SPIN(xb_ld(&bar[XB_XGEN(b.x)]) == gen, bar);
            __builtin_amdgcn_fence(__ATOMIC_ACQUIRE, "agent");
            asm volatile("s_waitcnt vmcnt(0)" ::: "memory");
        }
    }
    __syncthreads();
}


__global__ void __launch_bounds__(256, 2) fwd_megakernel(Params p) {
  __shared__ __attribute__((aligned(16))) unsigned char smem[SMEM_BYTES];
  __shared__ uint4 xb_words;
  cg::grid_group grid = cg::this_grid();
  unsigned char* ws = p.ws;
  if (threadIdx.x == 0) xb_words = make_uint4(0u, 0u, 0u, 0u);
  __syncthreads();
  const XcdBarrier xb = xcd_barrier_post((unsigned*)(ws + OFF_BAR), (volatile XLAS unsigned*)&xb_words);
  phase0_misc(p, smem);
  __syncthreads();
  convert_layer(p, 0, smem);
  if (p.ws == nullptr) grid.sync();
  for (int l = 0; l < DEPTH; ++l) {
    const bool need_ctx = l < DEPTH - 1;
    const int MT = need_ctx ? NTOK / 128 : NLAT / 128;
    xcd_barrier(xb);
    if (l > 0) convert_layer(p, l, smem);
    norm_phase(p, l, p.norm1_g + l * D, 0, 1024, NTOK);
    xcd_barrier(xb);
    inproj_phase(p, l, smem);
    xcd_barrier(xb);
    mixer_phase(p, l, smem);
    xcd_barrier(xb);
    glu_phase(p, MT, smem);
    xcd_barrier(xb);
    merge_phase(p, MT, smem);
    xcd_barrier(xb);
    resid_phase(p, l, (const bf16_t*)(ws + OFF_M), D, (const bf16_t*)(ws + OFF_W_OUT), 2048, (float*)(ws + OFF_H), MT, smem);
    xcd_barrier(xb);
    norm_phase(p, l, p.norm2_g + l * D, 3072, 4096, MT * 128);
    xcd_barrier(xb);
    ff1_phase(p, MT, smem);
    xcd_barrier(xb);
    resid_phase(p, l, (const bf16_t*)(ws + OFF_U), DFF, (const bf16_t*)(ws + OFF_W_FF2), 5120, need_ctx ? (float*)(ws + OFF_H) : p.out, MT, smem);
  }
}

extern "C" void kernel_launch(void* const* d_in, const int* in_sizes, int n_in, void* d_out, int out_size, void* d_ws, size_t ws_size, hipStream_t stream) {
  static int grid_blocks = 0;
  if (!grid_blocks) {
    int dev = 0, cus = 0, per_cu = 0;
    (void)hipGetDevice(&dev);
    (void)hipDeviceGetAttribute(&cus, hipDeviceAttributeMultiprocessorCount, dev);
    (void)hipOccupancyMaxActiveBlocksPerMultiprocessor(&per_cu, fwd_megakernel, 256, 0);
    if (per_cu > 2) per_cu = 2;
    if (per_cu < 1) per_cu = 1;
    grid_blocks = cus * per_cu;
  }
  if (ws_size < WS_NEED) { fprintf(stderr, "workspace too small: %zu < %zu\n", ws_size, (size_t)WS_NEED); return; }
  (void)hipMemsetAsync((unsigned char*)d_ws + OFF_BAR, 0, BAR_BYTES, stream);
  Params p{};
  const float* const* in = (const float* const*)d_in;
  p.x = in[0]; p.c = in[1]; p.ctx = in[2]; p.c_ctx = in[3]; p.w_mod = in[4]; p.b_mod = in[5]; p.norm1_g = in[6]; p.norm2_g = in[7]; p.w_in = in[8];
  p.dq_g = in[9]; p.dk_g = in[10]; p.lq1 = in[11]; p.lk1 = in[12]; p.lq2 = in[13]; p.lk2 = in[14]; p.dout_g = in[15];
  p.s5_lre = in[16]; p.s5_lim = in[17]; p.s5_ldt = in[18]; p.s5_bre = in[19]; p.s5_bim = in[20]; p.s5_cre = in[21]; p.s5_cim = in[22]; p.s5_d = in[23]; p.s5_wglu = in[24];
  p.wq_g = in[25]; p.wk_g = in[26]; p.w_sink = in[27];
  p.w_pd = in[28]; p.w_ps = in[29]; p.w_pw = in[30]; p.w_out = in[31]; p.w_ff1 = in[32]; p.w_ff2 = in[33];
  p.out = (float*)d_out; p.ws = (unsigned char*)d_ws;
  void* args[] = {&p};
  hipError_t e = hipLaunchCooperativeKernel((void*)fwd_megakernel, dim3(grid_blocks), dim3(256), args, 0, stream);
  if (e != hipSuccess) fprintf(stderr, "cooperative launch failed: %s (grid %d)\n", hipGetErrorString(e), grid_blocks);
}
```

```cpp
#include <hip/hip_runtime.h>
#include <hip/hip_cooperative_groups.h>
#include <cstdio>
#include <cstdint>
namespace cg = cooperative_groups;

typedef unsigned short bf16_t;
typedef short bf16x8 __attribute__((ext_vector_type(8)));
typedef short bf16x4 __attribute__((ext_vector_type(4)));
typedef float f32x4 __attribute__((ext_vector_type(4)));
typedef float f32x2 __attribute__((ext_vector_type(2)));
typedef unsigned u32x4 __attribute__((ext_vector_type(4)));
typedef unsigned u32x2 __attribute__((ext_vector_type(2)));
typedef __bf16 bf2_t __attribute__((ext_vector_type(2)));

#define DI __device__ __forceinline__
#define MFMA16(a, b, c) __builtin_amdgcn_mfma_f32_16x16x32_bf16((a), (b), (c), 0, 0, 0)

constexpr int D = 1024, NB = 4, SEQ = 4096, DEPTH = 4, CTX = 256, POS = CTX + SEQ  ;
constexpr int NLAT = NB * SEQ  , NCTX = NB * CTX  , NTOK = NLAT + NCTX  ;
constexpr int DIN = 5888, DFF = 4096;
constexpr float EPS = 1e-6f;
constexpr float LOG2E = 1.4426950408889634f;
constexpr int NCH = POS / 32;

constexpr size_t SZ_W_IN = (size_t)DIN * D * 2, SZ_W_GLU = 512 * 512 * 2, SZ_W_P = 1024 * 512 * 2, SZ_W_OUT = (size_t)D * D * 2, SZ_W_FF = (size_t)D * DFF * 2;
constexpr size_t OFF_W_IN = 0;
constexpr size_t OFF_W_GLU = OFF_W_IN + SZ_W_IN;
constexpr size_t OFF_W_PD = OFF_W_GLU + SZ_W_GLU;
constexpr size_t OFF_W_PS = OFF_W_PD + SZ_W_P;
constexpr size_t OFF_W_PW = OFF_W_PS + SZ_W_P;
constexpr size_t OFF_W_OUT = OFF_W_PW + SZ_W_P;
constexpr size_t OFF_W_FF1 = OFF_W_OUT + SZ_W_OUT;
constexpr size_t OFF_W_FF2 = OFF_W_FF1 + SZ_W_FF;
constexpr size_t OFF_MODV = OFF_W_FF2 + SZ_W_FF;
constexpr size_t OFF_ROPE = OFF_MODV + (size_t)DEPTH * 5 * 6144 * 4;
constexpr size_t OFF_LAM = OFF_ROPE + 8192;
constexpr size_t OFF_H = OFF_LAM + 256;
constexpr size_t OFF_ABUF = OFF_H + (size_t)NTOK * D * 4;
constexpr size_t OFF_R1 = OFF_ABUF + (size_t)NTOK * D * 2;
constexpr size_t SZ_HEADBUF = (size_t)NB * 8 * POS * 64 * 2;
constexpr size_t OFF_QD = OFF_R1;
constexpr size_t OFF_KD = OFF_QD + SZ_HEADBUF;
constexpr size_t OFF_VDT = OFF_KD + SZ_HEADBUF;
constexpr size_t OFF_SU = OFF_VDT + SZ_HEADBUF;
constexpr size_t OFF_QW = OFF_SU + (size_t)NTOK * 512 * 2;
constexpr size_t OFF_KW = OFF_QW + SZ_HEADBUF;
constexpr size_t OFF_VWT = OFF_KW + SZ_HEADBUF / 4;
constexpr size_t OFF_GATES = OFF_VWT + SZ_HEADBUF / 4;
constexpr size_t OFF_YD = OFF_GATES + (size_t)NTOK * 3072 * 2;
constexpr size_t OFF_YS = OFF_YD + (size_t)NTOK * 512 * 2;
constexpr size_t OFF_YW = OFF_YS + (size_t)NTOK * 512 * 2;
constexpr size_t OFF_GB = OFF_YW + (size_t)NTOK * 512 * 2;
constexpr size_t OFF_EB = OFF_GB + (size_t)NTOK * 512 * 2;
constexpr size_t OFF_END = OFF_EB + (size_t)NB * 32 * 2 * (NCH + 8) * 64 * 8;
constexpr size_t OFF_BAR = OFF_END;
constexpr size_t BAR_BYTES = 16384;
constexpr size_t WS_NEED = OFF_BAR + BAR_BYTES;
constexpr size_t OFF_M = OFF_QD;
constexpr size_t OFF_U = OFF_R1;
static_assert((size_t)NTOK * DFF * 2 <= OFF_END - OFF_R1, "u alias");

struct Params {
  const float *x, *c, *ctx, *c_ctx, *w_mod, *b_mod, *norm1_g, *norm2_g, *w_in;
  const float *dq_g, *dk_g, *lq1, *lk1, *lq2, *lk2, *dout_g;
  const float *s5_lre, *s5_lim, *s5_ldt, *s5_bre, *s5_bim, *s5_cre, *s5_cim, *s5_d, *s5_wglu;
  const float *wq_g, *wk_g, *w_sink;
  const float *w_pd, *w_ps, *w_pw, *w_out, *w_ff1, *w_ff2;
  float* out;
  unsigned char* ws;
};

DI int get_tid() { int t = threadIdx.x; asm volatile("" : "+v"(t)); return t; }
DI int get_bid() { int b = blockIdx.x; asm volatile("" : "+s"(b)); return b; }
DI unsigned pack2(float lo, float hi) { f32x2 v = {lo, hi}; bf2_t r = __builtin_convertvector(v, bf2_t); return __builtin_bit_cast(unsigned, r); }
DI float sigmoidf_(float x) { return 1.0f / (1.0f + __expf(-x)); }
DI float gelu_tanh(float x) { const float z = 0.7978845608028654f * (x + 0.044715f * x * x * x); const float e = __expf(2.0f * z); const float t = 1.0f - 2.0f / (e + 1.0f); return 0.5f * x * (1.0f + t); }
DI f32x4 ld_bf4(const bf16_t* p_) { const u32x2 r = *(const u32x2*)p_; f32x4 v; v[0] = __uint_as_float(r[0] << 16); v[1] = __uint_as_float(r[0] & 0xffff0000u); v[2] = __uint_as_float(r[1] << 16); v[3] = __uint_as_float(r[1] & 0xffff0000u); return v; }
DI float xshfl(float v, int m) { return __shfl_xor(v, m, 64); }

constexpr int SMEM_BYTES = 65552;
constexpr int LDT = 72;

DI u32x4 gload_async(const void* ptr) { u32x4 r; asm volatile("global_load_dwordx4 %0, %1, off" : "=v"(r) : "v"(ptr) : "memory"); return r; }
#define VM_WAIT8(N, R, Q) asm volatile("s_waitcnt vmcnt(" #N ")" : "+v"(R[0]), "+v"(R[1]), "+v"(R[2]), "+v"(R[3]), "+v"(Q[0]), "+v"(Q[1]), "+v"(Q[2]), "+v"(Q[3]) :: "memory")
DI void gemm_mainloop(f32x4 (&acc)[4][4], const bf16_t* __restrict__ A, int lda, const bf16_t* __restrict__ B, int ldb, int K, bf16_t* As, bf16_t* Bs) {
  const int tid = get_tid(), lane = tid & 63, wid = tid >> 6, wr = wid >> 1, wc = wid & 1, lr = lane & 15, lg = lane >> 4;
  const int crow = tid >> 3, ckc = (tid & 7) * 8;
  constexpr int TB = 128 * 64;
  const int swc = (((tid & 7) ^ (crow & 7)) * 8);
  u32x4 ra0[4], rb0[4], ra1[4], rb1[4];
  const bf16_t* Ap = A + (size_t)crow * lda + ckc; const bf16_t* Bp = B + (size_t)crow * ldb + ckc;
#define GM_LOAD(RA, RB, KOFF) do { _Pragma("unroll") for (int i = 0; i < 4; ++i) { RA[i] = gload_async(Ap + (size_t)(i * 32) * lda + (KOFF)); RB[i] = gload_async(Bp + (size_t)(i * 32) * ldb + (KOFF)); } } while (0)
#define GM_STORE(RA, RB, BUF) do { _Pragma("unroll") for (int i = 0; i < 4; ++i) { *(u32x4*)(As + (BUF) * 2 * TB + (crow + i * 32) * 64 + swc) = RA[i]; *(u32x4*)(As + (BUF) * 2 * TB + TB + (crow + i * 32) * 64 + swc) = RB[i]; } } while (0)
#define GM_COMPUTE(BUF) do { const bf16_t* as_ = As + (BUF) * 2 * TB; const bf16_t* bs_ = as_ + TB; \
    _Pragma("unroll") for (int ks = 0; ks < 2; ++ks) { bf16x8 af[4], bfr[4]; const int co_ = ((ks * 4 + lg) ^ (lr & 7)) * 8; \
      _Pragma("unroll") for (int mi = 0; mi < 4; ++mi) af[mi] = *(const bf16x8*)(as_ + (wr * 64 + mi * 16 + lr) * 64 + co_); \
      _Pragma("unroll") for (int ni = 0; ni < 4; ++ni) bfr[ni] = *(const bf16x8*)(bs_ + (wc * 64 + ni * 16 + lr) * 64 + co_); \
      _Pragma("unroll") for (int mi = 0; mi < 4; ++mi) _Pragma("unroll") for (int ni = 0; ni < 4; ++ni) acc[mi][ni] = MFMA16(bfr[ni], af[mi], acc[mi][ni]); } } while (0)
  asm volatile("s_waitcnt vmcnt(0)" ::: "memory");
  GM_LOAD(ra0, rb0, 0); GM_LOAD(ra1, rb1, 64);
  __syncthreads();
  VM_WAIT8(8, ra0, rb0); GM_STORE(ra0, rb0, 0); GM_LOAD(ra0, rb0, (128 < K ? 128 : 0));
  __syncthreads();
  for (int k0 = 0; k0 < K; k0 += 128) {
    const int kn1 = k0 + 192 < K ? k0 + 192 : 0, kn0 = k0 + 256 < K ? k0 + 256 : 0;
    VM_WAIT8(8, ra1, rb1); GM_STORE(ra1, rb1, 1); GM_LOAD(ra1, rb1, kn1);
    GM_COMPUTE(0); __syncthreads();
    VM_WAIT8(8, ra0, rb0); GM_STORE(ra0, rb0, 0); GM_LOAD(ra0, rb0, kn0);
    GM_COMPUTE(1); __syncthreads();
  }
  VM_WAIT8(0, ra0, rb0); VM_WAIT8(0, ra1, rb1);
#undef GM_LOAD
#undef GM_STORE
#undef GM_COMPUTE
}
DI void zero_acc(f32x4 (&acc)[4][4]) {
#pragma unroll
  for (int mi = 0; mi < 4; ++mi)
#pragma unroll
    for (int ni = 0; ni < 4; ++ni) acc[mi][ni] = (f32x4){0.f, 0.f, 0.f, 0.f};
}

DI void convert_tile(const float* __restrict__ src, int K, int N, bf16_t* __restrict__ dst, int kt, int nt, float* tile) {
  const int tid = get_tid();
  { const int r = tid >> 4, c4 = (tid & 15) * 4;
#pragma unroll
    for (int i = 0; i < 4; ++i) { const int k = r + i * 16; const f32x4 v = *(const f32x4*)(src + (size_t)(kt * 64 + k) * N + nt * 64 + c4);
      tile[k * 65 + c4 + 0] = v[0]; tile[k * 65 + c4 + 1] = v[1]; tile[k * 65 + c4 + 2] = v[2]; tile[k * 65 + c4 + 3] = v[3]; } }
  __syncthreads();
  { const int n = tid >> 2, kc = (tid & 3) * 16; u32x4 o0, o1;
#pragma unroll
    for (int q = 0; q < 4; ++q) { o0[q] = pack2(tile[(kc + 2 * q) * 65 + n], tile[(kc + 2 * q + 1) * 65 + n]); o1[q] = pack2(tile[(kc + 8 + 2 * q) * 65 + n], tile[(kc + 8 + 2 * q + 1) * 65 + n]); }
    bf16_t* d = dst + (size_t)(nt * 64 + n) * K + kt * 64 + kc; *(u32x4*)d = o0; *(u32x4*)(d + 8) = o1; }
  __syncthreads();
}
DI void convert_item(const Params& p, int l, int t, float* tile) {
  unsigned char* ws = p.ws;
  const float* src; bf16_t* dst; int K, N, idx;
  if (t < 1472) { idx = t; src = p.w_in + (size_t)l * D * DIN; K = D; N = DIN; dst = (bf16_t*)(ws + OFF_W_IN); }
  else if (t < 1536) { idx = t - 1472; src = p.s5_wglu + (size_t)l * 512 * 512; K = 512; N = 512; dst = (bf16_t*)(ws + OFF_W_GLU); }
  else if (t < 1664) { idx = t - 1536; src = p.w_pd + (size_t)l * 512 * D; K = 512; N = D; dst = (bf16_t*)(ws + OFF_W_PD); }
  else if (t < 1792) { idx = t - 1664; src = p.w_ps + (size_t)l * 512 * D; K = 512; N = D; dst = (bf16_t*)(ws + OFF_W_PS); }
  else if (t < 1920) { idx = t - 1792; src = p.w_pw + (size_t)l * 512 * D; K = 512; N = D; dst = (bf16_t*)(ws + OFF_W_PW); }
  else if (t < 2176) { idx = t - 1920; src = p.w_out + (size_t)l * D * D; K = D; N = D; dst = (bf16_t*)(ws + OFF_W_OUT); }
  else if (t < 3200) { idx = t - 2176; src = p.w_ff1 + (size_t)l * D * DFF; K = D; N = DFF; dst = (bf16_t*)(ws + OFF_W_FF1); }
  else { idx = t - 3200; src = p.w_ff2 + (size_t)l * DFF * D; K = DFF; N = D; dst = (bf16_t*)(ws + OFF_W_FF2); }
  const int nts = N / 64; convert_tile(src, K, N, dst, idx / nts, idx % nts, tile);
}
constexpr int CONV_EARLY = 3200, CONV_ALL = 4224;
DI void convert_layer(const Params& p, int l, int t_begin, unsigned char* smem) {
  float* tile = (float*)smem;
  for (int t = t_begin + get_bid(); t < CONV_ALL; t += gridDim.x) convert_item(p, l, t, tile);
}
DI void convert_steal(const Params& p, int l, unsigned char* smem) {
  float* tile = (float*)smem;
  volatile int* smw = (volatile int*)(smem + SMEM_BYTES - 16);
  unsigned* ctr = (unsigned*)(p.ws + OFF_LAM) + 48 + l;
  for (;;) {
    __syncthreads();
    if (get_tid() == 0) *smw = (int)atomicAdd(ctr, 1u);
    __syncthreads();
    int t = *smw; t = __builtin_amdgcn_readfirstlane(t);
    if (t >= CONV_EARLY) break;
    convert_item(p, l, t, tile);
  }
}

DI void phase0_misc(const Params& p, unsigned char* smem) {
  unsigned char* ws = p.ws;
  const int tid = get_tid();
  if (get_bid() == 0) {
    float* rope = (float*)(ws + OFF_ROPE);
    for (int i = tid; i < 1024; i += 256) { const int pos = i >> 4, f = i & 15; const float inv = powf(10000.0f, -(float)f / 16.0f); const float ang = (float)pos * inv; rope[i] = cosf(ang); rope[1024 + i] = sinf(ang); }
    if (tid < DEPTH) { const int l = tid; float s1 = 0.f, s2 = 0.f;
      for (int i = 0; i < 64; ++i) { s1 += p.lq1[l * 64 + i] * p.lk1[l * 64 + i]; s2 += p.lq2[l * 64 + i] * p.lk2[l * 64 + i]; }
      const float lam_init = 0.8f - 0.6f * expf(-0.3f * (float)l);
      ((float*)(ws + OFF_LAM))[l] = expf(s1) - expf(s2) + lam_init; }
    if (tid >= 64 && tid < 64 + DEPTH) { const int l = tid - 64; float a = 0.f, b2 = 0.f, c2 = 0.f, d2 = 0.f;
      for (int i = 0; i < 64; ++i) { a = fmaxf(a, fabsf(p.dq_g[l * 64 + i])); b2 = fmaxf(b2, fabsf(p.dk_g[l * 64 + i])); c2 = fmaxf(c2, fabsf(p.wq_g[l * 64 + i])); d2 = fmaxf(d2, fabsf(p.wk_g[l * 64 + i])); }
      ((float*)(ws + OFF_LAM))[4 + l] = 8.0f * LOG2E * 1.02f * a * b2;
      ((float*)(ws + OFF_LAM))[8 + l] = 8.0f * LOG2E * 1.02f * c2 * d2;
      for (int i = 0; i < 8; ++i) ((unsigned*)(ws + OFF_LAM))[16 + l * 8 + i] = 0u;
      ((unsigned*)(ws + OFF_LAM))[48 + l] = 0u; }
  }
  float* sc = (float*)smem;
  float* red = sc + 5 * 1024;
  for (int i = tid; i < 5 * 1024; i += 256) { const int bb = i >> 10, k = i & 1023; const float v = bb < 4 ? p.c[bb * 1024 + k] : p.c_ctx[k]; sc[i] = v / (1.0f + __expf(-v)); }
  __syncthreads();
  float* modv = (float*)(ws + OFF_MODV);
  for (int t = get_bid(); t < DEPTH * 96; t += gridDim.x) {
    const int l = t / 96, cb = t % 96, kq = tid >> 6, cl = tid & 63, col = cb * 64 + cl;
    const float* w = p.w_mod + (size_t)l * D * 6144 + col;
    float s[5] = {0.f, 0.f, 0.f, 0.f, 0.f};
    for (int k = kq * 256; k < kq * 256 + 256; ++k) { const float wv = w[(size_t)k * 6144];
#pragma unroll
      for (int bb = 0; bb < 5; ++bb) s[bb] += sc[bb * 1024 + k] * wv; }
#pragma unroll
    for (int bb = 0; bb < 5; ++bb) red[(kq * 5 + bb) * 64 + cl] = s[bb];
    __syncthreads();
    for (int i = tid; i < 5 * 64; i += 256) { const int bb = i >> 6, c2 = i & 63; const float v = red[(0 * 5 + bb) * 64 + c2] + red[(1 * 5 + bb) * 64 + c2] + red[(2 * 5 + bb) * 64 + c2] + red[(3 * 5 + bb) * 64 + c2];
      modv[((size_t)l * 5 + bb) * 6144 + cb * 64 + c2] = v + p.b_mod[l * 6144 + cb * 64 + c2]; }
    __syncthreads();
  }
}

DI void norm_phase(const Params& p, int l, const float* gvec, int sh_off, int sc_off, int nrows, bool first = false) {
  const int tid = get_tid(), lane = tid & 63, wid = tid >> 6;
  const float* h = (const float*)(p.ws + OFF_H); bf16_t* out = (bf16_t*)(p.ws + OFF_ABUF);
  const float* modv = (const float*)(p.ws + OFF_MODV) + (size_t)l * 5 * 6144;
  for (int t = get_bid(); t < nrows / 4; t += gridDim.x) {
    const int row = t * 4 + wid; const int bb = row < NLAT ? row / SEQ : 4;
    const float* hr = first ? (row < NLAT ? p.x + (size_t)row * D : p.ctx + (size_t)(row - NLAT) * D) : h + (size_t)row * D; const float* mv = modv + bb * 6144;
    f32x4 v[4]; float ss = 0.f;
#pragma unroll
    for (int it = 0; it < 4; ++it) { v[it] = *(const f32x4*)(hr + it * 256 + lane * 4); ss += v[it][0] * v[it][0] + v[it][1] * v[it][1] + v[it][2] * v[it][2] + v[it][3] * v[it][3]; }
#pragma unroll
    for (int m = 1; m < 64; m <<= 1) ss += xshfl(ss, m);
    const float rstd = rsqrtf(ss * (1.0f / 1024.0f) + EPS);
#pragma unroll
    for (int it = 0; it < 4; ++it) { const int idx = it * 256 + lane * 4;
      const f32x4 g = *(const f32x4*)(gvec + idx), s1 = *(const f32x4*)(mv + sc_off + idx), s0 = *(const f32x4*)(mv + sh_off + idx);
      float y[4];
#pragma unroll
      for (int j = 0; j < 4; ++j) y[j] = v[it][j] * rstd * g[j] * (1.0f + s1[j]) + s0[j];
      u32x2 o; o[0] = pack2(y[0], y[1]); o[1] = pack2(y[2], y[3]); *(u32x2*)(out + (size_t)row * D + idx) = o; }
  }
}

DI void inproj_epilogue(const Params& p, int l, const f32x4 (&acc)[4][4], int m0, int n0) {
  unsigned char* ws = p.ws;
  const int tid = get_tid(), lane = tid & 63, wid = tid >> 6, wr = wid >> 1, wc = wid & 1, lr = lane & 15, lg = lane >> 4;
  const bool is_lat = m0 < NLAT;
  int b, i0; if (is_lat) { b = m0 / SEQ; i0 = m0 % SEQ; } else { const int c0 = m0 - NLAT; b = c0 / CTX; i0 = c0 % CTX; }
  const int pos0 = is_lat ? CTX + i0 : i0;
  const int hc = n0 + wc * 64;
  int seg;
  if (n0 < 512) seg = 0; else if (n0 < 1024) seg = 1; else if (n0 < 1536) seg = 2; else if (n0 < 2048) seg = 3; else if (n0 < 2560) seg = 4; else if (n0 < 2688) seg = 5; else if (n0 < 2816) seg = 6; else seg = 7;
  if (seg == 0 || seg == 1 || seg == 4 || seg == 5) {
    const float* gv; bf16_t* dst; float qs = 1.0f;
    if (seg == 0) { const int c = hc; gv = p.dq_g + l * 64; dst = (bf16_t*)(ws + OFF_QD) + ((size_t)((b * 2 + c / 256) * 4 + (c % 256) / 64) * POS) * 64; qs = 0.125f * LOG2E; }
    else if (seg == 1) { const int c = hc - 512; gv = p.dk_g + l * 64; dst = (bf16_t*)(ws + OFF_KD) + ((size_t)((b * 2 + c / 256) * 4 + (c % 256) / 64) * POS) * 64; }
    else if (seg == 4) { const int c = hc - 2048; gv = p.wq_g + l * 64; dst = (bf16_t*)(ws + OFF_QW) + ((size_t)(b * 8 + c / 64) * POS) * 64; qs = 0.125f * LOG2E; }
    else { const int c = hc - 2560; gv = p.wk_g + l * 64; dst = (bf16_t*)(ws + OFF_KW) + ((size_t)(b * 2 + c / 64) * POS) * 64; }
    const float* rope = (const float*)(ws + OFF_ROPE);
    f32x4 gq[4];
#pragma unroll
    for (int ni = 0; ni < 4; ++ni) gq[ni] = *(const f32x4*)(gv + ni * 16 + lg * 4);
#pragma unroll
    for (int mi = 0; mi < 4; ++mi) {
      const int r = wr * 64 + mi * 16 + lr;
      float ss = 0.f;
#pragma unroll
      for (int ni = 0; ni < 4; ++ni)
#pragma unroll
        for (int j = 0; j < 4; ++j) ss += acc[mi][ni][j] * acc[mi][ni][j];
      ss += xshfl(ss, 16); ss += xshfl(ss, 32);
      const float rstd = rsqrtf(ss * (1.0f / 64.0f) + EPS);
      f32x4 v[4];
#pragma unroll
      for (int ni = 0; ni < 4; ++ni) v[ni] = acc[mi][ni] * rstd * gq[ni];
      if (is_lat) {
        const int li = i0 + r, gr = li >> 6, gc = li & 63;
#pragma unroll
        for (int ni = 0; ni < 2; ++ni) {
          const int pi = ni == 0 ? gr : gc;
          const f32x4 cs = *(const f32x4*)(rope + pi * 16 + lg * 4), sn = *(const f32x4*)(rope + 1024 + pi * 16 + lg * 4);
          const f32x4 x1 = v[ni], x2 = v[ni + 2];
          v[ni] = x1 * cs - x2 * sn; v[ni + 2] = x2 * cs + x1 * sn;
        }
      }
      bf16_t* drow = dst + (size_t)(pos0 + r) * 64 + lg * 4;
#pragma unroll
      for (int ni = 0; ni < 4; ++ni) { u32x2 o; o[0] = pack2(v[ni][0] * qs, v[ni][1] * qs); o[1] = pack2(v[ni][2] * qs, v[ni][3] * qs); *(u32x2*)(drow + ni * 16) = o; }
    }
  } else if (seg == 2 || seg == 6) {
#pragma unroll
    for (int mi = 0; mi < 4; ++mi) {
      const int pos = pos0 + wr * 64 + mi * 16 + lr;
#pragma unroll
      for (int ni = 0; ni < 4; ++ni)
#pragma unroll
        for (int j = 0; j < 4; ++j) {
          const int col = hc + ni * 16 + lg * 4 + j; bf16_t* dst;
          if (seg == 2) { const int c = col - 1024; dst = (bf16_t*)(ws + OFF_VDT) + ((size_t)(b * 4 + c / 128) * 128 + (c % 128)) * POS + pos; }
          else { const int c = col - 2688; dst = (bf16_t*)(ws + OFF_VWT) + ((size_t)(b * 2 + c / 64) * 64 + (c % 64)) * POS + pos; }
          *dst = (bf16_t)(pack2(acc[mi][ni][j], 0.f) & 0xffffu);
        }
    }
  } else if (seg == 3) {
    bf16_t* su = (bf16_t*)(ws + OFF_SU);
#pragma unroll
    for (int mi = 0; mi < 4; ++mi) { const int pos = pos0 + wr * 64 + mi * 16 + lr;
#pragma unroll
      for (int ni = 0; ni < 4; ++ni) { u32x2 o; o[0] = pack2(acc[mi][ni][0], acc[mi][ni][1]); o[1] = pack2(acc[mi][ni][2], acc[mi][ni][3]);
        *(u32x2*)(su + ((size_t)(b * 32 + (hc - 1536) / 16 + ni) * POS + pos) * 16 + lg * 4) = o; } }
  } else {
    bf16_t* gt = (bf16_t*)(ws + OFF_GATES);
#pragma unroll
    for (int mi = 0; mi < 4; ++mi) { const int row = m0 + wr * 64 + mi * 16 + lr;
#pragma unroll
      for (int ni = 0; ni < 4; ++ni) { u32x2 o; o[0] = pack2(sigmoidf_(acc[mi][ni][0]), sigmoidf_(acc[mi][ni][1])); o[1] = pack2(sigmoidf_(acc[mi][ni][2]), sigmoidf_(acc[mi][ni][3]));
        *(u32x2*)(gt + (size_t)row * 3072 + (hc - 2816) + ni * 16 + lg * 4) = o; } }
  }
}
DI void inproj_phase(const Params& p, int l, unsigned char* smem) {
  bf16_t* As = (bf16_t*)smem; bf16_t* Bs = As + 128 * LDT;
  const bf16_t* A = (const bf16_t*)(p.ws + OFF_ABUF); const bf16_t* W = (const bf16_t*)(p.ws + OFF_W_IN);
  constexpr int NT = DIN / 128, MT = NTOK / 128;
  for (int t = get_bid(); t < MT * NT; t += gridDim.x) {
    const int mt = t / NT, nt = t % NT;
    f32x4 acc[4][4]; zero_acc(acc);
    gemm_mainloop(acc, A + (size_t)mt * 128 * D, D, W + (size_t)nt * 128 * D, D, D, As, Bs);
    inproj_epilogue(p, l, acc, mt * 128, nt * 128);
  }
}

constexpr int NW = 4;
constexpr int NTHR = NW * 64;
constexpr int QU = NW * 32;
template <int DV, bool TWOK>
DI void attn_core_d1(f32x4 (&O)[2][DV / 16], float (&lsum)[2], const bf16x8 (&Qf)[2][2], float negm,
                  const bf16_t* __restrict__ Kp0, const bf16_t* __restrict__ Kp1, const bf16_t* __restrict__ Vt, int t0, int t1, int tm0, int tm1, int qlat0, unsigned char* smem) {
  constexpr int KB = TWOK ? 16384 : 8192, BUFB = KB + DV * 128;
  constexpr int NKL = (TWOK ? 16 : 8) / NW, NVL = DV / 8 / NW;
  const int tid = get_tid(), lane = tid & 63, wid = __builtin_amdgcn_readfirstlane(tid >> 6), lr = lane & 15, lg = lane >> 4;
  const int rl = lane >> 3, lc = (lane & 7) ^ rl;
  const int n0 = t1 - t0, ntl = n0 + (tm1 - tm0);
  u32x4 rk[NKL], rv[NVL];
#define ATTN_GLOAD(KEY0) do { const int key0_ = (KEY0); \
    _Pragma("unroll") for (int i = 0; i < NKL; ++i) { const int L = wid + i * NW; const bf16_t* kp_ = (i * NW >= 8) ? Kp1 : Kp0; rk[i] = *(const u32x4*)(kp_ + (size_t)(key0_ + (L & 7) * 8 + rl) * 64 + lc * 8); } \
    _Pragma("unroll") for (int i = 0; i < NVL; ++i) { const int L = wid + i * NW; rv[i] = *(const u32x4*)(Vt + (size_t)(L * 8 + rl) * POS + key0_ + lc * 8); } } while (0)
#define ATTN_LSTORE(BUF) do { unsigned char* buf_ = (BUF); \
    _Pragma("unroll") for (int i = 0; i < NKL; ++i) *(u32x4*)(buf_ + (wid + i * NW) * 1024 + lane * 16) = rk[i]; \
    _Pragma("unroll") for (int i = 0; i < NVL; ++i) *(u32x4*)(buf_ + KB + (wid + i * NW) * 1024 + lane * 16) = rv[i]; } while (0)
  ATTN_GLOAD((n0 > 0 ? t0 : tm0) * 64);
  __syncthreads();
  ATTN_LSTORE(smem);
  const int sw = lr & 7;
  for (int it = 0; it < ntl; ++it) {
    const bool masked = it >= n0;
    const int key0 = (masked ? tm0 + (it - n0) : t0 + it) * 64;
    const unsigned char* Kb = smem + (it & 1) * BUFB; const unsigned char* Vb = Kb + KB;
    __syncthreads();
    if (it + 1 < ntl) ATTN_GLOAD(((it + 1) >= n0 ? tm0 + (it + 1 - n0) : t0 + it + 1) * 64);
    f32x4 s[4][2];
#pragma unroll
    for (int kt = 0; kt < 4; ++kt) {
      const unsigned char* kr = Kb + (kt * 16 + lr) * 128;
      if (!TWOK) {
        const bf16x8 k0f = *(const bf16x8*)(kr + ((lg ^ sw) << 4)), k1f = *(const bf16x8*)(kr + (((4 + lg) ^ sw) << 4));
#pragma unroll
        for (int qt = 0; qt < 2; ++qt) { f32x4 z = {negm, negm, negm, negm}; z = MFMA16(k0f, Qf[qt][0], z); s[kt][qt] = MFMA16(k1f, Qf[qt][1], z); }
      } else {
#pragma unroll
        for (int qt = 0; qt < 2; ++qt) {
          const bf16x8 k0f = *(const bf16x8*)(kr + qt * 8192 + ((lg ^ sw) << 4)), k1f = *(const bf16x8*)(kr + qt * 8192 + (((4 + lg) ^ sw) << 4));
          f32x4 z = {negm, negm, negm, negm}; z = MFMA16(k0f, Qf[qt][0], z); s[kt][qt] = MFMA16(k1f, Qf[qt][1], z); }
      }
    }
    if (masked) {
#pragma unroll
      for (int kt = 0; kt < 4; ++kt)
#pragma unroll
        for (int qt = 0; qt < 2; ++qt)
#pragma unroll
          for (int j = 0; j < 4; ++j) { const int kl = key0 - CTX + kt * 16 + lg * 4 + j, ql = qlat0 + qt * 16 + lr; const int rel = kl - ql; if (rel > 128 || rel < -128) s[kt][qt][j] = -INFINITY; }
    }
    bf16x8 pf[2][2];
#pragma unroll
    for (int qt = 0; qt < 2; ++qt) {
      float rs = 0.f;
#pragma unroll
      for (int kt = 0; kt < 4; ++kt)
#pragma unroll
        for (int j = 0; j < 4; ++j) { const float e = __builtin_amdgcn_exp2f(s[kt][qt][j]); s[kt][qt][j] = e; rs += e; }
      lsum[qt] += rs;
#pragma unroll
      for (int kk = 0; kk < 2; ++kk) {
        u32x4 w; w[0] = pack2(s[2 * kk][qt][0], s[2 * kk][qt][1]); w[1] = pack2(s[2 * kk][qt][2], s[2 * kk][qt][3]);
        w[2] = pack2(s[2 * kk + 1][qt][0], s[2 * kk + 1][qt][1]); w[3] = pack2(s[2 * kk + 1][qt][2], s[2 * kk + 1][qt][3]);
        pf[qt][kk] = __builtin_bit_cast(bf16x8, w);
      }
    }
#pragma unroll
    for (int et = 0; et < DV / 16; ++et)
#pragma unroll
      for (int kk = 0; kk < 2; ++kk) {
        const unsigned char* vr = Vb + (et * 16 + lr) * 128 + (lg & 1) * 8;
        const int c0 = kk * 4 + (lg >> 1);
        const bf16x4 lo = *(const bf16x4*)(vr + ((c0 ^ sw) << 4)), hi = *(const bf16x4*)(vr + (((c0 + 2) ^ sw) << 4));
        const bf16x8 vf = __builtin_shufflevector(lo, hi, 0, 1, 2, 3, 4, 5, 6, 7);
        O[0][et] = MFMA16(vf, pf[0][kk], O[0][et]);
        O[1][et] = MFMA16(vf, pf[1][kk], O[1][et]);
      }
    if (it + 1 < ntl) ATTN_LSTORE(smem + ((it + 1) & 1) * BUFB);
  }
#undef ATTN_GLOAD
#undef ATTN_LSTORE
}

#define VM_WAIT4(N, R, Q) asm volatile("s_waitcnt vmcnt(" #N ")" : "+v"(R[0]), "+v"(R[1]), "+v"(Q[0]), "+v"(Q[1]) :: "memory")
template <int DV, bool TWOK>
DI void attn_core(f32x4 (&O)[2][DV / 16], float (&lsum)[2], const bf16x8 (&Qf)[2][2], float negm,
                  const bf16_t* __restrict__ Kp0, const bf16_t* __restrict__ Kp1, const bf16_t* __restrict__ Vt, int t0, int t1, int tm0, int tm1, int qlat0, unsigned char* smem) {
  constexpr int KB = TWOK ? 16384 : 8192, BUFB = KB + DV * 128;
  constexpr int NKL = (TWOK ? 16 : 8) / NW, NVL = DV / 8 / NW;
  static_assert((NKL == 4 && NVL == 4) || (NKL == 2 && NVL == 2), "wait macros are written for 8 or 4 loads per set");
  const int tid = get_tid(), lane = tid & 63, wid = __builtin_amdgcn_readfirstlane(tid >> 6), lr = lane & 15, lg = lane >> 4;
  const int rl = lane >> 3, lc = (lane & 7) ^ rl;
  const int n0 = t1 - t0, ntl = n0 + (tm1 - tm0);
  u32x4 rk0[NKL], rv0[NVL], rk1[NKL], rv1[NVL];
#define ATTN_TILE(I) ({ int i_ = (I); i_ = i_ < ntl ? i_ : ntl - 1; (i_ < n0 ? t0 + i_ : tm0 + (i_ - n0)) * 64; })
#define ATTN_GLOAD(RK, RV, KEY0) do { const int key0_ = (KEY0); \
    _Pragma("unroll") for (int i = 0; i < NKL; ++i) { const int L = wid + i * NW; const bf16_t* kp_ = (i * NW >= 8) ? Kp1 : Kp0; RK[i] = gload_async(kp_ + (size_t)(key0_ + (L & 7) * 8 + rl) * 64 + lc * 8); } \
    _Pragma("unroll") for (int i = 0; i < NVL; ++i) { const int L = wid + i * NW; RV[i] = gload_async(Vt + (size_t)(L * 8 + rl) * POS + key0_ + lc * 8); } } while (0)
#define ATTN_LSTORE(RK, RV, BUF) do { unsigned char* buf_ = (BUF); \
    _Pragma("unroll") for (int i = 0; i < NKL; ++i) *(u32x4*)(buf_ + (wid + i * NW) * 1024 + lane * 16) = RK[i]; \
    _Pragma("unroll") for (int i = 0; i < NVL; ++i) *(u32x4*)(buf_ + KB + (wid + i * NW) * 1024 + lane * 16) = RV[i]; } while (0)
#define ATTN_WAIT(RK, RV) do { if constexpr (NKL == 4) VM_WAIT8(8, RK, RV); else VM_WAIT4(4, RK, RV); } while (0)
#define ATTN_DRAIN(RK, RV) do { if constexpr (NKL == 4) VM_WAIT8(0, RK, RV); else VM_WAIT4(0, RK, RV); } while (0)
  const int sw = lr & 7;
#define ATTN_COMPUTE(IT, BUFP) do { const int it_ = (IT); const bool masked = it_ >= n0; const int key0 = (masked ? tm0 + (it_ - n0) : t0 + it_) * 64; \
    const unsigned char* Kb = (BUFP); const unsigned char* Vb = Kb + KB; \
    bf16x8 pf[2][2]; \
    _Pragma("unroll") for (int qt = 0; qt < 2; ++qt) { f32x4 s4[4]; \
      _Pragma("unroll") for (int kt = 0; kt < 4; ++kt) { const unsigned char* kq = Kb + (kt * 16 + lr) * 128 + (TWOK ? qt * 8192 : 0); \
        const bf16x8 k0f = *(const bf16x8*)(kq + ((lg ^ sw) << 4)), k1f = *(const bf16x8*)(kq + (((4 + lg) ^ sw) << 4)); \
        f32x4 z = {negm, negm, negm, negm}; z = MFMA16(k0f, Qf[qt][0], z); s4[kt] = MFMA16(k1f, Qf[qt][1], z); } \
      if (masked) { \
        _Pragma("unroll") for (int kt = 0; kt < 4; ++kt) _Pragma("unroll") for (int j = 0; j < 4; ++j) { \
          const int kl = key0 - CTX + kt * 16 + lg * 4 + j, ql = qlat0 + qt * 16 + lr; const int rel = kl - ql; if (rel > 128 || rel < -128) s4[kt][j] = -INFINITY; } } \
      float rs = 0.f; \
      _Pragma("unroll") for (int kt = 0; kt < 4; ++kt) _Pragma("unroll") for (int j = 0; j < 4; ++j) { const float e = __builtin_amdgcn_exp2f(s4[kt][j]); s4[kt][j] = e; rs += e; } \
      lsum[qt] += rs; \
      _Pragma("unroll") for (int kk = 0; kk < 2; ++kk) { u32x4 w; w[0] = pack2(s4[2 * kk][0], s4[2 * kk][1]); w[1] = pack2(s4[2 * kk][2], s4[2 * kk][3]); \
        w[2] = pack2(s4[2 * kk + 1][0], s4[2 * kk + 1][1]); w[3] = pack2(s4[2 * kk + 1][2], s4[2 * kk + 1][3]); pf[qt][kk] = __builtin_bit_cast(bf16x8, w); } } \
    _Pragma("unroll") for (int et = 0; et < DV / 16; ++et) _Pragma("unroll") for (int kk = 0; kk < 2; ++kk) { \
        const unsigned char* vr = Vb + (et * 16 + lr) * 128 + (lg & 1) * 8; const int c0 = kk * 4 + (lg >> 1); \
        const bf16x4 lo = *(const bf16x4*)(vr + ((c0 ^ sw) << 4)), hi = *(const bf16x4*)(vr + (((c0 + 2) ^ sw) << 4)); \
        const bf16x8 vf = __builtin_shufflevector(lo, hi, 0, 1, 2, 3, 4, 5, 6, 7); \
        O[0][et] = MFMA16(vf, pf[0][kk], O[0][et]); O[1][et] = MFMA16(vf, pf[1][kk], O[1][et]); } } while (0)
  asm volatile("s_waitcnt vmcnt(0)" ::: "memory");
  ATTN_GLOAD(rk0, rv0, ATTN_TILE(0)); ATTN_GLOAD(rk1, rv1, ATTN_TILE(1));
  __syncthreads();
  ATTN_WAIT(rk0, rv0); ATTN_LSTORE(rk0, rv0, smem); ATTN_GLOAD(rk0, rv0, ATTN_TILE(2));
  for (int it = 0; it < ntl; it += 2) {
    __syncthreads();
    ATTN_COMPUTE(it, smem);
    ATTN_WAIT(rk1, rv1); ATTN_LSTORE(rk1, rv1, smem + BUFB); ATTN_GLOAD(rk1, rv1, ATTN_TILE(it + 3));
    __syncthreads();
    ATTN_COMPUTE(it + 1, smem + BUFB);
    ATTN_WAIT(rk0, rv0); ATTN_LSTORE(rk0, rv0, smem); ATTN_GLOAD(rk0, rv0, ATTN_TILE(it + 4));
  }
  ATTN_DRAIN(rk0, rv0); ATTN_DRAIN(rk1, rv1);
#undef ATTN_TILE
#undef ATTN_GLOAD
#undef ATTN_LSTORE
#undef ATTN_WAIT
#undef ATTN_DRAIN
#undef ATTN_COMPUTE
}

constexpr int QUD = NW * 16;
DI void diff_unit(const Params& p, int l, int b, int hd, bool is_lat, int qi, unsigned char* smem) {
  unsigned char* ws = p.ws;
  const int tid = get_tid(), lane = tid & 63, wid = __builtin_amdgcn_readfirstlane(tid >> 6), lr = lane & 15, lg = lane >> 4;
  const int qpos0 = (is_lat ? CTX + qi * QUD : qi * QUD) + wid * 16;
  const int ntile = is_lat ? POS / 64 : CTX / 64;
  const float lam = ((const float*)(ws + OFF_LAM))[l];
  const float negm = -((const float*)(ws + OFF_LAM))[4 + l];
  const float lam_init = 0.8f - 0.6f * expf(-0.3f * (float)l);
  const size_t hoff0 = (size_t)((b * 2 + 0) * 4 + hd) * POS * 64, hoff1 = (size_t)((b * 2 + 1) * 4 + hd) * POS * 64;
  const bf16_t* Qd = (const bf16_t*)(ws + OFF_QD); const bf16_t* Kd = (const bf16_t*)(ws + OFF_KD);
  bf16x8 Qf[2][2];
#pragma unroll
  for (int ks = 0; ks < 2; ++ks) { Qf[0][ks] = *(const bf16x8*)(Qd + hoff0 + (size_t)(qpos0 + lr) * 64 + ks * 32 + lg * 8); Qf[1][ks] = *(const bf16x8*)(Qd + hoff1 + (size_t)(qpos0 + lr) * 64 + ks * 32 + lg * 8); }
  float lsum[2] = {0.f, 0.f};
  f32x4 O[2][8];
#pragma unroll
  for (int m = 0; m < 2; ++m)
#pragma unroll
    for (int et = 0; et < 8; ++et) O[m][et] = (f32x4){0.f, 0.f, 0.f, 0.f};
  attn_core_d1<128, true>(O, lsum, Qf, negm, Kd + hoff0, Kd + hoff1, (const bf16_t*)(ws + OFF_VDT) + (size_t)(b * 4 + hd) * 128 * POS, 0, ntile, 0, 0, 0, smem);
  float l0 = lsum[0], l1 = lsum[1];
  l0 += xshfl(l0, 16); l0 += xshfl(l0, 32); l1 += xshfl(l1, 16); l1 += xshfl(l1, 32);
  const float i0 = 1.0f / l0, i1 = lam / l1;
  float ss = 0.f;
#pragma unroll
  for (int et = 0; et < 8; ++et) { O[0][et] = O[0][et] * i0 - O[1][et] * i1;
#pragma unroll
    for (int j = 0; j < 4; ++j) ss += O[0][et][j] * O[0][et][j]; }
  ss += xshfl(ss, 16); ss += xshfl(ss, 32);
  const float rs = rsqrtf(ss * (1.0f / 128.0f) + EPS) * (1.0f - lam_init);
  const float* og = p.dout_g + l * 128; bf16_t* yd = (bf16_t*)(ws + OFF_YD);
  const int qpos = qpos0 + lr;
  const int row = is_lat ? b * SEQ + (qpos - CTX) : NLAT + b * CTX + qpos;
#pragma unroll
  for (int et = 0; et < 8; ++et) { const f32x4 g = *(const f32x4*)(og + et * 16 + lg * 4); const f32x4 y = O[0][et] * rs * g;
    u32x2 o; o[0] = pack2(y[0], y[1]); o[1] = pack2(y[2], y[3]); *(u32x2*)(yd + (size_t)row * 512 + hd * 128 + et * 16 + lg * 4) = o; }
}

DI void win_unit(const Params& p, int l, int b, int qh, bool is_lat, int qi, unsigned char* smem) {
  unsigned char* ws = p.ws;
  const int tid = get_tid(), lane = tid & 63, wid = __builtin_amdgcn_readfirstlane(tid >> 6), lr = lane & 15, lg = lane >> 4;
  const int qpos0 = (is_lat ? CTX + qi * QU : qi * QU) + wid * 32;
  const int kv = qh >> 2;
  const bf16_t* Qp = (const bf16_t*)(ws + OFF_QW) + ((size_t)(b * 8 + qh) * POS + qpos0) * 64;
  bf16x8 Qf[2][2];
#pragma unroll
  for (int qt = 0; qt < 2; ++qt)
#pragma unroll
    for (int ks = 0; ks < 2; ++ks) Qf[qt][ks] = *(const bf16x8*)(Qp + (qt * 16 + lr) * 64 + ks * 32 + lg * 8);
  const float sk = p.w_sink[l * 8 + qh] * LOG2E;
  const float mfix = fmaxf(((const float*)(ws + OFF_LAM))[8 + l], sk);
  const float l0 = lg == 0 ? __builtin_amdgcn_exp2f(sk - mfix) : 0.f;
  float lsum[2] = {l0, l0};
  f32x4 O[2][4];
#pragma unroll
  for (int qt = 0; qt < 2; ++qt)
#pragma unroll
    for (int et = 0; et < 4; ++et) O[qt][et] = (f32x4){0.f, 0.f, 0.f, 0.f};
  int tm0 = 0, tm1 = 0;
  if (is_lat) { const int q0 = qi * QU; tm0 = (q0 + 128) / 64; if (tm0 < 4) tm0 = 4; tm1 = (q0 + QU + 384) / 64; if (tm1 > POS / 64) tm1 = POS / 64; }
  attn_core<64, false>(O, lsum, Qf, -mfix, (const bf16_t*)(ws + OFF_KW) + (size_t)(b * 2 + kv) * POS * 64, nullptr, (const bf16_t*)(ws + OFF_VWT) + (size_t)(b * 2 + kv) * 64 * POS, 0, 4, tm0, tm1, qpos0 - CTX, smem);
  bf16_t* yw = (bf16_t*)(ws + OFF_YW);
#pragma unroll
  for (int qt = 0; qt < 2; ++qt) {
    float ls = lsum[qt]; ls += xshfl(ls, 16); ls += xshfl(ls, 32);
    const float inv = 1.0f / ls;
    const int qpos = qpos0 + qt * 16 + lr;
    const int row = is_lat ? b * SEQ + (qpos - CTX) : NLAT + b * CTX + qpos;
#pragma unroll
    for (int et = 0; et < 4; ++et) { const f32x4 y = O[qt][et] * inv; u32x2 o; o[0] = pack2(y[0], y[1]); o[1] = pack2(y[2], y[3]);
      *(u32x2*)(yw + (size_t)row * 512 + qh * 64 + et * 16 + lg * 4) = o; }
  }
}

constexpr int NR = NW / 2, CR = NCH / NR;
constexpr int BST = 20, SST = 136;
constexpr int S5_WAVE_LDS = 128 * BST * 4 + 16 * SST * 2;
constexpr int EB_PER_UNIT = 2 * (NCH + 8) * 64 * 2;
DI int s5_row(int b, int k, int t) { return k < 8 ? NLAT + b * CTX + k * 32 + t : b * SEQ + (k - 8) * 32 + t; }
DI int s5_cmap(int d, int k) { return d == 0 ? k : (k < 8 ? 7 - k : 143 - k); }
DI void s5_make_bf(const Params& p, int l, int d, int g, float fre, float fim, bf16x8 (&Bf)[8], int lr, int lg) {
#pragma unroll
  for (int q = 0; q < 8; ++q) {
    const int pp = 16 * (q & 3) + lr;
    const float fr = __shfl(fre, pp, 64), fi = __shfl(fim, pp, 64);
    u32x4 w = {0u, 0u, 0u, 0u};
    if (lg < 2) {
      const size_t bo = ((size_t)((l * 2 + d) * 32 + g) * 64 + pp) * 16 + lg * 8;
      const f32x4 br0 = *(const f32x4*)(p.s5_bre + bo), br1 = *(const f32x4*)(p.s5_bre + bo + 4), bi0 = *(const f32x4*)(p.s5_bim + bo), bi1 = *(const f32x4*)(p.s5_bim + bo + 4);
      f32x4 v0, v1;
      if (q < 4) { v0 = fr * br0 - fi * bi0; v1 = fr * br1 - fi * bi1; } else { v0 = fr * bi0 + fi * br0; v1 = fr * bi1 + fi * br1; }
      w[0] = pack2(v0[0], v0[1]); w[1] = pack2(v0[2], v0[3]); w[2] = pack2(v1[0], v1[1]); w[3] = pack2(v1[2], v1[3]);
    }
    Bf[q] = __builtin_bit_cast(bf16x8, w);
  }
}
DI u32x4 s5_load_uf(const bf16_t* sug, int k, int tt, int lr, int lg) { u32x4 uw = {0u, 0u, 0u, 0u}; if (lg < 2) uw = *(const u32x4*)(sug + (size_t)(k * 32 + tt * 16 + lr) * 16 + lg * 8); return uw; }
DI void s5_bu_tile(u32x4 uw, const bf16x8 (&Bf)[8], float* Bsm, int lr, int lg) {
  const bf16x8 uf = __builtin_bit_cast(bf16x8, uw);
#pragma unroll
  for (int q = 0; q < 8; ++q) { f32x4 z = {0.f, 0.f, 0.f, 0.f}; z = MFMA16(Bf[q], uf, z);
#pragma unroll
    for (int jj = 0; jj < 4; ++jj) Bsm[(q * 16 + lg * 4 + jj) * BST + lr] = z[jj]; }
}
#define S5_SCAN(D, AR, AI, WRITE) do { \
    _Pragma("unroll") for (int hb = 0; hb < 2; ++hb) { const int cb = ((D) ? 1 - hb : hb) * 2;     \
      const f32x4 br0_ = *(const f32x4*)(Bsm + lane * BST + cb * 4), br1_ = *(const f32x4*)(Bsm + lane * BST + cb * 4 + 4); \
      const f32x4 bi0_ = *(const f32x4*)(Bsm + (64 + lane) * BST + cb * 4), bi1_ = *(const f32x4*)(Bsm + (64 + lane) * BST + cb * 4 + 4); \
      _Pragma("unroll") for (int st = 0; st < 8; ++st) { const int t8 = (D) ? 7 - st : st; const int tl = cb * 4 + t8; \
        const float br = t8 < 4 ? br0_[t8 & 3] : br1_[t8 & 3], bi = t8 < 4 ? bi0_[t8 & 3] : bi1_[t8 & 3]; \
        const float nr = (AR) * sr - (AI) * si + br, ni = (AR) * si + (AI) * sr + bi; sr = nr; si = ni; \
        if (WRITE) { const unsigned pk = pack2(sr, si); Ssm[tl * SST + lane] = (bf16_t)(pk & 0xffffu); Ssm[tl * SST + 64 + lane] = (bf16_t)(pk >> 16); } } } } while (0)
DI void s5_unit(const Params& p, int l, int b, int g, unsigned char* smem) {
  unsigned char* ws = p.ws;
  const int tid = get_tid(), lane = tid & 63, wid = __builtin_amdgcn_readfirstlane(tid >> 6), lr = lane & 15, lg = lane >> 4;
  float* Bsm = (float*)(smem + wid * S5_WAVE_LDS);
  bf16_t* Ssm = (bf16_t*)(smem + wid * S5_WAVE_LDS + 128 * BST * 4);
  const bf16_t* sug = (const bf16_t*)(ws + OFF_SU) + (size_t)(b * 32 + g) * POS * 16;
  float* Eb = (float*)(ws + OFF_EB) + (size_t)(b * 32 + g) * EB_PER_UNIT;
  float are[2], aim[2], fre[2], fim[2];
#pragma unroll
  for (int d = 0; d < 2; ++d) {
    const int pi = ((l * 2 + d) * 32 + g) * 64 + lane;
    const float lre = p.s5_lre[pi], lim = p.s5_lim[pi], dt = expf(p.s5_ldt[(l * 2 + d) * 32 + g]);
    const float mag = expf(lre * dt), ang = lim * dt;
    are[d] = mag * cosf(ang); aim[d] = mag * sinf(ang);
    const float den = lre * lre + lim * lim, nre = are[d] - 1.0f;
    fre[d] = (nre * lre + aim[d] * lim) / den; fim[d] = (aim[d] * lre - nre * lim) / den;
  }
  bf16x8 Bf[2][8];
  s5_make_bf(p, l, 0, g, fre[0], fim[0], Bf[0], lr, lg);
  s5_make_bf(p, l, 1, g, fre[1], fim[1], Bf[1], lr, lg);
  {
    const int d = wid & 1, r = wid >> 1;
    const float ar = d ? are[1] : are[0], ai = d ? aim[1] : aim[0];
    float sr = 0.f, si = 0.f;
    for (int ci = 0; ci < CR; ++ci) {
      const int c = r * CR + ci, k = s5_cmap(d, c);
      { float* e_ = Eb + ((size_t)(d * (NCH + 8) + c) * 64 + lane) * 2; __hip_atomic_store(e_, sr, __ATOMIC_RELAXED, __HIP_MEMORY_SCOPE_AGENT); __hip_atomic_store(e_ + 1, si, __ATOMIC_RELAXED, __HIP_MEMORY_SCOPE_AGENT); }
      const u32x4 ua = s5_load_uf(sug, k, d ? 1 : 0, lr, lg), ub = s5_load_uf(sug, k, d ? 0 : 1, lr, lg);
#pragma unroll
      for (int hh = 0; hh < 2; ++hh) {
        const u32x4 uw = hh ? ub : ua;
        __builtin_amdgcn_wave_barrier();
        if (d) s5_bu_tile(uw, Bf[1], Bsm, lr, lg); else s5_bu_tile(uw, Bf[0], Bsm, lr, lg);
        __builtin_amdgcn_wave_barrier();
        if (d) S5_SCAN(1, ar, ai, false); else S5_SCAN(0, ar, ai, false);
      }
    }
    { float* e_ = Eb + ((size_t)(d * (NCH + 8) + NCH + r) * 64 + lane) * 2; __hip_atomic_store(e_, sr, __ATOMIC_RELAXED, __HIP_MEMORY_SCOPE_AGENT); __hip_atomic_store(e_ + 1, si, __ATOMIC_RELAXED, __HIP_MEMORY_SCOPE_AGENT); }
  }
  asm volatile("s_waitcnt vmcnt(0)" ::: "memory"); __syncthreads();
  bf16x8 Cf[2][4];
  float a32r[2], a32i[2], aCRr[2], aCRi[2];
#pragma unroll
  for (int d = 0; d < 2; ++d) {
#pragma unroll
    for (int ks = 0; ks < 4; ++ks) {
      const float* src = (ks < 2 ? p.s5_cre : p.s5_cim) + ((size_t)((l * 2 + d) * 32 + g) * 16 + lr) * 64 + (ks & 1) * 32 + lg * 8;
      const f32x4 v0 = *(const f32x4*)src, v1 = *(const f32x4*)(src + 4); const float sg = ks < 2 ? 1.0f : -1.0f;
      u32x4 w; w[0] = pack2(sg * v0[0], sg * v0[1]); w[1] = pack2(sg * v0[2], sg * v0[3]); w[2] = pack2(sg * v1[0], sg * v1[1]); w[3] = pack2(sg * v1[2], sg * v1[3]);
      Cf[d][ks] = __builtin_bit_cast(bf16x8, w);
    }
    float pr = are[d], pi_ = aim[d];
#pragma unroll
    for (int q = 0; q < 5; ++q) { const float nr = pr * pr - pi_ * pi_, ni = 2.0f * pr * pi_; pr = nr; pi_ = ni; }
    a32r[d] = pr; a32i[d] = pi_;
    float rr = 1.f, ri = 0.f, br_ = pr, bi_ = pi_;
#pragma unroll
    for (int bit = 0; bit < 7; ++bit) { if ((CR >> bit) & 1) { const float nr = rr * br_ - ri * bi_, ni = rr * bi_ + ri * br_; rr = nr; ri = ni; } const float nr = br_ * br_ - bi_ * bi_, ni = 2.0f * br_ * bi_; br_ = nr; bi_ = ni; }
    aCRr[d] = rr; aCRi[d] = ri;
  }
  const f32x4 dsk = *(const f32x4*)(p.s5_d + l * 512 + g * 16 + lg * 4);
  bf16_t* gb = (bf16_t*)(ws + OFF_GB);
  for (int k = wid; k < NCH; k += NW) {
    f32x4 acc[2] = {{0.f, 0.f, 0.f, 0.f}, {0.f, 0.f, 0.f, 0.f}};
    u32x4 uq[2]; uq[0] = s5_load_uf(sug, k, 0, lr, lg); uq[1] = s5_load_uf(sug, k, 1, lr, lg);
    u32x2 us[2]; us[0] = *(const u32x2*)(sug + (size_t)(k * 32 + lr) * 16 + lg * 4); us[1] = *(const u32x2*)(sug + (size_t)(k * 32 + 16 + lr) * 16 + lg * 4);
    float s0[2][2];
#pragma unroll
    for (int d = 0; d < 2; ++d) { const float* e_ = Eb + ((size_t)(d * (NCH + 8) + s5_cmap(d, k)) * 64 + lane) * 2;
      s0[d][0] = __hip_atomic_load(e_, __ATOMIC_RELAXED, __HIP_MEMORY_SCOPE_AGENT); s0[d][1] = __hip_atomic_load(e_ + 1, __ATOMIC_RELAXED, __HIP_MEMORY_SCOPE_AGENT); }
#pragma unroll
    for (int d = 0; d < 2; ++d) {
      const int c = s5_cmap(d, k), r = c / CR, j = c - r * CR;
      const float* Ed = Eb + (size_t)d * (NCH + 8) * 128 + lane * 2;
      float tr = 0.f, ti = 0.f;
#pragma unroll
      for (int r2 = 0; r2 < NR - 1; ++r2) if (r2 < r) {
        const float er = __hip_atomic_load(Ed + (size_t)(NCH + r2) * 128, __ATOMIC_RELAXED, __HIP_MEMORY_SCOPE_AGENT), ei = __hip_atomic_load(Ed + (size_t)(NCH + r2) * 128 + 1, __ATOMIC_RELAXED, __HIP_MEMORY_SCOPE_AGENT);
        const float nr = aCRr[d] * tr - aCRi[d] * ti + er, ni = aCRr[d] * ti + aCRi[d] * tr + ei; tr = nr; ti = ni; }
      float pr = 1.f, pi_ = 0.f, br_ = a32r[d], bi_ = a32i[d];
      for (int bit = 0; bit < 7; ++bit) { if ((j >> bit) & 1) { const float nr = pr * br_ - pi_ * bi_, ni = pr * bi_ + pi_ * br_; pr = nr; pi_ = ni; } const float nr = br_ * br_ - bi_ * bi_, ni = 2.0f * br_ * bi_; br_ = nr; bi_ = ni; }
      float sr = s0[d][0] + (pr * tr - pi_ * ti), si = s0[d][1] + (pr * ti + pi_ * tr);
#pragma unroll
      for (int hh = 0; hh < 2; ++hh) {
        const int tt = d ? 1 - hh : hh;
        __builtin_amdgcn_wave_barrier();
        s5_bu_tile(uq[tt], Bf[d], Bsm, lr, lg);
        __builtin_amdgcn_wave_barrier();
        if (d) S5_SCAN(1, are[1], aim[1], true); else S5_SCAN(0, are[0], aim[0], true);
        __builtin_amdgcn_wave_barrier();
#pragma unroll
        for (int ks = 0; ks < 4; ++ks) { const bf16x8 sf = *(const bf16x8*)(Ssm + lr * SST + ks * 32 + lg * 8); acc[tt] = MFMA16(Cf[d][ks], sf, acc[tt]); }
      }
    }
#pragma unroll
    for (int tt = 0; tt < 2; ++tt) { const int row = s5_row(b, k, tt * 16 + lr);
      f32x4 u; u[0] = __uint_as_float(us[tt][0] << 16); u[1] = __uint_as_float(us[tt][0] & 0xffff0000u); u[2] = __uint_as_float(us[tt][1] << 16); u[3] = __uint_as_float(us[tt][1] & 0xffff0000u);
      float y[4];
#pragma unroll
      for (int j = 0; j < 4; ++j) y[j] = gelu_tanh(acc[tt][j] + u[j] * dsk[j]);
      u32x2 o; o[0] = pack2(y[0], y[1]); o[1] = pack2(y[2], y[3]); *(u32x2*)(gb + (size_t)row * 512 + g * 16 + lg * 4) = o; }
  }
}

DI void mixer_phase(const Params& p, int l, unsigned char* smem) {
  const bool need_ctx = l < DEPTH - 1;
  volatile int* smw = (volatile int*)(smem + SMEM_BYTES - 16);
  constexpr int QL = SEQ / QU, QC = CTX / QU, QLD = SEQ / QUD, QCD = CTX / QUD;
  const int n_s5 = 16, n_dl = 2 * QLD, n_dc = need_ctx ? 2 * QCD : 0, n_wl = 4 * QL, n_wc = need_ctx ? 4 * QC : 0;
  const int total = n_dl + n_s5 + n_dc + n_wl + n_wc;
  const int x0 = get_bid() & 7;
  for (int dx = 0; dx < 8; ++dx) {
    const int xq = (x0 + dx) & 7;
    unsigned* ctr = (unsigned*)(p.ws + OFF_LAM) + 16 + l * 8 + xq;
    for (;;) {
      __syncthreads();
      if (get_tid() == 0) *smw = (int)atomicAdd(ctr, 1u);
      __syncthreads();
      int u = *smw;
      u = __builtin_amdgcn_readfirstlane(u);
      if (u >= total) break;
      int type, bq, hd, qi; bool is_lat = true;
      if (u < n_s5) { const int idx = xq * 16 + u; type = 1; bq = idx >> 5; hd = idx & 31; qi = 0; }
      else if ((u -= n_s5) < n_dl) { const int gidx = xq + 8 * (u / QLD); type = 0; bq = gidx >> 2; hd = gidx & 3; qi = u % QLD; }
      else if ((u -= n_dl) < n_dc) { const int gidx = xq + 8 * (u / QCD); type = 0; is_lat = false; bq = gidx >> 2; hd = gidx & 3; qi = u % QCD; }
      else if ((u -= n_dc) < n_wl) { type = 2; bq = xq >> 1; hd = (xq & 1) * 4 + (u & 3); qi = u >> 2; }
      else { u -= n_wl; type = 2; is_lat = false; bq = xq >> 1; hd = (xq & 1) * 4 + (u & 3); qi = u >> 2; }
      if (type == 0) diff_unit(p, l, bq, hd, is_lat, qi, smem);
      else if (type == 1) s5_unit(p, l, bq, hd, smem);
      else win_unit(p, l, bq, hd, is_lat, qi, smem);
    }
  }
}

#define EPI_LOOP_BEGIN { const int tid_ = get_tid(), lane_ = tid_ & 63, wid_ = tid_ >> 6, wr_ = wid_ >> 1, wc_ = wid_ & 1, lr_ = lane_ & 15, lg_ = lane_ >> 4; \
  _Pragma("unroll") for (int mi = 0; mi < 4; ++mi) { const int row = m0 + wr_ * 64 + mi * 16 + lr_; \
  _Pragma("unroll") for (int ni = 0; ni < 4; ++ni) { const int col = n0 + wc_ * 64 + ni * 16 + lg_ * 4;
#define EPI_LOOP_END } } }

DI void glu_phase(const Params& p, int MT, unsigned char* smem) {
  bf16_t* As = (bf16_t*)smem; bf16_t* Bs = As + 128 * LDT;
  const bf16_t* G = (const bf16_t*)(p.ws + OFF_GB); const bf16_t* W = (const bf16_t*)(p.ws + OFF_W_GLU); bf16_t* ys = (bf16_t*)(p.ws + OFF_YS);
  constexpr int NT = 4;
  for (int t = get_bid(); t < MT * NT; t += gridDim.x) {
    const int m0 = (t / NT) * 128, n0 = (t % NT) * 128;
    f32x4 acc[4][4]; zero_acc(acc);
    gemm_mainloop(acc, G + (size_t)m0 * 512, 512, W + (size_t)n0 * 512, 512, 512, As, Bs);
    EPI_LOOP_BEGIN
      const u32x2 gr = *(const u32x2*)(G + (size_t)row * 512 + col);
      const float g0 = __uint_as_float(gr[0] << 16), g1 = __uint_as_float(gr[0] & 0xffff0000u), g2 = __uint_as_float(gr[1] << 16), g3 = __uint_as_float(gr[1] & 0xffff0000u);
      u32x2 o; o[0] = pack2(g0 * sigmoidf_(acc[mi][ni][0]), g1 * sigmoidf_(acc[mi][ni][1])); o[1] = pack2(g2 * sigmoidf_(acc[mi][ni][2]), g3 * sigmoidf_(acc[mi][ni][3]));
      *(u32x2*)(ys + (size_t)row * 512 + col) = o;
    EPI_LOOP_END
  }
}
DI void merge_phase(const Params& p, int MT, unsigned char* smem) {
  bf16_t* As = (bf16_t*)smem; bf16_t* Bs = As + 128 * LDT;
  const bf16_t* gt = (const bf16_t*)(p.ws + OFF_GATES); bf16_t* mo = (bf16_t*)(p.ws + OFF_M);
  constexpr int NT = 8;
  for (int t = get_bid(); t < MT * NT; t += gridDim.x) {
    const int m0 = (t / NT) * 128, n0 = (t % NT) * 128;
    f32x4 acc[4][4]; zero_acc(acc);
#pragma unroll 1
    for (int br = 0; br < 3; ++br) {
      const bf16_t* Y = (const bf16_t*)(p.ws + (br == 0 ? OFF_YD : br == 1 ? OFF_YS : OFF_YW));
      const bf16_t* W = (const bf16_t*)(p.ws + (br == 0 ? OFF_W_PD : br == 1 ? OFF_W_PS : OFF_W_PW));
      gemm_mainloop(acc, Y + (size_t)m0 * 512, 512, W + (size_t)n0 * 512, 512, 512, As, Bs);
      if (br < 2) {
        EPI_LOOP_BEGIN
          const f32x4 g0 = ld_bf4(gt + (size_t)row * 3072 + br * 1024 + col), g1 = ld_bf4(gt + (size_t)row * 3072 + (br + 1) * 1024 + col);
#pragma unroll
          for (int j = 0; j < 4; ++j) acc[mi][ni][j] *= fmaxf(g0[j], 1e-30f) / fmaxf(g1[j], 1e-30f);
        EPI_LOOP_END
      } else {
        EPI_LOOP_BEGIN
          const f32x4 g2 = ld_bf4(gt + (size_t)row * 3072 + 2048 + col);
          u32x2 o; o[0] = pack2(acc[mi][ni][0] * fmaxf(g2[0], 1e-30f), acc[mi][ni][1] * fmaxf(g2[1], 1e-30f)); o[1] = pack2(acc[mi][ni][2] * fmaxf(g2[2], 1e-30f), acc[mi][ni][3] * fmaxf(g2[3], 1e-30f));
          *(u32x2*)(mo + (size_t)row * D + col) = o;
        EPI_LOOP_END
      }
    }
  }
}
DI void resid_phase(const Params& p, int l, const bf16_t* A, int K, const bf16_t* W, int gate_off, float* dst, int MT, unsigned char* smem, bool first = false) {
  bf16_t* As = (bf16_t*)smem; bf16_t* Bs = As + 128 * LDT;
  const float* h = (const float*)(p.ws + OFF_H);
  const float* modv = (const float*)(p.ws + OFF_MODV) + (size_t)l * 5 * 6144;
  constexpr int NT = 8;
  for (int t = get_bid(); t < MT * NT; t += gridDim.x) {
    const int m0 = (t / NT) * 128, n0 = (t % NT) * 128;
    f32x4 acc[4][4]; zero_acc(acc);
    gemm_mainloop(acc, A + (size_t)m0 * K, K, W + (size_t)n0 * K, K, K, As, Bs);
    const int bb = m0 < NLAT ? m0 / SEQ : 4;
    EPI_LOOP_BEGIN
      const f32x4 gv = *(const f32x4*)(modv + bb * 6144 + gate_off + col);
      const f32x4 hv = *(const f32x4*)((first ? (row < NLAT ? p.x + (size_t)row * D : p.ctx + (size_t)(row - NLAT) * D) : h + (size_t)row * D) + col);
      *(f32x4*)(dst + (size_t)row * D + col) = hv + gv * acc[mi][ni];
    EPI_LOOP_END
  }
}
DI void ff1_phase(const Params& p, int MT, unsigned char* smem) {
  bf16_t* As = (bf16_t*)smem; bf16_t* Bs = As + 128 * LDT;
  const bf16_t* A = (const bf16_t*)(p.ws + OFF_ABUF); const bf16_t* W = (const bf16_t*)(p.ws + OFF_W_FF1); bf16_t* uo = (bf16_t*)(p.ws + OFF_U);
  constexpr int NT = DFF / 128;
  for (int t = get_bid(); t < MT * NT; t += gridDim.x) {
    const int m0 = (t / NT) * 128, n0 = (t % NT) * 128;
    f32x4 acc[4][4]; zero_acc(acc);
    gemm_mainloop(acc, A + (size_t)m0 * D, D, W + (size_t)n0 * D, D, D, As, Bs);
    EPI_LOOP_BEGIN
      float r[4];
#pragma unroll
      for (int j = 0; j < 4; ++j) { const float v = fmaxf(acc[mi][ni][j], 0.f); r[j] = v * v; }
      u32x2 o; o[0] = pack2(r[0], r[1]); o[1] = pack2(r[2], r[3]); *(u32x2*)(uo + (size_t)row * DFF + col) = o;
    EPI_LOOP_END
  }
}

#define XB_TMO      128
#define XB_XCNT(j)  (256  + 64 * (j))
#define XB_XSUB(j)  (1280 + 64 * (j))
#define XB_XGEN(j)  (2304 + 64 * (j))
#define XB_TOP      3328
#define XB_TOPGEN   3392
#define XCD_BAR_WORDS 3456
#define XB_SPIN_CAP (1u << 18)
#define XLAS __attribute__((address_space(3)))

__device__ __forceinline__ unsigned xb_ld(unsigned* p)              { return __hip_atomic_load(p, __ATOMIC_RELAXED, __HIP_MEMORY_SCOPE_AGENT); }
__device__ __forceinline__ unsigned xb_add(unsigned* p, unsigned v) { return __hip_atomic_fetch_add(p, v, __ATOMIC_RELAXED, __HIP_MEMORY_SCOPE_AGENT); }
__device__ __forceinline__ unsigned xb_xcc_id() { return (unsigned)__builtin_amdgcn_s_getreg((3 << 11) | 20) & 0xFu; }
#define XB_SPIN(cond, bar) do { unsigned _sp = 0; while (cond) { __builtin_amdgcn_s_sleep(1); \
    if ((++_sp & 255u) == 0u) { if (xb_ld(&(bar)[XB_TMO])) break; if (_sp > XB_SPIN_CAP) { atomicAdd(&(bar)[XB_TMO], 1u); break; } } } } while (0)

struct XcdBarrier {
    unsigned* bar; unsigned x;
    volatile XLAS unsigned* st;
};

__device__ __forceinline__ XcdBarrier xcd_barrier_post(unsigned* bar, volatile XLAS unsigned* st) {
    XcdBarrier b; b.bar = bar; b.x = xb_xcc_id(); b.st = st;
    if (threadIdx.x == 0) (void)xb_add(&bar[XB_XCNT(b.x)], 1u);
    return b;
}
__device__ __forceinline__ void xcd_barrier_complete(unsigned* bar, unsigned x, unsigned& nloc, unsigned& nx) {
    const unsigned G = gridDim.x * gridDim.y * gridDim.z;
    unsigned sum, cnt, mine, sp = 0u;
    for (;;) {
        sum = 0u; cnt = 0u; mine = 0u;
#pragma unroll
        for (unsigned j = 0; j < 16; ++j) { const unsigned c = xb_ld(&bar[XB_XCNT(j)]); sum += c; cnt += (c > 0u) ? 1u : 0u; mine = (j == x) ? c : mine; }
        if (sum == G) break;
        __builtin_amdgcn_s_sleep(1);
        if ((++sp & 255u) == 0u) { if (xb_ld(&bar[XB_TMO])) break; if (sp > XB_SPIN_CAP) { atomicAdd(&bar[XB_TMO], 1u); break; } }
    }
    nloc = mine > 0u ? mine : 1u; nx = cnt > 0u ? cnt : 1u;
}

__device__ __forceinline__ void xcd_barrier(const XcdBarrier& b) {
    asm volatile("s_waitcnt vmcnt(0)" ::: "memory");
    __syncthreads();
    if (threadIdx.x == 0) {
        unsigned* bar = b.bar;
        __builtin_amdgcn_s_waitcnt(0);
        unsigned nloc = b.st[0], nx = b.st[1];
        if (nloc == 0u) { xcd_barrier_complete(bar, b.x, nloc, nx); b.st[0] = nloc; b.st[1] = nx; }
        const unsigned old = xb_add(&bar[XB_XSUB(b.x)], 1u);
        const unsigned gen = old / nloc;
        if (old + 1u == (gen + 1u) * nloc) {
            __builtin_amdgcn_fence(__ATOMIC_RELEASE, "agent");
            asm volatile("s_waitcnt vmcnt(0)" ::: "memory");
            const unsigned og = xb_add(&bar[XB_TOP], 1u);
            const unsigned tg = og / nx;
            if (og + 1u == (tg + 1u) * nx) xb_add(&bar[XB_TOPGEN], 1u);
            else XB_SPIN(xb_ld(&bar[XB_TOPGEN]) == tg, bar);
            __builtin_amdgcn_fence(__ATOMIC_ACQUIRE, "agent");
            xb_add(&bar[XB_XGEN(b.x)], 1u);
            asm volatile("s_waitcnt vmcnt(0)" ::: "memory");
        } else {
            XB_SPIN(xb_ld(&bar[XB_XGEN(b.x)]) == gen, bar);
            __builtin_amdgcn_fence(__ATOMIC_ACQUIRE, "agent");
            asm volatile("s_waitcnt vmcnt(0)" ::: "memory");
        }
    }
    __syncthreads();
}


__global__ void __launch_bounds__(256, 2) fwd_megakernel(Params p) {
  __shared__ __attribute__((aligned(16))) unsigned char smem[SMEM_BYTES];
  __shared__ uint4 xb_words;
  cg::grid_group grid = cg::this_grid();
  unsigned char* ws = p.ws;
  if (threadIdx.x == 0) xb_words = make_uint4(0u, 0u, 0u, 0u);
  __syncthreads();
  const XcdBarrier xb = xcd_barrier_post((unsigned*)(ws + OFF_BAR), (volatile XLAS unsigned*)&xb_words);
  phase0_misc(p, smem);
  __syncthreads();
  convert_layer(p, 0, 0, smem);
  if (p.ws == nullptr) grid.sync();
  for (int l = 0; l < DEPTH; ++l) {
    const bool need_ctx = l < DEPTH - 1;
    const int MT = need_ctx ? NTOK / 128 : NLAT / 128;
    xcd_barrier(xb);
    if (l > 0) convert_layer(p, l, CONV_EARLY, smem);
    norm_phase(p, l, p.norm1_g + l * D, 0, 1024, NTOK, l == 0);
    xcd_barrier(xb);
    inproj_phase(p, l, smem);
    xcd_barrier(xb);
    mixer_phase(p, l, smem);
    xcd_barrier(xb);
    glu_phase(p, MT, smem);
    xcd_barrier(xb);
    merge_phase(p, MT, smem);
    xcd_barrier(xb);
    resid_phase(p, l, (const bf16_t*)(ws + OFF_M), D, (const bf16_t*)(ws + OFF_W_OUT), 2048, (float*)(ws + OFF_H), MT, smem, l == 0);
    xcd_barrier(xb);
    norm_phase(p, l, p.norm2_g + l * D, 3072, 4096, MT * 128);
    xcd_barrier(xb);
    ff1_phase(p, MT, smem);
    xcd_barrier(xb);
    resid_phase(p, l, (const bf16_t*)(ws + OFF_U), DFF, (const bf16_t*)(ws + OFF_W_FF2), 5120, need_ctx ? (float*)(ws + OFF_H) : p.out, MT, smem);
    if (need_ctx) convert_steal(p, l + 1, smem);
  }
}

extern "C" void kernel_launch(void* const* d_in, const int* in_sizes, int n_in, void* d_out, int out_size, void* d_ws, size_t ws_size, hipStream_t stream) {
  static int grid_blocks = 0;
  if (!grid_blocks) {
    int dev = 0, cus = 0, per_cu = 0;
    (void)hipGetDevice(&dev);
    (void)hipDeviceGetAttribute(&cus, hipDeviceAttributeMultiprocessorCount, dev);
    (void)hipOccupancyMaxActiveBlocksPerMultiprocessor(&per_cu, fwd_megakernel, 256, 0);
    if (per_cu > 2) per_cu = 2;
    if (per_cu < 1) per_cu = 1;
    grid_blocks = cus * per_cu;
  }
  if (ws_size < WS_NEED) { fprintf(stderr, "workspace too small: %zu < %zu\n", ws_size, (size_t)WS_NEED); return; }
  (void)hipMemsetAsync((unsigned char*)d_ws + OFF_BAR, 0, BAR_BYTES, stream);
  Params p{};
  const float* const* in = (const float* const*)d_in;
  p.x = in[0]; p.c = in[1]; p.ctx = in[2]; p.c_ctx = in[3]; p.w_mod = in[4]; p.b_mod = in[5]; p.norm1_g = in[6]; p.norm2_g = in[7]; p.w_in = in[8];
  p.dq_g = in[9]; p.dk_g = in[10]; p.lq1 = in[11]; p.lk1 = in[12]; p.lq2 = in[13]; p.lk2 = in[14]; p.dout_g = in[15];
  p.s5_lre = in[16]; p.s5_lim = in[17]; p.s5_ldt = in[18]; p.s5_bre = in[19]; p.s5_bim = in[20]; p.s5_cre = in[21]; p.s5_cim = in[22]; p.s5_d = in[23]; p.s5_wglu = in[24];
  p.wq_g = in[25]; p.wk_g = in[26]; p.w_sink = in[27];
  p.w_pd = in[28]; p.w_ps = in[29]; p.w_pw = in[30]; p.w_out = in[31]; p.w_ff1 = in[32]; p.w_ff2 = in[33];
  p.out = (float*)d_out; p.ws = (unsigned char*)d_ws;
  void* args[] = {&p};
  hipError_t e = hipLaunchCooperativeKernel((void*)fwd_megakernel, dim3(grid_blocks), dim3(256), args, 0, stream);
  if (e != hipSuccess) fprintf(stderr, "cooperative launch failed: %s (grid %d)\n", hipGetErrorString(e), grid_blocks);
}
```

```cpp
#include <hip/hip_runtime.h>
#include <hip/hip_cooperative_groups.h>
#include <cstdio>
#include <cstdint>
namespace cg = cooperative_groups;

typedef unsigned short bf16_t;
typedef short bf16x8 __attribute__((ext_vector_type(8)));
typedef short bf16x4 __attribute__((ext_vector_type(4)));
typedef float f32x4 __attribute__((ext_vector_type(4)));
typedef float f32x2 __attribute__((ext_vector_type(2)));
typedef unsigned u32x4 __attribute__((ext_vector_type(4)));
typedef unsigned u32x2 __attribute__((ext_vector_type(2)));
typedef __bf16 bf2_t __attribute__((ext_vector_type(2)));

#define DI __device__ __forceinline__
#define MFMA16(a, b, c) __builtin_amdgcn_mfma_f32_16x16x32_bf16((a), (b), (c), 0, 0, 0)

constexpr int D = 1024, NB = 4, SEQ = 4096, DEPTH = 4, CTX = 256, POS = CTX + SEQ  ;
constexpr int NLAT = NB * SEQ  , NCTX = NB * CTX  , NTOK = NLAT + NCTX  ;
constexpr int DIN = 5888, DFF = 4096;
constexpr float EPS = 1e-6f;
constexpr float LOG2E = 1.4426950408889634f;
constexpr int NCH = POS / 32;

constexpr size_t SZ_W_IN = (size_t)DIN * D * 2, SZ_W_GLU = 512 * 512 * 2, SZ_W_P = 1024 * 512 * 2, SZ_W_OUT = (size_t)D * D * 2, SZ_W_FF = (size_t)D * DFF * 2;
constexpr size_t OFF_W_IN = 0;
constexpr size_t OFF_W_GLU = OFF_W_IN + SZ_W_IN;
constexpr size_t OFF_W_PD = OFF_W_GLU + SZ_W_GLU;
constexpr size_t OFF_W_PS = OFF_W_PD + SZ_W_P;
constexpr size_t OFF_W_PW = OFF_W_PS + SZ_W_P;
constexpr size_t OFF_W_OUT = OFF_W_PW + SZ_W_P;
constexpr size_t OFF_W_FF1 = OFF_W_OUT + SZ_W_OUT;
constexpr size_t OFF_W_FF2 = OFF_W_FF1 + SZ_W_FF;
constexpr size_t OFF_MODV = OFF_W_FF2 + SZ_W_FF;
constexpr size_t OFF_ROPE = OFF_MODV + (size_t)DEPTH * 5 * 6144 * 4;
constexpr size_t OFF_LAM = OFF_ROPE + 8192;
constexpr size_t OFF_H = OFF_LAM + 256;
constexpr size_t OFF_ABUF = OFF_H + (size_t)NTOK * D * 4;
constexpr size_t OFF_R1 = OFF_ABUF + (size_t)NTOK * D * 2;
constexpr size_t SZ_HEADBUF = (size_t)NB * 8 * POS * 64 * 2;
constexpr size_t OFF_QD = OFF_R1;
constexpr size_t OFF_KD = OFF_QD + SZ_HEADBUF;
constexpr size_t OFF_VDT = OFF_KD + SZ_HEADBUF;
constexpr size_t OFF_SU = OFF_VDT + SZ_HEADBUF;
constexpr size_t OFF_QW = OFF_SU + (size_t)NTOK * 512 * 2;
constexpr size_t OFF_KW = OFF_QW + SZ_HEADBUF;
constexpr size_t OFF_VWT = OFF_KW + SZ_HEADBUF / 4;
constexpr size_t OFF_GATES = OFF_VWT + SZ_HEADBUF / 4;
constexpr size_t OFF_YD = OFF_GATES + (size_t)NTOK * 3072 * 2;
constexpr size_t OFF_YS = OFF_YD + (size_t)NTOK * 512 * 2;
constexpr size_t OFF_YW = OFF_YS + (size_t)NTOK * 512 * 2;
constexpr size_t OFF_GB = OFF_YW + (size_t)NTOK * 512 * 2;
constexpr size_t OFF_EB = OFF_GB + (size_t)NTOK * 512 * 2;
constexpr size_t OFF_END = OFF_EB + (size_t)NB * 32 * 2 * (NCH + 8) * 64 * 8;
constexpr size_t OFF_BAR = OFF_END;
constexpr size_t BAR_BYTES = 16384;
constexpr size_t WS_NEED = OFF_BAR + BAR_BYTES;
constexpr size_t OFF_M = OFF_QD;
constexpr size_t OFF_U = OFF_R1;
static_assert((size_t)NTOK * DFF * 2 <= OFF_END - OFF_R1, "u alias");

struct Params {
  const float *x, *c, *ctx, *c_ctx, *w_mod, *b_mod, *norm1_g, *norm2_g, *w_in;
  const float *dq_g, *dk_g, *lq1, *lk1, *lq2, *lk2, *dout_g;
  const float *s5_lre, *s5_lim, *s5_ldt, *s5_bre, *s5_bim, *s5_cre, *s5_cim, *s5_d, *s5_wglu;
  const float *wq_g, *wk_g, *w_sink;
  const float *w_pd, *w_ps, *w_pw, *w_out, *w_ff1, *w_ff2;
  float* out;
  unsigned char* ws;
};

DI int get_tid() { int t = threadIdx.x; asm volatile("" : "+v"(t)); return t; }
DI int get_bid() { int b = blockIdx.x; asm volatile("" : "+s"(b)); return b; }
DI unsigned pack2(float lo, float hi) { f32x2 v = {lo, hi}; bf2_t r = __builtin_convertvector(v, bf2_t); return __builtin_bit_cast(unsigned, r); }
DI float sigmoidf_(float x) { return 1.0f / (1.0f + __expf(-x)); }
DI float gelu_tanh(float x) { const float z = 0.7978845608028654f * (x + 0.044715f * x * x * x); const float e = __expf(2.0f * z); const float t = 1.0f - 2.0f / (e + 1.0f); return 0.5f * x * (1.0f + t); }
DI f32x4 ld_bf4(const bf16_t* p_) { const u32x2 r = *(const u32x2*)p_; f32x4 v; v[0] = __uint_as_float(r[0] << 16); v[1] = __uint_as_float(r[0] & 0xffff0000u); v[2] = __uint_as_float(r[1] << 16); v[3] = __uint_as_float(r[1] & 0xffff0000u); return v; }
DI float xshfl(float v, int m) { return __shfl_xor(v, m, 64); }

constexpr int SMEM_BYTES = 65552;
constexpr int LDT = 72;

DI u32x4 gload_async(const void* ptr) { u32x4 r; asm volatile("global_load_dwordx4 %0, %1, off" : "=v"(r) : "v"(ptr) : "memory"); return r; }
#define VM_WAIT8(N, R, Q) asm volatile("s_waitcnt vmcnt(" #N ")" : "+v"(R[0]), "+v"(R[1]), "+v"(R[2]), "+v"(R[3]), "+v"(Q[0]), "+v"(Q[1]), "+v"(Q[2]), "+v"(Q[3]) :: "memory")
template <bool PERM = false>
DI void gemm_mainloop(f32x4 (&acc)[4][4], const bf16_t* __restrict__ A, int lda, const bf16_t* __restrict__ B, int ldb, int K, bf16_t* As, bf16_t* Bs) {
  const int tid = get_tid(), lane = tid & 63, wid = tid >> 6, wr = wid >> 1, wc = wid & 1, lr = lane & 15, lg = lane >> 4;
  const int crow = tid >> 3, ckc = (tid & 7) * 8;
  constexpr int TB = 128 * 64;
  const int swc = (((tid & 7) ^ (crow & 7)) * 8);
  const int swcB = PERM ? (((tid & 7) ^ ((((crow >> 3) & 3) * 2 + ((crow & 7) >> 1)) & 7)) * 8) : swc;
  u32x4 ra0[4], rb0[4], ra1[4], rb1[4];
  const bf16_t* Ap = A + (size_t)crow * lda + ckc; const bf16_t* Bp = B + (size_t)crow * ldb + ckc;
#define GM_LOAD(RA, RB, KOFF) do { _Pragma("unroll") for (int i = 0; i < 4; ++i) { RA[i] = gload_async(Ap + (size_t)(i * 32) * lda + (KOFF)); RB[i] = gload_async(Bp + (size_t)(i * 32) * ldb + (KOFF)); } } while (0)
#define GM_STORE(RA, RB, BUF) do { _Pragma("unroll") for (int i = 0; i < 4; ++i) { *(u32x4*)(As + (BUF) * 2 * TB + (crow + i * 32) * 64 + swc) = RA[i]; *(u32x4*)(As + (BUF) * 2 * TB + TB + (crow + i * 32) * 64 + swcB) = RB[i]; } } while (0)
#define GM_COMPUTE(BUF) do { const bf16_t* as_ = As + (BUF) * 2 * TB; const bf16_t* bs_ = as_ + TB; \
    _Pragma("unroll") for (int ks = 0; ks < 2; ++ks) { bf16x8 af[4], bfr[4]; const int co_ = ((ks * 4 + lg) ^ (lr & 7)) * 8; \
      _Pragma("unroll") for (int mi = 0; mi < 4; ++mi) af[mi] = *(const bf16x8*)(as_ + (wr * 64 + mi * 16 + lr) * 64 + co_); \
      _Pragma("unroll") for (int ni = 0; ni < 4; ++ni) { \
        if (PERM) { const int rw_ = (ni & 1) * 4 + (lr & 3); const int key_ = ((lr >> 2) * 2 + (rw_ >> 1)) & 7; bfr[ni] = *(const bf16x8*)(bs_ + (wc * 64 + (ni >> 1) * 32 + (lr >> 2) * 8 + rw_) * 64 + (((ks * 4 + lg) ^ key_) * 8)); } \
        else bfr[ni] = *(const bf16x8*)(bs_ + (wc * 64 + ni * 16 + lr) * 64 + co_); } \
      _Pragma("unroll") for (int mi = 0; mi < 4; ++mi) _Pragma("unroll") for (int ni = 0; ni < 4; ++ni) acc[mi][ni] = MFMA16(bfr[ni], af[mi], acc[mi][ni]); } } while (0)
  asm volatile("s_waitcnt vmcnt(0)" ::: "memory");
  GM_LOAD(ra0, rb0, 0); GM_LOAD(ra1, rb1, 64);
  __syncthreads();
  VM_WAIT8(8, ra0, rb0); GM_STORE(ra0, rb0, 0); GM_LOAD(ra0, rb0, (128 < K ? 128 : 0));
  __syncthreads();
  for (int k0 = 0; k0 < K; k0 += 128) {
    const int kn1 = k0 + 192 < K ? k0 + 192 : 0, kn0 = k0 + 256 < K ? k0 + 256 : 0;
    VM_WAIT8(8, ra1, rb1); GM_STORE(ra1, rb1, 1); GM_LOAD(ra1, rb1, kn1);
    GM_COMPUTE(0); __syncthreads();
    VM_WAIT8(8, ra0, rb0); GM_STORE(ra0, rb0, 0); GM_LOAD(ra0, rb0, kn0);
    GM_COMPUTE(1); __syncthreads();
  }
  VM_WAIT8(0, ra0, rb0); VM_WAIT8(0, ra1, rb1);
#undef GM_LOAD
#undef GM_STORE
#undef GM_COMPUTE
}
DI void zero_acc(f32x4 (&acc)[4][4]) {
#pragma unroll
  for (int mi = 0; mi < 4; ++mi)
#pragma unroll
    for (int ni = 0; ni < 4; ++ni) acc[mi][ni] = (f32x4){0.f, 0.f, 0.f, 0.f};
}

DI void convert_tile(const float* __restrict__ src, int K, int N, bf16_t* __restrict__ dst, int kt, int nt, float* tile) {
  const int tid = get_tid();
  { const int r = tid >> 4, c4 = (tid & 15) * 4;
#pragma unroll
    for (int i = 0; i < 4; ++i) { const int k = r + i * 16; const f32x4 v = *(const f32x4*)(src + (size_t)(kt * 64 + k) * N + nt * 64 + c4);
      tile[k * 65 + c4 + 0] = v[0]; tile[k * 65 + c4 + 1] = v[1]; tile[k * 65 + c4 + 2] = v[2]; tile[k * 65 + c4 + 3] = v[3]; } }
  __syncthreads();
  { const int n = tid >> 2, kc = (tid & 3) * 16; u32x4 o0, o1;
#pragma unroll
    for (int q = 0; q < 4; ++q) { o0[q] = pack2(tile[(kc + 2 * q) * 65 + n], tile[(kc + 2 * q + 1) * 65 + n]); o1[q] = pack2(tile[(kc + 8 + 2 * q) * 65 + n], tile[(kc + 8 + 2 * q + 1) * 65 + n]); }
    bf16_t* d = dst + (size_t)(nt * 64 + n) * K + kt * 64 + kc; *(u32x4*)d = o0; *(u32x4*)(d + 8) = o1; }
  __syncthreads();
}
DI void convert_item(const Params& p, int l, int t, float* tile) {
  unsigned char* ws = p.ws;
  const float* src; bf16_t* dst; int K, N, idx;
  if (t < 1472) { idx = t; src = p.w_in + (size_t)l * D * DIN; K = D; N = DIN; dst = (bf16_t*)(ws + OFF_W_IN); }
  else if (t < 1536) { idx = t - 1472; src = p.s5_wglu + (size_t)l * 512 * 512; K = 512; N = 512; dst = (bf16_t*)(ws + OFF_W_GLU); }
  else if (t < 1664) { idx = t - 1536; src = p.w_pd + (size_t)l * 512 * D; K = 512; N = D; dst = (bf16_t*)(ws + OFF_W_PD); }
  else if (t < 1792) { idx = t - 1664; src = p.w_ps + (size_t)l * 512 * D; K = 512; N = D; dst = (bf16_t*)(ws + OFF_W_PS); }
  else if (t < 1920) { idx = t - 1792; src = p.w_pw + (size_t)l * 512 * D; K = 512; N = D; dst = (bf16_t*)(ws + OFF_W_PW); }
  else if (t < 2176) { idx = t - 1920; src = p.w_out + (size_t)l * D * D; K = D; N = D; dst = (bf16_t*)(ws + OFF_W_OUT); }
  else if (t < 3200) { idx = t - 2176; src = p.w_ff1 + (size_t)l * D * DFF; K = D; N = DFF; dst = (bf16_t*)(ws + OFF_W_FF1); }
  else { idx = t - 3200; src = p.w_ff2 + (size_t)l * DFF * D; K = DFF; N = D; dst = (bf16_t*)(ws + OFF_W_FF2); }
  const int nts = N / 64; convert_tile(src, K, N, dst, idx / nts, idx % nts, tile);
}
constexpr int CONV_EARLY = 3200, CONV_ALL = 4224;
DI void convert_layer(const Params& p, int l, int t_begin, unsigned char* smem) {
  float* tile = (float*)smem;
  for (int t = t_begin + get_bid(); t < CONV_ALL; t += gridDim.x) convert_item(p, l, t, tile);
}
DI void convert_steal(const Params& p, int l, unsigned char* smem) {
  float* tile = (float*)smem;
  volatile int* smw = (volatile int*)(smem + SMEM_BYTES - 16);
  unsigned* ctr = (unsigned*)(p.ws + OFF_LAM) + 48 + l;
  for (;;) {
    __syncthreads();
    if (get_tid() == 0) *smw = (int)atomicAdd(ctr, 1u);
    __syncthreads();
    int t = *smw; t = __builtin_amdgcn_readfirstlane(t);
    if (t >= CONV_EARLY) break;
    convert_item(p, l, t, tile);
  }
}

DI void phase0_misc(const Params& p, unsigned char* smem) {
  unsigned char* ws = p.ws;
  const int tid = get_tid();
  if (get_bid() == 0) {
    float* rope = (float*)(ws + OFF_ROPE);
    for (int i = tid; i < 1024; i += 256) { const int pos = i >> 4, f = i & 15; const float inv = powf(10000.0f, -(float)f / 16.0f); const float ang = (float)pos * inv; rope[i] = cosf(ang); rope[1024 + i] = sinf(ang); }
    if (tid < DEPTH) { const int l = tid; float s1 = 0.f, s2 = 0.f;
      for (int i = 0; i < 64; ++i) { s1 += p.lq1[l * 64 + i] * p.lk1[l * 64 + i]; s2 += p.lq2[l * 64 + i] * p.lk2[l * 64 + i]; }
      const float lam_init = 0.8f - 0.6f * expf(-0.3f * (float)l);
      ((float*)(ws + OFF_LAM))[l] = expf(s1) - expf(s2) + lam_init; }
    if (tid >= 64 && tid < 64 + DEPTH) { const int l = tid - 64; float a = 0.f, b2 = 0.f, c2 = 0.f, d2 = 0.f;
      for (int i = 0; i < 64; ++i) { a = fmaxf(a, fabsf(p.dq_g[l * 64 + i])); b2 = fmaxf(b2, fabsf(p.dk_g[l * 64 + i])); c2 = fmaxf(c2, fabsf(p.wq_g[l * 64 + i])); d2 = fmaxf(d2, fabsf(p.wk_g[l * 64 + i])); }
      ((float*)(ws + OFF_LAM))[4 + l] = 8.0f * LOG2E * 1.02f * a * b2;
      ((float*)(ws + OFF_LAM))[8 + l] = 8.0f * LOG2E * 1.02f * c2 * d2;
      for (int i = 0; i < 8; ++i) ((unsigned*)(ws + OFF_LAM))[16 + l * 8 + i] = 0u;
      ((unsigned*)(ws + OFF_LAM))[48 + l] = 0u; }
  }
  float* sc = (float*)smem;
  float* red = sc + 5 * 1024;
  for (int i = tid; i < 5 * 1024; i += 256) { const int bb = i >> 10, k = i & 1023; const float v = bb < 4 ? p.c[bb * 1024 + k] : p.c_ctx[k]; sc[i] = v / (1.0f + __expf(-v)); }
  __syncthreads();
  float* modv = (float*)(ws + OFF_MODV);
  for (int t = get_bid(); t < DEPTH * 96; t += gridDim.x) {
    const int l = t / 96, cb = t % 96, kq = tid >> 6, cl = tid & 63, col = cb * 64 + cl;
    const float* w = p.w_mod + (size_t)l * D * 6144 + col;
    float s[5] = {0.f, 0.f, 0.f, 0.f, 0.f};
    for (int k = kq * 256; k < kq * 256 + 256; ++k) { const float wv = w[(size_t)k * 6144];
#pragma unroll
      for (int bb = 0; bb < 5; ++bb) s[bb] += sc[bb * 1024 + k] * wv; }
#pragma unroll
    for (int bb = 0; bb < 5; ++bb) red[(kq * 5 + bb) * 64 + cl] = s[bb];
    __syncthreads();
    for (int i = tid; i < 5 * 64; i += 256) { const int bb = i >> 6, c2 = i & 63; const float v = red[(0 * 5 + bb) * 64 + c2] + red[(1 * 5 + bb) * 64 + c2] + red[(2 * 5 + bb) * 64 + c2] + red[(3 * 5 + bb) * 64 + c2];
      modv[((size_t)l * 5 + bb) * 6144 + cb * 64 + c2] = v + p.b_mod[l * 6144 + cb * 64 + c2]; }
    __syncthreads();
  }
}

DI void norm_phase(const Params& p, int l, const float* gvec, int sh_off, int sc_off, int nrows, bool first = false) {
  const int tid = get_tid(), lane = tid & 63, wid = tid >> 6;
  const float* h = (const float*)(p.ws + OFF_H); bf16_t* out = (bf16_t*)(p.ws + OFF_ABUF);
  const float* modv = (const float*)(p.ws + OFF_MODV) + (size_t)l * 5 * 6144;
  for (int t = get_bid(); t < nrows / 4; t += gridDim.x) {
    const int row = t * 4 + wid; const int bb = row < NLAT ? row / SEQ : 4;
    const float* hr = first ? (row < NLAT ? p.x + (size_t)row * D : p.ctx + (size_t)(row - NLAT) * D) : h + (size_t)row * D; const float* mv = modv + bb * 6144;
    f32x4 v[4]; float ss = 0.f;
#pragma unroll
    for (int it = 0; it < 4; ++it) { v[it] = *(const f32x4*)(hr + it * 256 + lane * 4); ss += v[it][0] * v[it][0] + v[it][1] * v[it][1] + v[it][2] * v[it][2] + v[it][3] * v[it][3]; }
#pragma unroll
    for (int m = 1; m < 64; m <<= 1) ss += xshfl(ss, m);
    const float rstd = rsqrtf(ss * (1.0f / 1024.0f) + EPS);
#pragma unroll
    for (int it = 0; it < 4; ++it) { const int idx = it * 256 + lane * 4;
      const f32x4 g = *(const f32x4*)(gvec + idx), s1 = *(const f32x4*)(mv + sc_off + idx), s0 = *(const f32x4*)(mv + sh_off + idx);
      float y[4];
#pragma unroll
      for (int j = 0; j < 4; ++j) y[j] = v[it][j] * rstd * g[j] * (1.0f + s1[j]) + s0[j];
      u32x2 o; o[0] = pack2(y[0], y[1]); o[1] = pack2(y[2], y[3]); *(u32x2*)(out + (size_t)row * D + idx) = o; }
  }
}

DI void inproj_epilogue(const Params& p, int l, const f32x4 (&acc)[4][4], int m0, int n0) {
  unsigned char* ws = p.ws;
  const int tid = get_tid(), lane = tid & 63, wid = tid >> 6, wr = wid >> 1, wc = wid & 1, lr = lane & 15, lg = lane >> 4;
  const bool is_lat = m0 < NLAT;
  int b, i0; if (is_lat) { b = m0 / SEQ; i0 = m0 % SEQ; } else { const int c0 = m0 - NLAT; b = c0 / CTX; i0 = c0 % CTX; }
  const int pos0 = is_lat ? CTX + i0 : i0;
  const int hc = n0 + wc * 64;
  int seg;
  if (n0 < 512) seg = 0; else if (n0 < 1024) seg = 1; else if (n0 < 1536) seg = 2; else if (n0 < 2048) seg = 3; else if (n0 < 2560) seg = 4; else if (n0 < 2688) seg = 5; else if (n0 < 2816) seg = 6; else seg = 7;
  if (seg == 0 || seg == 1 || seg == 4 || seg == 5) {
    const float* gv; bf16_t* dst; float qs = 1.0f;
    if (seg == 0) { const int c = hc; gv = p.dq_g + l * 64; dst = (bf16_t*)(ws + OFF_QD) + ((size_t)((b * 2 + c / 256) * 4 + (c % 256) / 64) * POS) * 64; qs = 0.125f * LOG2E; }
    else if (seg == 1) { const int c = hc - 512; gv = p.dk_g + l * 64; dst = (bf16_t*)(ws + OFF_KD) + ((size_t)((b * 2 + c / 256) * 4 + (c % 256) / 64) * POS) * 64; }
    else if (seg == 4) { const int c = hc - 2048; gv = p.wq_g + l * 64; dst = (bf16_t*)(ws + OFF_QW) + ((size_t)(b * 8 + c / 64) * POS) * 64; qs = 0.125f * LOG2E; }
    else { const int c = hc - 2560; gv = p.wk_g + l * 64; dst = (bf16_t*)(ws + OFF_KW) + ((size_t)(b * 2 + c / 64) * POS) * 64; }
    const float* rope = (const float*)(ws + OFF_ROPE);
    f32x4 gq[4];
#pragma unroll
    for (int ni = 0; ni < 4; ++ni) gq[ni] = *(const f32x4*)(gv + ni * 16 + lg * 4);
#pragma unroll
    for (int mi = 0; mi < 4; ++mi) {
      const int r = wr * 64 + mi * 16 + lr;
      float ss = 0.f;
#pragma unroll
      for (int ni = 0; ni < 4; ++ni)
#pragma unroll
        for (int j = 0; j < 4; ++j) ss += acc[mi][ni][j] * acc[mi][ni][j];
      ss += xshfl(ss, 16); ss += xshfl(ss, 32);
      const float rstd = rsqrtf(ss * (1.0f / 64.0f) + EPS);
      f32x4 v[4];
#pragma unroll
      for (int ni = 0; ni < 4; ++ni) v[ni] = acc[mi][ni] * rstd * gq[ni];
      if (is_lat) {
        const int li = i0 + r, gr = li >> 6, gc = li & 63;
#pragma unroll
        for (int ni = 0; ni < 2; ++ni) {
          const int pi = ni == 0 ? gr : gc;
          const f32x4 cs = *(const f32x4*)(rope + pi * 16 + lg * 4), sn = *(const f32x4*)(rope + 1024 + pi * 16 + lg * 4);
          const f32x4 x1 = v[ni], x2 = v[ni + 2];
          v[ni] = x1 * cs - x2 * sn; v[ni + 2] = x2 * cs + x1 * sn;
        }
      }
      bf16_t* drow = dst + (size_t)(pos0 + r) * 64 + lg * 4;
#pragma unroll
      for (int ni = 0; ni < 4; ++ni) { u32x2 o; o[0] = pack2(v[ni][0] * qs, v[ni][1] * qs); o[1] = pack2(v[ni][2] * qs, v[ni][3] * qs); *(u32x2*)(drow + ni * 16) = o; }
    }
  } else if (seg == 2 || seg == 6) {
#pragma unroll
    for (int mi = 0; mi < 4; ++mi) {
      const int pos = pos0 + wr * 64 + mi * 16 + lr;
#pragma unroll
      for (int ni = 0; ni < 4; ++ni)
#pragma unroll
        for (int j = 0; j < 4; ++j) {
          const int col = hc + ni * 16 + lg * 4 + j; bf16_t* dst;
          if (seg == 2) { const int c = col - 1024; dst = (bf16_t*)(ws + OFF_VDT) + ((size_t)(b * 4 + c / 128) * 128 + (c % 128)) * POS + pos; }
          else { const int c = col - 2688; dst = (bf16_t*)(ws + OFF_VWT) + ((size_t)(b * 2 + c / 64) * 64 + (c % 64)) * POS + pos; }
          *dst = (bf16_t)(pack2(acc[mi][ni][j], 0.f) & 0xffffu);
        }
    }
  } else if (seg == 3) {
    bf16_t* su = (bf16_t*)(ws + OFF_SU);
#pragma unroll
    for (int mi = 0; mi < 4; ++mi) { const int pos = pos0 + wr * 64 + mi * 16 + lr;
#pragma unroll
      for (int ni = 0; ni < 4; ++ni) { u32x2 o; o[0] = pack2(acc[mi][ni][0], acc[mi][ni][1]); o[1] = pack2(acc[mi][ni][2], acc[mi][ni][3]);
        *(u32x2*)(su + ((size_t)(b * 32 + (hc - 1536) / 16 + ni) * POS + pos) * 16 + lg * 4) = o; } }
  } else {
    bf16_t* gt = (bf16_t*)(ws + OFF_GATES);
#pragma unroll
    for (int mi = 0; mi < 4; ++mi) { const int row = m0 + wr * 64 + mi * 16 + lr;
#pragma unroll
      for (int ni = 0; ni < 4; ++ni) { u32x2 o; o[0] = pack2(sigmoidf_(acc[mi][ni][0]), sigmoidf_(acc[mi][ni][1])); o[1] = pack2(sigmoidf_(acc[mi][ni][2]), sigmoidf_(acc[mi][ni][3]));
        *(u32x2*)(gt + (size_t)row * 3072 + (hc - 2816) + ni * 16 + lg * 4) = o; } }
  }
}
DI void inproj_phase(const Params& p, int l, unsigned char* smem) {
  bf16_t* As = (bf16_t*)smem; bf16_t* Bs = As + 128 * LDT;
  const bf16_t* A = (const bf16_t*)(p.ws + OFF_ABUF); const bf16_t* W = (const bf16_t*)(p.ws + OFF_W_IN);
  constexpr int NT = DIN / 128, MT = NTOK / 128;
  for (int t = get_bid(); t < MT * NT; t += gridDim.x) {
    const int mt = t / NT, nt = t % NT;
    f32x4 acc[4][4]; zero_acc(acc);
    gemm_mainloop(acc, A + (size_t)mt * 128 * D, D, W + (size_t)nt * 128 * D, D, D, As, Bs);
    inproj_epilogue(p, l, acc, mt * 128, nt * 128);
  }
}

constexpr int NW = 4;
constexpr int NTHR = NW * 64;
constexpr int QU = NW * 32;
template <int DV, bool TWOK>
DI void attn_core_d1(f32x4 (&O)[2][DV / 16], float (&lsum)[2], const bf16x8 (&Qf)[2][2], float negm,
                  const bf16_t* __restrict__ Kp0, const bf16_t* __restrict__ Kp1, const bf16_t* __restrict__ Vt, int t0, int t1, int tm0, int tm1, int qlat0, unsigned char* smem) {
  constexpr int KB = TWOK ? 16384 : 8192, BUFB = KB + DV * 128;
  constexpr int NKL = (TWOK ? 16 : 8) / NW, NVL = DV / 8 / NW;
  const int tid = get_tid(), lane = tid & 63, wid = __builtin_amdgcn_readfirstlane(tid >> 6), lr = lane & 15, lg = lane >> 4;
  const int rl = lane >> 3, lc = (lane & 7) ^ rl;
  const int n0 = t1 - t0, ntl = n0 + (tm1 - tm0);
  u32x4 rk[NKL], rv[NVL];
#define ATTN_GLOAD(KEY0) do { const int key0_ = (KEY0); \
    _Pragma("unroll") for (int i = 0; i < NKL; ++i) { const int L = wid + i * NW; const bf16_t* kp_ = (i * NW >= 8) ? Kp1 : Kp0; rk[i] = *(const u32x4*)(kp_ + (size_t)(key0_ + (L & 7) * 8 + rl) * 64 + lc * 8); } \
    _Pragma("unroll") for (int i = 0; i < NVL; ++i) { const int L = wid + i * NW; rv[i] = *(const u32x4*)(Vt + (size_t)(L * 8 + rl) * POS + key0_ + lc * 8); } } while (0)
#define ATTN_LSTORE(BUF) do { unsigned char* buf_ = (BUF); \
    _Pragma("unroll") for (int i = 0; i < NKL; ++i) *(u32x4*)(buf_ + (wid + i * NW) * 1024 + lane * 16) = rk[i]; \
    _Pragma("unroll") for (int i = 0; i < NVL; ++i) *(u32x4*)(buf_ + KB + (wid + i * NW) * 1024 + lane * 16) = rv[i]; } while (0)
  ATTN_GLOAD((n0 > 0 ? t0 : tm0) * 64);
  __syncthreads();
  ATTN_LSTORE(smem);
  const int sw = lr & 7;
  for (int it = 0; it < ntl; ++it) {
    const bool masked = it >= n0;
    const int key0 = (masked ? tm0 + (it - n0) : t0 + it) * 64;
    const unsigned char* Kb = smem + (it & 1) * BUFB; const unsigned char* Vb = Kb + KB;
    __syncthreads();
    if (it + 1 < ntl) ATTN_GLOAD(((it + 1) >= n0 ? tm0 + (it + 1 - n0) : t0 + it + 1) * 64);
    f32x4 s[4][2];
#pragma unroll
    for (int kt = 0; kt < 4; ++kt) {
      const unsigned char* kr = Kb + (kt * 16 + lr) * 128;
      if (!TWOK) {
        const bf16x8 k0f = *(const bf16x8*)(kr + ((lg ^ sw) << 4)), k1f = *(const bf16x8*)(kr + (((4 + lg) ^ sw) << 4));
#pragma unroll
        for (int qt = 0; qt < 2; ++qt) { f32x4 z = {negm, negm, negm, negm}; z = MFMA16(k0f, Qf[qt][0], z); s[kt][qt] = MFMA16(k1f, Qf[qt][1], z); }
      } else {
#pragma unroll
        for (int qt = 0; qt < 2; ++qt) {
          const bf16x8 k0f = *(const bf16x8*)(kr + qt * 8192 + ((lg ^ sw) << 4)), k1f = *(const bf16x8*)(kr + qt * 8192 + (((4 + lg) ^ sw) << 4));
          f32x4 z = {negm, negm, negm, negm}; z = MFMA16(k0f, Qf[qt][0], z); s[kt][qt] = MFMA16(k1f, Qf[qt][1], z); }
      }
    }
    if (masked) {
#pragma unroll
      for (int kt = 0; kt < 4; ++kt)
#pragma unroll
        for (int qt = 0; qt < 2; ++qt)
#pragma unroll
          for (int j = 0; j < 4; ++j) { const int kl = key0 - CTX + kt * 16 + lg * 4 + j, ql = qlat0 + qt * 16 + lr; const int rel = kl - ql; if (rel > 128 || rel < -128) s[kt][qt][j] = -INFINITY; }
    }
    bf16x8 pf[2][2];
#pragma unroll
    for (int qt = 0; qt < 2; ++qt) {
      float rs = 0.f;
#pragma unroll
      for (int kt = 0; kt < 4; ++kt)
#pragma unroll
        for (int j = 0; j < 4; ++j) { const float e = __builtin_amdgcn_exp2f(s[kt][qt][j]); s[kt][qt][j] = e; rs += e; }
      lsum[qt] += rs;
#pragma unroll
      for (int kk = 0; kk < 2; ++kk) {
        u32x4 w; w[0] = pack2(s[2 * kk][qt][0], s[2 * kk][qt][1]); w[1] = pack2(s[2 * kk][qt][2], s[2 * kk][qt][3]);
        w[2] = pack2(s[2 * kk + 1][qt][0], s[2 * kk + 1][qt][1]); w[3] = pack2(s[2 * kk + 1][qt][2], s[2 * kk + 1][qt][3]);
        pf[qt][kk] = __builtin_bit_cast(bf16x8, w);
      }
    }
#pragma unroll
    for (int et = 0; et < DV / 16; ++et)
#pragma unroll
      for (int kk = 0; kk < 2; ++kk) {
        const unsigned char* vr = Vb + (et * 16 + lr) * 128 + (lg & 1) * 8;
        const int c0 = kk * 4 + (lg >> 1);
        const bf16x4 lo = *(const bf16x4*)(vr + ((c0 ^ sw) << 4)), hi = *(const bf16x4*)(vr + (((c0 + 2) ^ sw) << 4));
        const bf16x8 vf = __builtin_shufflevector(lo, hi, 0, 1, 2, 3, 4, 5, 6, 7);
        O[0][et] = MFMA16(vf, pf[0][kk], O[0][et]);
        O[1][et] = MFMA16(vf, pf[1][kk], O[1][et]);
      }
    if (it + 1 < ntl) ATTN_LSTORE(smem + ((it + 1) & 1) * BUFB);
  }
#undef ATTN_GLOAD
#undef ATTN_LSTORE
}

#define VM_WAIT4(N, R, Q) asm volatile("s_waitcnt vmcnt(" #N ")" : "+v"(R[0]), "+v"(R[1]), "+v"(Q[0]), "+v"(Q[1]) :: "memory")
template <int DV, bool TWOK>
DI void attn_core(f32x4 (&O)[2][DV / 16], float (&lsum)[2], const bf16x8 (&Qf)[2][2], float negm,
                  const bf16_t* __restrict__ Kp0, const bf16_t* __restrict__ Kp1, const bf16_t* __restrict__ Vt, int t0, int t1, int tm0, int tm1, int qlat0, unsigned char* smem) {
  constexpr int KB = TWOK ? 16384 : 8192, BUFB = KB + DV * 128;
  constexpr int NKL = (TWOK ? 16 : 8) / NW, NVL = DV / 8 / NW;
  static_assert((NKL == 4 && NVL == 4) || (NKL == 2 && NVL == 2), "wait macros are written for 8 or 4 loads per set");
  const int tid = get_tid(), lane = tid & 63, wid = __builtin_amdgcn_readfirstlane(tid >> 6), lr = lane & 15, lg = lane >> 4;
  const int rl = lane >> 3, lc = (lane & 7) ^ rl;
  const int n0 = t1 - t0, ntl = n0 + (tm1 - tm0);
  u32x4 rk0[NKL], rv0[NVL], rk1[NKL], rv1[NVL];
#define ATTN_TILE(I) ({ int i_ = (I); i_ = i_ < ntl ? i_ : ntl - 1; (i_ < n0 ? t0 + i_ : tm0 + (i_ - n0)) * 64; })
#define ATTN_GLOAD(RK, RV, KEY0) do { const int key0_ = (KEY0); \
    _Pragma("unroll") for (int i = 0; i < NKL; ++i) { const int L = wid + i * NW; const bf16_t* kp_ = (i * NW >= 8) ? Kp1 : Kp0; RK[i] = gload_async(kp_ + (size_t)(key0_ + (L & 7) * 8 + rl) * 64 + lc * 8); } \
    _Pragma("unroll") for (int i = 0; i < NVL; ++i) { const int L = wid + i * NW; RV[i] = gload_async(Vt + (size_t)(L * 8 + rl) * POS + key0_ + lc * 8); } } while (0)
#define ATTN_LSTORE(RK, RV, BUF) do { unsigned char* buf_ = (BUF); \
    _Pragma("unroll") for (int i = 0; i < NKL; ++i) *(u32x4*)(buf_ + (wid + i * NW) * 1024 + lane * 16) = RK[i]; \
    _Pragma("unroll") for (int i = 0; i < NVL; ++i) *(u32x4*)(buf_ + KB + (wid + i * NW) * 1024 + lane * 16) = RV[i]; } while (0)
#define ATTN_WAIT(RK, RV) do { if constexpr (NKL == 4) VM_WAIT8(8, RK, RV); else VM_WAIT4(4, RK, RV); } while (0)
#define ATTN_DRAIN(RK, RV) do { if constexpr (NKL == 4) VM_WAIT8(0, RK, RV); else VM_WAIT4(0, RK, RV); } while (0)
  const int sw = lr & 7;
#define ATTN_COMPUTE(IT, BUFP) do { const int it_ = (IT); const bool masked = it_ >= n0; const int key0 = (masked ? tm0 + (it_ - n0) : t0 + it_) * 64; \
    const unsigned char* Kb = (BUFP); const unsigned char* Vb = Kb + KB; \
    bf16x8 pf[2][2]; \
    _Pragma("unroll") for (int qt = 0; qt < 2; ++qt) { f32x4 s4[4]; \
      _Pragma("unroll") for (int kt = 0; kt < 4; ++kt) { const unsigned char* kq = Kb + (kt * 16 + lr) * 128 + (TWOK ? qt * 8192 : 0); \
        const bf16x8 k0f = *(const bf16x8*)(kq + ((lg ^ sw) << 4)), k1f = *(const bf16x8*)(kq + (((4 + lg) ^ sw) << 4)); \
        f32x4 z = {negm, negm, negm, negm}; z = MFMA16(k0f, Qf[qt][0], z); s4[kt] = MFMA16(k1f, Qf[qt][1], z); } \
      if (masked) { \
        _Pragma("unroll") for (int kt = 0; kt < 4; ++kt) _Pragma("unroll") for (int j = 0; j < 4; ++j) { \
          const int kl = key0 - CTX + kt * 16 + lg * 4 + j, ql = qlat0 + qt * 16 + lr; const int rel = kl - ql; if (rel > 128 || rel < -128) s4[kt][j] = -INFINITY; } } \
      float rs = 0.f; \
      _Pragma("unroll") for (int kt = 0; kt < 4; ++kt) _Pragma("unroll") for (int j = 0; j < 4; ++j) { const float e = __builtin_amdgcn_exp2f(s4[kt][j]); s4[kt][j] = e; rs += e; } \
      lsum[qt] += rs; \
      _Pragma("unroll") for (int kk = 0; kk < 2; ++kk) { u32x4 w; w[0] = pack2(s4[2 * kk][0], s4[2 * kk][1]); w[1] = pack2(s4[2 * kk][2], s4[2 * kk][3]); \
        w[2] = pack2(s4[2 * kk + 1][0], s4[2 * kk + 1][1]); w[3] = pack2(s4[2 * kk + 1][2], s4[2 * kk + 1][3]); pf[qt][kk] = __builtin_bit_cast(bf16x8, w); } } \
    _Pragma("unroll") for (int et = 0; et < DV / 16; ++et) _Pragma("unroll") for (int kk = 0; kk < 2; ++kk) { \
        const unsigned char* vr = Vb + (et * 16 + lr) * 128 + (lg & 1) * 8; const int c0 = kk * 4 + (lg >> 1); \
        const bf16x4 lo = *(const bf16x4*)(vr + ((c0 ^ sw) << 4)), hi = *(const bf16x4*)(vr + (((c0 + 2) ^ sw) << 4)); \
        const bf16x8 vf = __builtin_shufflevector(lo, hi, 0, 1, 2, 3, 4, 5, 6, 7); \
        O[0][et] = MFMA16(vf, pf[0][kk], O[0][et]); O[1][et] = MFMA16(vf, pf[1][kk], O[1][et]); } } while (0)
  asm volatile("s_waitcnt vmcnt(0)" ::: "memory");
  ATTN_GLOAD(rk0, rv0, ATTN_TILE(0)); ATTN_GLOAD(rk1, rv1, ATTN_TILE(1));
  __syncthreads();
  ATTN_WAIT(rk0, rv0); ATTN_LSTORE(rk0, rv0, smem); ATTN_GLOAD(rk0, rv0, ATTN_TILE(2));
  for (int it = 0; it < ntl; it += 2) {
    __syncthreads();
    ATTN_COMPUTE(it, smem);
    ATTN_WAIT(rk1, rv1); ATTN_LSTORE(rk1, rv1, smem + BUFB); ATTN_GLOAD(rk1, rv1, ATTN_TILE(it + 3));
    __syncthreads();
    ATTN_COMPUTE(it + 1, smem + BUFB);
    ATTN_WAIT(rk0, rv0); ATTN_LSTORE(rk0, rv0, smem); ATTN_GLOAD(rk0, rv0, ATTN_TILE(it + 4));
  }
  ATTN_DRAIN(rk0, rv0); ATTN_DRAIN(rk1, rv1);
#undef ATTN_TILE
#undef ATTN_GLOAD
#undef ATTN_LSTORE
#undef ATTN_WAIT
#undef ATTN_DRAIN
#undef ATTN_COMPUTE
}

constexpr int QUD = NW * 16;
DI void diff_unit(const Params& p, int l, int b, int hd, bool is_lat, int qi, unsigned char* smem) {
  unsigned char* ws = p.ws;
  const int tid = get_tid(), lane = tid & 63, wid = __builtin_amdgcn_readfirstlane(tid >> 6), lr = lane & 15, lg = lane >> 4;
  const int qpos0 = (is_lat ? CTX + qi * QUD : qi * QUD) + wid * 16;
  const int ntile = is_lat ? POS / 64 : CTX / 64;
  const float lam = ((const float*)(ws + OFF_LAM))[l];
  const float negm = -((const float*)(ws + OFF_LAM))[4 + l];
  const float lam_init = 0.8f - 0.6f * expf(-0.3f * (float)l);
  const size_t hoff0 = (size_t)((b * 2 + 0) * 4 + hd) * POS * 64, hoff1 = (size_t)((b * 2 + 1) * 4 + hd) * POS * 64;
  const bf16_t* Qd = (const bf16_t*)(ws + OFF_QD); const bf16_t* Kd = (const bf16_t*)(ws + OFF_KD);
  bf16x8 Qf[2][2];
#pragma unroll
  for (int ks = 0; ks < 2; ++ks) { Qf[0][ks] = *(const bf16x8*)(Qd + hoff0 + (size_t)(qpos0 + lr) * 64 + ks * 32 + lg * 8); Qf[1][ks] = *(const bf16x8*)(Qd + hoff1 + (size_t)(qpos0 + lr) * 64 + ks * 32 + lg * 8); }
  float lsum[2] = {0.f, 0.f};
  f32x4 O[2][8];
#pragma unroll
  for (int m = 0; m < 2; ++m)
#pragma unroll
    for (int et = 0; et < 8; ++et) O[m][et] = (f32x4){0.f, 0.f, 0.f, 0.f};
  attn_core_d1<128, true>(O, lsum, Qf, negm, Kd + hoff0, Kd + hoff1, (const bf16_t*)(ws + OFF_VDT) + (size_t)(b * 4 + hd) * 128 * POS, 0, ntile, 0, 0, 0, smem);
  float l0 = lsum[0], l1 = lsum[1];
  l0 += xshfl(l0, 16); l0 += xshfl(l0, 32); l1 += xshfl(l1, 16); l1 += xshfl(l1, 32);
  const float i0 = 1.0f / l0, i1 = lam / l1;
  float ss = 0.f;
#pragma unroll
  for (int et = 0; et < 8; ++et) { O[0][et] = O[0][et] * i0 - O[1][et] * i1;
#pragma unroll
    for (int j = 0; j < 4; ++j) ss += O[0][et][j] * O[0][et][j]; }
  ss += xshfl(ss, 16); ss += xshfl(ss, 32);
  const float rs = rsqrtf(ss * (1.0f / 128.0f) + EPS) * (1.0f - lam_init);
  const float* og = p.dout_g + l * 128; bf16_t* yd = (bf16_t*)(ws + OFF_YD);
  const int qpos = qpos0 + lr;
  const int row = is_lat ? b * SEQ + (qpos - CTX) : NLAT + b * CTX + qpos;
#pragma unroll
  for (int et = 0; et < 8; ++et) { const f32x4 g = *(const f32x4*)(og + et * 16 + lg * 4); const f32x4 y = O[0][et] * rs * g;
    u32x2 o; o[0] = pack2(y[0], y[1]); o[1] = pack2(y[2], y[3]); *(u32x2*)(yd + (size_t)row * 512 + hd * 128 + et * 16 + lg * 4) = o; }
}

DI void win_unit(const Params& p, int l, int b, int qh, bool is_lat, int qi, unsigned char* smem) {
  unsigned char* ws = p.ws;
  const int tid = get_tid(), lane = tid & 63, wid = __builtin_amdgcn_readfirstlane(tid >> 6), lr = lane & 15, lg = lane >> 4;
  const int qpos0 = (is_lat ? CTX + qi * QU : qi * QU) + wid * 32;
  const int kv = qh >> 2;
  const bf16_t* Qp = (const bf16_t*)(ws + OFF_QW) + ((size_t)(b * 8 + qh) * POS + qpos0) * 64;
  bf16x8 Qf[2][2];
#pragma unroll
  for (int qt = 0; qt < 2; ++qt)
#pragma unroll
    for (int ks = 0; ks < 2; ++ks) Qf[qt][ks] = *(const bf16x8*)(Qp + (qt * 16 + lr) * 64 + ks * 32 + lg * 8);
  const float sk = p.w_sink[l * 8 + qh] * LOG2E;
  const float mfix = fmaxf(((const float*)(ws + OFF_LAM))[8 + l], sk);
  const float l0 = lg == 0 ? __builtin_amdgcn_exp2f(sk - mfix) : 0.f;
  float lsum[2] = {l0, l0};
  f32x4 O[2][4];
#pragma unroll
  for (int qt = 0; qt < 2; ++qt)
#pragma unroll
    for (int et = 0; et < 4; ++et) O[qt][et] = (f32x4){0.f, 0.f, 0.f, 0.f};
  int tm0 = 0, tm1 = 0;
  if (is_lat) { const int q0 = qi * QU; tm0 = (q0 + 128) / 64; if (tm0 < 4) tm0 = 4; tm1 = (q0 + QU + 384) / 64; if (tm1 > POS / 64) tm1 = POS / 64; }
  attn_core<64, false>(O, lsum, Qf, -mfix, (const bf16_t*)(ws + OFF_KW) + (size_t)(b * 2 + kv) * POS * 64, nullptr, (const bf16_t*)(ws + OFF_VWT) + (size_t)(b * 2 + kv) * 64 * POS, 0, 4, tm0, tm1, qpos0 - CTX, smem);
  bf16_t* yw = (bf16_t*)(ws + OFF_YW);
#pragma unroll
  for (int qt = 0; qt < 2; ++qt) {
    float ls = lsum[qt]; ls += xshfl(ls, 16); ls += xshfl(ls, 32);
    const float inv = 1.0f / ls;
    const int qpos = qpos0 + qt * 16 + lr;
    const int row = is_lat ? b * SEQ + (qpos - CTX) : NLAT + b * CTX + qpos;
#pragma unroll
    for (int et = 0; et < 4; ++et) { const f32x4 y = O[qt][et] * inv; u32x2 o; o[0] = pack2(y[0], y[1]); o[1] = pack2(y[2], y[3]);
      *(u32x2*)(yw + (size_t)row * 512 + qh * 64 + et * 16 + lg * 4) = o; }
  }
}

constexpr int NR = NW / 2, CR = NCH / NR;
constexpr int BST = 20, SST = 136;
constexpr int S5_WAVE_LDS = 128 * BST * 4 + 16 * SST * 2;
constexpr int EB_PER_UNIT = 2 * (NCH + 8) * 64 * 2;
DI int s5_row(int b, int k, int t) { return k < 8 ? NLAT + b * CTX + k * 32 + t : b * SEQ + (k - 8) * 32 + t; }
DI int s5_cmap(int d, int k) { return d == 0 ? k : (k < 8 ? 7 - k : 143 - k); }
DI void s5_make_bf(const Params& p, int l, int d, int g, float fre, float fim, bf16x8 (&Bf)[8], int lr, int lg) {
#pragma unroll
  for (int q = 0; q < 8; ++q) {
    const int pp = 16 * (q & 3) + lr;
    const float fr = __shfl(fre, pp, 64), fi = __shfl(fim, pp, 64);
    u32x4 w = {0u, 0u, 0u, 0u};
    if (lg < 2) {
      const size_t bo = ((size_t)((l * 2 + d) * 32 + g) * 64 + pp) * 16 + lg * 8;
      const f32x4 br0 = *(const f32x4*)(p.s5_bre + bo), br1 = *(const f32x4*)(p.s5_bre + bo + 4), bi0 = *(const f32x4*)(p.s5_bim + bo), bi1 = *(const f32x4*)(p.s5_bim + bo + 4);
      f32x4 v0, v1;
      if (q < 4) { v0 = fr * br0 - fi * bi0; v1 = fr * br1 - fi * bi1; } else { v0 = fr * bi0 + fi * br0; v1 = fr * bi1 + fi * br1; }
      w[0] = pack2(v0[0], v0[1]); w[1] = pack2(v0[2], v0[3]); w[2] = pack2(v1[0], v1[1]); w[3] = pack2(v1[2], v1[3]);
    }
    Bf[q] = __builtin_bit_cast(bf16x8, w);
  }
}
DI u32x4 s5_load_uf(const bf16_t* sug, int k, int tt, int lr, int lg) { u32x4 uw = {0u, 0u, 0u, 0u}; if (lg < 2) uw = *(const u32x4*)(sug + (size_t)(k * 32 + tt * 16 + lr) * 16 + lg * 8); return uw; }
DI void s5_bu_tile(u32x4 uw, const bf16x8 (&Bf)[8], float* Bsm, int lr, int lg) {
  const bf16x8 uf = __builtin_bit_cast(bf16x8, uw);
#pragma unroll
  for (int q = 0; q < 8; ++q) { f32x4 z = {0.f, 0.f, 0.f, 0.f}; z = MFMA16(Bf[q], uf, z);
#pragma unroll
    for (int jj = 0; jj < 4; ++jj) Bsm[(q * 16 + lg * 4 + jj) * BST + lr] = z[jj]; }
}
#define S5_SCAN(D, AR, AI, WRITE) do { \
    _Pragma("unroll") for (int hb = 0; hb < 2; ++hb) { const int cb = ((D) ? 1 - hb : hb) * 2;     \
      const f32x4 br0_ = *(const f32x4*)(Bsm + lane * BST + cb * 4), br1_ = *(const f32x4*)(Bsm + lane * BST + cb * 4 + 4); \
      const f32x4 bi0_ = *(const f32x4*)(Bsm + (64 + lane) * BST + cb * 4), bi1_ = *(const f32x4*)(Bsm + (64 + lane) * BST + cb * 4 + 4); \
      _Pragma("unroll") for (int st = 0; st < 8; ++st) { const int t8 = (D) ? 7 - st : st; const int tl = cb * 4 + t8; \
        const float br = t8 < 4 ? br0_[t8 & 3] : br1_[t8 & 3], bi = t8 < 4 ? bi0_[t8 & 3] : bi1_[t8 & 3]; \
        const float nr = (AR) * sr - (AI) * si + br, ni = (AR) * si + (AI) * sr + bi; sr = nr; si = ni; \
        if (WRITE) { const unsigned pk = pack2(sr, si); Ssm[tl * SST + lane] = (bf16_t)(pk & 0xffffu); Ssm[tl * SST + 64 + lane] = (bf16_t)(pk >> 16); } } } } while (0)
DI void s5_unit(const Params& p, int l, int b, int g, unsigned char* smem) {
  unsigned char* ws = p.ws;
  const int tid = get_tid(), lane = tid & 63, wid = __builtin_amdgcn_readfirstlane(tid >> 6), lr = lane & 15, lg = lane >> 4;
  float* Bsm = (float*)(smem + wid * S5_WAVE_LDS);
  bf16_t* Ssm = (bf16_t*)(smem + wid * S5_WAVE_LDS + 128 * BST * 4);
  const bf16_t* sug = (const bf16_t*)(ws + OFF_SU) + (size_t)(b * 32 + g) * POS * 16;
  float* Eb = (float*)(ws + OFF_EB) + (size_t)(b * 32 + g) * EB_PER_UNIT;
  float are[2], aim[2], fre[2], fim[2];
#pragma unroll
  for (int d = 0; d < 2; ++d) {
    const int pi = ((l * 2 + d) * 32 + g) * 64 + lane;
    const float lre = p.s5_lre[pi], lim = p.s5_lim[pi], dt = expf(p.s5_ldt[(l * 2 + d) * 32 + g]);
    const float mag = expf(lre * dt), ang = lim * dt;
    are[d] = mag * cosf(ang); aim[d] = mag * sinf(ang);
    const float den = lre * lre + lim * lim, nre = are[d] - 1.0f;
    fre[d] = (nre * lre + aim[d] * lim) / den; fim[d] = (aim[d] * lre - nre * lim) / den;
  }
  bf16x8 Bf[2][8];
  s5_make_bf(p, l, 0, g, fre[0], fim[0], Bf[0], lr, lg);
  s5_make_bf(p, l, 1, g, fre[1], fim[1], Bf[1], lr, lg);
  {
    const int d = wid & 1, r = wid >> 1;
    const float ar = d ? are[1] : are[0], ai = d ? aim[1] : aim[0];
    float sr = 0.f, si = 0.f;
    for (int ci = 0; ci < CR; ++ci) {
      const int c = r * CR + ci, k = s5_cmap(d, c);
      { float* e_ = Eb + ((size_t)(d * (NCH + 8) + c) * 64 + lane) * 2; __hip_atomic_store(e_, sr, __ATOMIC_RELAXED, __HIP_MEMORY_SCOPE_AGENT); __hip_atomic_store(e_ + 1, si, __ATOMIC_RELAXED, __HIP_MEMORY_SCOPE_AGENT); }
      const u32x4 ua = s5_load_uf(sug, k, d ? 1 : 0, lr, lg), ub = s5_load_uf(sug, k, d ? 0 : 1, lr, lg);
#pragma unroll
      for (int hh = 0; hh < 2; ++hh) {
        const u32x4 uw = hh ? ub : ua;
        __builtin_amdgcn_wave_barrier();
        if (d) s5_bu_tile(uw, Bf[1], Bsm, lr, lg); else s5_bu_tile(uw, Bf[0], Bsm, lr, lg);
        __builtin_amdgcn_wave_barrier();
        if (d) S5_SCAN(1, ar, ai, false); else S5_SCAN(0, ar, ai, false);
      }
    }
    { float* e_ = Eb + ((size_t)(d * (NCH + 8) + NCH + r) * 64 + lane) * 2; __hip_atomic_store(e_, sr, __ATOMIC_RELAXED, __HIP_MEMORY_SCOPE_AGENT); __hip_atomic_store(e_ + 1, si, __ATOMIC_RELAXED, __HIP_MEMORY_SCOPE_AGENT); }
  }
  asm volatile("s_waitcnt vmcnt(0)" ::: "memory"); __syncthreads();
  bf16x8 Cf[2][4];
  float a32r[2], a32i[2], aCRr[2], aCRi[2];
#pragma unroll
  for (int d = 0; d < 2; ++d) {
#pragma unroll
    for (int ks = 0; ks < 4; ++ks) {
      const float* src = (ks < 2 ? p.s5_cre : p.s5_cim) + ((size_t)((l * 2 + d) * 32 + g) * 16 + lr) * 64 + (ks & 1) * 32 + lg * 8;
      const f32x4 v0 = *(const f32x4*)src, v1 = *(const f32x4*)(src + 4); const float sg = ks < 2 ? 1.0f : -1.0f;
      u32x4 w; w[0] = pack2(sg * v0[0], sg * v0[1]); w[1] = pack2(sg * v0[2], sg * v0[3]); w[2] = pack2(sg * v1[0], sg * v1[1]); w[3] = pack2(sg * v1[2], sg * v1[3]);
      Cf[d][ks] = __builtin_bit_cast(bf16x8, w);
    }
    float pr = are[d], pi_ = aim[d];
#pragma unroll
    for (int q = 0; q < 5; ++q) { const float nr = pr * pr - pi_ * pi_, ni = 2.0f * pr * pi_; pr = nr; pi_ = ni; }
    a32r[d] = pr; a32i[d] = pi_;
    float rr = 1.f, ri = 0.f, br_ = pr, bi_ = pi_;
#pragma unroll
    for (int bit = 0; bit < 7; ++bit) { if ((CR >> bit) & 1) { const float nr = rr * br_ - ri * bi_, ni = rr * bi_ + ri * br_; rr = nr; ri = ni; } const float nr = br_ * br_ - bi_ * bi_, ni = 2.0f * br_ * bi_; br_ = nr; bi_ = ni; }
    aCRr[d] = rr; aCRi[d] = ri;
  }
  const f32x4 dsk = *(const f32x4*)(p.s5_d + l * 512 + g * 16 + lg * 4);
  bf16_t* gb = (bf16_t*)(ws + OFF_GB);
  for (int k = wid; k < NCH; k += NW) {
    f32x4 acc[2] = {{0.f, 0.f, 0.f, 0.f}, {0.f, 0.f, 0.f, 0.f}};
    u32x4 uq[2]; uq[0] = s5_load_uf(sug, k, 0, lr, lg); uq[1] = s5_load_uf(sug, k, 1, lr, lg);
    u32x2 us[2]; us[0] = *(const u32x2*)(sug + (size_t)(k * 32 + lr) * 16 + lg * 4); us[1] = *(const u32x2*)(sug + (size_t)(k * 32 + 16 + lr) * 16 + lg * 4);
    float s0[2][2];
#pragma unroll
    for (int d = 0; d < 2; ++d) { const float* e_ = Eb + ((size_t)(d * (NCH + 8) + s5_cmap(d, k)) * 64 + lane) * 2;
      s0[d][0] = __hip_atomic_load(e_, __ATOMIC_RELAXED, __HIP_MEMORY_SCOPE_AGENT); s0[d][1] = __hip_atomic_load(e_ + 1, __ATOMIC_RELAXED, __HIP_MEMORY_SCOPE_AGENT); }
#pragma unroll
    for (int d = 0; d < 2; ++d) {
      const int c = s5_cmap(d, k), r = c / CR, j = c - r * CR;
      const float* Ed = Eb + (size_t)d * (NCH + 8) * 128 + lane * 2;
      float tr = 0.f, ti = 0.f;
#pragma unroll
      for (int r2 = 0; r2 < NR - 1; ++r2) if (r2 < r) {
        const float er = __hip_atomic_load(Ed + (size_t)(NCH + r2) * 128, __ATOMIC_RELAXED, __HIP_MEMORY_SCOPE_AGENT), ei = __hip_atomic_load(Ed + (size_t)(NCH + r2) * 128 + 1, __ATOMIC_RELAXED, __HIP_MEMORY_SCOPE_AGENT);
        const float nr = aCRr[d] * tr - aCRi[d] * ti + er, ni = aCRr[d] * ti + aCRi[d] * tr + ei; tr = nr; ti = ni; }
      float pr = 1.f, pi_ = 0.f, br_ = a32r[d], bi_ = a32i[d];
      for (int bit = 0; bit < 7; ++bit) { if ((j >> bit) & 1) { const float nr = pr * br_ - pi_ * bi_, ni = pr * bi_ + pi_ * br_; pr = nr; pi_ = ni; } const float nr = br_ * br_ - bi_ * bi_, ni = 2.0f * br_ * bi_; br_ = nr; bi_ = ni; }
      float sr = s0[d][0] + (pr * tr - pi_ * ti), si = s0[d][1] + (pr * ti + pi_ * tr);
#pragma unroll
      for (int hh = 0; hh < 2; ++hh) {
        const int tt = d ? 1 - hh : hh;
        __builtin_amdgcn_wave_barrier();
        s5_bu_tile(uq[tt], Bf[d], Bsm, lr, lg);
        __builtin_amdgcn_wave_barrier();
        if (d) S5_SCAN(1, are[1], aim[1], true); else S5_SCAN(0, are[0], aim[0], true);
        __builtin_amdgcn_wave_barrier();
#pragma unroll
        for (int ks = 0; ks < 4; ++ks) { const bf16x8 sf = *(const bf16x8*)(Ssm + lr * SST + ks * 32 + lg * 8); acc[tt] = MFMA16(Cf[d][ks], sf, acc[tt]); }
      }
    }
#pragma unroll
    for (int tt = 0; tt < 2; ++tt) { const int row = s5_row(b, k, tt * 16 + lr);
      f32x4 u; u[0] = __uint_as_float(us[tt][0] << 16); u[1] = __uint_as_float(us[tt][0] & 0xffff0000u); u[2] = __uint_as_float(us[tt][1] << 16); u[3] = __uint_as_float(us[tt][1] & 0xffff0000u);
      float y[4];
#pragma unroll
      for (int j = 0; j < 4; ++j) y[j] = gelu_tanh(acc[tt][j] + u[j] * dsk[j]);
      u32x2 o; o[0] = pack2(y[0], y[1]); o[1] = pack2(y[2], y[3]); *(u32x2*)(gb + (size_t)row * 512 + g * 16 + lg * 4) = o; }
  }
}

DI void mixer_phase(const Params& p, int l, unsigned char* smem) {
  const bool need_ctx = l < DEPTH - 1;
  volatile int* smw = (volatile int*)(smem + SMEM_BYTES - 16);
  constexpr int QL = SEQ / QU, QC = CTX / QU, QLD = SEQ / QUD, QCD = CTX / QUD;
  const int n_s5 = 16, n_dl = 2 * QLD, n_dc = need_ctx ? 2 * QCD : 0, n_wl = 4 * QL, n_wc = need_ctx ? 4 * QC : 0;
  const int total = n_dl + n_s5 + n_dc + n_wl + n_wc;
  const int x0 = get_bid() & 7;
  for (int dx = 0; dx < 8; ++dx) {
    const int xq = (x0 + dx) & 7;
    unsigned* ctr = (unsigned*)(p.ws + OFF_LAM) + 16 + l * 8 + xq;
    for (;;) {
      __syncthreads();
      if (get_tid() == 0) *smw = (int)atomicAdd(ctr, 1u);
      __syncthreads();
      int u = *smw;
      u = __builtin_amdgcn_readfirstlane(u);
      if (u >= total) break;
      int type, bq, hd, qi; bool is_lat = true;
      if (u < n_s5) { const int idx = xq * 16 + u; type = 1; bq = idx >> 5; hd = idx & 31; qi = 0; }
      else if ((u -= n_s5) < n_dl) { const int gidx = xq + 8 * (u / QLD); type = 0; bq = gidx >> 2; hd = gidx & 3; qi = u % QLD; }
      else if ((u -= n_dl) < n_dc) { const int gidx = xq + 8 * (u / QCD); type = 0; is_lat = false; bq = gidx >> 2; hd = gidx & 3; qi = u % QCD; }
      else if ((u -= n_dc) < n_wl) { type = 2; bq = xq >> 1; hd = (xq & 1) * 4 + (u & 3); qi = u >> 2; }
      else { u -= n_wl; type = 2; is_lat = false; bq = xq >> 1; hd = (xq & 1) * 4 + (u & 3); qi = u >> 2; }
      if (type == 0) diff_unit(p, l, bq, hd, is_lat, qi, smem);
      else if (type == 1) s5_unit(p, l, bq, hd, smem);
      else win_unit(p, l, bq, hd, is_lat, qi, smem);
    }
  }
}

#define EPI_LOOP_BEGIN { const int tid_ = get_tid(), lane_ = tid_ & 63, wid_ = tid_ >> 6, wr_ = wid_ >> 1, wc_ = wid_ & 1, lr_ = lane_ & 15, lg_ = lane_ >> 4; \
  _Pragma("unroll") for (int mi = 0; mi < 4; ++mi) { const int row = m0 + wr_ * 64 + mi * 16 + lr_; \
  _Pragma("unroll") for (int ni = 0; ni < 4; ++ni) { const int col = n0 + wc_ * 64 + ni * 16 + lg_ * 4;
#define EPI_LOOP_END } } }

DI void glu_phase(const Params& p, int MT, unsigned char* smem) {
  bf16_t* As = (bf16_t*)smem; bf16_t* Bs = As + 128 * LDT;
  const bf16_t* G = (const bf16_t*)(p.ws + OFF_GB); const bf16_t* W = (const bf16_t*)(p.ws + OFF_W_GLU); bf16_t* ys = (bf16_t*)(p.ws + OFF_YS);
  constexpr int NT = 4;
  for (int t = get_bid(); t < MT * NT; t += gridDim.x) {
    const int m0 = (t / NT) * 128, n0 = (t % NT) * 128;
    f32x4 acc[4][4]; zero_acc(acc);
    gemm_mainloop(acc, G + (size_t)m0 * 512, 512, W + (size_t)n0 * 512, 512, 512, As, Bs);
    EPI_LOOP_BEGIN
      const u32x2 gr = *(const u32x2*)(G + (size_t)row * 512 + col);
      const float g0 = __uint_as_float(gr[0] << 16), g1 = __uint_as_float(gr[0] & 0xffff0000u), g2 = __uint_as_float(gr[1] << 16), g3 = __uint_as_float(gr[1] & 0xffff0000u);
      u32x2 o; o[0] = pack2(g0 * sigmoidf_(acc[mi][ni][0]), g1 * sigmoidf_(acc[mi][ni][1])); o[1] = pack2(g2 * sigmoidf_(acc[mi][ni][2]), g3 * sigmoidf_(acc[mi][ni][3]));
      *(u32x2*)(ys + (size_t)row * 512 + col) = o;
    EPI_LOOP_END
  }
}
DI void merge_phase(const Params& p, int MT, unsigned char* smem) {
  bf16_t* As = (bf16_t*)smem; bf16_t* Bs = As + 128 * LDT;
  const bf16_t* gt = (const bf16_t*)(p.ws + OFF_GATES); bf16_t* mo = (bf16_t*)(p.ws + OFF_M);
  constexpr int NT = 8;
  for (int t = get_bid(); t < MT * NT; t += gridDim.x) {
    const int m0 = (t / NT) * 128, n0 = (t % NT) * 128;
    f32x4 acc[4][4]; zero_acc(acc);
#pragma unroll 1
    for (int br = 0; br < 3; ++br) {
      const bf16_t* Y = (const bf16_t*)(p.ws + (br == 0 ? OFF_YD : br == 1 ? OFF_YS : OFF_YW));
      const bf16_t* W = (const bf16_t*)(p.ws + (br == 0 ? OFF_W_PD : br == 1 ? OFF_W_PS : OFF_W_PW));
      gemm_mainloop(acc, Y + (size_t)m0 * 512, 512, W + (size_t)n0 * 512, 512, 512, As, Bs);
      if (br < 2) {
        EPI_LOOP_BEGIN
          const f32x4 g0 = ld_bf4(gt + (size_t)row * 3072 + br * 1024 + col), g1 = ld_bf4(gt + (size_t)row * 3072 + (br + 1) * 1024 + col);
#pragma unroll
          for (int j = 0; j < 4; ++j) acc[mi][ni][j] *= fmaxf(g0[j], 1e-30f) / fmaxf(g1[j], 1e-30f);
        EPI_LOOP_END
      } else {
        EPI_LOOP_BEGIN
          const f32x4 g2 = ld_bf4(gt + (size_t)row * 3072 + 2048 + col);
          u32x2 o; o[0] = pack2(acc[mi][ni][0] * fmaxf(g2[0], 1e-30f), acc[mi][ni][1] * fmaxf(g2[1], 1e-30f)); o[1] = pack2(acc[mi][ni][2] * fmaxf(g2[2], 1e-30f), acc[mi][ni][3] * fmaxf(g2[3], 1e-30f));
          *(u32x2*)(mo + (size_t)row * D + col) = o;
        EPI_LOOP_END
      }
    }
  }
}
DI void resid_phase(const Params& p, int l, const bf16_t* A, int K, const bf16_t* W, int gate_off, float* dst, int MT, unsigned char* smem, bool first = false) {
  bf16_t* As = (bf16_t*)smem; bf16_t* Bs = As + 128 * LDT;
  const float* h = (const float*)(p.ws + OFF_H);
  const float* modv = (const float*)(p.ws + OFF_MODV) + (size_t)l * 5 * 6144;
  constexpr int NT = 8;
  for (int t = get_bid(); t < MT * NT; t += gridDim.x) {
    const int m0 = (t / NT) * 128, n0 = (t % NT) * 128;
    f32x4 acc[4][4]; zero_acc(acc);
    gemm_mainloop(acc, A + (size_t)m0 * K, K, W + (size_t)n0 * K, K, K, As, Bs);
    const int bb = m0 < NLAT ? m0 / SEQ : 4;
    EPI_LOOP_BEGIN
      const f32x4 gv = *(const f32x4*)(modv + bb * 6144 + gate_off + col);
      const f32x4 hv = *(const f32x4*)((first ? (row < NLAT ? p.x + (size_t)row * D : p.ctx + (size_t)(row - NLAT) * D) : h + (size_t)row * D) + col);
      *(f32x4*)(dst + (size_t)row * D + col) = hv + gv * acc[mi][ni];
    EPI_LOOP_END
  }
}
DI void ff1_phase(const Params& p, int MT, unsigned char* smem) {
  bf16_t* As = (bf16_t*)smem; bf16_t* Bs = As + 128 * LDT;
  const bf16_t* A = (const bf16_t*)(p.ws + OFF_ABUF); const bf16_t* W = (const bf16_t*)(p.ws + OFF_W_FF1); bf16_t* uo = (bf16_t*)(p.ws + OFF_U);
  constexpr int NT = DFF / 128;
  for (int t = get_bid(); t < MT * NT; t += gridDim.x) {
    const int m0 = (t / NT) * 128, n0 = (t % NT) * 128;
    f32x4 acc[4][4]; zero_acc(acc);
    gemm_mainloop<true>(acc, A + (size_t)m0 * D, D, W + (size_t)n0 * D, D, D, As, Bs);
    const int tid_ = get_tid(), lane_ = tid_ & 63, wid_ = tid_ >> 6, wr_ = wid_ >> 1, wc_ = wid_ & 1, lr_ = lane_ & 15, lg_ = lane_ >> 4;
#pragma unroll
    for (int mi = 0; mi < 4; ++mi) { const int row = m0 + wr_ * 64 + mi * 16 + lr_;
#pragma unroll
      for (int q = 0; q < 2; ++q) { const int col = n0 + wc_ * 64 + q * 32 + lg_ * 8;
        float r[8];
#pragma unroll
        for (int j = 0; j < 4; ++j) { const float v0 = fmaxf(acc[mi][2 * q][j], 0.f), v1 = fmaxf(acc[mi][2 * q + 1][j], 0.f); r[j] = v0 * v0; r[4 + j] = v1 * v1; }
        u32x4 o; o[0] = pack2(r[0], r[1]); o[1] = pack2(r[2], r[3]); o[2] = pack2(r[4], r[5]); o[3] = pack2(r[6], r[7]);
        *(u32x4*)(uo + (size_t)row * DFF + col) = o; } }
  }
}

#define XB_TMO      128
#define XB_XCNT(j)  (256  + 64 * (j))
#define XB_XSUB(j)  (1280 + 64 * (j))
#define XB_XGEN(j)  (2304 + 64 * (j))
#define XB_TOP      3328
#define XB_TOPGEN   3392
#define XCD_BAR_WORDS 3456
#define XB_SPIN_CAP (1u << 18)
#define XLAS __attribute__((address_space(3)))

__device__ __forceinline__ unsigned xb_ld(unsigned* p)              { return __hip_atomic_load(p, __ATOMIC_RELAXED, __HIP_MEMORY_SCOPE_AGENT); }
__device__ __forceinline__ unsigned xb_add(unsigned* p, unsigned v) { return __hip_atomic_fetch_add(p, v, __ATOMIC_RELAXED, __HIP_MEMORY_SCOPE_AGENT); }
__device__ __forceinline__ unsigned xb_xcc_id() { return (unsigned)__builtin_amdgcn_s_getreg((3 << 11) | 20) & 0xFu; }
#define XB_SPIN(cond, bar) do { unsigned _sp = 0; while (cond) { __builtin_amdgcn_s_sleep(1); \
    if ((++_sp & 255u) == 0u) { if (xb_ld(&(bar)[XB_TMO])) break; if (_sp > XB_SPIN_CAP) { atomicAdd(&(bar)[XB_TMO], 1u); break; } } } } while (0)

struct XcdBarrier {
    unsigned* bar; unsigned x;
    volatile XLAS unsigned* st;
};

__device__ __forceinline__ XcdBarrier xcd_barrier_post(unsigned* bar, volatile XLAS unsigned* st) {
    XcdBarrier b; b.bar = bar; b.x = xb_xcc_id(); b.st = st;
    if (threadIdx.x == 0) (void)xb_add(&bar[XB_XCNT(b.x)], 1u);
    return b;
}
__device__ __forceinline__ void xcd_barrier_complete(unsigned* bar, unsigned x, unsigned& nloc, unsigned& nx) {
    const unsigned G = gridDim.x * gridDim.y * gridDim.z;
    unsigned sum, cnt, mine, sp = 0u;
    for (;;) {
        sum = 0u; cnt = 0u; mine = 0u;
#pragma unroll
        for (unsigned j = 0; j < 16; ++j) { const unsigned c = xb_ld(&bar[XB_XCNT(j)]); sum += c; cnt += (c > 0u) ? 1u : 0u; mine = (j == x) ? c : mine; }
        if (sum == G) break;
        __builtin_amdgcn_s_sleep(1);
        if ((++sp & 255u) == 0u) { if (xb_ld(&bar[XB_TMO])) break; if (sp > XB_SPIN_CAP) { atomicAdd(&bar[XB_TMO], 1u); break; } }
    }
    nloc = mine > 0u ? mine : 1u; nx = cnt > 0u ? cnt : 1u;
}

__device__ __forceinline__ void xcd_barrier(const XcdBarrier& b) {
    asm volatile("s_waitcnt vmcnt(0)" ::: "memory");
    __syncthreads();
    if (threadIdx.x == 0) {
        unsigned* bar = b.bar;
        __builtin_amdgcn_s_waitcnt(0);
        unsigned nloc = b.st[0], nx = b.st[1];
        if (nloc == 0u) { xcd_barrier_complete(bar, b.x, nloc, nx); b.st[0] = nloc; b.st[1] = nx; }
        const unsigned old = xb_add(&bar[XB_XSUB(b.x)], 1u);
        const unsigned gen = old / nloc;
        if (old + 1u == (gen + 1u) * nloc) {
            __builtin_amdgcn_fence(__ATOMIC_RELEASE, "agent");
            asm volatile("s_waitcnt vmcnt(0)" ::: "memory");
            const unsigned og = xb_add(&bar[XB_TOP], 1u);
            const unsigned tg = og / nx;
            if (og + 1u == (tg + 1u) * nx) xb_add(&bar[XB_TOPGEN], 1u);
            else XB_SPIN(xb_ld(&bar[XB_TOPGEN]) == tg, bar);
            __builtin_amdgcn_fence(__ATOMIC_ACQUIRE, "agent");
            xb_add(&bar[XB_XGEN(b.x)], 1u);
            asm volatile("s_waitcnt vmcnt(0)" ::: "memory");
        } else {
            XB_SPIN(xb_ld(&bar[XB_XGEN(b.x)]) == gen, bar);
            __builtin_amdgcn_fence(__ATOMIC_ACQUIRE, "agent");
            asm volatile("s_waitcnt vmcnt(0)" ::: "memory");
        }
    }
    __syncthreads();
}


__global__ void __launch_bounds__(256, 2) fwd_megakernel(Params p) {
  __shared__ __attribute__((aligned(16))) unsigned char smem[SMEM_BYTES];
  __shared__ uint4 xb_words;
  cg::grid_group grid = cg::this_grid();
  unsigned char* ws = p.ws;
  if (threadIdx.x == 0) xb_words = make_uint4(0u, 0u, 0u, 0u);
  __syncthreads();
  const XcdBarrier xb = xcd_barrier_post((unsigned*)(ws + OFF_BAR), (volatile XLAS unsigned*)&xb_words);
  phase0_misc(p, smem);
  __syncthreads();
  convert_layer(p, 0, 0, smem);
  if (p.ws == nullptr) grid.sync();
  for (int l = 0; l < DEPTH; ++l) {
    const bool need_ctx = l < DEPTH - 1;
    const int MT = need_ctx ? NTOK / 128 : NLAT / 128;
    xcd_barrier(xb);
    if (l > 0) convert_layer(p, l, CONV_EARLY, smem);
    norm_phase(p, l, p.norm1_g + l * D, 0, 1024, NTOK, l == 0);
    xcd_barrier(xb);
    inproj_phase(p, l, smem);
    xcd_barrier(xb);
    mixer_phase(p, l, smem);
    xcd_barrier(xb);
    glu_phase(p, MT, smem);
    xcd_barrier(xb);
    merge_phase(p, MT, smem);
    xcd_barrier(xb);
    resid_phase(p, l, (const bf16_t*)(ws + OFF_M), D, (const bf16_t*)(ws + OFF_W_OUT), 2048, (float*)(ws + OFF_H), MT, smem, l == 0);
    xcd_barrier(xb);
    norm_phase(p, l, p.norm2_g + l * D, 3072, 4096, MT * 128);
    xcd_barrier(xb);
    ff1_phase(p, MT, smem);
    xcd_barrier(xb);
    resid_phase(p, l, (const bf16_t*)(ws + OFF_U), DFF, (const bf16_t*)(ws + OFF_W_FF2), 5120, need_ctx ? (float*)(ws + OFF_H) : p.out, MT, smem);
    if (need_ctx) convert_steal(p, l + 1, smem);
  }
}

extern "C" void kernel_launch(void* const* d_in, const int* in_sizes, int n_in, void* d_out, int out_size, void* d_ws, size_t ws_size, hipStream_t stream) {
  static int grid_blocks = 0;
  if (!grid_blocks) {
    int dev = 0, cus = 0, per_cu = 0;
    (void)hipGetDevice(&dev);
    (void)hipDeviceGetAttribute(&cus, hipDeviceAttributeMultiprocessorCount, dev);
    (void)hipOccupancyMaxActiveBlocksPerMultiprocessor(&per_cu, fwd_megakernel, 256, 0);
    if (per_cu > 2) per_cu = 2;
    if (per_cu < 1) per_cu = 1;
    grid_blocks = cus * per_cu;
  }
  if (ws_size < WS_NEED) { fprintf(stderr, "workspace too small: %zu < %zu\n", ws_size, (size_t)WS_NEED); return; }
  (void)hipMemsetAsync((unsigned char*)d_ws + OFF_BAR, 0, BAR_BYTES, stream);
  Params p{};
  const float* const* in = (const float* const*)d_in;
  p.x = in[0]; p.c = in[1]; p.ctx = in[2]; p.c_ctx = in[3]; p.w_mod = in[4]; p.b_mod = in[5]; p.norm1_g = in[6]; p.norm2_g = in[7]; p.w_in = in[8];
  p.dq_g = in[9]; p.dk_g = in[10]; p.lq1 = in[11]; p.lk1 = in[12]; p.lq2 = in[13]; p.lk2 = in[14]; p.dout_g = in[15];
  p.s5_lre = in[16]; p.s5_lim = in[17]; p.s5_ldt = in[18]; p.s5_bre = in[19]; p.s5_bim = in[20]; p.s5_cre = in[21]; p.s5_cim = in[22]; p.s5_d = in[23]; p.s5_wglu = in[24];
  p.wq_g = in[25]; p.wk_g = in[26]; p.w_sink = in[27];
  p.w_pd = in[28]; p.w_ps = in[29]; p.w_pw = in[30]; p.w_out = in[31]; p.w_ff1 = in[32]; p.w_ff2 = in[33];
  p.out = (float*)d_out; p.ws = (unsigned char*)d_ws;
  void* args[] = {&p};
  hipError_t e = hipLaunchCooperativeKernel((void*)fwd_megakernel, dim3(grid_blocks), dim3(256), args, 0, stream);
  if (e != hipSuccess) fprintf(stderr, "cooperative launch failed: %s (grid %d)\n", hipGetErrorString(e), grid_blocks);
}
```

```cpp
#include <hip/hip_runtime.h>
#include <hip/hip_cooperative_groups.h>
#include <cstdio>
#include <cstdint>
namespace cg = cooperative_groups;

typedef unsigned short bf16_t;
typedef short bf16x8 __attribute__((ext_vector_type(8)));
typedef short bf16x4 __attribute__((ext_vector_type(4)));
typedef float f32x4 __attribute__((ext_vector_type(4)));
typedef float f32x2 __attribute__((ext_vector_type(2)));
typedef unsigned u32x4 __attribute__((ext_vector_type(4)));
typedef unsigned u32x2 __attribute__((ext_vector_type(2)));
typedef __bf16 bf2_t __attribute__((ext_vector_type(2)));

#define DI __device__ __forceinline__
#define MFMA16(a, b, c) __builtin_amdgcn_mfma_f32_16x16x32_bf16((a), (b), (c), 0, 0, 0)

constexpr int D = 1024, NB = 4, SEQ = 4096, DEPTH = 4, CTX = 256, POS = CTX + SEQ  ;
constexpr int NLAT = NB * SEQ  , NCTX = NB * CTX  , NTOK = NLAT + NCTX  ;
constexpr int DIN = 5888, DFF = 4096;
constexpr float EPS = 1e-6f;
constexpr float LOG2E = 1.4426950408889634f;
constexpr int NCH = POS / 32;

constexpr size_t SZ_W_IN = (size_t)DIN * D * 2, SZ_W_GLU = 512 * 512 * 2, SZ_W_P = 1024 * 512 * 2, SZ_W_OUT = (size_t)D * D * 2, SZ_W_FF = (size_t)D * DFF * 2;
constexpr size_t OFF_W_IN = 0;
constexpr size_t OFF_W_GLU = OFF_W_IN + SZ_W_IN;
constexpr size_t OFF_W_PD = OFF_W_GLU + SZ_W_GLU;
constexpr size_t OFF_W_PS = OFF_W_PD + SZ_W_P;
constexpr size_t OFF_W_PW = OFF_W_PS + SZ_W_P;
constexpr size_t OFF_W_OUT = OFF_W_PW + SZ_W_P;
constexpr size_t OFF_W_FF1 = OFF_W_OUT + SZ_W_OUT;
constexpr size_t OFF_W_FF2 = OFF_W_FF1 + SZ_W_FF;
constexpr size_t OFF_MODV = OFF_W_FF2 + SZ_W_FF;
constexpr size_t OFF_ROPE = OFF_MODV + (size_t)DEPTH * 5 * 6144 * 4;
constexpr size_t OFF_LAM = OFF_ROPE + 8192;
constexpr size_t OFF_H = OFF_LAM + 256;
constexpr size_t OFF_ABUF = OFF_H + (size_t)NTOK * D * 4;
constexpr size_t OFF_R1 = OFF_ABUF + (size_t)NTOK * D * 2;
constexpr size_t SZ_HEADBUF = (size_t)NB * 8 * POS * 64 * 2;
constexpr size_t OFF_QD = OFF_R1;
constexpr size_t OFF_KD = OFF_QD + SZ_HEADBUF;
constexpr size_t OFF_VDT = OFF_KD + SZ_HEADBUF;
constexpr size_t OFF_SU = OFF_VDT + SZ_HEADBUF;
constexpr size_t OFF_QW = OFF_SU + (size_t)NTOK * 512 * 2;
constexpr size_t OFF_KW = OFF_QW + SZ_HEADBUF;
constexpr size_t OFF_VWT = OFF_KW + SZ_HEADBUF / 4;
constexpr size_t OFF_GATES = OFF_VWT + SZ_HEADBUF / 4;
constexpr size_t OFF_YD = OFF_GATES + (size_t)NTOK * 3072 * 2;
constexpr size_t OFF_YS = OFF_YD + (size_t)NTOK * 512 * 2;
constexpr size_t OFF_YW = OFF_YS + (size_t)NTOK * 512 * 2;
constexpr size_t OFF_GB = OFF_YW + (size_t)NTOK * 512 * 2;
constexpr size_t OFF_EB = OFF_GB + (size_t)NTOK * 512 * 2;
constexpr size_t OFF_END = OFF_EB + (size_t)NB * 32 * 2 * (NCH + 8) * 64 * 8;
constexpr size_t OFF_BAR = OFF_END;
constexpr size_t BAR_BYTES = 16384;
constexpr size_t WS_NEED = OFF_BAR + BAR_BYTES;
constexpr size_t OFF_M = OFF_QD;
constexpr size_t OFF_U = OFF_R1;
static_assert((size_t)NTOK * DFF * 2 <= OFF_END - OFF_R1, "u alias");

struct Params {
  const float *x, *c, *ctx, *c_ctx, *w_mod, *b_mod, *norm1_g, *norm2_g, *w_in;
  const float *dq_g, *dk_g, *lq1, *lk1, *lq2, *lk2, *dout_g;
  const float *s5_lre, *s5_lim, *s5_ldt, *s5_bre, *s5_bim, *s5_cre, *s5_cim, *s5_d, *s5_wglu;
  const float *wq_g, *wk_g, *w_sink;
  const float *w_pd, *w_ps, *w_pw, *w_out, *w_ff1, *w_ff2;
  float* out;
  unsigned char* ws;
};

DI int get_tid() { int t = threadIdx.x; asm volatile("" : "+v"(t)); return t; }
DI int get_bid() { int b = blockIdx.x; asm volatile("" : "+s"(b)); return b; }
DI unsigned pack2(float lo, float hi) { f32x2 v = {lo, hi}; bf2_t r = __builtin_convertvector(v, bf2_t); return __builtin_bit_cast(unsigned, r); }
DI float sigmoidf_(float x) { return 1.0f / (1.0f + __expf(-x)); }
DI float gelu_tanh(float x) { const float z = 0.7978845608028654f * (x + 0.044715f * x * x * x); const float e = __expf(2.0f * z); const float t = 1.0f - 2.0f / (e + 1.0f); return 0.5f * x * (1.0f + t); }
DI f32x4 ld_bf4(const bf16_t* p_) { const u32x2 r = *(const u32x2*)p_; f32x4 v; v[0] = __uint_as_float(r[0] << 16); v[1] = __uint_as_float(r[0] & 0xffff0000u); v[2] = __uint_as_float(r[1] << 16); v[3] = __uint_as_float(r[1] & 0xffff0000u); return v; }
DI float xshfl(float v, int m) { return __shfl_xor(v, m, 64); }

constexpr int SMEM_BYTES = 65552;
constexpr int LDT = 72;

DI u32x4 gload_async(const void* ptr) { u32x4 r; asm volatile("global_load_dwordx4 %0, %1, off" : "=v"(r) : "v"(ptr) : "memory"); return r; }
#define VM_WAIT8(N, R, Q) asm volatile("s_waitcnt vmcnt(" #N ")" : "+v"(R[0]), "+v"(R[1]), "+v"(R[2]), "+v"(R[3]), "+v"(Q[0]), "+v"(Q[1]), "+v"(Q[2]), "+v"(Q[3]) :: "memory")
template <bool PERM = false>
DI void gemm_mainloop(f32x4 (&acc)[4][4], const bf16_t* __restrict__ A, int lda, const bf16_t* __restrict__ B, int ldb, int K, bf16_t* As, bf16_t* Bs) {
  const int tid = get_tid(), lane = tid & 63, wid = tid >> 6, wr = wid >> 1, wc = wid & 1, lr = lane & 15, lg = lane >> 4;
  const int crow = tid >> 3, ckc = (tid & 7) * 8;
  constexpr int TB = 128 * 64;
  const int swc = (((tid & 7) ^ (crow & 7)) * 8);
  const int swcB = PERM ? (((tid & 7) ^ ((((crow >> 3) & 3) * 2 + ((crow & 7) >> 1)) & 7)) * 8) : swc;
  u32x4 ra0[4], rb0[4], ra1[4], rb1[4];
  const bf16_t* Ap = A + (size_t)crow * lda + ckc; const bf16_t* Bp = B + (size_t)crow * ldb + ckc;
#define GM_LOAD(RA, RB, KOFF) do { _Pragma("unroll") for (int i = 0; i < 4; ++i) { RA[i] = gload_async(Ap + (size_t)(i * 32) * lda + (KOFF)); RB[i] = gload_async(Bp + (size_t)(i * 32) * ldb + (KOFF)); } } while (0)
#define GM_STORE(RA, RB, BUF) do { _Pragma("unroll") for (int i = 0; i < 4; ++i) { *(u32x4*)(As + (BUF) * 2 * TB + (crow + i * 32) * 64 + swc) = RA[i]; *(u32x4*)(As + (BUF) * 2 * TB + TB + (crow + i * 32) * 64 + swcB) = RB[i]; } } while (0)
#define GM_COMPUTE(BUF) do { const bf16_t* as_ = As + (BUF) * 2 * TB; const bf16_t* bs_ = as_ + TB; \
    bf16x8 af[2][4], bfr[2][4];     \
    _Pragma("unroll") for (int ks = 0; ks < 2; ++ks) { const int co_ = ((ks * 4 + lg) ^ (lr & 7)) * 8; \
      _Pragma("unroll") for (int mi = 0; mi < 4; ++mi) af[ks][mi] = *(const bf16x8*)(as_ + (wr * 64 + mi * 16 + lr) * 64 + co_); \
      _Pragma("unroll") for (int ni = 0; ni < 4; ++ni) { \
        if (PERM) { const int rw_ = (ni & 1) * 4 + (lr & 3); const int key_ = ((lr >> 2) * 2 + (rw_ >> 1)) & 7; bfr[ks][ni] = *(const bf16x8*)(bs_ + (wc * 64 + (ni >> 1) * 32 + (lr >> 2) * 8 + rw_) * 64 + (((ks * 4 + lg) ^ key_) * 8)); } \
        else bfr[ks][ni] = *(const bf16x8*)(bs_ + (wc * 64 + ni * 16 + lr) * 64 + co_); } } \
    __builtin_amdgcn_sched_barrier(0); \
    __builtin_amdgcn_s_setprio(1); \
    _Pragma("unroll") for (int ks = 0; ks < 2; ++ks) _Pragma("unroll") for (int mi = 0; mi < 4; ++mi) _Pragma("unroll") for (int ni = 0; ni < 4; ++ni) acc[mi][ni] = MFMA16(bfr[ks][ni], af[ks][mi], acc[mi][ni]); \
    __builtin_amdgcn_s_setprio(0); \
    __builtin_amdgcn_sched_barrier(0); } while (0)
  asm volatile("s_waitcnt vmcnt(0)" ::: "memory");
  GM_LOAD(ra0, rb0, 0); GM_LOAD(ra1, rb1, 64);
  __syncthreads();
  VM_WAIT8(8, ra0, rb0); GM_STORE(ra0, rb0, 0); GM_LOAD(ra0, rb0, (128 < K ? 128 : 0));
  __syncthreads();
  for (int k0 = 0; k0 < K; k0 += 128) {
    const int kn1 = k0 + 192 < K ? k0 + 192 : 0, kn0 = k0 + 256 < K ? k0 + 256 : 0;
    VM_WAIT8(8, ra1, rb1); GM_STORE(ra1, rb1, 1); GM_LOAD(ra1, rb1, kn1);
    GM_COMPUTE(0); __syncthreads();
    VM_WAIT8(8, ra0, rb0); GM_STORE(ra0, rb0, 0); GM_LOAD(ra0, rb0, kn0);
    GM_COMPUTE(1); __syncthreads();
  }
  VM_WAIT8(0, ra0, rb0); VM_WAIT8(0, ra1, rb1);
#undef GM_LOAD
#undef GM_STORE
#undef GM_COMPUTE
}
DI void zero_acc(f32x4 (&acc)[4][4]) {
#pragma unroll
  for (int mi = 0; mi < 4; ++mi)
#pragma unroll
    for (int ni = 0; ni < 4; ++ni) acc[mi][ni] = (f32x4){0.f, 0.f, 0.f, 0.f};
}

DI void convert_tile(const float* __restrict__ src, int K, int N, bf16_t* __restrict__ dst, int kt, int nt, float* tile) {
  const int tid = get_tid();
  { const int r = tid >> 4, c4 = (tid & 15) * 4;
#pragma unroll
    for (int i = 0; i < 4; ++i) { const int k = r + i * 16; const f32x4 v = *(const f32x4*)(src + (size_t)(kt * 64 + k) * N + nt * 64 + c4);
      tile[k * 65 + c4 + 0] = v[0]; tile[k * 65 + c4 + 1] = v[1]; tile[k * 65 + c4 + 2] = v[2]; tile[k * 65 + c4 + 3] = v[3]; } }
  __syncthreads();
  { const int n = tid >> 2, kc = (tid & 3) * 16; u32x4 o0, o1;
#pragma unroll
    for (int q = 0; q < 4; ++q) { o0[q] = pack2(tile[(kc + 2 * q) * 65 + n], tile[(kc + 2 * q + 1) * 65 + n]); o1[q] = pack2(tile[(kc + 8 + 2 * q) * 65 + n], tile[(kc + 8 + 2 * q + 1) * 65 + n]); }
    bf16_t* d = dst + (size_t)(nt * 64 + n) * K + kt * 64 + kc; *(u32x4*)d = o0; *(u32x4*)(d + 8) = o1; }
  __syncthreads();
}
DI void convert_item(const Params& p, int l, int t, float* tile) {
  unsigned char* ws = p.ws;
  const float* src; bf16_t* dst; int K, N, idx;
  if (t < 1472) { idx = t; src = p.w_in + (size_t)l * D * DIN; K = D; N = DIN; dst = (bf16_t*)(ws + OFF_W_IN); }
  else if (t < 1536) { idx = t - 1472; src = p.s5_wglu + (size_t)l * 512 * 512; K = 512; N = 512; dst = (bf16_t*)(ws + OFF_W_GLU); }
  else if (t < 1664) { idx = t - 1536; src = p.w_pd + (size_t)l * 512 * D; K = 512; N = D; dst = (bf16_t*)(ws + OFF_W_PD); }
  else if (t < 1792) { idx = t - 1664; src = p.w_ps + (size_t)l * 512 * D; K = 512; N = D; dst = (bf16_t*)(ws + OFF_W_PS); }
  else if (t < 1920) { idx = t - 1792; src = p.w_pw + (size_t)l * 512 * D; K = 512; N = D; dst = (bf16_t*)(ws + OFF_W_PW); }
  else if (t < 2176) { idx = t - 1920; src = p.w_out + (size_t)l * D * D; K = D; N = D; dst = (bf16_t*)(ws + OFF_W_OUT); }
  else if (t < 3200) { idx = t - 2176; src = p.w_ff1 + (size_t)l * D * DFF; K = D; N = DFF; dst = (bf16_t*)(ws + OFF_W_FF1); }
  else { idx = t - 3200; src = p.w_ff2 + (size_t)l * DFF * D; K = DFF; N = D; dst = (bf16_t*)(ws + OFF_W_FF2); }
  const int nts = N / 64; convert_tile(src, K, N, dst, idx / nts, idx % nts, tile);
}
constexpr int CONV_EARLY = 3200, CONV_ALL = 4224;
DI void convert_layer(const Params& p, int l, int t_begin, unsigned char* smem) {
  float* tile = (float*)smem;
  for (int t = t_begin + get_bid(); t < CONV_ALL; t += gridDim.x) convert_item(p, l, t, tile);
}
DI void convert_steal(const Params& p, int l, unsigned char* smem) {
  float* tile = (float*)smem;
  volatile int* smw = (volatile int*)(smem + SMEM_BYTES - 16);
  unsigned* ctr = (unsigned*)(p.ws + OFF_LAM) + 48 + l;
  for (;;) {
    __syncthreads();
    if (get_tid() == 0) *smw = (int)atomicAdd(ctr, 1u);
    __syncthreads();
    int t = *smw; t = __builtin_amdgcn_readfirstlane(t);
    if (t >= CONV_EARLY) break;
    convert_item(p, l, t, tile);
  }
}

DI void phase0_misc(const Params& p, unsigned char* smem) {
  unsigned char* ws = p.ws;
  const int tid = get_tid();
  if (get_bid() == 0) {
    float* rope = (float*)(ws + OFF_ROPE);
    for (int i = tid; i < 1024; i += 256) { const int pos = i >> 4, f = i & 15; const float inv = powf(10000.0f, -(float)f / 16.0f); const float ang = (float)pos * inv; rope[i] = cosf(ang); rope[1024 + i] = sinf(ang); }
    if (tid < DEPTH) { const int l = tid; float s1 = 0.f, s2 = 0.f;
      for (int i = 0; i < 64; ++i) { s1 += p.lq1[l * 64 + i] * p.lk1[l * 64 + i]; s2 += p.lq2[l * 64 + i] * p.lk2[l * 64 + i]; }
      const float lam_init = 0.8f - 0.6f * expf(-0.3f * (float)l);
      ((float*)(ws + OFF_LAM))[l] = expf(s1) - expf(s2) + lam_init; }
    if (tid >= 64 && tid < 64 + DEPTH) { const int l = tid - 64; float a = 0.f, b2 = 0.f, c2 = 0.f, d2 = 0.f;
      for (int i = 0; i < 64; ++i) { a = fmaxf(a, fabsf(p.dq_g[l * 64 + i])); b2 = fmaxf(b2, fabsf(p.dk_g[l * 64 + i])); c2 = fmaxf(c2, fabsf(p.wq_g[l * 64 + i])); d2 = fmaxf(d2, fabsf(p.wk_g[l * 64 + i])); }
      ((float*)(ws + OFF_LAM))[4 + l] = 8.0f * LOG2E * 1.02f * a * b2;
      ((float*)(ws + OFF_LAM))[8 + l] = 8.0f * LOG2E * 1.02f * c2 * d2;
      for (int i = 0; i < 8; ++i) ((unsigned*)(ws + OFF_LAM))[16 + l * 8 + i] = 0u;
      ((unsigned*)(ws + OFF_LAM))[48 + l] = 0u; }
  }
  float* sc = (float*)smem;
  float* red = sc + 5 * 1024;
  for (int i = tid; i < 5 * 1024; i += 256) { const int bb = i >> 10, k = i & 1023; const float v = bb < 4 ? p.c[bb * 1024 + k] : p.c_ctx[k]; sc[i] = v / (1.0f + __expf(-v)); }
  __syncthreads();
  float* modv = (float*)(ws + OFF_MODV);
  for (int t = get_bid(); t < DEPTH * 96; t += gridDim.x) {
    const int l = t / 96, cb = t % 96, kq = tid >> 6, cl = tid & 63, col = cb * 64 + cl;
    const float* w = p.w_mod + (size_t)l * D * 6144 + col;
    float s[5] = {0.f, 0.f, 0.f, 0.f, 0.f};
    for (int k = kq * 256; k < kq * 256 + 256; ++k) { const float wv = w[(size_t)k * 6144];
#pragma unroll
      for (int bb = 0; bb < 5; ++bb) s[bb] += sc[bb * 1024 + k] * wv; }
#pragma unroll
    for (int bb = 0; bb < 5; ++bb) red[(kq * 5 + bb) * 64 + cl] = s[bb];
    __syncthreads();
    for (int i = tid; i < 5 * 64; i += 256) { const int bb = i >> 6, c2 = i & 63; const float v = red[(0 * 5 + bb) * 64 + c2] + red[(1 * 5 + bb) * 64 + c2] + red[(2 * 5 + bb) * 64 + c2] + red[(3 * 5 + bb) * 64 + c2];
      modv[((size_t)l * 5 + bb) * 6144 + cb * 64 + c2] = v + p.b_mod[l * 6144 + cb * 64 + c2]; }
    __syncthreads();
  }
}

DI void norm_phase(const Params& p, int l, const float* gvec, int sh_off, int sc_off, int nrows, bool first = false) {
  const int tid = get_tid(), lane = tid & 63, wid = tid >> 6;
  const float* h = (const float*)(p.ws + OFF_H); bf16_t* out = (bf16_t*)(p.ws + OFF_ABUF);
  const float* modv = (const float*)(p.ws + OFF_MODV) + (size_t)l * 5 * 6144;
  for (int t = get_bid(); t < nrows / 4; t += gridDim.x) {
    const int row = t * 4 + wid; const int bb = row < NLAT ? row / SEQ : 4;
    const float* hr = first ? (row < NLAT ? p.x + (size_t)row * D : p.ctx + (size_t)(row - NLAT) * D) : h + (size_t)row * D; const float* mv = modv + bb * 6144;
    f32x4 v[4]; float ss = 0.f;
#pragma unroll
    for (int it = 0; it < 4; ++it) { v[it] = *(const f32x4*)(hr + it * 256 + lane * 4); ss += v[it][0] * v[it][0] + v[it][1] * v[it][1] + v[it][2] * v[it][2] + v[it][3] * v[it][3]; }
#pragma unroll
    for (int m = 1; m < 64; m <<= 1) ss += xshfl(ss, m);
    const float rstd = rsqrtf(ss * (1.0f / 1024.0f) + EPS);
#pragma unroll
    for (int it = 0; it < 4; ++it) { const int idx = it * 256 + lane * 4;
      const f32x4 g = *(const f32x4*)(gvec + idx), s1 = *(const f32x4*)(mv + sc_off + idx), s0 = *(const f32x4*)(mv + sh_off + idx);
      float y[4];
#pragma unroll
      for (int j = 0; j < 4; ++j) y[j] = v[it][j] * rstd * g[j] * (1.0f + s1[j]) + s0[j];
      u32x2 o; o[0] = pack2(y[0], y[1]); o[1] = pack2(y[2], y[3]); *(u32x2*)(out + (size_t)row * D + idx) = o; }
  }
}

DI void inproj_epilogue(const Params& p, int l, const f32x4 (&acc)[4][4], int m0, int n0) {
  unsigned char* ws = p.ws;
  const int tid = get_tid(), lane = tid & 63, wid = tid >> 6, wr = wid >> 1, wc = wid & 1, lr = lane & 15, lg = lane >> 4;
  const bool is_lat = m0 < NLAT;
  int b, i0; if (is_lat) { b = m0 / SEQ; i0 = m0 % SEQ; } else { const int c0 = m0 - NLAT; b = c0 / CTX; i0 = c0 % CTX; }
  const int pos0 = is_lat ? CTX + i0 : i0;
  const int hc = n0 + wc * 64;
  int seg;
  if (n0 < 512) seg = 0; else if (n0 < 1024) seg = 1; else if (n0 < 1536) seg = 2; else if (n0 < 2048) seg = 3; else if (n0 < 2560) seg = 4; else if (n0 < 2688) seg = 5; else if (n0 < 2816) seg = 6; else seg = 7;
  if (seg == 0 || seg == 1 || seg == 4 || seg == 5) {
    const float* gv; bf16_t* dst; float qs = 1.0f;
    if (seg == 0) { const int c = hc; gv = p.dq_g + l * 64; dst = (bf16_t*)(ws + OFF_QD) + ((size_t)((b * 2 + c / 256) * 4 + (c % 256) / 64) * POS) * 64; qs = 0.125f * LOG2E; }
    else if (seg == 1) { const int c = hc - 512; gv = p.dk_g + l * 64; dst = (bf16_t*)(ws + OFF_KD) + ((size_t)((b * 2 + c / 256) * 4 + (c % 256) / 64) * POS) * 64; }
    else if (seg == 4) { const int c = hc - 2048; gv = p.wq_g + l * 64; dst = (bf16_t*)(ws + OFF_QW) + ((size_t)(b * 8 + c / 64) * POS) * 64; qs = 0.125f * LOG2E; }
    else { const int c = hc - 2560; gv = p.wk_g + l * 64; dst = (bf16_t*)(ws + OFF_KW) + ((size_t)(b * 2 + c / 64) * POS) * 64; }
    const float* rope = (const float*)(ws + OFF_ROPE);
    f32x4 gq[4];
#pragma unroll
    for (int ni = 0; ni < 4; ++ni) gq[ni] = *(const f32x4*)(gv + ni * 16 + lg * 4);
#pragma unroll
    for (int mi = 0; mi < 4; ++mi) {
      const int r = wr * 64 + mi * 16 + lr;
      float ss = 0.f;
#pragma unroll
      for (int ni = 0; ni < 4; ++ni)
#pragma unroll
        for (int j = 0; j < 4; ++j) ss += acc[mi][ni][j] * acc[mi][ni][j];
      ss += xshfl(ss, 16); ss += xshfl(ss, 32);
      const float rstd = rsqrtf(ss * (1.0f / 64.0f) + EPS);
      f32x4 v[4];
#pragma unroll
      for (int ni = 0; ni < 4; ++ni) v[ni] = acc[mi][ni] * rstd * gq[ni];
      if (is_lat) {
        const int li = i0 + r, gr = li >> 6, gc = li & 63;
#pragma unroll
        for (int ni = 0; ni < 2; ++ni) {
          const int pi = ni == 0 ? gr : gc;
          const f32x4 cs = *(const f32x4*)(rope + pi * 16 + lg * 4), sn = *(const f32x4*)(rope + 1024 + pi * 16 + lg * 4);
          const f32x4 x1 = v[ni], x2 = v[ni + 2];
          v[ni] = x1 * cs - x2 * sn; v[ni + 2] = x2 * cs + x1 * sn;
        }
      }
      bf16_t* drow = dst + (size_t)(pos0 + r) * 64 + lg * 4;
#pragma unroll
      for (int ni = 0; ni < 4; ++ni) { u32x2 o; o[0] = pack2(v[ni][0] * qs, v[ni][1] * qs); o[1] = pack2(v[ni][2] * qs, v[ni][3] * qs); *(u32x2*)(drow + ni * 16) = o; }
    }
  } else if (seg == 2 || seg == 6) {
#pragma unroll
    for (int mi = 0; mi < 4; ++mi) {
      const int pos = pos0 + wr * 64 + mi * 16 + lr;
#pragma unroll
      for (int ni = 0; ni < 4; ++ni)
#pragma unroll
        for (int j = 0; j < 4; ++j) {
          const int col = hc + ni * 16 + lg * 4 + j; bf16_t* dst;
          if (seg == 2) { const int c = col - 1024; dst = (bf16_t*)(ws + OFF_VDT) + ((size_t)(b * 4 + c / 128) * 128 + (c % 128)) * POS + pos; }
          else { const int c = col - 2688; dst = (bf16_t*)(ws + OFF_VWT) + ((size_t)(b * 2 + c / 64) * 64 + (c % 64)) * POS + pos; }
          *dst = (bf16_t)(pack2(acc[mi][ni][j], 0.f) & 0xffffu);
        }
    }
  } else if (seg == 3) {
    bf16_t* su = (bf16_t*)(ws + OFF_SU);
#pragma unroll
    for (int mi = 0; mi < 4; ++mi) { const int pos = pos0 + wr * 64 + mi * 16 + lr;
#pragma unroll
      for (int ni = 0; ni < 4; ++ni) { u32x2 o; o[0] = pack2(acc[mi][ni][0], acc[mi][ni][1]); o[1] = pack2(acc[mi][ni][2], acc[mi][ni][3]);
        *(u32x2*)(su + ((size_t)(b * 32 + (hc - 1536) / 16 + ni) * POS + pos) * 16 + lg * 4) = o; } }
  } else {
    bf16_t* gt = (bf16_t*)(ws + OFF_GATES);
#pragma unroll
    for (int mi = 0; mi < 4; ++mi) { const int row = m0 + wr * 64 + mi * 16 + lr;
#pragma unroll
      for (int ni = 0; ni < 4; ++ni) { u32x2 o; o[0] = pack2(sigmoidf_(acc[mi][ni][0]), sigmoidf_(acc[mi][ni][1])); o[1] = pack2(sigmoidf_(acc[mi][ni][2]), sigmoidf_(acc[mi][ni][3]));
        *(u32x2*)(gt + (size_t)row * 3072 + (hc - 2816) + ni * 16 + lg * 4) = o; } }
  }
}
DI void inproj_phase(const Params& p, int l, unsigned char* smem) {
  bf16_t* As = (bf16_t*)smem; bf16_t* Bs = As + 128 * LDT;
  const bf16_t* A = (const bf16_t*)(p.ws + OFF_ABUF); const bf16_t* W = (const bf16_t*)(p.ws + OFF_W_IN);
  constexpr int NT = DIN / 128, MT = NTOK / 128;
  for (int t = get_bid(); t < MT * NT; t += gridDim.x) {
    const int mt = t / NT, nt = t % NT;
    f32x4 acc[4][4]; zero_acc(acc);
    gemm_mainloop(acc, A + (size_t)mt * 128 * D, D, W + (size_t)nt * 128 * D, D, D, As, Bs);
    inproj_epilogue(p, l, acc, mt * 128, nt * 128);
  }
}

constexpr int NW = 4;
constexpr int NTHR = NW * 64;
constexpr int QU = NW * 32;
template <int DV, bool TWOK>
DI void attn_core_d1(f32x4 (&O)[2][DV / 16], float (&lsum)[2], const bf16x8 (&Qf)[2][2], float negm,
                  const bf16_t* __restrict__ Kp0, const bf16_t* __restrict__ Kp1, const bf16_t* __restrict__ Vt, int t0, int t1, int tm0, int tm1, int qlat0, unsigned char* smem) {
  constexpr int KB = TWOK ? 16384 : 8192, BUFB = KB + DV * 128;
  constexpr int NKL = (TWOK ? 16 : 8) / NW, NVL = DV / 8 / NW;
  const int tid = get_tid(), lane = tid & 63, wid = __builtin_amdgcn_readfirstlane(tid >> 6), lr = lane & 15, lg = lane >> 4;
  const int rl = lane >> 3, lc = (lane & 7) ^ rl;
  const int n0 = t1 - t0, ntl = n0 + (tm1 - tm0);
  u32x4 rk[NKL], rv[NVL];
#define ATTN_GLOAD(KEY0) do { const int key0_ = (KEY0); \
    _Pragma("unroll") for (int i = 0; i < NKL; ++i) { const int L = wid + i * NW; const bf16_t* kp_ = (i * NW >= 8) ? Kp1 : Kp0; rk[i] = *(const u32x4*)(kp_ + (size_t)(key0_ + (L & 7) * 8 + rl) * 64 + lc * 8); } \
    _Pragma("unroll") for (int i = 0; i < NVL; ++i) { const int L = wid + i * NW; rv[i] = *(const u32x4*)(Vt + (size_t)(L * 8 + rl) * POS + key0_ + lc * 8); } } while (0)
#define ATTN_LSTORE(BUF) do { unsigned char* buf_ = (BUF); \
    _Pragma("unroll") for (int i = 0; i < NKL; ++i) *(u32x4*)(buf_ + (wid + i * NW) * 1024 + lane * 16) = rk[i]; \
    _Pragma("unroll") for (int i = 0; i < NVL; ++i) *(u32x4*)(buf_ + KB + (wid + i * NW) * 1024 + lane * 16) = rv[i]; } while (0)
  ATTN_GLOAD((n0 > 0 ? t0 : tm0) * 64);
  __syncthreads();
  ATTN_LSTORE(smem);
  const int sw = lr & 7;
  for (int it = 0; it < ntl; ++it) {
    const bool masked = it >= n0;
    const int key0 = (masked ? tm0 + (it - n0) : t0 + it) * 64;
    const unsigned char* Kb = smem + (it & 1) * BUFB; const unsigned char* Vb = Kb + KB;
    __syncthreads();
    if (it + 1 < ntl) ATTN_GLOAD(((it + 1) >= n0 ? tm0 + (it + 1 - n0) : t0 + it + 1) * 64);
    f32x4 s[4][2];
#pragma unroll
    for (int kt = 0; kt < 4; ++kt) {
      const unsigned char* kr = Kb + (kt * 16 + lr) * 128;
      if (!TWOK) {
        const bf16x8 k0f = *(const bf16x8*)(kr + ((lg ^ sw) << 4)), k1f = *(const bf16x8*)(kr + (((4 + lg) ^ sw) << 4));
#pragma unroll
        for (int qt = 0; qt < 2; ++qt) { f32x4 z = {negm, negm, negm, negm}; z = MFMA16(k0f, Qf[qt][0], z); s[kt][qt] = MFMA16(k1f, Qf[qt][1], z); }
      } else {
#pragma unroll
        for (int qt = 0; qt < 2; ++qt) {
          const bf16x8 k0f = *(const bf16x8*)(kr + qt * 8192 + ((lg ^ sw) << 4)), k1f = *(const bf16x8*)(kr + qt * 8192 + (((4 + lg) ^ sw) << 4));
          f32x4 z = {negm, negm, negm, negm}; z = MFMA16(k0f, Qf[qt][0], z); s[kt][qt] = MFMA16(k1f, Qf[qt][1], z); }
      }
    }
    if (masked) {
#pragma unroll
      for (int kt = 0; kt < 4; ++kt)
#pragma unroll
        for (int qt = 0; qt < 2; ++qt)
#pragma unroll
          for (int j = 0; j < 4; ++j) { const int kl = key0 - CTX + kt * 16 + lg * 4 + j, ql = qlat0 + qt * 16 + lr; const int rel = kl - ql; if (rel > 128 || rel < -128) s[kt][qt][j] = -INFINITY; }
    }
    bf16x8 pf[2][2];
#pragma unroll
    for (int qt = 0; qt < 2; ++qt) {
      float rs = 0.f;
#pragma unroll
      for (int kt = 0; kt < 4; ++kt)
#pragma unroll
        for (int j = 0; j < 4; ++j) { const float e = __builtin_amdgcn_exp2f(s[kt][qt][j]); s[kt][qt][j] = e; rs += e; }
      lsum[qt] += rs;
#pragma unroll
      for (int kk = 0; kk < 2; ++kk) {
        u32x4 w; w[0] = pack2(s[2 * kk][qt][0], s[2 * kk][qt][1]); w[1] = pack2(s[2 * kk][qt][2], s[2 * kk][qt][3]);
        w[2] = pack2(s[2 * kk + 1][qt][0], s[2 * kk + 1][qt][1]); w[3] = pack2(s[2 * kk + 1][qt][2], s[2 * kk + 1][qt][3]);
        pf[qt][kk] = __builtin_bit_cast(bf16x8, w);
      }
    }
#pragma unroll
    for (int et = 0; et < DV / 16; ++et)
#pragma unroll
      for (int kk = 0; kk < 2; ++kk) {
        const unsigned char* vr = Vb + (et * 16 + lr) * 128 + (lg & 1) * 8;
        const int c0 = kk * 4 + (lg >> 1);
        const bf16x4 lo = *(const bf16x4*)(vr + ((c0 ^ sw) << 4)), hi = *(const bf16x4*)(vr + (((c0 + 2) ^ sw) << 4));
        const bf16x8 vf = __builtin_shufflevector(lo, hi, 0, 1, 2, 3, 4, 5, 6, 7);
        O[0][et] = MFMA16(vf, pf[0][kk], O[0][et]);
        O[1][et] = MFMA16(vf, pf[1][kk], O[1][et]);
      }
    if (it + 1 < ntl) ATTN_LSTORE(smem + ((it + 1) & 1) * BUFB);
  }
#undef ATTN_GLOAD
#undef ATTN_LSTORE
}

#define VM_WAIT4(N, R, Q) asm volatile("s_waitcnt vmcnt(" #N ")" : "+v"(R[0]), "+v"(R[1]), "+v"(Q[0]), "+v"(Q[1]) :: "memory")
template <int DV, bool TWOK>
DI void attn_core(f32x4 (&O)[2][DV / 16], float (&lsum)[2], const bf16x8 (&Qf)[2][2], float negm,
                  const bf16_t* __restrict__ Kp0, const bf16_t* __restrict__ Kp1, const bf16_t* __restrict__ Vt, int t0, int t1, int tm0, int tm1, int qlat0, unsigned char* smem) {
  constexpr int KB = TWOK ? 16384 : 8192, BUFB = KB + DV * 128;
  constexpr int NKL = (TWOK ? 16 : 8) / NW, NVL = DV / 8 / NW;
  static_assert((NKL == 4 && NVL == 4) || (NKL == 2 && NVL == 2), "wait macros are written for 8 or 4 loads per set");
  const int tid = get_tid(), lane = tid & 63, wid = __builtin_amdgcn_readfirstlane(tid >> 6), lr = lane & 15, lg = lane >> 4;
  const int rl = lane >> 3, lc = (lane & 7) ^ rl;
  const int n0 = t1 - t0, ntl = n0 + (tm1 - tm0);
  u32x4 rk0[NKL], rv0[NVL], rk1[NKL], rv1[NVL];
#define ATTN_TILE(I) ({ int i_ = (I); i_ = i_ < ntl ? i_ : ntl - 1; (i_ < n0 ? t0 + i_ : tm0 + (i_ - n0)) * 64; })
#define ATTN_GLOAD(RK, RV, KEY0) do { const int key0_ = (KEY0); \
    _Pragma("unroll") for (int i = 0; i < NKL; ++i) { const int L = wid + i * NW; const bf16_t* kp_ = (i * NW >= 8) ? Kp1 : Kp0; RK[i] = gload_async(kp_ + (size_t)(key0_ + (L & 7) * 8 + rl) * 64 + lc * 8); } \
    _Pragma("unroll") for (int i = 0; i < NVL; ++i) { const int L = wid + i * NW; RV[i] = gload_async(Vt + (size_t)(L * 8 + rl) * POS + key0_ + lc * 8); } } while (0)
#define ATTN_LSTORE(RK, RV, BUF) do { unsigned char* buf_ = (BUF); \
    _Pragma("unroll") for (int i = 0; i < NKL; ++i) *(u32x4*)(buf_ + (wid + i * NW) * 1024 + lane * 16) = RK[i]; \
    _Pragma("unroll") for (int i = 0; i < NVL; ++i) *(u32x4*)(buf_ + KB + (wid + i * NW) * 1024 + lane * 16) = RV[i]; } while (0)
#define ATTN_WAIT(RK, RV) do { if constexpr (NKL == 4) VM_WAIT8(8, RK, RV); else VM_WAIT4(4, RK, RV); } while (0)
#define ATTN_DRAIN(RK, RV) do { if constexpr (NKL == 4) VM_WAIT8(0, RK, RV); else VM_WAIT4(0, RK, RV); } while (0)
  const int sw = lr & 7;
#define ATTN_COMPUTE(IT, BUFP) do { const int it_ = (IT); const bool masked = it_ >= n0; const int key0 = (masked ? tm0 + (it_ - n0) : t0 + it_) * 64; \
    const unsigned char* Kb = (BUFP); const unsigned char* Vb = Kb + KB; \
    bf16x8 pf[2][2]; \
    _Pragma("unroll") for (int qt = 0; qt < 2; ++qt) { f32x4 s4[4]; \
      _Pragma("unroll") for (int kt = 0; kt < 4; ++kt) { const unsigned char* kq = Kb + (kt * 16 + lr) * 128 + (TWOK ? qt * 8192 : 0); \
        const bf16x8 k0f = *(const bf16x8*)(kq + ((lg ^ sw) << 4)), k1f = *(const bf16x8*)(kq + (((4 + lg) ^ sw) << 4)); \
        f32x4 z = {negm, negm, negm, negm}; z = MFMA16(k0f, Qf[qt][0], z); s4[kt] = MFMA16(k1f, Qf[qt][1], z); } \
      if (masked) { \
        _Pragma("unroll") for (int kt = 0; kt < 4; ++kt) _Pragma("unroll") for (int j = 0; j < 4; ++j) { \
          const int kl = key0 - CTX + kt * 16 + lg * 4 + j, ql = qlat0 + qt * 16 + lr; const int rel = kl - ql; if (rel > 128 || rel < -128) s4[kt][j] = -INFINITY; } } \
      float rs = 0.f; \
      _Pragma("unroll") for (int kt = 0; kt < 4; ++kt) _Pragma("unroll") for (int j = 0; j < 4; ++j) { const float e = __builtin_amdgcn_exp2f(s4[kt][j]); s4[kt][j] = e; rs += e; } \
      lsum[qt] += rs; \
      _Pragma("unroll") for (int kk = 0; kk < 2; ++kk) { u32x4 w; w[0] = pack2(s4[2 * kk][0], s4[2 * kk][1]); w[1] = pack2(s4[2 * kk][2], s4[2 * kk][3]); \
        w[2] = pack2(s4[2 * kk + 1][0], s4[2 * kk + 1][1]); w[3] = pack2(s4[2 * kk + 1][2], s4[2 * kk + 1][3]); pf[qt][kk] = __builtin_bit_cast(bf16x8, w); } } \
    _Pragma("unroll") for (int et = 0; et < DV / 16; ++et) _Pragma("unroll") for (int kk = 0; kk < 2; ++kk) { \
        const unsigned char* vr = Vb + (et * 16 + lr) * 128 + (lg & 1) * 8; const int c0 = kk * 4 + (lg >> 1); \
        const bf16x4 lo = *(const bf16x4*)(vr + ((c0 ^ sw) << 4)), hi = *(const bf16x4*)(vr + (((c0 + 2) ^ sw) << 4)); \
        const bf16x8 vf = __builtin_shufflevector(lo, hi, 0, 1, 2, 3, 4, 5, 6, 7); \
        O[0][et] = MFMA16(vf, pf[0][kk], O[0][et]); O[1][et] = MFMA16(vf, pf[1][kk], O[1][et]); } } while (0)
  asm volatile("s_waitcnt vmcnt(0)" ::: "memory");
  ATTN_GLOAD(rk0, rv0, ATTN_TILE(0)); ATTN_GLOAD(rk1, rv1, ATTN_TILE(1));
  __syncthreads();
  ATTN_WAIT(rk0, rv0); ATTN_LSTORE(rk0, rv0, smem); ATTN_GLOAD(rk0, rv0, ATTN_TILE(2));
  for (int it = 0; it < ntl; it += 2) {
    __syncthreads();
    ATTN_COMPUTE(it, smem);
    ATTN_WAIT(rk1, rv1); ATTN_LSTORE(rk1, rv1, smem + BUFB); ATTN_GLOAD(rk1, rv1, ATTN_TILE(it + 3));
    __syncthreads();
    ATTN_COMPUTE(it + 1, smem + BUFB);
    ATTN_WAIT(rk0, rv0); ATTN_LSTORE(rk0, rv0, smem); ATTN_GLOAD(rk0, rv0, ATTN_TILE(it + 4));
  }
  ATTN_DRAIN(rk0, rv0); ATTN_DRAIN(rk1, rv1);
#undef ATTN_TILE
#undef ATTN_GLOAD
#undef ATTN_LSTORE
#undef ATTN_WAIT
#undef ATTN_DRAIN
#undef ATTN_COMPUTE
}

constexpr int QUD = NW * 16;
DI void diff_unit(const Params& p, int l, int b, int hd, bool is_lat, int qi, unsigned char* smem) {
  unsigned char* ws = p.ws;
  const int tid = get_tid(), lane = tid & 63, wid = __builtin_amdgcn_readfirstlane(tid >> 6), lr = lane & 15, lg = lane >> 4;
  const int qpos0 = (is_lat ? CTX + qi * QUD : qi * QUD) + wid * 16;
  const int ntile = is_lat ? POS / 64 : CTX / 64;
  const float lam = ((const float*)(ws + OFF_LAM))[l];
  const float negm = -((const float*)(ws + OFF_LAM))[4 + l];
  const float lam_init = 0.8f - 0.6f * expf(-0.3f * (float)l);
  const size_t hoff0 = (size_t)((b * 2 + 0) * 4 + hd) * POS * 64, hoff1 = (size_t)((b * 2 + 1) * 4 + hd) * POS * 64;
  const bf16_t* Qd = (const bf16_t*)(ws + OFF_QD); const bf16_t* Kd = (const bf16_t*)(ws + OFF_KD);
  bf16x8 Qf[2][2];
#pragma unroll
  for (int ks = 0; ks < 2; ++ks) { Qf[0][ks] = *(const bf16x8*)(Qd + hoff0 + (size_t)(qpos0 + lr) * 64 + ks * 32 + lg * 8); Qf[1][ks] = *(const bf16x8*)(Qd + hoff1 + (size_t)(qpos0 + lr) * 64 + ks * 32 + lg * 8); }
  float lsum[2] = {0.f, 0.f};
  f32x4 O[2][8];
#pragma unroll
  for (int m = 0; m < 2; ++m)
#pragma unroll
    for (int et = 0; et < 8; ++et) O[m][et] = (f32x4){0.f, 0.f, 0.f, 0.f};
  attn_core_d1<128, true>(O, lsum, Qf, negm, Kd + hoff0, Kd + hoff1, (const bf16_t*)(ws + OFF_VDT) + (size_t)(b * 4 + hd) * 128 * POS, 0, ntile, 0, 0, 0, smem);
  float l0 = lsum[0], l1 = lsum[1];
  l0 += xshfl(l0, 16); l0 += xshfl(l0, 32); l1 += xshfl(l1, 16); l1 += xshfl(l1, 32);
  const float i0 = 1.0f / l0, i1 = lam / l1;
  float ss = 0.f;
#pragma unroll
  for (int et = 0; et < 8; ++et) { O[0][et] = O[0][et] * i0 - O[1][et] * i1;
#pragma unroll
    for (int j = 0; j < 4; ++j) ss += O[0][et][j] * O[0][et][j]; }
  ss += xshfl(ss, 16); ss += xshfl(ss, 32);
  const float rs = rsqrtf(ss * (1.0f / 128.0f) + EPS) * (1.0f - lam_init);
  const float* og = p.dout_g + l * 128; bf16_t* yd = (bf16_t*)(ws + OFF_YD);
  const int qpos = qpos0 + lr;
  const int row = is_lat ? b * SEQ + (qpos - CTX) : NLAT + b * CTX + qpos;
#pragma unroll
  for (int et = 0; et < 8; ++et) { const f32x4 g = *(const f32x4*)(og + et * 16 + lg * 4); const f32x4 y = O[0][et] * rs * g;
    u32x2 o; o[0] = pack2(y[0], y[1]); o[1] = pack2(y[2], y[3]); *(u32x2*)(yd + (size_t)row * 512 + hd * 128 + et * 16 + lg * 4) = o; }
}

DI void win_unit(const Params& p, int l, int b, int qh, bool is_lat, int qi, unsigned char* smem) {
  unsigned char* ws = p.ws;
  const int tid = get_tid(), lane = tid & 63, wid = __builtin_amdgcn_readfirstlane(tid >> 6), lr = lane & 15, lg = lane >> 4;
  const int qpos0 = (is_lat ? CTX + qi * QU : qi * QU) + wid * 32;
  const int kv = qh >> 2;
  const bf16_t* Qp = (const bf16_t*)(ws + OFF_QW) + ((size_t)(b * 8 + qh) * POS + qpos0) * 64;
  bf16x8 Qf[2][2];
#pragma unroll
  for (int qt = 0; qt < 2; ++qt)
#pragma unroll
    for (int ks = 0; ks < 2; ++ks) Qf[qt][ks] = *(const bf16x8*)(Qp + (qt * 16 + lr) * 64 + ks * 32 + lg * 8);
  const float sk = p.w_sink[l * 8 + qh] * LOG2E;
  const float mfix = fmaxf(((const float*)(ws + OFF_LAM))[8 + l], sk);
  const float l0 = lg == 0 ? __builtin_amdgcn_exp2f(sk - mfix) : 0.f;
  float lsum[2] = {l0, l0};
  f32x4 O[2][4];
#pragma unroll
  for (int qt = 0; qt < 2; ++qt)
#pragma unroll
    for (int et = 0; et < 4; ++et) O[qt][et] = (f32x4){0.f, 0.f, 0.f, 0.f};
  int tm0 = 0, tm1 = 0;
  if (is_lat) { const int q0 = qi * QU; tm0 = (q0 + 128) / 64; if (tm0 < 4) tm0 = 4; tm1 = (q0 + QU + 384) / 64; if (tm1 > POS / 64) tm1 = POS / 64; }
  attn_core<64, false>(O, lsum, Qf, -mfix, (const bf16_t*)(ws + OFF_KW) + (size_t)(b * 2 + kv) * POS * 64, nullptr, (const bf16_t*)(ws + OFF_VWT) + (size_t)(b * 2 + kv) * 64 * POS, 0, 4, tm0, tm1, qpos0 - CTX, smem);
  bf16_t* yw = (bf16_t*)(ws + OFF_YW);
#pragma unroll
  for (int qt = 0; qt < 2; ++qt) {
    float ls = lsum[qt]; ls += xshfl(ls, 16); ls += xshfl(ls, 32);
    const float inv = 1.0f / ls;
    const int qpos = qpos0 + qt * 16 + lr;
    const int row = is_lat ? b * SEQ + (qpos - CTX) : NLAT + b * CTX + qpos;
#pragma unroll
    for (int et = 0; et < 4; ++et) { const f32x4 y = O[qt][et] * inv; u32x2 o; o[0] = pack2(y[0], y[1]); o[1] = pack2(y[2], y[3]);
      *(u32x2*)(yw + (size_t)row * 512 + qh * 64 + et * 16 + lg * 4) = o; }
  }
}

constexpr int NR = NW / 2, CR = NCH / NR;
constexpr int BST = 20, SST = 136;
constexpr int S5_WAVE_LDS = 128 * BST * 4 + 16 * SST * 2;
constexpr int EB_PER_UNIT = 2 * (NCH + 8) * 64 * 2;
DI int s5_row(int b, int k, int t) { return k < 8 ? NLAT + b * CTX + k * 32 + t : b * SEQ + (k - 8) * 32 + t; }
DI int s5_cmap(int d, int k) { return d == 0 ? k : (k < 8 ? 7 - k : 143 - k); }
DI void s5_make_bf(const Params& p, int l, int d, int g, float fre, float fim, bf16x8 (&Bf)[8], int lr, int lg) {
#pragma unroll
  for (int q = 0; q < 8; ++q) {
    const int pp = 16 * (q & 3) + lr;
    const float fr = __shfl(fre, pp, 64), fi = __shfl(fim, pp, 64);
    u32x4 w = {0u, 0u, 0u, 0u};
    if (lg < 2) {
      const size_t bo = ((size_t)((l * 2 + d) * 32 + g) * 64 + pp) * 16 + lg * 8;
      const f32x4 br0 = *(const f32x4*)(p.s5_bre + bo), br1 = *(const f32x4*)(p.s5_bre + bo + 4), bi0 = *(const f32x4*)(p.s5_bim + bo), bi1 = *(const f32x4*)(p.s5_bim + bo + 4);
      f32x4 v0, v1;
      if (q < 4) { v0 = fr * br0 - fi * bi0; v1 = fr * br1 - fi * bi1; } else { v0 = fr * bi0 + fi * br0; v1 = fr * bi1 + fi * br1; }
      w[0] = pack2(v0[0], v0[1]); w[1] = pack2(v0[2], v0[3]); w[2] = pack2(v1[0], v1[1]); w[3] = pack2(v1[2], v1[3]);
    }
    Bf[q] = __builtin_bit_cast(bf16x8, w);
  }
}
DI u32x4 s5_load_uf(const bf16_t* sug, int k, int tt, int lr, int lg) { u32x4 uw = {0u, 0u, 0u, 0u}; if (lg < 2) uw = *(const u32x4*)(sug + (size_t)(k * 32 + tt * 16 + lr) * 16 + lg * 8); return uw; }
DI void s5_bu_tile(u32x4 uw, const bf16x8 (&Bf)[8], float* Bsm, int lr, int lg) {
  const bf16x8 uf = __builtin_bit_cast(bf16x8, uw);
#pragma unroll
  for (int q = 0; q < 8; ++q) { f32x4 z = {0.f, 0.f, 0.f, 0.f}; z = MFMA16(Bf[q], uf, z);
#pragma unroll
    for (int jj = 0; jj < 4; ++jj) Bsm[(q * 16 + lg * 4 + jj) * BST + lr] = z[jj]; }
}
#define S5_SCAN(D, AR, AI, WRITE) do { \
    _Pragma("unroll") for (int hb = 0; hb < 2; ++hb) { const int cb = ((D) ? 1 - hb : hb) * 2;     \
      const f32x4 br0_ = *(const f32x4*)(Bsm + lane * BST + cb * 4), br1_ = *(const f32x4*)(Bsm + lane * BST + cb * 4 + 4); \
      const f32x4 bi0_ = *(const f32x4*)(Bsm + (64 + lane) * BST + cb * 4), bi1_ = *(const f32x4*)(Bsm + (64 + lane) * BST + cb * 4 + 4); \
      _Pragma("unroll") for (int st = 0; st < 8; ++st) { const int t8 = (D) ? 7 - st : st; const int tl = cb * 4 + t8; \
        const float br = t8 < 4 ? br0_[t8 & 3] : br1_[t8 & 3], bi = t8 < 4 ? bi0_[t8 & 3] : bi1_[t8 & 3]; \
        const float nr = (AR) * sr - (AI) * si + br, ni = (AR) * si + (AI) * sr + bi; sr = nr; si = ni; \
        if (WRITE) { const unsigned pk = pack2(sr, si); Ssm[tl * SST + lane] = (bf16_t)(pk & 0xffffu); Ssm[tl * SST + 64 + lane] = (bf16_t)(pk >> 16); } } } } while (0)
DI void s5_unit(const Params& p, int l, int b, int g, unsigned char* smem) {
  unsigned char* ws = p.ws;
  const int tid = get_tid(), lane = tid & 63, wid = __builtin_amdgcn_readfirstlane(tid >> 6), lr = lane & 15, lg = lane >> 4;
  float* Bsm = (float*)(smem + wid * S5_WAVE_LDS);
  bf16_t* Ssm = (bf16_t*)(smem + wid * S5_WAVE_LDS + 128 * BST * 4);
  const bf16_t* sug = (const bf16_t*)(ws + OFF_SU) + (size_t)(b * 32 + g) * POS * 16;
  float* Eb = (float*)(ws + OFF_EB) + (size_t)(b * 32 + g) * EB_PER_UNIT;
  float are[2], aim[2], fre[2], fim[2];
#pragma unroll
  for (int d = 0; d < 2; ++d) {
    const int pi = ((l * 2 + d) * 32 + g) * 64 + lane;
    const float lre = p.s5_lre[pi], lim = p.s5_lim[pi], dt = expf(p.s5_ldt[(l * 2 + d) * 32 + g]);
    const float mag = expf(lre * dt), ang = lim * dt;
    are[d] = mag * cosf(ang); aim[d] = mag * sinf(ang);
    const float den = lre * lre + lim * lim, nre = are[d] - 1.0f;
    fre[d] = (nre * lre + aim[d] * lim) / den; fim[d] = (aim[d] * lre - nre * lim) / den;
  }
  bf16x8 Bf[2][8];
  s5_make_bf(p, l, 0, g, fre[0], fim[0], Bf[0], lr, lg);
  s5_make_bf(p, l, 1, g, fre[1], fim[1], Bf[1], lr, lg);
  {
    const int d = wid & 1, r = wid >> 1;
    const float ar = d ? are[1] : are[0], ai = d ? aim[1] : aim[0];
    float sr = 0.f, si = 0.f;
    for (int ci = 0; ci < CR; ++ci) {
      const int c = r * CR + ci, k = s5_cmap(d, c);
      { float* e_ = Eb + ((size_t)(d * (NCH + 8) + c) * 64 + lane) * 2; __hip_atomic_store(e_, sr, __ATOMIC_RELAXED, __HIP_MEMORY_SCOPE_AGENT); __hip_atomic_store(e_ + 1, si, __ATOMIC_RELAXED, __HIP_MEMORY_SCOPE_AGENT); }
      const u32x4 ua = s5_load_uf(sug, k, d ? 1 : 0, lr, lg), ub = s5_load_uf(sug, k, d ? 0 : 1, lr, lg);
#pragma unroll
      for (int hh = 0; hh < 2; ++hh) {
        const u32x4 uw = hh ? ub : ua;
        __builtin_amdgcn_wave_barrier();
        if (d) s5_bu_tile(uw, Bf[1], Bsm, lr, lg); else s5_bu_tile(uw, Bf[0], Bsm, lr, lg);
        __builtin_amdgcn_wave_barrier();
        if (d) S5_SCAN(1, ar, ai, false); else S5_SCAN(0, ar, ai, false);
      }
    }
    { float* e_ = Eb + ((size_t)(d * (NCH + 8) + NCH + r) * 64 + lane) * 2; __hip_atomic_store(e_, sr, __ATOMIC_RELAXED, __HIP_MEMORY_SCOPE_AGENT); __hip_atomic_store(e_ + 1, si, __ATOMIC_RELAXED, __HIP_MEMORY_SCOPE_AGENT); }
  }
  asm volatile("s_waitcnt vmcnt(0)" ::: "memory"); __syncthreads();
  bf16x8 Cf[2][4];
  float a32r[2], a32i[2], aCRr[2], aCRi[2];
#pragma unroll
  for (int d = 0; d < 2; ++d) {
#pragma unroll
    for (int ks = 0; ks < 4; ++ks) {
      const float* src = (ks < 2 ? p.s5_cre : p.s5_cim) + ((size_t)((l * 2 + d) * 32 + g) * 16 + lr) * 64 + (ks & 1) * 32 + lg * 8;
      const f32x4 v0 = *(const f32x4*)src, v1 = *(const f32x4*)(src + 4); const float sg = ks < 2 ? 1.0f : -1.0f;
      u32x4 w; w[0] = pack2(sg * v0[0], sg * v0[1]); w[1] = pack2(sg * v0[2], sg * v0[3]); w[2] = pack2(sg * v1[0], sg * v1[1]); w[3] = pack2(sg * v1[2], sg * v1[3]);
      Cf[d][ks] = __builtin_bit_cast(bf16x8, w);
    }
    float pr = are[d], pi_ = aim[d];
#pragma unroll
    for (int q = 0; q < 5; ++q) { const float nr = pr * pr - pi_ * pi_, ni = 2.0f * pr * pi_; pr = nr; pi_ = ni; }
    a32r[d] = pr; a32i[d] = pi_;
    float rr = 1.f, ri = 0.f, br_ = pr, bi_ = pi_;
#pragma unroll
    for (int bit = 0; bit < 7; ++bit) { if ((CR >> bit) & 1) { const float nr = rr * br_ - ri * bi_, ni = rr * bi_ + ri * br_; rr = nr; ri = ni; } const float nr = br_ * br_ - bi_ * bi_, ni = 2.0f * br_ * bi_; br_ = nr; bi_ = ni; }
    aCRr[d] = rr; aCRi[d] = ri;
  }
  const f32x4 dsk = *(const f32x4*)(p.s5_d + l * 512 + g * 16 + lg * 4);
  bf16_t* gb = (bf16_t*)(ws + OFF_GB);
  for (int k = wid; k < NCH; k += NW) {
    f32x4 acc[2] = {{0.f, 0.f, 0.f, 0.f}, {0.f, 0.f, 0.f, 0.f}};
    u32x4 uq[2]; uq[0] = s5_load_uf(sug, k, 0, lr, lg); uq[1] = s5_load_uf(sug, k, 1, lr, lg);
    u32x2 us[2]; us[0] = *(const u32x2*)(sug + (size_t)(k * 32 + lr) * 16 + lg * 4); us[1] = *(const u32x2*)(sug + (size_t)(k * 32 + 16 + lr) * 16 + lg * 4);
    float s0[2][2];
#pragma unroll
    for (int d = 0; d < 2; ++d) { const float* e_ = Eb + ((size_t)(d * (NCH + 8) + s5_cmap(d, k)) * 64 + lane) * 2;
      s0[d][0] = __hip_atomic_load(e_, __ATOMIC_RELAXED, __HIP_MEMORY_SCOPE_AGENT); s0[d][1] = __hip_atomic_load(e_ + 1, __ATOMIC_RELAXED, __HIP_MEMORY_SCOPE_AGENT); }
#pragma unroll
    for (int d = 0; d < 2; ++d) {
      const int c = s5_cmap(d, k), r = c / CR, j = c - r * CR;
      const float* Ed = Eb + (size_t)d * (NCH + 8) * 128 + lane * 2;
      float tr = 0.f, ti = 0.f;
#pragma unroll
      for (int r2 = 0; r2 < NR - 1; ++r2) if (r2 < r) {
        const float er = __hip_atomic_load(Ed + (size_t)(NCH + r2) * 128, __ATOMIC_RELAXED, __HIP_MEMORY_SCOPE_AGENT), ei = __hip_atomic_load(Ed + (size_t)(NCH + r2) * 128 + 1, __ATOMIC_RELAXED, __HIP_MEMORY_SCOPE_AGENT);
        const float nr = aCRr[d] * tr - aCRi[d] * ti + er, ni = aCRr[d] * ti + aCRi[d] * tr + ei; tr = nr; ti = ni; }
      float pr = 1.f, pi_ = 0.f, br_ = a32r[d], bi_ = a32i[d];
      for (int bit = 0; bit < 7; ++bit) { if ((j >> bit) & 1) { const float nr = pr * br_ - pi_ * bi_, ni = pr * bi_ + pi_ * br_; pr = nr; pi_ = ni; } const float nr = br_ * br_ - bi_ * bi_, ni = 2.0f * br_ * bi_; br_ = nr; bi_ = ni; }
      float sr = s0[d][0] + (pr * tr - pi_ * ti), si = s0[d][1] + (pr * ti + pi_ * tr);
#pragma unroll
      for (int hh = 0; hh < 2; ++hh) {
        const int tt = d ? 1 - hh : hh;
        __builtin_amdgcn_wave_barrier();
        s5_bu_tile(uq[tt], Bf[d], Bsm, lr, lg);
        __builtin_amdgcn_wave_barrier();
        if (d) S5_SCAN(1, are[1], aim[1], true); else S5_SCAN(0, are[0], aim[0], true);
        __builtin_amdgcn_wave_barrier();
#pragma unroll
        for (int ks = 0; ks < 4; ++ks) { const bf16x8 sf = *(const bf16x8*)(Ssm + lr * SST + ks * 32 + lg * 8); acc[tt] = MFMA16(Cf[d][ks], sf, acc[tt]); }
      }
    }
#pragma unroll
    for (int tt = 0; tt < 2; ++tt) { const int row = s5_row(b, k, tt * 16 + lr);
      f32x4 u; u[0] = __uint_as_float(us[tt][0] << 16); u[1] = __uint_as_float(us[tt][0] & 0xffff0000u); u[2] = __uint_as_float(us[tt][1] << 16); u[3] = __uint_as_float(us[tt][1] & 0xffff0000u);
      float y[4];
#pragma unroll
      for (int j = 0; j < 4; ++j) y[j] = gelu_tanh(acc[tt][j] + u[j] * dsk[j]);
      u32x2 o; o[0] = pack2(y[0], y[1]); o[1] = pack2(y[2], y[3]); *(u32x2*)(gb + (size_t)row * 512 + g * 16 + lg * 4) = o; }
  }
}

DI void mixer_phase(const Params& p, int l, unsigned char* smem) {
  const bool need_ctx = l < DEPTH - 1;
  volatile int* smw = (volatile int*)(smem + SMEM_BYTES - 16);
  constexpr int QL = SEQ / QU, QC = CTX / QU, QLD = SEQ / QUD, QCD = CTX / QUD;
  const int n_s5 = 16, n_dl = 2 * QLD, n_dc = need_ctx ? 2 * QCD : 0, n_wl = 4 * QL, n_wc = need_ctx ? 4 * QC : 0;
  const int total = n_dl + n_s5 + n_dc + n_wl + n_wc;
  const int x0 = get_bid() & 7;
  for (int dx = 0; dx < 8; ++dx) {
    const int xq = (x0 + dx) & 7;
    unsigned* ctr = (unsigned*)(p.ws + OFF_LAM) + 16 + l * 8 + xq;
    for (;;) {
      __syncthreads();
      if (get_tid() == 0) *smw = (int)atomicAdd(ctr, 1u);
      __syncthreads();
      int u = *smw;
      u = __builtin_amdgcn_readfirstlane(u);
      if (u >= total) break;
      int type, bq, hd, qi; bool is_lat = true;
      if (u < n_s5) { const int idx = xq * 16 + u; type = 1; bq = idx >> 5; hd = idx & 31; qi = 0; }
      else if ((u -= n_s5) < n_dl) { const int gidx = xq + 8 * (u / QLD); type = 0; bq = gidx >> 2; hd = gidx & 3; qi = u % QLD; }
      else if ((u -= n_dl) < n_dc) { const int gidx = xq + 8 * (u / QCD); type = 0; is_lat = false; bq = gidx >> 2; hd = gidx & 3; qi = u % QCD; }
      else if ((u -= n_dc) < n_wl) { type = 2; bq = xq >> 1; hd = (xq & 1) * 4 + (u & 3); qi = u >> 2; }
      else { u -= n_wl; type = 2; is_lat = false; bq = xq >> 1; hd = (xq & 1) * 4 + (u & 3); qi = u >> 2; }
      if (type == 0) diff_unit(p, l, bq, hd, is_lat, qi, smem);
      else if (type == 1) s5_unit(p, l, bq, hd, smem);
      else win_unit(p, l, bq, hd, is_lat, qi, smem);
    }
  }
}

#define EPI_LOOP_BEGIN { const int tid_ = get_tid(), lane_ = tid_ & 63, wid_ = tid_ >> 6, wr_ = wid_ >> 1, wc_ = wid_ & 1, lr_ = lane_ & 15, lg_ = lane_ >> 4; \
  _Pragma("unroll") for (int mi = 0; mi < 4; ++mi) { const int row = m0 + wr_ * 64 + mi * 16 + lr_; \
  _Pragma("unroll") for (int ni = 0; ni < 4; ++ni) { const int col = n0 + wc_ * 64 + ni * 16 + lg_ * 4;
#define EPI_LOOP_END } } }

DI void glu_phase(const Params& p, int MT, unsigned char* smem) {
  bf16_t* As = (bf16_t*)smem; bf16_t* Bs = As + 128 * LDT;
  const bf16_t* G = (const bf16_t*)(p.ws + OFF_GB); const bf16_t* W = (const bf16_t*)(p.ws + OFF_W_GLU); bf16_t* ys = (bf16_t*)(p.ws + OFF_YS);
  constexpr int NT = 4;
  for (int t = get_bid(); t < MT * NT; t += gridDim.x) {
    const int m0 = (t / NT) * 128, n0 = (t % NT) * 128;
    f32x4 acc[4][4]; zero_acc(acc);
    gemm_mainloop(acc, G + (size_t)m0 * 512, 512, W + (size_t)n0 * 512, 512, 512, As, Bs);
    EPI_LOOP_BEGIN
      const u32x2 gr = *(const u32x2*)(G + (size_t)row * 512 + col);
      const float g0 = __uint_as_float(gr[0] << 16), g1 = __uint_as_float(gr[0] & 0xffff0000u), g2 = __uint_as_float(gr[1] << 16), g3 = __uint_as_float(gr[1] & 0xffff0000u);
      u32x2 o; o[0] = pack2(g0 * sigmoidf_(acc[mi][ni][0]), g1 * sigmoidf_(acc[mi][ni][1])); o[1] = pack2(g2 * sigmoidf_(acc[mi][ni][2]), g3 * sigmoidf_(acc[mi][ni][3]));
      *(u32x2*)(ys + (size_t)row * 512 + col) = o;
    EPI_LOOP_END
  }
}
DI void merge_phase(const Params& p, int MT, unsigned char* smem) {
  bf16_t* As = (bf16_t*)smem; bf16_t* Bs = As + 128 * LDT;
  const bf16_t* gt = (const bf16_t*)(p.ws + OFF_GATES); bf16_t* mo = (bf16_t*)(p.ws + OFF_M);
  constexpr int NT = 8;
  for (int t = get_bid(); t < MT * NT; t += gridDim.x) {
    const int m0 = (t / NT) * 128, n0 = (t % NT) * 128;
    f32x4 acc[4][4]; zero_acc(acc);
#pragma unroll 1
    for (int br = 0; br < 3; ++br) {
      const bf16_t* Y = (const bf16_t*)(p.ws + (br == 0 ? OFF_YD : br == 1 ? OFF_YS : OFF_YW));
      const bf16_t* W = (const bf16_t*)(p.ws + (br == 0 ? OFF_W_PD : br == 1 ? OFF_W_PS : OFF_W_PW));
      gemm_mainloop(acc, Y + (size_t)m0 * 512, 512, W + (size_t)n0 * 512, 512, 512, As, Bs);
      if (br < 2) {
        EPI_LOOP_BEGIN
          const f32x4 g0 = ld_bf4(gt + (size_t)row * 3072 + br * 1024 + col), g1 = ld_bf4(gt + (size_t)row * 3072 + (br + 1) * 1024 + col);
#pragma unroll
          for (int j = 0; j < 4; ++j) acc[mi][ni][j] *= fmaxf(g0[j], 1e-30f) / fmaxf(g1[j], 1e-30f);
        EPI_LOOP_END
      } else {
        EPI_LOOP_BEGIN
          const f32x4 g2 = ld_bf4(gt + (size_t)row * 3072 + 2048 + col);
          u32x2 o; o[0] = pack2(acc[mi][ni][0] * fmaxf(g2[0], 1e-30f), acc[mi][ni][1] * fmaxf(g2[1], 1e-30f)); o[1] = pack2(acc[mi][ni][2] * fmaxf(g2[2], 1e-30f), acc[mi][ni][3] * fmaxf(g2[3], 1e-30f));
          *(u32x2*)(mo + (size_t)row * D + col) = o;
        EPI_LOOP_END
      }
    }
  }
}
DI void resid_phase(const Params& p, int l, const bf16_t* A, int K, const bf16_t* W, int gate_off, float* dst, int MT, unsigned char* smem, bool first = false) {
  bf16_t* As = (bf16_t*)smem; bf16_t* Bs = As + 128 * LDT;
  const float* h = (const float*)(p.ws + OFF_H);
  const float* modv = (const float*)(p.ws + OFF_MODV) + (size_t)l * 5 * 6144;
  constexpr int NT = 8;
  for (int t = get_bid(); t < MT * NT; t += gridDim.x) {
    const int m0 = (t / NT) * 128, n0 = (t % NT) * 128;
    f32x4 acc[4][4]; zero_acc(acc);
    gemm_mainloop(acc, A + (size_t)m0 * K, K, W + (size_t)n0 * K, K, K, As, Bs);
    const int bb = m0 < NLAT ? m0 / SEQ : 4;
    EPI_LOOP_BEGIN
      const f32x4 gv = *(const f32x4*)(modv + bb * 6144 + gate_off + col);
      const f32x4 hv = *(const f32x4*)((first ? (row < NLAT ? p.x + (size_t)row * D : p.ctx + (size_t)(row - NLAT) * D) : h + (size_t)row * D) + col);
      *(f32x4*)(dst + (size_t)row * D + col) = hv + gv * acc[mi][ni];
    EPI_LOOP_END
  }
}
DI void ff1_phase(const Params& p, int MT, unsigned char* smem) {
  bf16_t* As = (bf16_t*)smem; bf16_t* Bs = As + 128 * LDT;
  const bf16_t* A = (const bf16_t*)(p.ws + OFF_ABUF); const bf16_t* W = (const bf16_t*)(p.ws + OFF_W_FF1); bf16_t* uo = (bf16_t*)(p.ws + OFF_U);
  constexpr int NT = DFF / 128;
  for (int t = get_bid(); t < MT * NT; t += gridDim.x) {
    const int m0 = (t / NT) * 128, n0 = (t % NT) * 128;
    f32x4 acc[4][4]; zero_acc(acc);
    gemm_mainloop<true>(acc, A + (size_t)m0 * D, D, W + (size_t)n0 * D, D, D, As, Bs);
    const int tid_ = get_tid(), lane_ = tid_ & 63, wid_ = tid_ >> 6, wr_ = wid_ >> 1, wc_ = wid_ & 1, lr_ = lane_ & 15, lg_ = lane_ >> 4;
#pragma unroll
    for (int mi = 0; mi < 4; ++mi) { const int row = m0 + wr_ * 64 + mi * 16 + lr_;
#pragma unroll
      for (int q = 0; q < 2; ++q) { const int col = n0 + wc_ * 64 + q * 32 + lg_ * 8;
        float r[8];
#pragma unroll
        for (int j = 0; j < 4; ++j) { const float v0 = fmaxf(acc[mi][2 * q][j], 0.f), v1 = fmaxf(acc[mi][2 * q + 1][j], 0.f); r[j] = v0 * v0; r[4 + j] = v1 * v1; }
        u32x4 o; o[0] = pack2(r[0], r[1]); o[1] = pack2(r[2], r[3]); o[2] = pack2(r[4], r[5]); o[3] = pack2(r[6], r[7]);
        *(u32x4*)(uo + (size_t)row * DFF + col) = o; } }
  }
}

#define XB_TMO      128
#define XB_XCNT(j)  (256  + 64 * (j))
#define XB_XSUB(j)  (1280 + 64 * (j))
#define XB_XGEN(j)  (2304 + 64 * (j))
#define XB_TOP      3328
#define XB_TOPGEN   3392
#define XCD_BAR_WORDS 3456
#define XB_SPIN_CAP (1u << 18)
#define XLAS __attribute__((address_space(3)))

__device__ __forceinline__ unsigned xb_ld(unsigned* p)              { return __hip_atomic_load(p, __ATOMIC_RELAXED, __HIP_MEMORY_SCOPE_AGENT); }
__device__ __forceinline__ unsigned xb_add(unsigned* p, unsigned v) { return __hip_atomic_fetch_add(p, v, __ATOMIC_RELAXED, __HIP_MEMORY_SCOPE_AGENT); }
__device__ __forceinline__ unsigned xb_xcc_id() { return (unsigned)__builtin_amdgcn_s_getreg((3 << 11) | 20) & 0xFu; }
#define XB_SPIN(cond, bar) do { unsigned _sp = 0; while (cond) { __builtin_amdgcn_s_sleep(1); \
    if ((++_sp & 255u) == 0u) { if (xb_ld(&(bar)[XB_TMO])) break; if (_sp > XB_SPIN_CAP) { atomicAdd(&(bar)[XB_TMO], 1u); break; } } } } while (0)

struct XcdBarrier {
    unsigned* bar; unsigned x;
    volatile XLAS unsigned* st;
};

__device__ __forceinline__ XcdBarrier xcd_barrier_post(unsigned* bar, volatile XLAS unsigned* st) {
    XcdBarrier b; b.bar = bar; b.x = xb_xcc_id(); b.st = st;
    if (threadIdx.x == 0) (void)xb_add(&bar[XB_XCNT(b.x)], 1u);
    return b;
}
__device__ __forceinline__ void xcd_barrier_complete(unsigned* bar, unsigned x, unsigned& nloc, unsigned& nx) {
    const unsigned G = gridDim.x * gridDim.y * gridDim.z;
    unsigned sum, cnt, mine, sp = 0u;
    for (;;) {
        sum = 0u; cnt = 0u; mine = 0u;
#pragma unroll
        for (unsigned j = 0; j < 16; ++j) { const unsigned c = xb_ld(&bar[XB_XCNT(j)]); sum += c; cnt += (c > 0u) ? 1u : 0u; mine = (j == x) ? c : mine; }
        if (sum == G) break;
        __builtin_amdgcn_s_sleep(1);
        if ((++sp & 255u) == 0u) { if (xb_ld(&bar[XB_TMO])) break; if (sp > XB_SPIN_CAP) { atomicAdd(&bar[XB_TMO], 1u); break; } }
    }
    nloc = mine > 0u ? mine : 1u; nx = cnt > 0u ? cnt : 1u;
}

__device__ __forceinline__ void xcd_barrier(const XcdBarrier& b) {
    asm volatile("s_waitcnt vmcnt(0)" ::: "memory");
    __syncthreads();
    if (threadIdx.x == 0) {
        unsigned* bar = b.bar;
        __builtin_amdgcn_s_waitcnt(0);
        unsigned nloc = b.st[0], nx = b.st[1];
        if (nloc == 0u) { xcd_barrier_complete(bar, b.x, nloc, nx); b.st[0] = nloc; b.st[1] = nx; }
        const unsigned old = xb_add(&bar[XB_XSUB(b.x)], 1u);
        const unsigned gen = old / nloc;
        if (old + 1u == (gen + 1u) * nloc) {
            __builtin_amdgcn_fence(__ATOMIC_RELEASE, "agent");
            asm volatile("s_waitcnt vmcnt(0)" ::: "memory");
            const unsigned og = xb_add(&bar[XB_TOP], 1u);
            const unsigned tg = og / nx;
            if (og + 1u == (tg + 1u) * nx) xb_add(&bar[XB_TOPGEN], 1u);
            else XB_SPIN(xb_ld(&bar[XB_TOPGEN]) == tg, bar);
            __builtin_amdgcn_fence(__ATOMIC_ACQUIRE, "agent");
            xb_add(&bar[XB_XGEN(b.x)], 1u);
            asm volatile("s_waitcnt vmcnt(0)" ::: "memory");
        } else {
            XB_SPIN(xb_ld(&bar[XB_XGEN(b.x)]) == gen, bar);
            __builtin_amdgcn_fence(__ATOMIC_ACQUIRE, "agent");
            asm volatile("s_waitcnt vmcnt(0)" ::: "memory");
        }
    }
    __syncthreads();
}


__global__ void __launch_bounds__(256, 2) fwd_megakernel(Params p) {
  __shared__ __attribute__((aligned(16))) unsigned char smem[SMEM_BYTES];
  __shared__ uint4 xb_words;
  cg::grid_group grid = cg::this_grid();
  unsigned char* ws = p.ws;
  if (threadIdx.x == 0) xb_words = make_uint4(0u, 0u, 0u, 0u);
  __syncthreads();
  const XcdBarrier xb = xcd_barrier_post((unsigned*)(ws + OFF_BAR), (volatile XLAS unsigned*)&xb_words);
  phase0_misc(p, smem);
  __syncthreads();
  convert_layer(p, 0, 0, smem);
  if (p.ws == nullptr) grid.sync();
  for (int l = 0; l < DEPTH; ++l) {
    const bool need_ctx = l < DEPTH - 1;
    const int MT = need_ctx ? NTOK / 128 : NLAT / 128;
    xcd_barrier(xb);
    if (l > 0) convert_layer(p, l, CONV_EARLY, smem);
    norm_phase(p, l, p.norm1_g + l * D, 0, 1024, NTOK, l == 0);
    xcd_barrier(xb);
    inproj_phase(p, l, smem);
    xcd_barrier(xb);
    mixer_phase(p, l, smem);
    xcd_barrier(xb);
    glu_phase(p, MT, smem);
    xcd_barrier(xb);
    merge_phase(p, MT, smem);
    xcd_barrier(xb);
    resid_phase(p, l, (const bf16_t*)(ws + OFF_M), D, (const bf16_t*)(ws + OFF_W_OUT), 2048, (float*)(ws + OFF_H), MT, smem, l == 0);
    xcd_barrier(xb);
    norm_phase(p, l, p.norm2_g + l * D, 3072, 4096, MT * 128);
    xcd_barrier(xb);
    ff1_phase(p, MT, smem);
    xcd_barrier(xb);
    resid_phase(p, l, (const bf16_t*)(ws + OFF_U), DFF, (const bf16_t*)(ws + OFF_W_FF2), 5120, need_ctx ? (float*)(ws + OFF_H) : p.out, MT, smem);
    if (need_ctx) convert_steal(p, l + 1, smem);
  }
}

extern "C" void kernel_launch(void* const* d_in, const int* in_sizes, int n_in, void* d_out, int out_size, void* d_ws, size_t ws_size, hipStream_t stream) {
  static int grid_blocks = 0;
  if (!grid_blocks) {
    int dev = 0, cus = 0, per_cu = 0;
    (void)hipGetDevice(&dev);
    (void)hipDeviceGetAttribute(&cus, hipDeviceAttributeMultiprocessorCount, dev);
    (void)hipOccupancyMaxActiveBlocksPerMultiprocessor(&per_cu, fwd_megakernel, 256, 0);
    if (per_cu > 2) per_cu = 2;
    if (per_cu < 1) per_cu = 1;
    grid_blocks = cus * per_cu;
  }
  if (ws_size < WS_NEED) { fprintf(stderr, "workspace too small: %zu < %zu\n", ws_size, (size_t)WS_NEED); return; }
  (void)hipMemsetAsync((unsigned char*)d_ws + OFF_BAR, 0, BAR_BYTES, stream);
  Params p{};
  const float* const* in = (const float* const*)d_in;
  p.x = in[0]; p.c = in[1]; p.ctx = in[2]; p.c_ctx = in[3]; p.w_mod = in[4]; p.b_mod = in[5]; p.norm1_g = in[6]; p.norm2_g = in[7]; p.w_in = in[8];
  p.dq_g = in[9]; p.dk_g = in[10]; p.lq1 = in[11]; p.lk1 = in[12]; p.lq2 = in[13]; p.lk2 = in[14]; p.dout_g = in[15];
  p.s5_lre = in[16]; p.s5_lim = in[17]; p.s5_ldt = in[18]; p.s5_bre = in[19]; p.s5_bim = in[20]; p.s5_cre = in[21]; p.s5_cim = in[22]; p.s5_d = in[23]; p.s5_wglu = in[24];
  p.wq_g = in[25]; p.wk_g = in[26]; p.w_sink = in[27];
  p.w_pd = in[28]; p.w_ps = in[29]; p.w_pw = in[30]; p.w_out = in[31]; p.w_ff1 = in[32]; p.w_ff2 = in[33];
  p.out = (float*)d_out; p.ws = (unsigned char*)d_ws;
  void* args[] = {&p};
  hipError_t e = hipLaunchCooperativeKernel((void*)fwd_megakernel, dim3(grid_blocks), dim3(256), args, 0, stream);
  if (e != hipSuccess) fprintf(stderr, "cooperative launch failed: %s (grid %d)\n", hipGetErrorString(e), grid_blocks);
}
```

```cpp
#include <hip/hip_runtime.h>
#include <hip/hip_cooperative_groups.h>
#include <cstdio>
#include <cstdint>
namespace cg = cooperative_groups;

typedef unsigned short bf16_t;
typedef short bf16x8 __attribute__((ext_vector_type(8)));
typedef short bf16x4 __attribute__((ext_vector_type(4)));
typedef float f32x4 __attribute__((ext_vector_type(4)));
typedef float f32x2 __attribute__((ext_vector_type(2)));
typedef unsigned u32x4 __attribute__((ext_vector_type(4)));
typedef unsigned u32x2 __attribute__((ext_vector_type(2)));
typedef __bf16 bf2_t __attribute__((ext_vector_type(2)));

#define DI __device__ __forceinline__
#define MFMA16(a, b, c) __builtin_amdgcn_mfma_f32_16x16x32_bf16((a), (b), (c), 0, 0, 0)

constexpr int D = 1024, NB = 4, SEQ = 4096, DEPTH = 4, CTX = 256, POS = CTX + SEQ  ;
constexpr int NLAT = NB * SEQ  , NCTX = NB * CTX  , NTOK = NLAT + NCTX  ;
constexpr int DIN = 5888, DFF = 4096;
constexpr float EPS = 1e-6f;
constexpr float LOG2E = 1.4426950408889634f;
constexpr int NCH = POS / 32;

constexpr size_t SZ_W_IN = (size_t)DIN * D * 2, SZ_W_GLU = 512 * 512 * 2, SZ_W_P = 1024 * 512 * 2, SZ_W_OUT = (size_t)D * D * 2, SZ_W_FF = (size_t)D * DFF * 2;
constexpr size_t OFF_W_IN = 0;
constexpr size_t OFF_W_GLU = OFF_W_IN + SZ_W_IN;
constexpr size_t OFF_W_PD = OFF_W_GLU + SZ_W_GLU;
constexpr size_t OFF_W_PS = OFF_W_PD + SZ_W_P;
constexpr size_t OFF_W_PW = OFF_W_PS + SZ_W_P;
constexpr size_t OFF_W_OUT = OFF_W_PW + SZ_W_P;
constexpr size_t OFF_W_FF1 = OFF_W_OUT + SZ_W_OUT;
constexpr size_t OFF_W_FF2 = OFF_W_FF1 + SZ_W_FF;
constexpr size_t OFF_MODV = OFF_W_FF2 + SZ_W_FF;
constexpr size_t OFF_ROPE = OFF_MODV + (size_t)DEPTH * 5 * 6144 * 4;
constexpr size_t OFF_LAM = OFF_ROPE + 8192;
constexpr size_t OFF_H = OFF_LAM + 256;
constexpr size_t OFF_ABUF = OFF_H + (size_t)NTOK * D * 4;
constexpr size_t OFF_R1 = OFF_ABUF + (size_t)NTOK * D * 2;
constexpr size_t SZ_HEADBUF = (size_t)NB * 8 * POS * 64 * 2;
constexpr size_t OFF_QD = OFF_R1;
constexpr size_t OFF_KD = OFF_QD + SZ_HEADBUF;
constexpr size_t OFF_VDT = OFF_KD + SZ_HEADBUF;
constexpr size_t OFF_SU = OFF_VDT + SZ_HEADBUF;
constexpr size_t OFF_QW = OFF_SU + (size_t)NTOK * 512 * 2;
constexpr size_t OFF_KW = OFF_QW + SZ_HEADBUF;
constexpr size_t OFF_VWT = OFF_KW + SZ_HEADBUF / 4;
constexpr size_t OFF_GATES = OFF_VWT + SZ_HEADBUF / 4;
constexpr size_t OFF_YD = OFF_GATES + (size_t)NTOK * 3072 * 2;
constexpr size_t OFF_YS = OFF_YD + (size_t)NTOK * 512 * 2;
constexpr size_t OFF_YW = OFF_YS + (size_t)NTOK * 512 * 2;
constexpr size_t OFF_GB = OFF_YW + (size_t)NTOK * 512 * 2;
constexpr size_t OFF_EB = OFF_GB + (size_t)NTOK * 512 * 2;
constexpr size_t OFF_END = OFF_EB + (size_t)NB * 32 * 2 * (NCH + 8) * 64 * 8;
constexpr size_t OFF_BAR = OFF_END;
constexpr size_t BAR_BYTES = 16384;
constexpr size_t WS_NEED = OFF_BAR + BAR_BYTES;
constexpr size_t OFF_M = OFF_QD;
constexpr size_t OFF_U = OFF_R1;
static_assert((size_t)NTOK * DFF * 2 <= OFF_END - OFF_R1, "u alias");

struct Params {
  const float *x, *c, *ctx, *c_ctx, *w_mod, *b_mod, *norm1_g, *norm2_g, *w_in;
  const float *dq_g, *dk_g, *lq1, *lk1, *lq2, *lk2, *dout_g;
  const float *s5_lre, *s5_lim, *s5_ldt, *s5_bre, *s5_bim, *s5_cre, *s5_cim, *s5_d, *s5_wglu;
  const float *wq_g, *wk_g, *w_sink;
  const float *w_pd, *w_ps, *w_pw, *w_out, *w_ff1, *w_ff2;
  float* out;
  unsigned char* ws;
};

DI int get_tid() { int t = threadIdx.x; asm volatile("" : "+v"(t)); return t; }
DI int get_bid() { int b = blockIdx.x; asm volatile("" : "+s"(b)); return b; }
DI unsigned pack2(float lo, float hi) { f32x2 v = {lo, hi}; bf2_t r = __builtin_convertvector(v, bf2_t); return __builtin_bit_cast(unsigned, r); }
DI float sigmoidf_(float x) { return 1.0f / (1.0f + __expf(-x)); }
DI float gelu_tanh(float x) { const float z = 0.7978845608028654f * (x + 0.044715f * x * x * x); const float e = __expf(2.0f * z); const float t = 1.0f - 2.0f / (e + 1.0f); return 0.5f * x * (1.0f + t); }
DI f32x4 ld_bf4(const bf16_t* p_) { const u32x2 r = *(const u32x2*)p_; f32x4 v; v[0] = __uint_as_float(r[0] << 16); v[1] = __uint_as_float(r[0] & 0xffff0000u); v[2] = __uint_as_float(r[1] << 16); v[3] = __uint_as_float(r[1] & 0xffff0000u); return v; }
DI float xshfl(float v, int m) { return __shfl_xor(v, m, 64); }

constexpr int SMEM_BYTES = 65552;
constexpr int LDT = 72;

DI u32x4 gload_async(const void* ptr) { u32x4 r; asm volatile("global_load_dwordx4 %0, %1, off" : "=v"(r) : "v"(ptr) : "memory"); return r; }
#define VM_WAIT8(N, R, Q) asm volatile("s_waitcnt vmcnt(" #N ")" : "+v"(R[0]), "+v"(R[1]), "+v"(R[2]), "+v"(R[3]), "+v"(Q[0]), "+v"(Q[1]), "+v"(Q[2]), "+v"(Q[3]) :: "memory")
template <bool PERM = false>
DI void gemm_mainloop(f32x4 (&acc)[4][4], const bf16_t* __restrict__ A, int lda, const bf16_t* __restrict__ B, int ldb, int K, bf16_t* As, bf16_t* Bs) {
  const int tid = get_tid(), lane = tid & 63, wid = tid >> 6, wr = wid >> 1, wc = wid & 1, lr = lane & 15, lg = lane >> 4;
  const int crow = tid >> 3, ckc = (tid & 7) * 8;
  constexpr int TB = 128 * 64;
  const int swc = (((tid & 7) ^ (crow & 7)) * 8);
  const int swcB = PERM ? (((tid & 7) ^ ((((crow >> 3) & 3) * 2 + ((crow & 7) >> 1)) & 7)) * 8) : swc;
  u32x4 ra0[4], rb0[4], ra1[4], rb1[4];
  const bf16_t* Ap = A + (size_t)crow * lda + ckc; const bf16_t* Bp = B + (size_t)crow * ldb + ckc;
#define GM_LOAD(RA, RB, KOFF) do { _Pragma("unroll") for (int i = 0; i < 4; ++i) { RA[i] = gload_async(Ap + (size_t)(i * 32) * lda + (KOFF)); RB[i] = gload_async(Bp + (size_t)(i * 32) * ldb + (KOFF)); } } while (0)
#define GM_STORE(RA, RB, BUF) do { _Pragma("unroll") for (int i = 0; i < 4; ++i) { *(u32x4*)(As + (BUF) * 2 * TB + (crow + i * 32) * 64 + swc) = RA[i]; *(u32x4*)(As + (BUF) * 2 * TB + TB + (crow + i * 32) * 64 + swcB) = RB[i]; } } while (0)
#define GM_COMPUTE(BUF) do { const bf16_t* as_ = As + (BUF) * 2 * TB; const bf16_t* bs_ = as_ + TB; \
    bf16x8 af[2][4], bfr[2][4];     \
    _Pragma("unroll") for (int ks = 0; ks < 2; ++ks) { const int co_ = ((ks * 4 + lg) ^ (lr & 7)) * 8; \
      _Pragma("unroll") for (int mi = 0; mi < 4; ++mi) af[ks][mi] = *(const bf16x8*)(as_ + (wr * 64 + mi * 16 + lr) * 64 + co_); \
      _Pragma("unroll") for (int ni = 0; ni < 4; ++ni) { \
        if (PERM) { const int rw_ = (ni & 1) * 4 + (lr & 3); const int key_ = ((lr >> 2) * 2 + (rw_ >> 1)) & 7; bfr[ks][ni] = *(const bf16x8*)(bs_ + (wc * 64 + (ni >> 1) * 32 + (lr >> 2) * 8 + rw_) * 64 + (((ks * 4 + lg) ^ key_) * 8)); } \
        else bfr[ks][ni] = *(const bf16x8*)(bs_ + (wc * 64 + ni * 16 + lr) * 64 + co_); } } \
    __builtin_amdgcn_sched_barrier(0); \
    __builtin_amdgcn_s_setprio(1); \
    _Pragma("unroll") for (int ks = 0; ks < 2; ++ks) _Pragma("unroll") for (int mi = 0; mi < 4; ++mi) _Pragma("unroll") for (int ni = 0; ni < 4; ++ni) acc[mi][ni] = MFMA16(bfr[ks][ni], af[ks][mi], acc[mi][ni]); \
    __builtin_amdgcn_s_setprio(0); \
    __builtin_amdgcn_sched_barrier(0); } while (0)
  asm volatile("s_waitcnt vmcnt(0)" ::: "memory");
  GM_LOAD(ra0, rb0, 0); GM_LOAD(ra1, rb1, 64);
  __syncthreads();
  VM_WAIT8(8, ra0, rb0); GM_STORE(ra0, rb0, 0); GM_LOAD(ra0, rb0, (128 < K ? 128 : 0));
  __syncthreads();
  for (int k0 = 0; k0 < K; k0 += 128) {
    const int kn1 = k0 + 192 < K ? k0 + 192 : 0, kn0 = k0 + 256 < K ? k0 + 256 : 0;
    VM_WAIT8(8, ra1, rb1); GM_STORE(ra1, rb1, 1); GM_LOAD(ra1, rb1, kn1);
    GM_COMPUTE(0); __syncthreads();
    VM_WAIT8(8, ra0, rb0); GM_STORE(ra0, rb0, 0); GM_LOAD(ra0, rb0, kn0);
    GM_COMPUTE(1); __syncthreads();
  }
  VM_WAIT8(0, ra0, rb0); VM_WAIT8(0, ra1, rb1);
#undef GM_LOAD
#undef GM_STORE
#undef GM_COMPUTE
}
DI void zero_acc(f32x4 (&acc)[4][4]) {
#pragma unroll
  for (int mi = 0; mi < 4; ++mi)
#pragma unroll
    for (int ni = 0; ni < 4; ++ni) acc[mi][ni] = (f32x4){0.f, 0.f, 0.f, 0.f};
}

DI void convert_tile(const float* __restrict__ src, int K, int N, bf16_t* __restrict__ dst, int kt, int nt, float* tile) {
  const int tid = get_tid();
  { const int r = tid >> 4, c4 = (tid & 15) * 4;
#pragma unroll
    for (int i = 0; i < 4; ++i) { const int k = r + i * 16; const f32x4 v = *(const f32x4*)(src + (size_t)(kt * 64 + k) * N + nt * 64 + c4);
      tile[k * 65 + c4 + 0] = v[0]; tile[k * 65 + c4 + 1] = v[1]; tile[k * 65 + c4 + 2] = v[2]; tile[k * 65 + c4 + 3] = v[3]; } }
  __syncthreads();
  { const int n = tid >> 2, kc = (tid & 3) * 16; u32x4 o0, o1;
#pragma unroll
    for (int q = 0; q < 4; ++q) { o0[q] = pack2(tile[(kc + 2 * q) * 65 + n], tile[(kc + 2 * q + 1) * 65 + n]); o1[q] = pack2(tile[(kc + 8 + 2 * q) * 65 + n], tile[(kc + 8 + 2 * q + 1) * 65 + n]); }
    bf16_t* d = dst + (size_t)(nt * 64 + n) * K + kt * 64 + kc; *(u32x4*)d = o0; *(u32x4*)(d + 8) = o1; }
  __syncthreads();
}
DI void convert_item(const Params& p, int l, int t, float* tile) {
  unsigned char* ws = p.ws;
  const float* src; bf16_t* dst; int K, N, idx;
  if (t < 1472) { idx = t; src = p.w_in + (size_t)l * D * DIN; K = D; N = DIN; dst = (bf16_t*)(ws + OFF_W_IN); }
  else if (t < 1536) { idx = t - 1472; src = p.s5_wglu + (size_t)l * 512 * 512; K = 512; N = 512; dst = (bf16_t*)(ws + OFF_W_GLU); }
  else if (t < 1664) { idx = t - 1536; src = p.w_pd + (size_t)l * 512 * D; K = 512; N = D; dst = (bf16_t*)(ws + OFF_W_PD); }
  else if (t < 1792) { idx = t - 1664; src = p.w_ps + (size_t)l * 512 * D; K = 512; N = D; dst = (bf16_t*)(ws + OFF_W_PS); }
  else if (t < 1920) { idx = t - 1792; src = p.w_pw + (size_t)l * 512 * D; K = 512; N = D; dst = (bf16_t*)(ws + OFF_W_PW); }
  else if (t < 2176) { idx = t - 1920; src = p.w_out + (size_t)l * D * D; K = D; N = D; dst = (bf16_t*)(ws + OFF_W_OUT); }
  else if (t < 3200) { idx = t - 2176; src = p.w_ff1 + (size_t)l * D * DFF; K = D; N = DFF; dst = (bf16_t*)(ws + OFF_W_FF1); }
  else { idx = t - 3200; src = p.w_ff2 + (size_t)l * DFF * D; K = DFF; N = D; dst = (bf16_t*)(ws + OFF_W_FF2); }
  const int nts = N / 64; convert_tile(src, K, N, dst, idx / nts, idx % nts, tile);
}
constexpr int CONV_EARLY = 3200, CONV_ALL = 4224;
DI void convert_layer(const Params& p, int l, int t_begin, unsigned char* smem) {
  float* tile = (float*)smem;
  for (int t = t_begin + get_bid(); t < CONV_ALL; t += gridDim.x) convert_item(p, l, t, tile);
}
DI void convert_steal(const Params& p, int l, unsigned char* smem) {
  float* tile = (float*)smem;
  volatile int* smw = (volatile int*)(smem + SMEM_BYTES - 16);
  unsigned* ctr = (unsigned*)(p.ws + OFF_LAM) + 48 + l;
  for (;;) {
    __syncthreads();
    if (get_tid() == 0) *smw = (int)atomicAdd(ctr, 1u);
    __syncthreads();
    int t = *smw; t = __builtin_amdgcn_readfirstlane(t);
    if (t >= CONV_EARLY) break;
    convert_item(p, l, t, tile);
  }
}

DI void phase0_misc(const Params& p, unsigned char* smem) {
  unsigned char* ws = p.ws;
  const int tid = get_tid();
  if (get_bid() == 0) {
    float* rope = (float*)(ws + OFF_ROPE);
    for (int i = tid; i < 1024; i += 256) { const int pos = i >> 4, f = i & 15; const float inv = powf(10000.0f, -(float)f / 16.0f); const float ang = (float)pos * inv; rope[i] = cosf(ang); rope[1024 + i] = sinf(ang); }
    if (tid < DEPTH) { const int l = tid; float s1 = 0.f, s2 = 0.f;
      for (int i = 0; i < 64; ++i) { s1 += p.lq1[l * 64 + i] * p.lk1[l * 64 + i]; s2 += p.lq2[l * 64 + i] * p.lk2[l * 64 + i]; }
      const float lam_init = 0.8f - 0.6f * expf(-0.3f * (float)l);
      ((float*)(ws + OFF_LAM))[l] = expf(s1) - expf(s2) + lam_init; }
    if (tid >= 64 && tid < 64 + DEPTH) { const int l = tid - 64; float a = 0.f, b2 = 0.f, c2 = 0.f, d2 = 0.f;
      for (int i = 0; i < 64; ++i) { a = fmaxf(a, fabsf(p.dq_g[l * 64 + i])); b2 = fmaxf(b2, fabsf(p.dk_g[l * 64 + i])); c2 = fmaxf(c2, fabsf(p.wq_g[l * 64 + i])); d2 = fmaxf(d2, fabsf(p.wk_g[l * 64 + i])); }
      ((float*)(ws + OFF_LAM))[4 + l] = 8.0f * LOG2E * 1.02f * a * b2;
      ((float*)(ws + OFF_LAM))[8 + l] = 8.0f * LOG2E * 1.02f * c2 * d2;
      for (int i = 0; i < 8; ++i) ((unsigned*)(ws + OFF_LAM))[16 + l * 8 + i] = 0u;
      ((unsigned*)(ws + OFF_LAM))[48 + l] = 0u; }
  }
  float* sc = (float*)smem;
  float* red = sc + 5 * 1024;
  for (int i = tid; i < 5 * 1024; i += 256) { const int bb = i >> 10, k = i & 1023; const float v = bb < 4 ? p.c[bb * 1024 + k] : p.c_ctx[k]; sc[i] = v / (1.0f + __expf(-v)); }
  __syncthreads();
  float* modv = (float*)(ws + OFF_MODV);
  for (int t = get_bid(); t < DEPTH * 96; t += gridDim.x) {
    const int l = t / 96, cb = t % 96, kq = tid >> 6, cl = tid & 63, col = cb * 64 + cl;
    const float* w = p.w_mod + (size_t)l * D * 6144 + col;
    float s[5] = {0.f, 0.f, 0.f, 0.f, 0.f};
    for (int k = kq * 256; k < kq * 256 + 256; ++k) { const float wv = w[(size_t)k * 6144];
#pragma unroll
      for (int bb = 0; bb < 5; ++bb) s[bb] += sc[bb * 1024 + k] * wv; }
#pragma unroll
    for (int bb = 0; bb < 5; ++bb) red[(kq * 5 + bb) * 64 + cl] = s[bb];
    __syncthreads();
    for (int i = tid; i < 5 * 64; i += 256) { const int bb = i >> 6, c2 = i & 63; const float v = red[(0 * 5 + bb) * 64 + c2] + red[(1 * 5 + bb) * 64 + c2] + red[(2 * 5 + bb) * 64 + c2] + red[(3 * 5 + bb) * 64 + c2];
      modv[((size_t)l * 5 + bb) * 6144 + cb * 64 + c2] = v + p.b_mod[l * 6144 + cb * 64 + c2]; }
    __syncthreads();
  }
}

DI void norm_phase(const Params& p, int l, const float* gvec, int sh_off, int sc_off, int nrows, bool first = false) {
  const int tid = get_tid(), lane = tid & 63, wid = tid >> 6;
  const float* h = (const float*)(p.ws + OFF_H); bf16_t* out = (bf16_t*)(p.ws + OFF_ABUF);
  const float* modv = (const float*)(p.ws + OFF_MODV) + (size_t)l * 5 * 6144;
  for (int t = get_bid(); t < nrows / 4; t += gridDim.x) {
    const int row = t * 4 + wid; const int bb = row < NLAT ? row / SEQ : 4;
    const float* hr = first ? (row < NLAT ? p.x + (size_t)row * D : p.ctx + (size_t)(row - NLAT) * D) : h + (size_t)row * D; const float* mv = modv + bb * 6144;
    f32x4 v[4]; float ss = 0.f;
#pragma unroll
    for (int it = 0; it < 4; ++it) { v[it] = *(const f32x4*)(hr + it * 256 + lane * 4); ss += v[it][0] * v[it][0] + v[it][1] * v[it][1] + v[it][2] * v[it][2] + v[it][3] * v[it][3]; }
#pragma unroll
    for (int m = 1; m < 64; m <<= 1) ss += xshfl(ss, m);
    const float rstd = rsqrtf(ss * (1.0f / 1024.0f) + EPS);
#pragma unroll
    for (int it = 0; it < 4; ++it) { const int idx = it * 256 + lane * 4;
      const f32x4 g = *(const f32x4*)(gvec + idx), s1 = *(const f32x4*)(mv + sc_off + idx), s0 = *(const f32x4*)(mv + sh_off + idx);
      float y[4];
#pragma unroll
      for (int j = 0; j < 4; ++j) y[j] = v[it][j] * rstd * g[j] * (1.0f + s1[j]) + s0[j];
      u32x2 o; o[0] = pack2(y[0], y[1]); o[1] = pack2(y[2], y[3]); *(u32x2*)(out + (size_t)row * D + idx) = o; }
  }
}

DI void inproj_epilogue(const Params& p, int l, const f32x4 (&acc)[4][4], int m0, int n0) {
  unsigned char* ws = p.ws;
  const int tid = get_tid(), lane = tid & 63, wid = tid >> 6, wr = wid >> 1, wc = wid & 1, lr = lane & 15, lg = lane >> 4;
  const bool is_lat = m0 < NLAT;
  int b, i0; if (is_lat) { b = m0 / SEQ; i0 = m0 % SEQ; } else { const int c0 = m0 - NLAT; b = c0 / CTX; i0 = c0 % CTX; }
  const int pos0 = is_lat ? CTX + i0 : i0;
  const int hc = n0 + wc * 64;
  int seg;
  if (n0 < 512) seg = 0; else if (n0 < 1024) seg = 1; else if (n0 < 1536) seg = 2; else if (n0 < 2048) seg = 3; else if (n0 < 2560) seg = 4; else if (n0 < 2688) seg = 5; else if (n0 < 2816) seg = 6; else seg = 7;
  if (seg == 0 || seg == 1 || seg == 4 || seg == 5) {
    const float* gv; bf16_t* dst; float qs = 1.0f;
    if (seg == 0) { const int c = hc; gv = p.dq_g + l * 64; dst = (bf16_t*)(ws + OFF_QD) + ((size_t)((b * 2 + c / 256) * 4 + (c % 256) / 64) * POS) * 64; qs = 0.125f * LOG2E; }
    else if (seg == 1) { const int c = hc - 512; gv = p.dk_g + l * 64; dst = (bf16_t*)(ws + OFF_KD) + ((size_t)((b * 2 + c / 256) * 4 + (c % 256) / 64) * POS) * 64; }
    else if (seg == 4) { const int c = hc - 2048; gv = p.wq_g + l * 64; dst = (bf16_t*)(ws + OFF_QW) + ((size_t)(b * 8 + c / 64) * POS) * 64; qs = 0.125f * LOG2E; }
    else { const int c = hc - 2560; gv = p.wk_g + l * 64; dst = (bf16_t*)(ws + OFF_KW) + ((size_t)(b * 2 + c / 64) * POS) * 64; }
    const float* rope = (const float*)(ws + OFF_ROPE);
    f32x4 gq[4];
#pragma unroll
    for (int ni = 0; ni < 4; ++ni) gq[ni] = *(const f32x4*)(gv + ni * 16 + lg * 4);
#pragma unroll
    for (int mi = 0; mi < 4; ++mi) {
      const int r = wr * 64 + mi * 16 + lr;
      float ss = 0.f;
#pragma unroll
      for (int ni = 0; ni < 4; ++ni)
#pragma unroll
        for (int j = 0; j < 4; ++j) ss += acc[mi][ni][j] * acc[mi][ni][j];
      ss += xshfl(ss, 16); ss += xshfl(ss, 32);
      const float rstd = rsqrtf(ss * (1.0f / 64.0f) + EPS);
      f32x4 v[4];
#pragma unroll
      for (int ni = 0; ni < 4; ++ni) v[ni] = acc[mi][ni] * rstd * gq[ni];
      if (is_lat) {
        const int li = i0 + r, gr = li >> 6, gc = li & 63;
#pragma unroll
        for (int ni = 0; ni < 2; ++ni) {
          const int pi = ni == 0 ? gr : gc;
          const f32x4 cs = *(const f32x4*)(rope + pi * 16 + lg * 4), sn = *(const f32x4*)(rope + 1024 + pi * 16 + lg * 4);
          const f32x4 x1 = v[ni], x2 = v[ni + 2];
          v[ni] = x1 * cs - x2 * sn; v[ni + 2] = x2 * cs + x1 * sn;
        }
      }
      bf16_t* drow = dst + (size_t)(pos0 + r) * 64 + lg * 4;
#pragma unroll
      for (int ni = 0; ni < 4; ++ni) { u32x2 o; o[0] = pack2(v[ni][0] * qs, v[ni][1] * qs); o[1] = pack2(v[ni][2] * qs, v[ni][3] * qs); *(u32x2*)(drow + ni * 16) = o; }
    }
  } else if (seg == 2 || seg == 6) {
#pragma unroll
    for (int mi = 0; mi < 4; ++mi) {
      const int pos = pos0 + wr * 64 + mi * 16 + lr;
#pragma unroll
      for (int ni = 0; ni < 4; ++ni)
#pragma unroll
        for (int j = 0; j < 4; ++j) {
          const int col = hc + ni * 16 + lg * 4 + j; bf16_t* dst;
          if (seg == 2) { const int c = col - 1024; dst = (bf16_t*)(ws + OFF_VDT) + ((size_t)(b * 4 + c / 128) * 128 + (c % 128)) * POS + pos; }
          else { const int c = col - 2688; dst = (bf16_t*)(ws + OFF_VWT) + ((size_t)(b * 2 + c / 64) * 64 + (c % 64)) * POS + pos; }
          *dst = (bf16_t)(pack2(acc[mi][ni][j], 0.f) & 0xffffu);
        }
    }
  } else if (seg == 3) {
    bf16_t* su = (bf16_t*)(ws + OFF_SU);
#pragma unroll
    for (int mi = 0; mi < 4; ++mi) { const int pos = pos0 + wr * 64 + mi * 16 + lr;
#pragma unroll
      for (int ni = 0; ni < 4; ++ni) { u32x2 o; o[0] = pack2(acc[mi][ni][0], acc[mi][ni][1]); o[1] = pack2(acc[mi][ni][2], acc[mi][ni][3]);
        *(u32x2*)(su + ((size_t)(b * 32 + (hc - 1536) / 16 + ni) * POS + pos) * 16 + lg * 4) = o; } }
  } else {
    bf16_t* gt = (bf16_t*)(ws + OFF_GATES);
#pragma unroll
    for (int mi = 0; mi < 4; ++mi) { const int row = m0 + wr * 64 + mi * 16 + lr;
#pragma unroll
      for (int ni = 0; ni < 4; ++ni) { u32x2 o; o[0] = pack2(sigmoidf_(acc[mi][ni][0]), sigmoidf_(acc[mi][ni][1])); o[1] = pack2(sigmoidf_(acc[mi][ni][2]), sigmoidf_(acc[mi][ni][3]));
        *(u32x2*)(gt + (size_t)row * 3072 + (hc - 2816) + ni * 16 + lg * 4) = o; } }
  }
}
DI void inproj_phase(const Params& p, int l, unsigned char* smem) {
  bf16_t* As = (bf16_t*)smem; bf16_t* Bs = As + 128 * LDT;
  const bf16_t* A = (const bf16_t*)(p.ws + OFF_ABUF); const bf16_t* W = (const bf16_t*)(p.ws + OFF_W_IN);
  constexpr int NT = DIN / 128, MT = NTOK / 128;
  for (int t = get_bid(); t < MT * NT; t += gridDim.x) {
    const int mt = t / NT, nt = t % NT;
    f32x4 acc[4][4]; zero_acc(acc);
    gemm_mainloop(acc, A + (size_t)mt * 128 * D, D, W + (size_t)nt * 128 * D, D, D, As, Bs);
    inproj_epilogue(p, l, acc, mt * 128, nt * 128);
  }
}

constexpr int NW = 4;
constexpr int NTHR = NW * 64;
constexpr int QU = NW * 32;
template <int DV, bool TWOK>
DI void attn_core_d1(f32x4 (&O)[2][DV / 16], float (&lsum)[2], const bf16x8 (&Qf)[2][2], float negm,
                  const bf16_t* __restrict__ Kp0, const bf16_t* __restrict__ Kp1, const bf16_t* __restrict__ Vt, int t0, int t1, int tm0, int tm1, int qlat0, unsigned char* smem) {
  constexpr int KB = TWOK ? 16384 : 8192, BUFB = KB + DV * 128;
  constexpr int NKL = (TWOK ? 16 : 8) / NW, NVL = DV / 8 / NW;
  const int tid = get_tid(), lane = tid & 63, wid = __builtin_amdgcn_readfirstlane(tid >> 6), lr = lane & 15, lg = lane >> 4;
  const int rl = lane >> 3, lc = (lane & 7) ^ rl;
  const int n0 = t1 - t0, ntl = n0 + (tm1 - tm0);
  u32x4 rk[NKL], rv[NVL];
#define ATTN_GLOAD(KEY0) do { const int key0_ = (KEY0); \
    _Pragma("unroll") for (int i = 0; i < NKL; ++i) { const int L = wid + i * NW; const bf16_t* kp_ = (i * NW >= 8) ? Kp1 : Kp0; rk[i] = *(const u32x4*)(kp_ + (size_t)(key0_ + (L & 7) * 8 + rl) * 64 + (((lane & 7) ^ ((((L & 3) * 2) + (rl >> 1)) & 7)) * 8)); } \
    _Pragma("unroll") for (int i = 0; i < NVL; ++i) { const int L = wid + i * NW; rv[i] = *(const u32x4*)(Vt + (size_t)(L * 8 + rl) * POS + key0_ + lc * 8); } } while (0)
#define ATTN_LSTORE(BUF) do { unsigned char* buf_ = (BUF); \
    _Pragma("unroll") for (int i = 0; i < NKL; ++i) *(u32x4*)(buf_ + (wid + i * NW) * 1024 + lane * 16) = rk[i]; \
    _Pragma("unroll") for (int i = 0; i < NVL; ++i) *(u32x4*)(buf_ + KB + (wid + i * NW) * 1024 + lane * 16) = rv[i]; } while (0)
  ATTN_GLOAD((n0 > 0 ? t0 : tm0) * 64);
  __syncthreads();
  ATTN_LSTORE(smem);
  const int sw = lr & 7;
  for (int it = 0; it < ntl; ++it) {
    const bool masked = it >= n0;
    const int key0 = (masked ? tm0 + (it - n0) : t0 + it) * 64;
    const unsigned char* Kb = smem + (it & 1) * BUFB; const unsigned char* Vb = Kb + KB;
    __syncthreads();
    if (it + 1 < ntl) ATTN_GLOAD(((it + 1) >= n0 ? tm0 + (it + 1 - n0) : t0 + it + 1) * 64);
    f32x4 s[4][2];
#pragma unroll
    for (int kt = 0; kt < 4; ++kt) {
      const unsigned char* kr = Kb + ((kt >> 1) * 32 + (lr >> 2) * 8 + (kt & 1) * 4 + (lr & 3)) * 128; const int kkey = ((lr >> 2) * 2 + (kt & 1) * 2 + ((lr & 3) >> 1)) & 7;
      if (!TWOK) {
        const bf16x8 k0f = *(const bf16x8*)(kr + ((lg ^ kkey) << 4)), k1f = *(const bf16x8*)(kr + (((4 + lg) ^ kkey) << 4));
#pragma unroll
        for (int qt = 0; qt < 2; ++qt) { f32x4 z = {negm, negm, negm, negm}; z = MFMA16(k0f, Qf[qt][0], z); s[kt][qt] = MFMA16(k1f, Qf[qt][1], z); }
      } else {
#pragma unroll
        for (int qt = 0; qt < 2; ++qt) {
          const bf16x8 k0f = *(const bf16x8*)(kr + qt * 8192 + ((lg ^ kkey) << 4)), k1f = *(const bf16x8*)(kr + qt * 8192 + (((4 + lg) ^ kkey) << 4));
          f32x4 z = {negm, negm, negm, negm}; z = MFMA16(k0f, Qf[qt][0], z); s[kt][qt] = MFMA16(k1f, Qf[qt][1], z); }
      }
    }
    if (masked) {
#pragma unroll
      for (int kt = 0; kt < 4; ++kt)
#pragma unroll
        for (int qt = 0; qt < 2; ++qt)
#pragma unroll
          for (int j = 0; j < 4; ++j) { const int kl = key0 - CTX + (kt >> 1) * 32 + lg * 8 + (kt & 1) * 4 + j, ql = qlat0 + qt * 16 + lr; const int rel = kl - ql; if (rel > 128 || rel < -128) s[kt][qt][j] = -INFINITY; }
    }
    bf16x8 pf[2][2];
#pragma unroll
    for (int qt = 0; qt < 2; ++qt) {
      float rs = 0.f;
#pragma unroll
      for (int kt = 0; kt < 4; ++kt)
#pragma unroll
        for (int j = 0; j < 4; ++j) { const float e = __builtin_amdgcn_exp2f(s[kt][qt][j]); s[kt][qt][j] = e; rs += e; }
      lsum[qt] += rs;
#pragma unroll
      for (int kk = 0; kk < 2; ++kk) {
        u32x4 w; w[0] = pack2(s[2 * kk][qt][0], s[2 * kk][qt][1]); w[1] = pack2(s[2 * kk][qt][2], s[2 * kk][qt][3]);
        w[2] = pack2(s[2 * kk + 1][qt][0], s[2 * kk + 1][qt][1]); w[3] = pack2(s[2 * kk + 1][qt][2], s[2 * kk + 1][qt][3]);
        pf[qt][kk] = __builtin_bit_cast(bf16x8, w);
      }
    }
#pragma unroll
    for (int et = 0; et < DV / 16; ++et)
#pragma unroll
      for (int kk = 0; kk < 2; ++kk) {
        const bf16x8 vf = *(const bf16x8*)(Vb + (et * 16 + lr) * 128 + (((kk * 4 + lg) ^ sw) << 4));
        O[0][et] = MFMA16(vf, pf[0][kk], O[0][et]);
        O[1][et] = MFMA16(vf, pf[1][kk], O[1][et]);
      }
    if (it + 1 < ntl) ATTN_LSTORE(smem + ((it + 1) & 1) * BUFB);
  }
#undef ATTN_GLOAD
#undef ATTN_LSTORE
}

#define VM_WAIT4(N, R, Q) asm volatile("s_waitcnt vmcnt(" #N ")" : "+v"(R[0]), "+v"(R[1]), "+v"(Q[0]), "+v"(Q[1]) :: "memory")
template <int DV, bool TWOK>
DI void attn_core(f32x4 (&O)[2][DV / 16], float (&lsum)[2], const bf16x8 (&Qf)[2][2], float negm,
                  const bf16_t* __restrict__ Kp0, const bf16_t* __restrict__ Kp1, const bf16_t* __restrict__ Vt, int t0, int t1, int tm0, int tm1, int qlat0, unsigned char* smem) {
  constexpr int KB = TWOK ? 16384 : 8192, BUFB = KB + DV * 128;
  constexpr int NKL = (TWOK ? 16 : 8) / NW, NVL = DV / 8 / NW;
  static_assert((NKL == 4 && NVL == 4) || (NKL == 2 && NVL == 2), "wait macros are written for 8 or 4 loads per set");
  const int tid = get_tid(), lane = tid & 63, wid = __builtin_amdgcn_readfirstlane(tid >> 6), lr = lane & 15, lg = lane >> 4;
  const int rl = lane >> 3, lc = (lane & 7) ^ rl;
  const int n0 = t1 - t0, ntl = n0 + (tm1 - tm0);
  u32x4 rk0[NKL], rv0[NVL], rk1[NKL], rv1[NVL];
#define ATTN_TILE(I) ({ int i_ = (I); i_ = i_ < ntl ? i_ : ntl - 1; (i_ < n0 ? t0 + i_ : tm0 + (i_ - n0)) * 64; })
#define ATTN_GLOAD(RK, RV, KEY0) do { const int key0_ = (KEY0); \
    _Pragma("unroll") for (int i = 0; i < NKL; ++i) { const int L = wid + i * NW; const bf16_t* kp_ = (i * NW >= 8) ? Kp1 : Kp0; RK[i] = gload_async(kp_ + (size_t)(key0_ + (L & 7) * 8 + rl) * 64 + (((lane & 7) ^ ((((L & 3) * 2) + (rl >> 1)) & 7)) * 8)); } \
    _Pragma("unroll") for (int i = 0; i < NVL; ++i) { const int L = wid + i * NW; RV[i] = gload_async(Vt + (size_t)(L * 8 + rl) * POS + key0_ + lc * 8); } } while (0)
#define ATTN_LSTORE(RK, RV, BUF) do { unsigned char* buf_ = (BUF); \
    _Pragma("unroll") for (int i = 0; i < NKL; ++i) *(u32x4*)(buf_ + (wid + i * NW) * 1024 + lane * 16) = RK[i]; \
    _Pragma("unroll") for (int i = 0; i < NVL; ++i) *(u32x4*)(buf_ + KB + (wid + i * NW) * 1024 + lane * 16) = RV[i]; } while (0)
#define ATTN_WAIT(RK, RV) do { if constexpr (NKL == 4) VM_WAIT8(8, RK, RV); else VM_WAIT4(4, RK, RV); } while (0)
#define ATTN_DRAIN(RK, RV) do { if constexpr (NKL == 4) VM_WAIT8(0, RK, RV); else VM_WAIT4(0, RK, RV); } while (0)
  const int sw = lr & 7;
#define ATTN_COMPUTE(IT, BUFP) do { const int it_ = (IT); const bool masked = it_ >= n0; const int key0 = (masked ? tm0 + (it_ - n0) : t0 + it_) * 64; \
    const unsigned char* Kb = (BUFP); const unsigned char* Vb = Kb + KB; \
    bf16x8 pf[2][2]; \
    _Pragma("unroll") for (int qt = 0; qt < 2; ++qt) { f32x4 s4[4]; \
      _Pragma("unroll") for (int kt = 0; kt < 4; ++kt) { const unsigned char* kq = Kb + ((kt >> 1) * 32 + (lr >> 2) * 8 + (kt & 1) * 4 + (lr & 3)) * 128 + (TWOK ? qt * 8192 : 0); const int kkey = ((lr >> 2) * 2 + (kt & 1) * 2 + ((lr & 3) >> 1)) & 7; \
        const bf16x8 k0f = *(const bf16x8*)(kq + ((lg ^ kkey) << 4)), k1f = *(const bf16x8*)(kq + (((4 + lg) ^ kkey) << 4)); \
        f32x4 z = {negm, negm, negm, negm}; z = MFMA16(k0f, Qf[qt][0], z); s4[kt] = MFMA16(k1f, Qf[qt][1], z); } \
      if (masked) { \
        _Pragma("unroll") for (int kt = 0; kt < 4; ++kt) _Pragma("unroll") for (int j = 0; j < 4; ++j) { \
          const int kl = key0 - CTX + (kt >> 1) * 32 + lg * 8 + (kt & 1) * 4 + j, ql = qlat0 + qt * 16 + lr; const int rel = kl - ql; if (rel > 128 || rel < -128) s4[kt][j] = -INFINITY; } } \
      float rs = 0.f; \
      _Pragma("unroll") for (int kt = 0; kt < 4; ++kt) _Pragma("unroll") for (int j = 0; j < 4; ++j) { const float e = __builtin_amdgcn_exp2f(s4[kt][j]); s4[kt][j] = e; rs += e; } \
      lsum[qt] += rs; \
      _Pragma("unroll") for (int kk = 0; kk < 2; ++kk) { u32x4 w; w[0] = pack2(s4[2 * kk][0], s4[2 * kk][1]); w[1] = pack2(s4[2 * kk][2], s4[2 * kk][3]); \
        w[2] = pack2(s4[2 * kk + 1][0], s4[2 * kk + 1][1]); w[3] = pack2(s4[2 * kk + 1][2], s4[2 * kk + 1][3]); pf[qt][kk] = __builtin_bit_cast(bf16x8, w); } } \
    _Pragma("unroll") for (int et = 0; et < DV / 16; ++et) _Pragma("unroll") for (int kk = 0; kk < 2; ++kk) { \
        const bf16x8 vf = *(const bf16x8*)(Vb + (et * 16 + lr) * 128 + (((kk * 4 + lg) ^ sw) << 4)); \
        O[0][et] = MFMA16(vf, pf[0][kk], O[0][et]); O[1][et] = MFMA16(vf, pf[1][kk], O[1][et]); } } while (0)
  asm volatile("s_waitcnt vmcnt(0)" ::: "memory");
  ATTN_GLOAD(rk0, rv0, ATTN_TILE(0)); ATTN_GLOAD(rk1, rv1, ATTN_TILE(1));
  __syncthreads();
  ATTN_WAIT(rk0, rv0); ATTN_LSTORE(rk0, rv0, smem); ATTN_GLOAD(rk0, rv0, ATTN_TILE(2));
  for (int it = 0; it < ntl; it += 2) {
    __syncthreads();
    ATTN_COMPUTE(it, smem);
    ATTN_WAIT(rk1, rv1); ATTN_LSTORE(rk1, rv1, smem + BUFB); ATTN_GLOAD(rk1, rv1, ATTN_TILE(it + 3));
    __syncthreads();
    ATTN_COMPUTE(it + 1, smem + BUFB);
    ATTN_WAIT(rk0, rv0); ATTN_LSTORE(rk0, rv0, smem); ATTN_GLOAD(rk0, rv0, ATTN_TILE(it + 4));
  }
  ATTN_DRAIN(rk0, rv0); ATTN_DRAIN(rk1, rv1);
#undef ATTN_TILE
#undef ATTN_GLOAD
#undef ATTN_LSTORE
#undef ATTN_WAIT
#undef ATTN_DRAIN
#undef ATTN_COMPUTE
}

constexpr int QUD = NW * 16;
DI void diff_unit(const Params& p, int l, int b, int hd, bool is_lat, int qi, unsigned char* smem) {
  unsigned char* ws = p.ws;
  const int tid = get_tid(), lane = tid & 63, wid = __builtin_amdgcn_readfirstlane(tid >> 6), lr = lane & 15, lg = lane >> 4;
  const int qpos0 = (is_lat ? CTX + qi * QUD : qi * QUD) + wid * 16;
  const int ntile = is_lat ? POS / 64 : CTX / 64;
  const float lam = ((const float*)(ws + OFF_LAM))[l];
  const float negm = -((const float*)(ws + OFF_LAM))[4 + l];
  const float lam_init = 0.8f - 0.6f * expf(-0.3f * (float)l);
  const size_t hoff0 = (size_t)((b * 2 + 0) * 4 + hd) * POS * 64, hoff1 = (size_t)((b * 2 + 1) * 4 + hd) * POS * 64;
  const bf16_t* Qd = (const bf16_t*)(ws + OFF_QD); const bf16_t* Kd = (const bf16_t*)(ws + OFF_KD);
  bf16x8 Qf[2][2];
#pragma unroll
  for (int ks = 0; ks < 2; ++ks) { Qf[0][ks] = *(const bf16x8*)(Qd + hoff0 + (size_t)(qpos0 + lr) * 64 + ks * 32 + lg * 8); Qf[1][ks] = *(const bf16x8*)(Qd + hoff1 + (size_t)(qpos0 + lr) * 64 + ks * 32 + lg * 8); }
  float lsum[2] = {0.f, 0.f};
  f32x4 O[2][8];
#pragma unroll
  for (int m = 0; m < 2; ++m)
#pragma unroll
    for (int et = 0; et < 8; ++et) O[m][et] = (f32x4){0.f, 0.f, 0.f, 0.f};
  attn_core_d1<128, true>(O, lsum, Qf, negm, Kd + hoff0, Kd + hoff1, (const bf16_t*)(ws + OFF_VDT) + (size_t)(b * 4 + hd) * 128 * POS, 0, ntile, 0, 0, 0, smem);
  float l0 = lsum[0], l1 = lsum[1];
  l0 += xshfl(l0, 16); l0 += xshfl(l0, 32); l1 += xshfl(l1, 16); l1 += xshfl(l1, 32);
  const float i0 = 1.0f / l0, i1 = lam / l1;
  float ss = 0.f;
#pragma unroll
  for (int et = 0; et < 8; ++et) { O[0][et] = O[0][et] * i0 - O[1][et] * i1;
#pragma unroll
    for (int j = 0; j < 4; ++j) ss += O[0][et][j] * O[0][et][j]; }
  ss += xshfl(ss, 16); ss += xshfl(ss, 32);
  const float rs = rsqrtf(ss * (1.0f / 128.0f) + EPS) * (1.0f - lam_init);
  const float* og = p.dout_g + l * 128; bf16_t* yd = (bf16_t*)(ws + OFF_YD);
  const int qpos = qpos0 + lr;
  const int row = is_lat ? b * SEQ + (qpos - CTX) : NLAT + b * CTX + qpos;
#pragma unroll
  for (int et = 0; et < 8; ++et) { const f32x4 g = *(const f32x4*)(og + et * 16 + lg * 4); const f32x4 y = O[0][et] * rs * g;
    u32x2 o; o[0] = pack2(y[0], y[1]); o[1] = pack2(y[2], y[3]); *(u32x2*)(yd + (size_t)row * 512 + hd * 128 + et * 16 + lg * 4) = o; }
}

DI void win_unit(const Params& p, int l, int b, int qh, bool is_lat, int qi, unsigned char* smem) {
  unsigned char* ws = p.ws;
  const int tid = get_tid(), lane = tid & 63, wid = __builtin_amdgcn_readfirstlane(tid >> 6), lr = lane & 15, lg = lane >> 4;
  const int qpos0 = (is_lat ? CTX + qi * QU : qi * QU) + wid * 32;
  const int kv = qh >> 2;
  const bf16_t* Qp = (const bf16_t*)(ws + OFF_QW) + ((size_t)(b * 8 + qh) * POS + qpos0) * 64;
  bf16x8 Qf[2][2];
#pragma unroll
  for (int qt = 0; qt < 2; ++qt)
#pragma unroll
    for (int ks = 0; ks < 2; ++ks) Qf[qt][ks] = *(const bf16x8*)(Qp + (qt * 16 + lr) * 64 + ks * 32 + lg * 8);
  const float sk = p.w_sink[l * 8 + qh] * LOG2E;
  const float mfix = fmaxf(((const float*)(ws + OFF_LAM))[8 + l], sk);
  const float l0 = lg == 0 ? __builtin_amdgcn_exp2f(sk - mfix) : 0.f;
  float lsum[2] = {l0, l0};
  f32x4 O[2][4];
#pragma unroll
  for (int qt = 0; qt < 2; ++qt)
#pragma unroll
    for (int et = 0; et < 4; ++et) O[qt][et] = (f32x4){0.f, 0.f, 0.f, 0.f};
  int tm0 = 0, tm1 = 0;
  if (is_lat) { const int q0 = qi * QU; tm0 = (q0 + 128) / 64; if (tm0 < 4) tm0 = 4; tm1 = (q0 + QU + 384) / 64; if (tm1 > POS / 64) tm1 = POS / 64; }
  attn_core<64, false>(O, lsum, Qf, -mfix, (const bf16_t*)(ws + OFF_KW) + (size_t)(b * 2 + kv) * POS * 64, nullptr, (const bf16_t*)(ws + OFF_VWT) + (size_t)(b * 2 + kv) * 64 * POS, 0, 4, tm0, tm1, qpos0 - CTX, smem);
  bf16_t* yw = (bf16_t*)(ws + OFF_YW);
#pragma unroll
  for (int qt = 0; qt < 2; ++qt) {
    float ls = lsum[qt]; ls += xshfl(ls, 16); ls += xshfl(ls, 32);
    const float inv = 1.0f / ls;
    const int qpos = qpos0 + qt * 16 + lr;
    const int row = is_lat ? b * SEQ + (qpos - CTX) : NLAT + b * CTX + qpos;
#pragma unroll
    for (int et = 0; et < 4; ++et) { const f32x4 y = O[qt][et] * inv; u32x2 o; o[0] = pack2(y[0], y[1]); o[1] = pack2(y[2], y[3]);
      *(u32x2*)(yw + (size_t)row * 512 + qh * 64 + et * 16 + lg * 4) = o; }
  }
}

constexpr int NR = NW / 2, CR = NCH / NR;
constexpr int BST = 20, SST = 136;
constexpr int S5_WAVE_LDS = 128 * BST * 4 + 16 * SST * 2;
constexpr int EB_PER_UNIT = 2 * (NCH + 8) * 64 * 2;
DI int s5_row(int b, int k, int t) { return k < 8 ? NLAT + b * CTX + k * 32 + t : b * SEQ + (k - 8) * 32 + t; }
DI int s5_cmap(int d, int k) { return d == 0 ? k : (k < 8 ? 7 - k : 143 - k); }
DI void s5_make_bf(const Params& p, int l, int d, int g, float fre, float fim, bf16x8 (&Bf)[8], int lr, int lg) {
#pragma unroll
  for (int q = 0; q < 8; ++q) {
    const int pp = 16 * (q & 3) + lr;
    const float fr = __shfl(fre, pp, 64), fi = __shfl(fim, pp, 64);
    u32x4 w = {0u, 0u, 0u, 0u};
    if (lg < 2) {
      const size_t bo = ((size_t)((l * 2 + d) * 32 + g) * 64 + pp) * 16 + lg * 8;
      const f32x4 br0 = *(const f32x4*)(p.s5_bre + bo), br1 = *(const f32x4*)(p.s5_bre + bo + 4), bi0 = *(const f32x4*)(p.s5_bim + bo), bi1 = *(const f32x4*)(p.s5_bim + bo + 4);
      f32x4 v0, v1;
      if (q < 4) { v0 = fr * br0 - fi * bi0; v1 = fr * br1 - fi * bi1; } else { v0 = fr * bi0 + fi * br0; v1 = fr * bi1 + fi * br1; }
      w[0] = pack2(v0[0], v0[1]); w[1] = pack2(v0[2], v0[3]); w[2] = pack2(v1[0], v1[1]); w[3] = pack2(v1[2], v1[3]);
    }
    Bf[q] = __builtin_bit_cast(bf16x8, w);
  }
}
DI u32x4 s5_load_uf(const bf16_t* sug, int k, int tt, int lr, int lg) { u32x4 uw = {0u, 0u, 0u, 0u}; if (lg < 2) uw = *(const u32x4*)(sug + (size_t)(k * 32 + tt * 16 + lr) * 16 + lg * 8); return uw; }
DI void s5_bu_tile(u32x4 uw, const bf16x8 (&Bf)[8], float* Bsm, int lr, int lg) {
  const bf16x8 uf = __builtin_bit_cast(bf16x8, uw);
#pragma unroll
  for (int q = 0; q < 8; ++q) { f32x4 z = {0.f, 0.f, 0.f, 0.f}; z = MFMA16(Bf[q], uf, z);
#pragma unroll
    for (int jj = 0; jj < 4; ++jj) Bsm[(q * 16 + lg * 4 + jj) * BST + lr] = z[jj]; }
}
#define S5_SCAN(D, AR, AI, WRITE) do { \
    _Pragma("unroll") for (int hb = 0; hb < 2; ++hb) { const int cb = ((D) ? 1 - hb : hb) * 2;     \
      const f32x4 br0_ = *(const f32x4*)(Bsm + lane * BST + cb * 4), br1_ = *(const f32x4*)(Bsm + lane * BST + cb * 4 + 4); \
      const f32x4 bi0_ = *(const f32x4*)(Bsm + (64 + lane) * BST + cb * 4), bi1_ = *(const f32x4*)(Bsm + (64 + lane) * BST + cb * 4 + 4); \
      _Pragma("unroll") for (int st = 0; st < 8; ++st) { const int t8 = (D) ? 7 - st : st; const int tl = cb * 4 + t8; \
        const float br = t8 < 4 ? br0_[t8 & 3] : br1_[t8 & 3], bi = t8 < 4 ? bi0_[t8 & 3] : bi1_[t8 & 3]; \
        const float nr = (AR) * sr - (AI) * si + br, ni = (AR) * si + (AI) * sr + bi; sr = nr; si = ni; \
        if (WRITE) { const unsigned pk = pack2(sr, si); Ssm[tl * SST + lane] = (bf16_t)(pk & 0xffffu); Ssm[tl * SST + 64 + lane] = (bf16_t)(pk >> 16); } } } } while (0)
DI void s5_unit(const Params& p, int l, int b, int g, unsigned char* smem) {
  unsigned char* ws = p.ws;
  const int tid = get_tid(), lane = tid & 63, wid = __builtin_amdgcn_readfirstlane(tid >> 6), lr = lane & 15, lg = lane >> 4;
  float* Bsm = (float*)(smem + wid * S5_WAVE_LDS);
  bf16_t* Ssm = (bf16_t*)(smem + wid * S5_WAVE_LDS + 128 * BST * 4);
  const bf16_t* sug = (const bf16_t*)(ws + OFF_SU) + (size_t)(b * 32 + g) * POS * 16;
  float* Eb = (float*)(ws + OFF_EB) + (size_t)(b * 32 + g) * EB_PER_UNIT;
  float are[2], aim[2], fre[2], fim[2];
#pragma unroll
  for (int d = 0; d < 2; ++d) {
    const int pi = ((l * 2 + d) * 32 + g) * 64 + lane;
    const float lre = p.s5_lre[pi], lim = p.s5_lim[pi], dt = expf(p.s5_ldt[(l * 2 + d) * 32 + g]);
    const float mag = expf(lre * dt), ang = lim * dt;
    are[d] = mag * cosf(ang); aim[d] = mag * sinf(ang);
    const float den = lre * lre + lim * lim, nre = are[d] - 1.0f;
    fre[d] = (nre * lre + aim[d] * lim) / den; fim[d] = (aim[d] * lre - nre * lim) / den;
  }
  bf16x8 Bf[2][8];
  s5_make_bf(p, l, 0, g, fre[0], fim[0], Bf[0], lr, lg);
  s5_make_bf(p, l, 1, g, fre[1], fim[1], Bf[1], lr, lg);
  {
    const int d = wid & 1, r = wid >> 1;
    const float ar = d ? are[1] : are[0], ai = d ? aim[1] : aim[0];
    float sr = 0.f, si = 0.f;
    for (int ci = 0; ci < CR; ++ci) {
      const int c = r * CR + ci, k = s5_cmap(d, c);
      { float* e_ = Eb + ((size_t)(d * (NCH + 8) + c) * 64 + lane) * 2; __hip_atomic_store(e_, sr, __ATOMIC_RELAXED, __HIP_MEMORY_SCOPE_AGENT); __hip_atomic_store(e_ + 1, si, __ATOMIC_RELAXED, __HIP_MEMORY_SCOPE_AGENT); }
      const u32x4 ua = s5_load_uf(sug, k, d ? 1 : 0, lr, lg), ub = s5_load_uf(sug, k, d ? 0 : 1, lr, lg);
#pragma unroll
      for (int hh = 0; hh < 2; ++hh) {
        const u32x4 uw = hh ? ub : ua;
        __builtin_amdgcn_wave_barrier();
        if (d) s5_bu_tile(uw, Bf[1], Bsm, lr, lg); else s5_bu_tile(uw, Bf[0], Bsm, lr, lg);
        __builtin_amdgcn_wave_barrier();
        if (d) S5_SCAN(1, ar, ai, false); else S5_SCAN(0, ar, ai, false);
      }
    }
    { float* e_ = Eb + ((size_t)(d * (NCH + 8) + NCH + r) * 64 + lane) * 2; __hip_atomic_store(e_, sr, __ATOMIC_RELAXED, __HIP_MEMORY_SCOPE_AGENT); __hip_atomic_store(e_ + 1, si, __ATOMIC_RELAXED, __HIP_MEMORY_SCOPE_AGENT); }
  }
  asm volatile("s_waitcnt vmcnt(0)" ::: "memory"); __syncthreads();
  bf16x8 Cf[2][4];
  float a32r[2], a32i[2], aCRr[2], aCRi[2];
#pragma unroll
  for (int d = 0; d < 2; ++d) {
#pragma unroll
    for (int ks = 0; ks < 4; ++ks) {
      const float* src = (ks < 2 ? p.s5_cre : p.s5_cim) + ((size_t)((l * 2 + d) * 32 + g) * 16 + lr) * 64 + (ks & 1) * 32 + lg * 8;
      const f32x4 v0 = *(const f32x4*)src, v1 = *(const f32x4*)(src + 4); const float sg = ks < 2 ? 1.0f : -1.0f;
      u32x4 w; w[0] = pack2(sg * v0[0], sg * v0[1]); w[1] = pack2(sg * v0[2], sg * v0[3]); w[2] = pack2(sg * v1[0], sg * v1[1]); w[3] = pack2(sg * v1[2], sg * v1[3]);
      Cf[d][ks] = __builtin_bit_cast(bf16x8, w);
    }
    float pr = are[d], pi_ = aim[d];
#pragma unroll
    for (int q = 0; q < 5; ++q) { const float nr = pr * pr - pi_ * pi_, ni = 2.0f * pr * pi_; pr = nr; pi_ = ni; }
    a32r[d] = pr; a32i[d] = pi_;
    float rr = 1.f, ri = 0.f, br_ = pr, bi_ = pi_;
#pragma unroll
    for (int bit = 0; bit < 7; ++bit) { if ((CR >> bit) & 1) { const float nr = rr * br_ - ri * bi_, ni = rr * bi_ + ri * br_; rr = nr; ri = ni; } const float nr = br_ * br_ - bi_ * bi_, ni = 2.0f * br_ * bi_; br_ = nr; bi_ = ni; }
    aCRr[d] = rr; aCRi[d] = ri;
  }
  const f32x4 dsk = *(const f32x4*)(p.s5_d + l * 512 + g * 16 + lg * 4);
  bf16_t* gb = (bf16_t*)(ws + OFF_GB);
  for (int k = wid; k < NCH; k += NW) {
    f32x4 acc[2] = {{0.f, 0.f, 0.f, 0.f}, {0.f, 0.f, 0.f, 0.f}};
    u32x4 uq[2]; uq[0] = s5_load_uf(sug, k, 0, lr, lg); uq[1] = s5_load_uf(sug, k, 1, lr, lg);
    u32x2 us[2]; us[0] = *(const u32x2*)(sug + (size_t)(k * 32 + lr) * 16 + lg * 4); us[1] = *(const u32x2*)(sug + (size_t)(k * 32 + 16 + lr) * 16 + lg * 4);
    float s0[2][2];
#pragma unroll
    for (int d = 0; d < 2; ++d) { const float* e_ = Eb + ((size_t)(d * (NCH + 8) + s5_cmap(d, k)) * 64 + lane) * 2;
      s0[d][0] = __hip_atomic_load(e_, __ATOMIC_RELAXED, __HIP_MEMORY_SCOPE_AGENT); s0[d][1] = __hip_atomic_load(e_ + 1, __ATOMIC_RELAXED, __HIP_MEMORY_SCOPE_AGENT); }
#pragma unroll
    for (int d = 0; d < 2; ++d) {
      const int c = s5_cmap(d, k), r = c / CR, j = c - r * CR;
      const float* Ed = Eb + (size_t)d * (NCH + 8) * 128 + lane * 2;
      float tr = 0.f, ti = 0.f;
#pragma unroll
      for (int r2 = 0; r2 < NR - 1; ++r2) if (r2 < r) {
        const float er = __hip_atomic_load(Ed + (size_t)(NCH + r2) * 128, __ATOMIC_RELAXED, __HIP_MEMORY_SCOPE_AGENT), ei = __hip_atomic_load(Ed + (size_t)(NCH + r2) * 128 + 1, __ATOMIC_RELAXED, __HIP_MEMORY_SCOPE_AGENT);
        const float nr = aCRr[d] * tr - aCRi[d] * ti + er, ni = aCRr[d] * ti + aCRi[d] * tr + ei; tr = nr; ti = ni; }
      float pr = 1.f, pi_ = 0.f, br_ = a32r[d], bi_ = a32i[d];
      for (int bit = 0; bit < 7; ++bit) { if ((j >> bit) & 1) { const float nr = pr * br_ - pi_ * bi_, ni = pr * bi_ + pi_ * br_; pr = nr; pi_ = ni; } const float nr = br_ * br_ - bi_ * bi_, ni = 2.0f * br_ * bi_; br_ = nr; bi_ = ni; }
      float sr = s0[d][0] + (pr * tr - pi_ * ti), si = s0[d][1] + (pr * ti + pi_ * tr);
#pragma unroll
      for (int hh = 0; hh < 2; ++hh) {
        const int tt = d ? 1 - hh : hh;
        __builtin_amdgcn_wave_barrier();
        s5_bu_tile(uq[tt], Bf[d], Bsm, lr, lg);
        __builtin_amdgcn_wave_barrier();
        if (d) S5_SCAN(1, are[1], aim[1], true); else S5_SCAN(0, are[0], aim[0], true);
        __builtin_amdgcn_wave_barrier();
#pragma unroll
        for (int ks = 0; ks < 4; ++ks) { const bf16x8 sf = *(const bf16x8*)(Ssm + lr * SST + ks * 32 + lg * 8); acc[tt] = MFMA16(Cf[d][ks], sf, acc[tt]); }
      }
    }
#pragma unroll
    for (int tt = 0; tt < 2; ++tt) { const int row = s5_row(b, k, tt * 16 + lr);
      f32x4 u; u[0] = __uint_as_float(us[tt][0] << 16); u[1] = __uint_as_float(us[tt][0] & 0xffff0000u); u[2] = __uint_as_float(us[tt][1] << 16); u[3] = __uint_as_float(us[tt][1] & 0xffff0000u);
      float y[4];
#pragma unroll
      for (int j = 0; j < 4; ++j) y[j] = gelu_tanh(acc[tt][j] + u[j] * dsk[j]);
      u32x2 o; o[0] = pack2(y[0], y[1]); o[1] = pack2(y[2], y[3]); *(u32x2*)(gb + (size_t)row * 512 + g * 16 + lg * 4) = o; }
  }
}

DI void mixer_phase(const Params& p, int l, unsigned char* smem) {
  const bool need_ctx = l < DEPTH - 1;
  volatile int* smw = (volatile int*)(smem + SMEM_BYTES - 16);
  constexpr int QL = SEQ / QU, QC = CTX / QU, QLD = SEQ / QUD, QCD = CTX / QUD;
  const int n_s5 = 16, n_dl = 2 * QLD, n_dc = need_ctx ? 2 * QCD : 0, n_wl = 4 * QL, n_wc = need_ctx ? 4 * QC : 0;
  const int total = n_dl + n_s5 + n_dc + n_wl + n_wc;
  const int x0 = get_bid() & 7;
  for (int dx = 0; dx < 8; ++dx) {
    const int xq = (x0 + dx) & 7;
    unsigned* ctr = (unsigned*)(p.ws + OFF_LAM) + 16 + l * 8 + xq;
    for (;;) {
      __syncthreads();
      if (get_tid() == 0) *smw = (int)atomicAdd(ctr, 1u);
      __syncthreads();
      int u = *smw;
      u = __builtin_amdgcn_readfirstlane(u);
      if (u >= total) break;
      int type, bq, hd, qi; bool is_lat = true;
      if (u < n_s5) { const int idx = xq * 16 + u; type = 1; bq = idx >> 5; hd = idx & 31; qi = 0; }
      else if ((u -= n_s5) < n_dl) { const int gidx = xq + 8 * (u / QLD); type = 0; bq = gidx >> 2; hd = gidx & 3; qi = u % QLD; }
      else if ((u -= n_dl) < n_dc) { const int gidx = xq + 8 * (u / QCD); type = 0; is_lat = false; bq = gidx >> 2; hd = gidx & 3; qi = u % QCD; }
      else if ((u -= n_dc) < n_wl) { type = 2; bq = xq >> 1; hd = (xq & 1) * 4 + (u & 3); qi = u >> 2; }
      else { u -= n_wl; type = 2; is_lat = false; bq = xq >> 1; hd = (xq & 1) * 4 + (u & 3); qi = u >> 2; }
      if (type == 0) diff_unit(p, l, bq, hd, is_lat, qi, smem);
      else if (type == 1) s5_unit(p, l, bq, hd, smem);
      else win_unit(p, l, bq, hd, is_lat, qi, smem);
    }
  }
}

#define EPI_LOOP_BEGIN { const int tid_ = get_tid(), lane_ = tid_ & 63, wid_ = tid_ >> 6, wr_ = wid_ >> 1, wc_ = wid_ & 1, lr_ = lane_ & 15, lg_ = lane_ >> 4; \
  _Pragma("unroll") for (int mi = 0; mi < 4; ++mi) { const int row = m0 + wr_ * 64 + mi * 16 + lr_; \
  _Pragma("unroll") for (int ni = 0; ni < 4; ++ni) { const int col = n0 + wc_ * 64 + ni * 16 + lg_ * 4;
#define EPI_LOOP_END } } }

DI void glu_phase(const Params& p, int MT, unsigned char* smem) {
  bf16_t* As = (bf16_t*)smem; bf16_t* Bs = As + 128 * LDT;
  const bf16_t* G = (const bf16_t*)(p.ws + OFF_GB); const bf16_t* W = (const bf16_t*)(p.ws + OFF_W_GLU); bf16_t* ys = (bf16_t*)(p.ws + OFF_YS);
  constexpr int NT = 4;
  for (int t = get_bid(); t < MT * NT; t += gridDim.x) {
    const int m0 = (t / NT) * 128, n0 = (t % NT) * 128;
    f32x4 acc[4][4]; zero_acc(acc);
    gemm_mainloop(acc, G + (size_t)m0 * 512, 512, W + (size_t)n0 * 512, 512, 512, As, Bs);
    EPI_LOOP_BEGIN
      const u32x2 gr = *(const u32x2*)(G + (size_t)row * 512 + col);
      const float g0 = __uint_as_float(gr[0] << 16), g1 = __uint_as_float(gr[0] & 0xffff0000u), g2 = __uint_as_float(gr[1] << 16), g3 = __uint_as_float(gr[1] & 0xffff0000u);
      u32x2 o; o[0] = pack2(g0 * sigmoidf_(acc[mi][ni][0]), g1 * sigmoidf_(acc[mi][ni][1])); o[1] = pack2(g2 * sigmoidf_(acc[mi][ni][2]), g3 * sigmoidf_(acc[mi][ni][3]));
      *(u32x2*)(ys + (size_t)row * 512 + col) = o;
    EPI_LOOP_END
  }
}
DI void merge_phase(const Params& p, int MT, unsigned char* smem) {
  bf16_t* As = (bf16_t*)smem; bf16_t* Bs = As + 128 * LDT;
  const bf16_t* gt = (const bf16_t*)(p.ws + OFF_GATES); bf16_t* mo = (bf16_t*)(p.ws + OFF_M);
  constexpr int NT = 8;
  for (int t = get_bid(); t < MT * NT; t += gridDim.x) {
    const int m0 = (t / NT) * 128, n0 = (t % NT) * 128;
    f32x4 acc[4][4]; zero_acc(acc);
#pragma unroll 1
    for (int br = 0; br < 3; ++br) {
      const bf16_t* Y = (const bf16_t*)(p.ws + (br == 0 ? OFF_YD : br == 1 ? OFF_YS : OFF_YW));
      const bf16_t* W = (const bf16_t*)(p.ws + (br == 0 ? OFF_W_PD : br == 1 ? OFF_W_PS : OFF_W_PW));
      gemm_mainloop(acc, Y + (size_t)m0 * 512, 512, W + (size_t)n0 * 512, 512, 512, As, Bs);
      if (br < 2) {
        EPI_LOOP_BEGIN
          const f32x4 g0 = ld_bf4(gt + (size_t)row * 3072 + br * 1024 + col), g1 = ld_bf4(gt + (size_t)row * 3072 + (br + 1) * 1024 + col);
#pragma unroll
          for (int j = 0; j < 4; ++j) acc[mi][ni][j] *= fmaxf(g0[j], 1e-30f) / fmaxf(g1[j], 1e-30f);
        EPI_LOOP_END
      } else {
        EPI_LOOP_BEGIN
          const f32x4 g2 = ld_bf4(gt + (size_t)row * 3072 + 2048 + col);
          u32x2 o; o[0] = pack2(acc[mi][ni][0] * fmaxf(g2[0], 1e-30f), acc[mi][ni][1] * fmaxf(g2[1], 1e-30f)); o[1] = pack2(acc[mi][ni][2] * fmaxf(g2[2], 1e-30f), acc[mi][ni][3] * fmaxf(g2[3], 1e-30f));
          *(u32x2*)(mo + (size_t)row * D + col) = o;
        EPI_LOOP_END
      }
    }
  }
}
DI void resid_phase(const Params& p, int l, const bf16_t* A, int K, const bf16_t* W, int gate_off, float* dst, int MT, unsigned char* smem, bool first = false) {
  bf16_t* As = (bf16_t*)smem; bf16_t* Bs = As + 128 * LDT;
  const float* h = (const float*)(p.ws + OFF_H);
  const float* modv = (const float*)(p.ws + OFF_MODV) + (size_t)l * 5 * 6144;
  constexpr int NT = 8;
  for (int t = get_bid(); t < MT * NT; t += gridDim.x) {
    const int m0 = (t / NT) * 128, n0 = (t % NT) * 128;
    f32x4 acc[4][4]; zero_acc(acc);
    gemm_mainloop(acc, A + (size_t)m0 * K, K, W + (size_t)n0 * K, K, K, As, Bs);
    const int bb = m0 < NLAT ? m0 / SEQ : 4;
    EPI_LOOP_BEGIN
      const f32x4 gv = *(const f32x4*)(modv + bb * 6144 + gate_off + col);
      const f32x4 hv = *(const f32x4*)((first ? (row < NLAT ? p.x + (size_t)row * D : p.ctx + (size_t)(row - NLAT) * D) : h + (size_t)row * D) + col);
      *(f32x4*)(dst + (size_t)row * D + col) = hv + gv * acc[mi][ni];
    EPI_LOOP_END
  }
}
DI void ff1_phase(const Params& p, int MT, unsigned char* smem) {
  bf16_t* As = (bf16_t*)smem; bf16_t* Bs = As + 128 * LDT;
  const bf16_t* A = (const bf16_t*)(p.ws + OFF_ABUF); const bf16_t* W = (const bf16_t*)(p.ws + OFF_W_FF1); bf16_t* uo = (bf16_t*)(p.ws + OFF_U);
  constexpr int NT = DFF / 128;
  for (int t = get_bid(); t < MT * NT; t += gridDim.x) {
    const int m0 = (t / NT) * 128, n0 = (t % NT) * 128;
    f32x4 acc[4][4]; zero_acc(acc);
    gemm_mainloop<true>(acc, A + (size_t)m0 * D, D, W + (size_t)n0 * D, D, D, As, Bs);
    const int tid_ = get_tid(), lane_ = tid_ & 63, wid_ = tid_ >> 6, wr_ = wid_ >> 1, wc_ = wid_ & 1, lr_ = lane_ & 15, lg_ = lane_ >> 4;
#pragma unroll
    for (int mi = 0; mi < 4; ++mi) { const int row = m0 + wr_ * 64 + mi * 16 + lr_;
#pragma unroll
      for (int q = 0; q < 2; ++q) { const int col = n0 + wc_ * 64 + q * 32 + lg_ * 8;
        float r[8];
#pragma unroll
        for (int j = 0; j < 4; ++j) { const float v0 = fmaxf(acc[mi][2 * q][j], 0.f), v1 = fmaxf(acc[mi][2 * q + 1][j], 0.f); r[j] = v0 * v0; r[4 + j] = v1 * v1; }
        u32x4 o; o[0] = pack2(r[0], r[1]); o[1] = pack2(r[2], r[3]); o[2] = pack2(r[4], r[5]); o[3] = pack2(r[6], r[7]);
        *(u32x4*)(uo + (size_t)row * DFF + col) = o; } }
  }
}

#define XB_TMO      128
#define XB_XCNT(j)  (256  + 64 * (j))
#define XB_XSUB(j)  (1280 + 64 * (j))
#define XB_XGEN(j)  (2304 + 64 * (j))
#define XB_TOP      3328
#define XB_TOPGEN   3392
#define XCD_BAR_WORDS 3456
#define XB_SPIN_CAP (1u << 18)
#define XLAS __attribute__((address_space(3)))

__device__ __forceinline__ unsigned xb_ld(unsigned* p)              { return __hip_atomic_load(p, __ATOMIC_RELAXED, __HIP_MEMORY_SCOPE_AGENT); }
__device__ __forceinline__ unsigned xb_add(unsigned* p, unsigned v) { return __hip_atomic_fetch_add(p, v, __ATOMIC_RELAXED, __HIP_MEMORY_SCOPE_AGENT); }
__device__ __forceinline__ unsigned xb_xcc_id() { return (unsigned)__builtin_amdgcn_s_getreg((3 << 11) | 20) & 0xFu; }
#define XB_SPIN(cond, bar) do { unsigned _sp = 0; while (cond) { __builtin_amdgcn_s_sleep(1); \
    if ((++_sp & 255u) == 0u) { if (xb_ld(&(bar)[XB_TMO])) break; if (_sp > XB_SPIN_CAP) { atomicAdd(&(bar)[XB_TMO], 1u); break; } } } } while (0)

struct XcdBarrier {
    unsigned* bar; unsigned x;
    volatile XLAS unsigned* st;
};

__device__ __forceinline__ XcdBarrier xcd_barrier_post(unsigned* bar, volatile XLAS unsigned* st) {
    XcdBarrier b; b.bar = bar; b.x = xb_xcc_id(); b.st = st;
    if (threadIdx.x == 0) (void)xb_add(&bar[XB_XCNT(b.x)], 1u);
    return b;
}
__device__ __forceinline__ void xcd_barrier_complete(unsigned* bar, unsigned x, unsigned& nloc, unsigned& nx) {
    const unsigned G = gridDim.x * gridDim.y * gridDim.z;
    unsigned sum, cnt, mine, sp = 0u;
    for (;;) {
        sum = 0u; cnt = 0u; mine = 0u;
#pragma unroll
        for (unsigned j = 0; j < 16; ++j) { const unsigned c = xb_ld(&bar[XB_XCNT(j)]); sum += c; cnt += (c > 0u) ? 1u : 0u; mine = (j == x) ? c : mine; }
        if (sum == G) break;
        __builtin_amdgcn_s_sleep(1);
        if ((++sp & 255u) == 0u) { if (xb_ld(&bar[XB_TMO])) break; if (sp > XB_SPIN_CAP) { atomicAdd(&bar[XB_TMO], 1u); break; } }
    }
    nloc = mine > 0u ? mine : 1u; nx = cnt > 0u ? cnt : 1u;
}

__device__ __forceinline__ void xcd_barrier(const XcdBarrier& b) {
    asm volatile("s_waitcnt vmcnt(0)" ::: "memory");
    __syncthreads();
    if (threadIdx.x == 0) {
        unsigned* bar = b.bar;
        __builtin_amdgcn_s_waitcnt(0);
        unsigned nloc = b.st[0], nx = b.st[1];
        if (nloc == 0u) { xcd_barrier_complete(bar, b.x, nloc, nx); b.st[0] = nloc; b.st[1] = nx; }
        const unsigned old = xb_add(&bar[XB_XSUB(b.x)], 1u);
        const unsigned gen = old / nloc;
        if (old + 1u == (gen + 1u) * nloc) {
            __builtin_amdgcn_fence(__ATOMIC_RELEASE, "agent");
            asm volatile("s_waitcnt vmcnt(0)" ::: "memory");
            const unsigned og = xb_add(&bar[XB_TOP], 1u);
            const unsigned tg = og / nx;
            if (og + 1u == (tg + 1u) * nx) xb_add(&bar[XB_TOPGEN], 1u);
            else XB_SPIN(xb_ld(&bar[XB_TOPGEN]) == tg, bar);
            __builtin_amdgcn_fence(__ATOMIC_ACQUIRE, "agent");
            xb_add(&bar[XB_XGEN(b.x)], 1u);
            asm volatile("s_waitcnt vmcnt(0)" ::: "memory");
        } else {
            XB_SPIN(xb_ld(&bar[XB_XGEN(b.x)]) == gen, bar);
            __builtin_amdgcn_fence(__ATOMIC_ACQUIRE, "agent");
            asm volatile("s_waitcnt vmcnt(0)" ::: "memory");
        }
    }
    __syncthreads();
}


__global__ void __launch_bounds__(256, 2) fwd_megakernel(Params p) {
  __shared__ __attribute__((aligned(16))) unsigned char smem[SMEM_BYTES];
  __shared__ uint4 xb_words;
  cg::grid_group grid = cg::this_grid();
  unsigned char* ws = p.ws;
  if (threadIdx.x == 0) xb_words = make_uint4(0u, 0u, 0u, 0u);
  __syncthreads();
  const XcdBarrier xb = xcd_barrier_post((unsigned*)(ws + OFF_BAR), (volatile XLAS unsigned*)&xb_words);
  phase0_misc(p, smem);
  __syncthreads();
  convert_layer(p, 0, 0, smem);
  if (p.ws == nullptr) grid.sync();
  for (int l = 0; l < DEPTH; ++l) {
    const bool need_ctx = l < DEPTH - 1;
    const int MT = need_ctx ? NTOK / 128 : NLAT / 128;
    xcd_barrier(xb);
    if (l > 0) convert_layer(p, l, CONV_EARLY, smem);
    norm_phase(p, l, p.norm1_g + l * D, 0, 1024, NTOK, l == 0);
    xcd_barrier(xb);
    inproj_phase(p, l, smem);
    xcd_barrier(xb);
    mixer_phase(p, l, smem);
    xcd_barrier(xb);
    glu_phase(p, MT, smem);
    xcd_barrier(xb);
    merge_phase(p, MT, smem);
    xcd_barrier(xb);
    resid_phase(p, l, (const bf16_t*)(ws + OFF_M), D, (const bf16_t*)(ws + OFF_W_OUT), 2048, (float*)(ws + OFF_H), MT, smem, l == 0);
    xcd_barrier(xb);
    norm_phase(p, l, p.norm2_g + l * D, 3072, 4096, MT * 128);
    xcd_barrier(xb);
    ff1_phase(p, MT, smem);
    xcd_barrier(xb);
    resid_phase(p, l, (const bf16_t*)(ws + OFF_U), DFF, (const bf16_t*)(ws + OFF_W_FF2), 5120, need_ctx ? (float*)(ws + OFF_H) : p.out, MT, smem);
    if (need_ctx) convert_steal(p, l + 1, smem);
  }
}

extern "C" void kernel_launch(void* const* d_in, const int* in_sizes, int n_in, void* d_out, int out_size, void* d_ws, size_t ws_size, hipStream_t stream) {
  static int grid_blocks = 0;
  if (!grid_blocks) {
    int dev = 0, cus = 0, per_cu = 0;
    (void)hipGetDevice(&dev);
    (void)hipDeviceGetAttribute(&cus, hipDeviceAttributeMultiprocessorCount, dev);
    (void)hipOccupancyMaxActiveBlocksPerMultiprocessor(&per_cu, fwd_megakernel, 256, 0);
    if (per_cu > 2) per_cu = 2;
    if (per_cu < 1) per_cu = 1;
    grid_blocks = cus * per_cu;
  }
  if (ws_size < WS_NEED) { fprintf(stderr, "workspace too small: %zu < %zu\n", ws_size, (size_t)WS_NEED); return; }
  (void)hipMemsetAsync((unsigned char*)d_ws + OFF_BAR, 0, BAR_BYTES, stream);
  Params p{};
  const float* const* in = (const float* const*)d_in;
  p.x = in[0]; p.c = in[1]; p.ctx = in[2]; p.c_ctx = in[3]; p.w_mod = in[4]; p.b_mod = in[5]; p.norm1_g = in[6]; p.norm2_g = in[7]; p.w_in = in[8];
  p.dq_g = in[9]; p.dk_g = in[10]; p.lq1 = in[11]; p.lk1 = in[12]; p.lq2 = in[13]; p.lk2 = in[14]; p.dout_g = in[15];
  p.s5_lre = in[16]; p.s5_lim = in[17]; p.s5_ldt = in[18]; p.s5_bre = in[19]; p.s5_bim = in[20]; p.s5_cre = in[21]; p.s5_cim = in[22]; p.s5_d = in[23]; p.s5_wglu = in[24];
  p.wq_g = in[25]; p.wk_g = in[26]; p.w_sink = in[27];
  p.w_pd = in[28]; p.w_ps = in[29]; p.w_pw = in[30]; p.w_out = in[31]; p.w_ff1 = in[32]; p.w_ff2 = in[33];
  p.out = (float*)d_out; p.ws = (unsigned char*)d_ws;
  void* args[] = {&p};
  hipError_t e = hipLaunchCooperativeKernel((void*)fwd_megakernel, dim3(grid_blocks), dim3(256), args, 0, stream);
  if (e != hipSuccess) fprintf(stderr, "cooperative launch failed: %s (grid %d)\n", hipGetErrorString(e), grid_blocks);
}
```

```cpp
#include <hip/hip_runtime.h>
#include <hip/hip_cooperative_groups.h>
#include <cstdio>
#include <cstdint>
namespace cg = cooperative_groups;

typedef unsigned short bf16_t;
typedef short bf16x8 __attribute__((ext_vector_type(8)));
typedef short bf16x4 __attribute__((ext_vector_type(4)));
typedef float f32x4 __attribute__((ext_vector_type(4)));
typedef float f32x2 __attribute__((ext_vector_type(2)));
typedef unsigned u32x4 __attribute__((ext_vector_type(4)));
typedef unsigned u32x2 __attribute__((ext_vector_type(2)));
typedef __bf16 bf2_t __attribute__((ext_vector_type(2)));

#define DI __device__ __forceinline__
#define MFMA16(a, b, c) __builtin_amdgcn_mfma_f32_16x16x32_bf16((a), (b), (c), 0, 0, 0)

constexpr int D = 1024, NB = 4, SEQ = 4096, DEPTH = 4, CTX = 256, POS = CTX + SEQ  ;
constexpr int NLAT = NB * SEQ  , NCTX = NB * CTX  , NTOK = NLAT + NCTX  ;
constexpr int DIN = 5888, DFF = 4096;
constexpr float EPS = 1e-6f;
constexpr float LOG2E = 1.4426950408889634f;
constexpr int NCH = POS / 32;

constexpr size_t SZ_W_IN = (size_t)DIN * D * 2, SZ_W_GLU = 512 * 512 * 2, SZ_W_P = 1024 * 512 * 2, SZ_W_OUT = (size_t)D * D * 2, SZ_W_FF = (size_t)D * DFF * 2;
constexpr size_t OFF_W_IN = 0;
constexpr size_t OFF_W_GLU = OFF_W_IN + SZ_W_IN;
constexpr size_t OFF_W_PD = OFF_W_GLU + SZ_W_GLU;
constexpr size_t OFF_W_PS = OFF_W_PD + SZ_W_P;
constexpr size_t OFF_W_PW = OFF_W_PS + SZ_W_P;
constexpr size_t OFF_W_OUT = OFF_W_PW + SZ_W_P;
constexpr size_t OFF_W_FF1 = OFF_W_OUT + SZ_W_OUT;
constexpr size_t OFF_W_FF2 = OFF_W_FF1 + SZ_W_FF;
constexpr size_t OFF_MODV = OFF_W_FF2 + SZ_W_FF;
constexpr size_t OFF_ROPE = OFF_MODV + (size_t)DEPTH * 5 * 6144 * 4;
constexpr size_t OFF_LAM = OFF_ROPE + 8192;
constexpr size_t OFF_H = OFF_LAM + 256;
constexpr size_t OFF_ABUF = OFF_H + (size_t)NTOK * D * 4;
constexpr size_t OFF_R1 = OFF_ABUF + (size_t)NTOK * D * 2;
constexpr size_t SZ_HEADBUF = (size_t)NB * 8 * POS * 64 * 2;
constexpr size_t OFF_QD = OFF_R1;
constexpr size_t OFF_KD = OFF_QD + SZ_HEADBUF;
constexpr size_t OFF_VDT = OFF_KD + SZ_HEADBUF;
constexpr size_t OFF_SU = OFF_VDT + SZ_HEADBUF;
constexpr size_t OFF_QW = OFF_SU + (size_t)NTOK * 512 * 2;
constexpr size_t OFF_KW = OFF_QW + SZ_HEADBUF;
constexpr size_t OFF_VWT = OFF_KW + SZ_HEADBUF / 4;
constexpr size_t OFF_GATES = OFF_VWT + SZ_HEADBUF / 4;
constexpr size_t OFF_YD = OFF_GATES + (size_t)NTOK * 3072 * 2;
constexpr size_t OFF_YS = OFF_YD + (size_t)NTOK * 512 * 2;
constexpr size_t OFF_YW = OFF_YS + (size_t)NTOK * 512 * 2;
constexpr size_t OFF_GB = OFF_YW + (size_t)NTOK * 512 * 2;
constexpr size_t OFF_EB = OFF_GB + (size_t)NTOK * 512 * 2;
constexpr size_t OFF_END = OFF_EB + (size_t)NB * 32 * 2 * (NCH + 8) * 64 * 8;
constexpr size_t OFF_BAR = OFF_END;
constexpr size_t BAR_BYTES = 16384;
constexpr size_t WS_NEED = OFF_BAR + BAR_BYTES;
constexpr size_t OFF_M = OFF_QD;
constexpr size_t OFF_U = OFF_R1;
static_assert((size_t)NTOK * DFF * 2 <= OFF_END - OFF_R1, "u alias");

struct Params {
  const float *x, *c, *ctx, *c_ctx, *w_mod, *b_mod, *norm1_g, *norm2_g, *w_in;
  const float *dq_g, *dk_g, *lq1, *lk1, *lq2, *lk2, *dout_g;
  const float *s5_lre, *s5_lim, *s5_ldt, *s5_bre, *s5_bim, *s5_cre, *s5_cim, *s5_d, *s5_wglu;
  const float *wq_g, *wk_g, *w_sink;
  const float *w_pd, *w_ps, *w_pw, *w_out, *w_ff1, *w_ff2;
  float* out;
  unsigned char* ws;
};

DI int get_tid() { int t = threadIdx.x; asm volatile("" : "+v"(t)); return t; }
DI int get_bid() { int b = blockIdx.x; asm volatile("" : "+s"(b)); return b; }
DI unsigned pack2(float lo, float hi) { f32x2 v = {lo, hi}; bf2_t r = __builtin_convertvector(v, bf2_t); return __builtin_bit_cast(unsigned, r); }
DI float sigmoidf_(float x) { return 1.0f / (1.0f + __expf(-x)); }
DI float gelu_tanh(float x) { const float z = 0.7978845608028654f * (x + 0.044715f * x * x * x); const float e = __expf(2.0f * z); const float t = 1.0f - 2.0f / (e + 1.0f); return 0.5f * x * (1.0f + t); }
DI f32x4 ld_bf4(const bf16_t* p_) { const u32x2 r = *(const u32x2*)p_; f32x4 v; v[0] = __uint_as_float(r[0] << 16); v[1] = __uint_as_float(r[0] & 0xffff0000u); v[2] = __uint_as_float(r[1] << 16); v[3] = __uint_as_float(r[1] & 0xffff0000u); return v; }
DI float xshfl(float v, int m) { return __shfl_xor(v, m, 64); }

constexpr int SMEM_BYTES = 65552;
constexpr int LDT = 72;

DI u32x4 gload_async(const void* ptr) { u32x4 r; asm volatile("global_load_dwordx4 %0, %1, off" : "=v"(r) : "v"(ptr) : "memory"); return r; }
DI u32x4 gload_async_s(const void* sbase, unsigned voff) { u32x4 r; asm volatile("global_load_dwordx4 %0, %1, %2" : "=v"(r) : "v"(voff), "s"(sbase) : "memory"); return r; }
#define VM_WAIT8(N, R, Q) asm volatile("s_waitcnt vmcnt(" #N ")" : "+v"(R[0]), "+v"(R[1]), "+v"(R[2]), "+v"(R[3]), "+v"(Q[0]), "+v"(Q[1]), "+v"(Q[2]), "+v"(Q[3]) :: "memory")
template <bool PERM = false>
DI void gemm_mainloop(f32x4 (&acc)[4][4], const bf16_t* __restrict__ A, int lda, const bf16_t* __restrict__ B, int ldb, int K, bf16_t* As, bf16_t* Bs) {
  const int tid = get_tid(), lane = tid & 63, wid = tid >> 6, wr = wid >> 1, wc = wid & 1, lr = lane & 15, lg = lane >> 4;
  const int crow = tid >> 3, ckc = (tid & 7) * 8;
  constexpr int TB = 128 * 64;
  const int swc = (((tid & 7) ^ (crow & 7)) * 8);
  const int swcB = PERM ? (((tid & 7) ^ ((((crow >> 3) & 3) * 2 + ((crow & 7) >> 1)) & 7)) * 8) : swc;
  u32x4 ra0[4], rb0[4], ra1[4], rb1[4];
  unsigned aoff[4], boff[4];
#pragma unroll
  for (int i = 0; i < 4; ++i) { aoff[i] = (unsigned)(((crow + i * 32) * lda + ckc) * 2); boff[i] = (unsigned)(((crow + i * 32) * ldb + ckc) * 2); }
#define GM_LOAD(RA, RB, KOFF) do { const char* ab_ = (const char*)A + (size_t)(KOFF) * 2; const char* bb_ = (const char*)B + (size_t)(KOFF) * 2; \
    _Pragma("unroll") for (int i = 0; i < 4; ++i) { RA[i] = gload_async_s(ab_, aoff[i]); RB[i] = gload_async_s(bb_, boff[i]); } } while (0)
#define GM_STORE(RA, RB, BUF) do { _Pragma("unroll") for (int i = 0; i < 4; ++i) { *(u32x4*)(As + (BUF) * 2 * TB + (crow + i * 32) * 64 + swc) = RA[i]; *(u32x4*)(As + (BUF) * 2 * TB + TB + (crow + i * 32) * 64 + swcB) = RB[i]; } } while (0)
#define GM_COMPUTE(BUF) do { const bf16_t* as_ = As + (BUF) * 2 * TB; const bf16_t* bs_ = as_ + TB; \
    bf16x8 af[2][4], bfr[2][4];     \
    _Pragma("unroll") for (int ks = 0; ks < 2; ++ks) { const int co_ = ((ks * 4 + lg) ^ (lr & 7)) * 8; \
      _Pragma("unroll") for (int mi = 0; mi < 4; ++mi) af[ks][mi] = *(const bf16x8*)(as_ + (wr * 64 + mi * 16 + lr) * 64 + co_); \
      _Pragma("unroll") for (int ni = 0; ni < 4; ++ni) { \
        if (PERM) { const int rw_ = (ni & 1) * 4 + (lr & 3); const int key_ = ((lr >> 2) * 2 + (rw_ >> 1)) & 7; bfr[ks][ni] = *(const bf16x8*)(bs_ + (wc * 64 + (ni >> 1) * 32 + (lr >> 2) * 8 + rw_) * 64 + (((ks * 4 + lg) ^ key_) * 8)); } \
        else bfr[ks][ni] = *(const bf16x8*)(bs_ + (wc * 64 + ni * 16 + lr) * 64 + co_); } } \
    __builtin_amdgcn_sched_barrier(0); \
    __builtin_amdgcn_s_setprio(1); \
    _Pragma("unroll") for (int ks = 0; ks < 2; ++ks) _Pragma("unroll") for (int mi = 0; mi < 4; ++mi) _Pragma("unroll") for (int ni = 0; ni < 4; ++ni) acc[mi][ni] = MFMA16(bfr[ks][ni], af[ks][mi], acc[mi][ni]); \
    __builtin_amdgcn_s_setprio(0); \
    __builtin_amdgcn_sched_barrier(0); } while (0)
  asm volatile("s_waitcnt vmcnt(0)" ::: "memory");
  GM_LOAD(ra0, rb0, 0); GM_LOAD(ra1, rb1, 64);
  __syncthreads();
  VM_WAIT8(8, ra0, rb0); GM_STORE(ra0, rb0, 0); GM_LOAD(ra0, rb0, (128 < K ? 128 : 0));
  __syncthreads();
  for (int k0 = 0; k0 < K; k0 += 128) {
    const int kn1 = k0 + 192 < K ? k0 + 192 : 0, kn0 = k0 + 256 < K ? k0 + 256 : 0;
    VM_WAIT8(8, ra1, rb1); GM_STORE(ra1, rb1, 1); GM_LOAD(ra1, rb1, kn1);
    GM_COMPUTE(0); __syncthreads();
    VM_WAIT8(8, ra0, rb0); GM_STORE(ra0, rb0, 0); GM_LOAD(ra0, rb0, kn0);
    GM_COMPUTE(1); __syncthreads();
  }
  VM_WAIT8(0, ra0, rb0); VM_WAIT8(0, ra1, rb1);
#undef GM_LOAD
#undef GM_STORE
#undef GM_COMPUTE
}
DI void zero_acc(f32x4 (&acc)[4][4]) {
#pragma unroll
  for (int mi = 0; mi < 4; ++mi)
#pragma unroll
    for (int ni = 0; ni < 4; ++ni) acc[mi][ni] = (f32x4){0.f, 0.f, 0.f, 0.f};
}

DI void convert_tile(const float* __restrict__ src, int K, int N, bf16_t* __restrict__ dst, int kt, int nt, float* tile) {
  const int tid = get_tid();
  { const int r = tid >> 4, c4 = (tid & 15) * 4;
#pragma unroll
    for (int i = 0; i < 4; ++i) { const int k = r + i * 16; const f32x4 v = *(const f32x4*)(src + (size_t)(kt * 64 + k) * N + nt * 64 + c4);
      tile[k * 65 + c4 + 0] = v[0]; tile[k * 65 + c4 + 1] = v[1]; tile[k * 65 + c4 + 2] = v[2]; tile[k * 65 + c4 + 3] = v[3]; } }
  __syncthreads();
  { const int n = tid >> 2, kc = (tid & 3) * 16; u32x4 o0, o1;
#pragma unroll
    for (int q = 0; q < 4; ++q) { o0[q] = pack2(tile[(kc + 2 * q) * 65 + n], tile[(kc + 2 * q + 1) * 65 + n]); o1[q] = pack2(tile[(kc + 8 + 2 * q) * 65 + n], tile[(kc + 8 + 2 * q + 1) * 65 + n]); }
    bf16_t* d = dst + (size_t)(nt * 64 + n) * K + kt * 64 + kc; *(u32x4*)d = o0; *(u32x4*)(d + 8) = o1; }
  __syncthreads();
}
DI void convert_item(const Params& p, int l, int t, float* tile) {
  unsigned char* ws = p.ws;
  const float* src; bf16_t* dst; int K, N, idx;
  if (t < 1472) { idx = t; src = p.w_in + (size_t)l * D * DIN; K = D; N = DIN; dst = (bf16_t*)(ws + OFF_W_IN); }
  else if (t < 1536) { idx = t - 1472; src = p.s5_wglu + (size_t)l * 512 * 512; K = 512; N = 512; dst = (bf16_t*)(ws + OFF_W_GLU); }
  else if (t < 1664) { idx = t - 1536; src = p.w_pd + (size_t)l * 512 * D; K = 512; N = D; dst = (bf16_t*)(ws + OFF_W_PD); }
  else if (t < 1792) { idx = t - 1664; src = p.w_ps + (size_t)l * 512 * D; K = 512; N = D; dst = (bf16_t*)(ws + OFF_W_PS); }
  else if (t < 1920) { idx = t - 1792; src = p.w_pw + (size_t)l * 512 * D; K = 512; N = D; dst = (bf16_t*)(ws + OFF_W_PW); }
  else if (t < 2176) { idx = t - 1920; src = p.w_out + (size_t)l * D * D; K = D; N = D; dst = (bf16_t*)(ws + OFF_W_OUT); }
  else if (t < 3200) { idx = t - 2176; src = p.w_ff1 + (size_t)l * D * DFF; K = D; N = DFF; dst = (bf16_t*)(ws + OFF_W_FF1); }
  else { idx = t - 3200; src = p.w_ff2 + (size_t)l * DFF * D; K = DFF; N = D; dst = (bf16_t*)(ws + OFF_W_FF2); }
  const int nts = N / 64; convert_tile(src, K, N, dst, idx / nts, idx % nts, tile);
}
constexpr int CONV_EARLY = 3200, CONV_ALL = 4224;
DI void convert_layer(const Params& p, int l, int t_begin, unsigned char* smem) {
  float* tile = (float*)smem;
  for (int t = t_begin + get_bid(); t < CONV_ALL; t += gridDim.x) convert_item(p, l, t, tile);
}
DI void convert_steal(const Params& p, int l, unsigned char* smem) {
  float* tile = (float*)smem;
  volatile int* smw = (volatile int*)(smem + SMEM_BYTES - 16);
  unsigned* ctr = (unsigned*)(p.ws + OFF_LAM) + 48 + l;
  for (;;) {
    __syncthreads();
    if (get_tid() == 0) *smw = (int)atomicAdd(ctr, 1u);
    __syncthreads();
    int t = *smw; t = __builtin_amdgcn_readfirstlane(t);
    if (t >= CONV_EARLY) break;
    convert_item(p, l, t, tile);
  }
}

DI void phase0_misc(const Params& p, unsigned char* smem) {
  unsigned char* ws = p.ws;
  const int tid = get_tid();
  if (get_bid() == 0) {
    float* rope = (float*)(ws + OFF_ROPE);
    for (int i = tid; i < 1024; i += 256) { const int pos = i >> 4, f = i & 15; const float inv = powf(10000.0f, -(float)f / 16.0f); const float ang = (float)pos * inv; rope[i] = cosf(ang); rope[1024 + i] = sinf(ang); }
    if (tid < DEPTH) { const int l = tid; float s1 = 0.f, s2 = 0.f;
      for (int i = 0; i < 64; ++i) { s1 += p.lq1[l * 64 + i] * p.lk1[l * 64 + i]; s2 += p.lq2[l * 64 + i] * p.lk2[l * 64 + i]; }
      const float lam_init = 0.8f - 0.6f * expf(-0.3f * (float)l);
      ((float*)(ws + OFF_LAM))[l] = expf(s1) - expf(s2) + lam_init; }
    if (tid >= 64 && tid < 64 + DEPTH) { const int l = tid - 64; float a = 0.f, b2 = 0.f, c2 = 0.f, d2 = 0.f;
      for (int i = 0; i < 64; ++i) { a = fmaxf(a, fabsf(p.dq_g[l * 64 + i])); b2 = fmaxf(b2, fabsf(p.dk_g[l * 64 + i])); c2 = fmaxf(c2, fabsf(p.wq_g[l * 64 + i])); d2 = fmaxf(d2, fabsf(p.wk_g[l * 64 + i])); }
      ((float*)(ws + OFF_LAM))[4 + l] = 8.0f * LOG2E * 1.02f * a * b2;
      ((float*)(ws + OFF_LAM))[8 + l] = 8.0f * LOG2E * 1.02f * c2 * d2;
      for (int i = 0; i < 8; ++i) ((unsigned*)(ws + OFF_LAM))[16 + l * 8 + i] = 0u;
      ((unsigned*)(ws + OFF_LAM))[48 + l] = 0u; }
  }
  float* sc = (float*)smem;
  float* red = sc + 5 * 1024;
  for (int i = tid; i < 5 * 1024; i += 256) { const int bb = i >> 10, k = i & 1023; const float v = bb < 4 ? p.c[bb * 1024 + k] : p.c_ctx[k]; sc[i] = v / (1.0f + __expf(-v)); }
  __syncthreads();
  float* modv = (float*)(ws + OFF_MODV);
  for (int t = get_bid(); t < DEPTH * 96; t += gridDim.x) {
    const int l = t / 96, cb = t % 96, kq = tid >> 6, cl = tid & 63, col = cb * 64 + cl;
    const float* w = p.w_mod + (size_t)l * D * 6144 + col;
    float s[5] = {0.f, 0.f, 0.f, 0.f, 0.f};
    for (int k = kq * 256; k < kq * 256 + 256; ++k) { const float wv = w[(size_t)k * 6144];
#pragma unroll
      for (int bb = 0; bb < 5; ++bb) s[bb] += sc[bb * 1024 + k] * wv; }
#pragma unroll
    for (int bb = 0; bb < 5; ++bb) red[(kq * 5 + bb) * 64 + cl] = s[bb];
    __syncthreads();
    for (int i = tid; i < 5 * 64; i += 256) { const int bb = i >> 6, c2 = i & 63; const float v = red[(0 * 5 + bb) * 64 + c2] + red[(1 * 5 + bb) * 64 + c2] + red[(2 * 5 + bb) * 64 + c2] + red[(3 * 5 + bb) * 64 + c2];
      modv[((size_t)l * 5 + bb) * 6144 + cb * 64 + c2] = v + p.b_mod[l * 6144 + cb * 64 + c2]; }
    __syncthreads();
  }
}

DI void norm_phase(const Params& p, int l, const float* gvec, int sh_off, int sc_off, int nrows, bool first = false) {
  const int tid = get_tid(), lane = tid & 63, wid = tid >> 6;
  const float* h = (const float*)(p.ws + OFF_H); bf16_t* out = (bf16_t*)(p.ws + OFF_ABUF);
  const float* modv = (const float*)(p.ws + OFF_MODV) + (size_t)l * 5 * 6144;
  for (int t = get_bid(); t < nrows / 4; t += gridDim.x) {
    const int row = t * 4 + wid; const int bb = row < NLAT ? row / SEQ : 4;
    const float* hr = first ? (row < NLAT ? p.x + (size_t)row * D : p.ctx + (size_t)(row - NLAT) * D) : h + (size_t)row * D; const float* mv = modv + bb * 6144;
    f32x4 v[4]; float ss = 0.f;
#pragma unroll
    for (int it = 0; it < 4; ++it) { v[it] = *(const f32x4*)(hr + it * 256 + lane * 4); ss += v[it][0] * v[it][0] + v[it][1] * v[it][1] + v[it][2] * v[it][2] + v[it][3] * v[it][3]; }
#pragma unroll
    for (int m = 1; m < 64; m <<= 1) ss += xshfl(ss, m);
    const float rstd = rsqrtf(ss * (1.0f / 1024.0f) + EPS);
#pragma unroll
    for (int it = 0; it < 4; ++it) { const int idx = it * 256 + lane * 4;
      const f32x4 g = *(const f32x4*)(gvec + idx), s1 = *(const f32x4*)(mv + sc_off + idx), s0 = *(const f32x4*)(mv + sh_off + idx);
      float y[4];
#pragma unroll
      for (int j = 0; j < 4; ++j) y[j] = v[it][j] * rstd * g[j] * (1.0f + s1[j]) + s0[j];
      u32x2 o; o[0] = pack2(y[0], y[1]); o[1] = pack2(y[2], y[3]); *(u32x2*)(out + (size_t)row * D + idx) = o; }
  }
}

DI void inproj_epilogue(const Params& p, int l, const f32x4 (&acc)[4][4], int m0, int n0) {
  unsigned char* ws = p.ws;
  const int tid = get_tid(), lane = tid & 63, wid = tid >> 6, wr = wid >> 1, wc = wid & 1, lr = lane & 15, lg = lane >> 4;
  const bool is_lat = m0 < NLAT;
  int b, i0; if (is_lat) { b = m0 / SEQ; i0 = m0 % SEQ; } else { const int c0 = m0 - NLAT; b = c0 / CTX; i0 = c0 % CTX; }
  const int pos0 = is_lat ? CTX + i0 : i0;
  const int hc = n0 + wc * 64;
  int seg;
  if (n0 < 512) seg = 0; else if (n0 < 1024) seg = 1; else if (n0 < 1536) seg = 2; else if (n0 < 2048) seg = 3; else if (n0 < 2560) seg = 4; else if (n0 < 2688) seg = 5; else if (n0 < 2816) seg = 6; else seg = 7;
  if (seg == 0 || seg == 1 || seg == 4 || seg == 5) {
    const float* gv; bf16_t* dst; float qs = 1.0f;
    if (seg == 0) { const int c = hc; gv = p.dq_g + l * 64; dst = (bf16_t*)(ws + OFF_QD) + ((size_t)((b * 2 + c / 256) * 4 + (c % 256) / 64) * POS) * 64; qs = 0.125f * LOG2E; }
    else if (seg == 1) { const int c = hc - 512; gv = p.dk_g + l * 64; dst = (bf16_t*)(ws + OFF_KD) + ((size_t)((b * 2 + c / 256) * 4 + (c % 256) / 64) * POS) * 64; }
    else if (seg == 4) { const int c = hc - 2048; gv = p.wq_g + l * 64; dst = (bf16_t*)(ws + OFF_QW) + ((size_t)(b * 8 + c / 64) * POS) * 64; qs = 0.125f * LOG2E; }
    else { const int c = hc - 2560; gv = p.wk_g + l * 64; dst = (bf16_t*)(ws + OFF_KW) + ((size_t)(b * 2 + c / 64) * POS) * 64; }
    const float* rope = (const float*)(ws + OFF_ROPE);
    f32x4 gq[4];
#pragma unroll
    for (int ni = 0; ni < 4; ++ni) gq[ni] = *(const f32x4*)(gv + ni * 16 + lg * 4);
#pragma unroll
    for (int mi = 0; mi < 4; ++mi) {
      const int r = wr * 64 + mi * 16 + lr;
      float ss = 0.f;
#pragma unroll
      for (int ni = 0; ni < 4; ++ni)
#pragma unroll
        for (int j = 0; j < 4; ++j) ss += acc[mi][ni][j] * acc[mi][ni][j];
      ss += xshfl(ss, 16); ss += xshfl(ss, 32);
      const float rstd = rsqrtf(ss * (1.0f / 64.0f) + EPS);
      f32x4 v[4];
#pragma unroll
      for (int ni = 0; ni < 4; ++ni) v[ni] = acc[mi][ni] * rstd * gq[ni];
      if (is_lat) {
        const int li = i0 + r, gr = li >> 6, gc = li & 63;
#pragma unroll
        for (int ni = 0; ni < 2; ++ni) {
          const int pi = ni == 0 ? gr : gc;
          const f32x4 cs = *(const f32x4*)(rope + pi * 16 + lg * 4), sn = *(const f32x4*)(rope + 1024 + pi * 16 + lg * 4);
          const f32x4 x1 = v[ni], x2 = v[ni + 2];
          v[ni] = x1 * cs - x2 * sn; v[ni + 2] = x2 * cs + x1 * sn;
        }
      }
      bf16_t* drow = dst + (size_t)(pos0 + r) * 64 + lg * 4;
#pragma unroll
      for (int ni = 0; ni < 4; ++ni) { u32x2 o; o[0] = pack2(v[ni][0] * qs, v[ni][1] * qs); o[1] = pack2(v[ni][2] * qs, v[ni][3] * qs); *(u32x2*)(drow + ni * 16) = o; }
    }
  } else if (seg == 2 || seg == 6) {
#pragma unroll
    for (int mi = 0; mi < 4; ++mi) {
      const int pos = pos0 + wr * 64 + mi * 16 + lr;
#pragma unroll
      for (int ni = 0; ni < 4; ++ni)
#pragma unroll
        for (int j = 0; j < 4; ++j) {
          const int col = hc + ni * 16 + lg * 4 + j; bf16_t* dst;
          if (seg == 2) { const int c = col - 1024; dst = (bf16_t*)(ws + OFF_VDT) + ((size_t)(b * 4 + c / 128) * 128 + (c % 128)) * POS + pos; }
          else { const int c = col - 2688; dst = (bf16_t*)(ws + OFF_VWT) + ((size_t)(b * 2 + c / 64) * 64 + (c % 64)) * POS + pos; }
          *dst = (bf16_t)(pack2(acc[mi][ni][j], 0.f) & 0xffffu);
        }
    }
  } else if (seg == 3) {
    bf16_t* su = (bf16_t*)(ws + OFF_SU);
#pragma unroll
    for (int mi = 0; mi < 4; ++mi) { const int pos = pos0 + wr * 64 + mi * 16 + lr;
#pragma unroll
      for (int ni = 0; ni < 4; ++ni) { u32x2 o; o[0] = pack2(acc[mi][ni][0], acc[mi][ni][1]); o[1] = pack2(acc[mi][ni][2], acc[mi][ni][3]);
        *(u32x2*)(su + ((size_t)(b * 32 + (hc - 1536) / 16 + ni) * POS + pos) * 16 + lg * 4) = o; } }
  } else {
    bf16_t* gt = (bf16_t*)(ws + OFF_GATES);
#pragma unroll
    for (int mi = 0; mi < 4; ++mi) { const int row = m0 + wr * 64 + mi * 16 + lr;
#pragma unroll
      for (int ni = 0; ni < 4; ++ni) { u32x2 o; o[0] = pack2(sigmoidf_(acc[mi][ni][0]), sigmoidf_(acc[mi][ni][1])); o[1] = pack2(sigmoidf_(acc[mi][ni][2]), sigmoidf_(acc[mi][ni][3]));
        *(u32x2*)(gt + (size_t)row * 3072 + (hc - 2816) + ni * 16 + lg * 4) = o; } }
  }
}
DI void inproj_phase(const Params& p, int l, unsigned char* smem) {
  bf16_t* As = (bf16_t*)smem; bf16_t* Bs = As + 128 * LDT;
  const bf16_t* A = (const bf16_t*)(p.ws + OFF_ABUF); const bf16_t* W = (const bf16_t*)(p.ws + OFF_W_IN);
  constexpr int NT = DIN / 128, MT = NTOK / 128;
  for (int t = get_bid(); t < MT * NT; t += gridDim.x) {
    const int mt = t / NT, nt = t % NT;
    f32x4 acc[4][4]; zero_acc(acc);
    gemm_mainloop(acc, A + (size_t)mt * 128 * D, D, W + (size_t)nt * 128 * D, D, D, As, Bs);
    inproj_epilogue(p, l, acc, mt * 128, nt * 128);
  }
}

constexpr int NW = 4;
constexpr int NTHR = NW * 64;
constexpr int QU = NW * 32;
template <int DV, bool TWOK>
DI void attn_core_d1(f32x4 (&O)[2][DV / 16], float (&lsum)[2], const bf16x8 (&Qf)[2][2], float negm,
                  const bf16_t* __restrict__ Kp0, const bf16_t* __restrict__ Kp1, const bf16_t* __restrict__ Vt, int t0, int t1, int tm0, int tm1, int qlat0, unsigned char* smem) {
  constexpr int KB = TWOK ? 16384 : 8192, BUFB = KB + DV * 128;
  constexpr int NKL = (TWOK ? 16 : 8) / NW, NVL = DV / 8 / NW;
  const int tid = get_tid(), lane = tid & 63, wid = __builtin_amdgcn_readfirstlane(tid >> 6), lr = lane & 15, lg = lane >> 4;
  const int rl = lane >> 3, lc = (lane & 7) ^ rl;
  const int n0 = t1 - t0, ntl = n0 + (tm1 - tm0);
  u32x4 rk[NKL], rv[NVL];
#define ATTN_GLOAD(KEY0) do { const int key0_ = (KEY0); \
    _Pragma("unroll") for (int i = 0; i < NKL; ++i) { const int L = wid + i * NW; const bf16_t* kp_ = (i * NW >= 8) ? Kp1 : Kp0; rk[i] = *(const u32x4*)(kp_ + (size_t)(key0_ + (L & 7) * 8 + rl) * 64 + (((lane & 7) ^ ((((L & 3) * 2) + (rl >> 1)) & 7)) * 8)); } \
    _Pragma("unroll") for (int i = 0; i < NVL; ++i) { const int L = wid + i * NW; rv[i] = *(const u32x4*)(Vt + (size_t)(L * 8 + rl) * POS + key0_ + lc * 8); } } while (0)
#define ATTN_LSTORE(BUF) do { unsigned char* buf_ = (BUF); \
    _Pragma("unroll") for (int i = 0; i < NKL; ++i) *(u32x4*)(buf_ + (wid + i * NW) * 1024 + lane * 16) = rk[i]; \
    _Pragma("unroll") for (int i = 0; i < NVL; ++i) *(u32x4*)(buf_ + KB + (wid + i * NW) * 1024 + lane * 16) = rv[i]; } while (0)
  ATTN_GLOAD((n0 > 0 ? t0 : tm0) * 64);
  __syncthreads();
  ATTN_LSTORE(smem);
  const int sw = lr & 7;
  for (int it = 0; it < ntl; ++it) {
    const bool masked = it >= n0;
    const int key0 = (masked ? tm0 + (it - n0) : t0 + it) * 64;
    const unsigned char* Kb = smem + (it & 1) * BUFB; const unsigned char* Vb = Kb + KB;
    __syncthreads();
    if (it + 1 < ntl) ATTN_GLOAD(((it + 1) >= n0 ? tm0 + (it + 1 - n0) : t0 + it + 1) * 64);
    f32x4 s[4][2];
#pragma unroll
    for (int kt = 0; kt < 4; ++kt) {
      const unsigned char* kr = Kb + ((kt >> 1) * 32 + (lr >> 2) * 8 + (kt & 1) * 4 + (lr & 3)) * 128; const int kkey = ((lr >> 2) * 2 + (kt & 1) * 2 + ((lr & 3) >> 1)) & 7;
      if (!TWOK) {
        const bf16x8 k0f = *(const bf16x8*)(kr + ((lg ^ kkey) << 4)), k1f = *(const bf16x8*)(kr + (((4 + lg) ^ kkey) << 4));
#pragma unroll
        for (int qt = 0; qt < 2; ++qt) { f32x4 z = {negm, negm, negm, negm}; z = MFMA16(k0f, Qf[qt][0], z); s[kt][qt] = MFMA16(k1f, Qf[qt][1], z); }
      } else {
#pragma unroll
        for (int qt = 0; qt < 2; ++qt) {
          const bf16x8 k0f = *(const bf16x8*)(kr + qt * 8192 + ((lg ^ kkey) << 4)), k1f = *(const bf16x8*)(kr + qt * 8192 + (((4 + lg) ^ kkey) << 4));
          f32x4 z = {negm, negm, negm, negm}; z = MFMA16(k0f, Qf[qt][0], z); s[kt][qt] = MFMA16(k1f, Qf[qt][1], z); }
      }
    }
    if (masked) {
#pragma unroll
      for (int kt = 0; kt < 4; ++kt)
#pragma unroll
        for (int qt = 0; qt < 2; ++qt)
#pragma unroll
          for (int j = 0; j < 4; ++j) { const int kl = key0 - CTX + (kt >> 1) * 32 + lg * 8 + (kt & 1) * 4 + j, ql = qlat0 + qt * 16 + lr; const int rel = kl - ql; if (rel > 128 || rel < -128) s[kt][qt][j] = -INFINITY; }
    }
    bf16x8 pf[2][2];
#pragma unroll
    for (int qt = 0; qt < 2; ++qt) {
      float rs = 0.f;
#pragma unroll
      for (int kt = 0; kt < 4; ++kt)
#pragma unroll
        for (int j = 0; j < 4; ++j) { const float e = __builtin_amdgcn_exp2f(s[kt][qt][j]); s[kt][qt][j] = e; rs += e; }
      lsum[qt] += rs;
#pragma unroll
      for (int kk = 0; kk < 2; ++kk) {
        u32x4 w; w[0] = pack2(s[2 * kk][qt][0], s[2 * kk][qt][1]); w[1] = pack2(s[2 * kk][qt][2], s[2 * kk][qt][3]);
        w[2] = pack2(s[2 * kk + 1][qt][0], s[2 * kk + 1][qt][1]); w[3] = pack2(s[2 * kk + 1][qt][2], s[2 * kk + 1][qt][3]);
        pf[qt][kk] = __builtin_bit_cast(bf16x8, w);
      }
    }
#pragma unroll
    for (int et = 0; et < DV / 16; ++et)
#pragma unroll
      for (int kk = 0; kk < 2; ++kk) {
        const bf16x8 vf = *(const bf16x8*)(Vb + (et * 16 + lr) * 128 + (((kk * 4 + lg) ^ sw) << 4));
        O[0][et] = MFMA16(vf, pf[0][kk], O[0][et]);
        O[1][et] = MFMA16(vf, pf[1][kk], O[1][et]);
      }
    if (it + 1 < ntl) ATTN_LSTORE(smem + ((it + 1) & 1) * BUFB);
  }
#undef ATTN_GLOAD
#undef ATTN_LSTORE
}

#define VM_WAIT4(N, R, Q) asm volatile("s_waitcnt vmcnt(" #N ")" : "+v"(R[0]), "+v"(R[1]), "+v"(Q[0]), "+v"(Q[1]) :: "memory")
template <int DV, bool TWOK>
DI void attn_core(f32x4 (&O)[2][DV / 16], float (&lsum)[2], const bf16x8 (&Qf)[2][2], float negm,
                  const bf16_t* __restrict__ Kp0, const bf16_t* __restrict__ Kp1, const bf16_t* __restrict__ Vt, int t0, int t1, int tm0, int tm1, int qlat0, unsigned char* smem) {
  constexpr int KB = TWOK ? 16384 : 8192, BUFB = KB + DV * 128;
  constexpr int NKL = (TWOK ? 16 : 8) / NW, NVL = DV / 8 / NW;
  static_assert((NKL == 4 && NVL == 4) || (NKL == 2 && NVL == 2), "wait macros are written for 8 or 4 loads per set");
  const int tid = get_tid(), lane = tid & 63, wid = __builtin_amdgcn_readfirstlane(tid >> 6), lr = lane & 15, lg = lane >> 4;
  const int rl = lane >> 3, lc = (lane & 7) ^ rl;
  const int n0 = t1 - t0, ntl = n0 + (tm1 - tm0);
  u32x4 rk0[NKL], rv0[NVL], rk1[NKL], rv1[NVL];
#define ATTN_TILE(I) ({ int i_ = (I); i_ = i_ < ntl ? i_ : ntl - 1; (i_ < n0 ? t0 + i_ : tm0 + (i_ - n0)) * 64; })
#define ATTN_GLOAD(RK, RV, KEY0) do { const int key0_ = (KEY0); \
    _Pragma("unroll") for (int i = 0; i < NKL; ++i) { const int L = wid + i * NW; const bf16_t* kp_ = (i * NW >= 8) ? Kp1 : Kp0; RK[i] = gload_async(kp_ + (size_t)(key0_ + (L & 7) * 8 + rl) * 64 + (((lane & 7) ^ ((((L & 3) * 2) + (rl >> 1)) & 7)) * 8)); } \
    _Pragma("unroll") for (int i = 0; i < NVL; ++i) { const int L = wid + i * NW; RV[i] = gload_async(Vt + (size_t)(L * 8 + rl) * POS + key0_ + lc * 8); } } while (0)
#define ATTN_LSTORE(RK, RV, BUF) do { unsigned char* buf_ = (BUF); \
    _Pragma("unroll") for (int i = 0; i < NKL; ++i) *(u32x4*)(buf_ + (wid + i * NW) * 1024 + lane * 16) = RK[i]; \
    _Pragma("unroll") for (int i = 0; i < NVL; ++i) *(u32x4*)(buf_ + KB + (wid + i * NW) * 1024 + lane * 16) = RV[i]; } while (0)
#define ATTN_WAIT(RK, RV) do { if constexpr (NKL == 4) VM_WAIT8(8, RK, RV); else VM_WAIT4(4, RK, RV); } while (0)
#define ATTN_DRAIN(RK, RV) do { if constexpr (NKL == 4) VM_WAIT8(0, RK, RV); else VM_WAIT4(0, RK, RV); } while (0)
  const int sw = lr & 7;
#define ATTN_COMPUTE(IT, BUFP) do { const int it_ = (IT); const bool masked = it_ >= n0; const int key0 = (masked ? tm0 + (it_ - n0) : t0 + it_) * 64; \
    const unsigned char* Kb = (BUFP); const unsigned char* Vb = Kb + KB; \
    bf16x8 pf[2][2]; \
    _Pragma("unroll") for (int qt = 0; qt < 2; ++qt) { f32x4 s4[4]; \
      _Pragma("unroll") for (int kt = 0; kt < 4; ++kt) { const unsigned char* kq = Kb + ((kt >> 1) * 32 + (lr >> 2) * 8 + (kt & 1) * 4 + (lr & 3)) * 128 + (TWOK ? qt * 8192 : 0); const int kkey = ((lr >> 2) * 2 + (kt & 1) * 2 + ((lr & 3) >> 1)) & 7; \
        const bf16x8 k0f = *(const bf16x8*)(kq + ((lg ^ kkey) << 4)), k1f = *(const bf16x8*)(kq + (((4 + lg) ^ kkey) << 4)); \
        f32x4 z = {negm, negm, negm, negm}; z = MFMA16(k0f, Qf[qt][0], z); s4[kt] = MFMA16(k1f, Qf[qt][1], z); } \
      if (masked) { \
        _Pragma("unroll") for (int kt = 0; kt < 4; ++kt) _Pragma("unroll") for (int j = 0; j < 4; ++j) { \
          const int kl = key0 - CTX + (kt >> 1) * 32 + lg * 8 + (kt & 1) * 4 + j, ql = qlat0 + qt * 16 + lr; const int rel = kl - ql; if (rel > 128 || rel < -128) s4[kt][j] = -INFINITY; } } \
      float rs = 0.f; \
      _Pragma("unroll") for (int kt = 0; kt < 4; ++kt) _Pragma("unroll") for (int j = 0; j < 4; ++j) { const float e = __builtin_amdgcn_exp2f(s4[kt][j]); s4[kt][j] = e; rs += e; } \
      lsum[qt] += rs; \
      _Pragma("unroll") for (int kk = 0; kk < 2; ++kk) { u32x4 w; w[0] = pack2(s4[2 * kk][0], s4[2 * kk][1]); w[1] = pack2(s4[2 * kk][2], s4[2 * kk][3]); \
        w[2] = pack2(s4[2 * kk + 1][0], s4[2 * kk + 1][1]); w[3] = pack2(s4[2 * kk + 1][2], s4[2 * kk + 1][3]); pf[qt][kk] = __builtin_bit_cast(bf16x8, w); } } \
    _Pragma("unroll") for (int et = 0; et < DV / 16; ++et) _Pragma("unroll") for (int kk = 0; kk < 2; ++kk) { \
        const bf16x8 vf = *(const bf16x8*)(Vb + (et * 16 + lr) * 128 + (((kk * 4 + lg) ^ sw) << 4)); \
        O[0][et] = MFMA16(vf, pf[0][kk], O[0][et]); O[1][et] = MFMA16(vf, pf[1][kk], O[1][et]); } } while (0)
  asm volatile("s_waitcnt vmcnt(0)" ::: "memory");
  ATTN_GLOAD(rk0, rv0, ATTN_TILE(0)); ATTN_GLOAD(rk1, rv1, ATTN_TILE(1));
  __syncthreads();
  ATTN_WAIT(rk0, rv0); ATTN_LSTORE(rk0, rv0, smem); ATTN_GLOAD(rk0, rv0, ATTN_TILE(2));
  for (int it = 0; it < ntl; it += 2) {
    __syncthreads();
    ATTN_COMPUTE(it, smem);
    ATTN_WAIT(rk1, rv1); ATTN_LSTORE(rk1, rv1, smem + BUFB); ATTN_GLOAD(rk1, rv1, ATTN_TILE(it + 3));
    __syncthreads();
    ATTN_COMPUTE(it + 1, smem + BUFB);
    ATTN_WAIT(rk0, rv0); ATTN_LSTORE(rk0, rv0, smem); ATTN_GLOAD(rk0, rv0, ATTN_TILE(it + 4));
  }
  ATTN_DRAIN(rk0, rv0); ATTN_DRAIN(rk1, rv1);
#undef ATTN_TILE
#undef ATTN_GLOAD
#undef ATTN_LSTORE
#undef ATTN_WAIT
#undef ATTN_DRAIN
#undef ATTN_COMPUTE
}

constexpr int QUD = NW * 16;
DI void diff_unit(const Params& p, int l, int b, int hd, bool is_lat, int qi, unsigned char* smem) {
  unsigned char* ws = p.ws;
  const int tid = get_tid(), lane = tid & 63, wid = __builtin_amdgcn_readfirstlane(tid >> 6), lr = lane & 15, lg = lane >> 4;
  const int qpos0 = (is_lat ? CTX + qi * QUD : qi * QUD) + wid * 16;
  const int ntile = is_lat ? POS / 64 : CTX / 64;
  const float lam = ((const float*)(ws + OFF_LAM))[l];
  const float negm = -((const float*)(ws + OFF_LAM))[4 + l];
  const float lam_init = 0.8f - 0.6f * expf(-0.3f * (float)l);
  const size_t hoff0 = (size_t)((b * 2 + 0) * 4 + hd) * POS * 64, hoff1 = (size_t)((b * 2 + 1) * 4 + hd) * POS * 64;
  const bf16_t* Qd = (const bf16_t*)(ws + OFF_QD); const bf16_t* Kd = (const bf16_t*)(ws + OFF_KD);
  bf16x8 Qf[2][2];
#pragma unroll
  for (int ks = 0; ks < 2; ++ks) { Qf[0][ks] = *(const bf16x8*)(Qd + hoff0 + (size_t)(qpos0 + lr) * 64 + ks * 32 + lg * 8); Qf[1][ks] = *(const bf16x8*)(Qd + hoff1 + (size_t)(qpos0 + lr) * 64 + ks * 32 + lg * 8); }
  float lsum[2] = {0.f, 0.f};
  f32x4 O[2][8];
#pragma unroll
  for (int m = 0; m < 2; ++m)
#pragma unroll
    for (int et = 0; et < 8; ++et) O[m][et] = (f32x4){0.f, 0.f, 0.f, 0.f};
  attn_core_d1<128, true>(O, lsum, Qf, negm, Kd + hoff0, Kd + hoff1, (const bf16_t*)(ws + OFF_VDT) + (size_t)(b * 4 + hd) * 128 * POS, 0, ntile, 0, 0, 0, smem);
  float l0 = lsum[0], l1 = lsum[1];
  l0 += xshfl(l0, 16); l0 += xshfl(l0, 32); l1 += xshfl(l1, 16); l1 += xshfl(l1, 32);
  const float i0 = 1.0f / l0, i1 = lam / l1;
  float ss = 0.f;
#pragma unroll
  for (int et = 0; et < 8; ++et) { O[0][et] = O[0][et] * i0 - O[1][et] * i1;
#pragma unroll
    for (int j = 0; j < 4; ++j) ss += O[0][et][j] * O[0][et][j]; }
  ss += xshfl(ss, 16); ss += xshfl(ss, 32);
  const float rs = rsqrtf(ss * (1.0f / 128.0f) + EPS) * (1.0f - lam_init);
  const float* og = p.dout_g + l * 128; bf16_t* yd = (bf16_t*)(ws + OFF_YD);
  const int qpos = qpos0 + lr;
  const int row = is_lat ? b * SEQ + (qpos - CTX) : NLAT + b * CTX + qpos;
#pragma unroll
  for (int et = 0; et < 8; ++et) { const f32x4 g = *(const f32x4*)(og + et * 16 + lg * 4); const f32x4 y = O[0][et] * rs * g;
    u32x2 o; o[0] = pack2(y[0], y[1]); o[1] = pack2(y[2], y[3]); *(u32x2*)(yd + (size_t)row * 512 + hd * 128 + et * 16 + lg * 4) = o; }
}

DI void win_unit(const Params& p, int l, int b, int qh, bool is_lat, int qi, unsigned char* smem) {
  unsigned char* ws = p.ws;
  const int tid = get_tid(), lane = tid & 63, wid = __builtin_amdgcn_readfirstlane(tid >> 6), lr = lane & 15, lg = lane >> 4;
  const int qpos0 = (is_lat ? CTX + qi * QU : qi * QU) + wid * 32;
  const int kv = qh >> 2;
  const bf16_t* Qp = (const bf16_t*)(ws + OFF_QW) + ((size_t)(b * 8 + qh) * POS + qpos0) * 64;
  bf16x8 Qf[2][2];
#pragma unroll
  for (int qt = 0; qt < 2; ++qt)
#pragma unroll
    for (int ks = 0; ks < 2; ++ks) Qf[qt][ks] = *(const bf16x8*)(Qp + (qt * 16 + lr) * 64 + ks * 32 + lg * 8);
  const float sk = p.w_sink[l * 8 + qh] * LOG2E;
  const float mfix = fmaxf(((const float*)(ws + OFF_LAM))[8 + l], sk);
  const float l0 = lg == 0 ? __builtin_amdgcn_exp2f(sk - mfix) : 0.f;
  float lsum[2] = {l0, l0};
  f32x4 O[2][4];
#pragma unroll
  for (int qt = 0; qt < 2; ++qt)
#pragma unroll
    for (int et = 0; et < 4; ++et) O[qt][et] = (f32x4){0.f, 0.f, 0.f, 0.f};
  int tm0 = 0, tm1 = 0;
  if (is_lat) { const int q0 = qi * QU; tm0 = (q0 + 128) / 64; if (tm0 < 4) tm0 = 4; tm1 = (q0 + QU + 384) / 64; if (tm1 > POS / 64) tm1 = POS / 64; }
  attn_core<64, false>(O, lsum, Qf, -mfix, (const bf16_t*)(ws + OFF_KW) + (size_t)(b * 2 + kv) * POS * 64, nullptr, (const bf16_t*)(ws + OFF_VWT) + (size_t)(b * 2 + kv) * 64 * POS, 0, 4, tm0, tm1, qpos0 - CTX, smem);
  bf16_t* yw = (bf16_t*)(ws + OFF_YW);
#pragma unroll
  for (int qt = 0; qt < 2; ++qt) {
    float ls = lsum[qt]; ls += xshfl(ls, 16); ls += xshfl(ls, 32);
    const float inv = 1.0f / ls;
    const int qpos = qpos0 + qt * 16 + lr;
    const int row = is_lat ? b * SEQ + (qpos - CTX) : NLAT + b * CTX + qpos;
#pragma unroll
    for (int et = 0; et < 4; ++et) { const f32x4 y = O[qt][et] * inv; u32x2 o; o[0] = pack2(y[0], y[1]); o[1] = pack2(y[2], y[3]);
      *(u32x2*)(yw + (size_t)row * 512 + qh * 64 + et * 16 + lg * 4) = o; }
  }
}

constexpr int NR = NW / 2, CR = NCH / NR;
constexpr int BST = 20, SST = 136;
constexpr int S5_WAVE_LDS = 128 * BST * 4 + 16 * SST * 2;
constexpr int EB_PER_UNIT = 2 * (NCH + 8) * 64 * 2;
DI int s5_row(int b, int k, int t) { return k < 8 ? NLAT + b * CTX + k * 32 + t : b * SEQ + (k - 8) * 32 + t; }
DI int s5_cmap(int d, int k) { return d == 0 ? k : (k < 8 ? 7 - k : 143 - k); }
DI void s5_make_bf(const Params& p, int l, int d, int g, float fre, float fim, bf16x8 (&Bf)[8], int lr, int lg) {
#pragma unroll
  for (int q = 0; q < 8; ++q) {
    const int pp = 16 * (q & 3) + lr;
    const float fr = __shfl(fre, pp, 64), fi = __shfl(fim, pp, 64);
    u32x4 w = {0u, 0u, 0u, 0u};
    if (lg < 2) {
      const size_t bo = ((size_t)((l * 2 + d) * 32 + g) * 64 + pp) * 16 + lg * 8;
      const f32x4 br0 = *(const f32x4*)(p.s5_bre + bo), br1 = *(const f32x4*)(p.s5_bre + bo + 4), bi0 = *(const f32x4*)(p.s5_bim + bo), bi1 = *(const f32x4*)(p.s5_bim + bo + 4);
      f32x4 v0, v1;
      if (q < 4) { v0 = fr * br0 - fi * bi0; v1 = fr * br1 - fi * bi1; } else { v0 = fr * bi0 + fi * br0; v1 = fr * bi1 + fi * br1; }
      w[0] = pack2(v0[0], v0[1]); w[1] = pack2(v0[2], v0[3]); w[2] = pack2(v1[0], v1[1]); w[3] = pack2(v1[2], v1[3]);
    }
    Bf[q] = __builtin_bit_cast(bf16x8, w);
  }
}
DI u32x4 s5_load_uf(const bf16_t* sug, int k, int tt, int lr, int lg) { u32x4 uw = {0u, 0u, 0u, 0u}; if (lg < 2) uw = *(const u32x4*)(sug + (size_t)(k * 32 + tt * 16 + lr) * 16 + lg * 8); return uw; }
DI void s5_bu_tile(u32x4 uw, const bf16x8 (&Bf)[8], float* Bsm, int lr, int lg) {
  const bf16x8 uf = __builtin_bit_cast(bf16x8, uw);
#pragma unroll
  for (int q = 0; q < 8; ++q) { f32x4 z = {0.f, 0.f, 0.f, 0.f}; z = MFMA16(Bf[q], uf, z);
#pragma unroll
    for (int jj = 0; jj < 4; ++jj) Bsm[(q * 16 + lg * 4 + jj) * BST + lr] = z[jj]; }
}
#define S5_SCAN(D, AR, AI, WRITE) do { \
    _Pragma("unroll") for (int hb = 0; hb < 2; ++hb) { const int cb = ((D) ? 1 - hb : hb) * 2;     \
      const f32x4 br0_ = *(const f32x4*)(Bsm + lane * BST + cb * 4), br1_ = *(const f32x4*)(Bsm + lane * BST + cb * 4 + 4); \
      const f32x4 bi0_ = *(const f32x4*)(Bsm + (64 + lane) * BST + cb * 4), bi1_ = *(const f32x4*)(Bsm + (64 + lane) * BST + cb * 4 + 4); \
      _Pragma("unroll") for (int st = 0; st < 8; ++st) { const int t8 = (D) ? 7 - st : st; const int tl = cb * 4 + t8; \
        const float br = t8 < 4 ? br0_[t8 & 3] : br1_[t8 & 3], bi = t8 < 4 ? bi0_[t8 & 3] : bi1_[t8 & 3]; \
        const float nr = (AR) * sr - (AI) * si + br, ni = (AR) * si + (AI) * sr + bi; sr = nr; si = ni; \
        if (WRITE) { const unsigned pk = pack2(sr, si); Ssm[tl * SST + lane] = (bf16_t)(pk & 0xffffu); Ssm[tl * SST + 64 + lane] = (bf16_t)(pk >> 16); } } } } while (0)
DI void s5_unit(const Params& p, int l, int b, int g, unsigned char* smem) {
  unsigned char* ws = p.ws;
  const int tid = get_tid(), lane = tid & 63, wid = __builtin_amdgcn_readfirstlane(tid >> 6), lr = lane & 15, lg = lane >> 4;
  float* Bsm = (float*)(smem + wid * S5_WAVE_LDS);
  bf16_t* Ssm = (bf16_t*)(smem + wid * S5_WAVE_LDS + 128 * BST * 4);
  const bf16_t* sug = (const bf16_t*)(ws + OFF_SU) + (size_t)(b * 32 + g) * POS * 16;
  float* Eb = (float*)(ws + OFF_EB) + (size_t)(b * 32 + g) * EB_PER_UNIT;
  float are[2], aim[2], fre[2], fim[2];
#pragma unroll
  for (int d = 0; d < 2; ++d) {
    const int pi = ((l * 2 + d) * 32 + g) * 64 + lane;
    const float lre = p.s5_lre[pi], lim = p.s5_lim[pi], dt = expf(p.s5_ldt[(l * 2 + d) * 32 + g]);
    const float mag = expf(lre * dt), ang = lim * dt;
    are[d] = mag * cosf(ang); aim[d] = mag * sinf(ang);
    const float den = lre * lre + lim * lim, nre = are[d] - 1.0f;
    fre[d] = (nre * lre + aim[d] * lim) / den; fim[d] = (aim[d] * lre - nre * lim) / den;
  }
  bf16x8 Bf[2][8];
  s5_make_bf(p, l, 0, g, fre[0], fim[0], Bf[0], lr, lg);
  s5_make_bf(p, l, 1, g, fre[1], fim[1], Bf[1], lr, lg);
  {
    const int d = wid & 1, r = wid >> 1;
    const float ar = d ? are[1] : are[0], ai = d ? aim[1] : aim[0];
    float sr = 0.f, si = 0.f;
    for (int ci = 0; ci < CR; ++ci) {
      const int c = r * CR + ci, k = s5_cmap(d, c);
      { float* e_ = Eb + ((size_t)(d * (NCH + 8) + c) * 64 + lane) * 2; __hip_atomic_store(e_, sr, __ATOMIC_RELAXED, __HIP_MEMORY_SCOPE_AGENT); __hip_atomic_store(e_ + 1, si, __ATOMIC_RELAXED, __HIP_MEMORY_SCOPE_AGENT); }
      const u32x4 ua = s5_load_uf(sug, k, d ? 1 : 0, lr, lg), ub = s5_load_uf(sug, k, d ? 0 : 1, lr, lg);
#pragma unroll
      for (int hh = 0; hh < 2; ++hh) {
        const u32x4 uw = hh ? ub : ua;
        __builtin_amdgcn_wave_barrier();
        if (d) s5_bu_tile(uw, Bf[1], Bsm, lr, lg); else s5_bu_tile(uw, Bf[0], Bsm, lr, lg);
        __builtin_amdgcn_wave_barrier();
        if (d) S5_SCAN(1, ar, ai, false); else S5_SCAN(0, ar, ai, false);
      }
    }
    { float* e_ = Eb + ((size_t)(d * (NCH + 8) + NCH + r) * 64 + lane) * 2; __hip_atomic_store(e_, sr, __ATOMIC_RELAXED, __HIP_MEMORY_SCOPE_AGENT); __hip_atomic_store(e_ + 1, si, __ATOMIC_RELAXED, __HIP_MEMORY_SCOPE_AGENT); }
  }
  asm volatile("s_waitcnt vmcnt(0)" ::: "memory"); __syncthreads();
  bf16x8 Cf[2][4];
  float a32r[2], a32i[2], aCRr[2], aCRi[2];
#pragma unroll
  for (int d = 0; d < 2; ++d) {
#pragma unroll
    for (int ks = 0; ks < 4; ++ks) {
      const float* src = (ks < 2 ? p.s5_cre : p.s5_cim) + ((size_t)((l * 2 + d) * 32 + g) * 16 + lr) * 64 + (ks & 1) * 32 + lg * 8;
      const f32x4 v0 = *(const f32x4*)src, v1 = *(const f32x4*)(src + 4); const float sg = ks < 2 ? 1.0f : -1.0f;
      u32x4 w; w[0] = pack2(sg * v0[0], sg * v0[1]); w[1] = pack2(sg * v0[2], sg * v0[3]); w[2] = pack2(sg * v1[0], sg * v1[1]); w[3] = pack2(sg * v1[2], sg * v1[3]);
      Cf[d][ks] = __builtin_bit_cast(bf16x8, w);
    }
    float pr = are[d], pi_ = aim[d];
#pragma unroll
    for (int q = 0; q < 5; ++q) { const float nr = pr * pr - pi_ * pi_, ni = 2.0f * pr * pi_; pr = nr; pi_ = ni; }
    a32r[d] = pr; a32i[d] = pi_;
    float rr = 1.f, ri = 0.f, br_ = pr, bi_ = pi_;
#pragma unroll
    for (int bit = 0; bit < 7; ++bit) { if ((CR >> bit) & 1) { const float nr = rr * br_ - ri * bi_, ni = rr * bi_ + ri * br_; rr = nr; ri = ni; } const float nr = br_ * br_ - bi_ * bi_, ni = 2.0f * br_ * bi_; br_ = nr; bi_ = ni; }
    aCRr[d] = rr; aCRi[d] = ri;
  }
  const f32x4 dsk = *(const f32x4*)(p.s5_d + l * 512 + g * 16 + lg * 4);
  bf16_t* gb = (bf16_t*)(ws + OFF_GB);
  for (int k = wid; k < NCH; k += NW) {
    f32x4 acc[2] = {{0.f, 0.f, 0.f, 0.f}, {0.f, 0.f, 0.f, 0.f}};
    u32x4 uq[2]; uq[0] = s5_load_uf(sug, k, 0, lr, lg); uq[1] = s5_load_uf(sug, k, 1, lr, lg);
    u32x2 us[2]; us[0] = *(const u32x2*)(sug + (size_t)(k * 32 + lr) * 16 + lg * 4); us[1] = *(const u32x2*)(sug + (size_t)(k * 32 + 16 + lr) * 16 + lg * 4);
    float s0[2][2];
#pragma unroll
    for (int d = 0; d < 2; ++d) { const float* e_ = Eb + ((size_t)(d * (NCH + 8) + s5_cmap(d, k)) * 64 + lane) * 2;
      s0[d][0] = __hip_atomic_load(e_, __ATOMIC_RELAXED, __HIP_MEMORY_SCOPE_AGENT); s0[d][1] = __hip_atomic_load(e_ + 1, __ATOMIC_RELAXED, __HIP_MEMORY_SCOPE_AGENT); }
#pragma unroll
    for (int d = 0; d < 2; ++d) {
      const int c = s5_cmap(d, k), r = c / CR, j = c - r * CR;
      const float* Ed = Eb + (size_t)d * (NCH + 8) * 128 + lane * 2;
      float tr = 0.f, ti = 0.f;
#pragma unroll
      for (int r2 = 0; r2 < NR - 1; ++r2) if (r2 < r) {
        const float er = __hip_atomic_load(Ed + (size_t)(NCH + r2) * 128, __ATOMIC_RELAXED, __HIP_MEMORY_SCOPE_AGENT), ei = __hip_atomic_load(Ed + (size_t)(NCH + r2) * 128 + 1, __ATOMIC_RELAXED, __HIP_MEMORY_SCOPE_AGENT);
        const float nr = aCRr[d] * tr - aCRi[d] * ti + er, ni = aCRr[d] * ti + aCRi[d] * tr + ei; tr = nr; ti = ni; }
      float pr = 1.f, pi_ = 0.f, br_ = a32r[d], bi_ = a32i[d];
      for (int bit = 0; bit < 7; ++bit) { if ((j >> bit) & 1) { const float nr = pr * br_ - pi_ * bi_, ni = pr * bi_ + pi_ * br_; pr = nr; pi_ = ni; } const float nr = br_ * br_ - bi_ * bi_, ni = 2.0f * br_ * bi_; br_ = nr; bi_ = ni; }
      float sr = s0[d][0] + (pr * tr - pi_ * ti), si = s0[d][1] + (pr * ti + pi_ * tr);
#pragma unroll
      for (int hh = 0; hh < 2; ++hh) {
        const int tt = d ? 1 - hh : hh;
        __builtin_amdgcn_wave_barrier();
        s5_bu_tile(uq[tt], Bf[d], Bsm, lr, lg);
        __builtin_amdgcn_wave_barrier();
        if (d) S5_SCAN(1, are[1], aim[1], true); else S5_SCAN(0, are[0], aim[0], true);
        __builtin_amdgcn_wave_barrier();
#pragma unroll
        for (int ks = 0; ks < 4; ++ks) { const bf16x8 sf = *(const bf16x8*)(Ssm + lr * SST + ks * 32 + lg * 8); acc[tt] = MFMA16(Cf[d][ks], sf, acc[tt]); }
      }
    }
#pragma unroll
    for (int tt = 0; tt < 2; ++tt) { const int row = s5_row(b, k, tt * 16 + lr);
      f32x4 u; u[0] = __uint_as_float(us[tt][0] << 16); u[1] = __uint_as_float(us[tt][0] & 0xffff0000u); u[2] = __uint_as_float(us[tt][1] << 16); u[3] = __uint_as_float(us[tt][1] & 0xffff0000u);
      float y[4];
#pragma unroll
      for (int j = 0; j < 4; ++j) y[j] = gelu_tanh(acc[tt][j] + u[j] * dsk[j]);
      u32x2 o; o[0] = pack2(y[0], y[1]); o[1] = pack2(y[2], y[3]); *(u32x2*)(gb + (size_t)row * 512 + g * 16 + lg * 4) = o; }
  }
}

DI void mixer_phase(const Params& p, int l, unsigned char* smem) {
  const bool need_ctx = l < DEPTH - 1;
  volatile int* smw = (volatile int*)(smem + SMEM_BYTES - 16);
  constexpr int QL = SEQ / QU, QC = CTX / QU, QLD = SEQ / QUD, QCD = CTX / QUD;
  const int n_s5 = 16, n_dl = 2 * QLD, n_dc = need_ctx ? 2 * QCD : 0, n_wl = 4 * QL, n_wc = need_ctx ? 4 * QC : 0;
  const int total = n_dl + n_s5 + n_dc + n_wl + n_wc;
  const int x0 = get_bid() & 7;
  for (int dx = 0; dx < 8; ++dx) {
    const int xq = (x0 + dx) & 7;
    unsigned* ctr = (unsigned*)(p.ws + OFF_LAM) + 16 + l * 8 + xq;
    for (;;) {
      __syncthreads();
      if (get_tid() == 0) *smw = (int)atomicAdd(ctr, 1u);
      __syncthreads();
      int u = *smw;
      u = __builtin_amdgcn_readfirstlane(u);
      if (u >= total) break;
      int type, bq, hd, qi; bool is_lat = true;
      if (u < n_s5) { const int idx = xq * 16 + u; type = 1; bq = idx >> 5; hd = idx & 31; qi = 0; }
      else if ((u -= n_s5) < n_dl) { const int gidx = xq + 8 * (u / QLD); type = 0; bq = gidx >> 2; hd = gidx & 3; qi = u % QLD; }
      else if ((u -= n_dl) < n_dc) { const int gidx = xq + 8 * (u / QCD); type = 0; is_lat = false; bq = gidx >> 2; hd = gidx & 3; qi = u % QCD; }
      else if ((u -= n_dc) < n_wl) { type = 2; bq = xq >> 1; hd = (xq & 1) * 4 + (u & 3); qi = u >> 2; }
      else { u -= n_wl; type = 2; is_lat = false; bq = xq >> 1; hd = (xq & 1) * 4 + (u & 3); qi = u >> 2; }
      if (type == 0) diff_unit(p, l, bq, hd, is_lat, qi, smem);
      else if (type == 1) s5_unit(p, l, bq, hd, smem);
      else win_unit(p, l, bq, hd, is_lat, qi, smem);
    }
  }
}

#define EPI_LOOP_BEGIN { const int tid_ = get_tid(), lane_ = tid_ & 63, wid_ = tid_ >> 6, wr_ = wid_ >> 1, wc_ = wid_ & 1, lr_ = lane_ & 15, lg_ = lane_ >> 4; \
  _Pragma("unroll") for (int mi = 0; mi < 4; ++mi) { const int row = m0 + wr_ * 64 + mi * 16 + lr_; \
  _Pragma("unroll") for (int ni = 0; ni < 4; ++ni) { const int col = n0 + wc_ * 64 + ni * 16 + lg_ * 4;
#define EPI_LOOP_END } } }

DI void glu_phase(const Params& p, int MT, unsigned char* smem) {
  bf16_t* As = (bf16_t*)smem; bf16_t* Bs = As + 128 * LDT;
  const bf16_t* G = (const bf16_t*)(p.ws + OFF_GB); const bf16_t* W = (const bf16_t*)(p.ws + OFF_W_GLU); bf16_t* ys = (bf16_t*)(p.ws + OFF_YS);
  constexpr int NT = 4;
  for (int t = get_bid(); t < MT * NT; t += gridDim.x) {
    const int m0 = (t / NT) * 128, n0 = (t % NT) * 128;
    f32x4 acc[4][4]; zero_acc(acc);
    gemm_mainloop(acc, G + (size_t)m0 * 512, 512, W + (size_t)n0 * 512, 512, 512, As, Bs);
    EPI_LOOP_BEGIN
      const u32x2 gr = *(const u32x2*)(G + (size_t)row * 512 + col);
      const float g0 = __uint_as_float(gr[0] << 16), g1 = __uint_as_float(gr[0] & 0xffff0000u), g2 = __uint_as_float(gr[1] << 16), g3 = __uint_as_float(gr[1] & 0xffff0000u);
      u32x2 o; o[0] = pack2(g0 * sigmoidf_(acc[mi][ni][0]), g1 * sigmoidf_(acc[mi][ni][1])); o[1] = pack2(g2 * sigmoidf_(acc[mi][ni][2]), g3 * sigmoidf_(acc[mi][ni][3]));
      *(u32x2*)(ys + (size_t)row * 512 + col) = o;
    EPI_LOOP_END
  }
}
DI void merge_phase(const Params& p, int MT, unsigned char* smem) {
  bf16_t* As = (bf16_t*)smem; bf16_t* Bs = As + 128 * LDT;
  const bf16_t* gt = (const bf16_t*)(p.ws + OFF_GATES); bf16_t* mo = (bf16_t*)(p.ws + OFF_M);
  constexpr int NT = 8;
  for (int t = get_bid(); t < MT * NT; t += gridDim.x) {
    const int m0 = (t / NT) * 128, n0 = (t % NT) * 128;
    f32x4 acc[4][4]; zero_acc(acc);
#pragma unroll 1
    for (int br = 0; br < 3; ++br) {
      const bf16_t* Y = (const bf16_t*)(p.ws + (br == 0 ? OFF_YD : br == 1 ? OFF_YS : OFF_YW));
      const bf16_t* W = (const bf16_t*)(p.ws + (br == 0 ? OFF_W_PD : br == 1 ? OFF_W_PS : OFF_W_PW));
      gemm_mainloop(acc, Y + (size_t)m0 * 512, 512, W + (size_t)n0 * 512, 512, 512, As, Bs);
      if (br < 2) {
        EPI_LOOP_BEGIN
          const f32x4 g0 = ld_bf4(gt + (size_t)row * 3072 + br * 1024 + col), g1 = ld_bf4(gt + (size_t)row * 3072 + (br + 1) * 1024 + col);
#pragma unroll
          for (int j = 0; j < 4; ++j) acc[mi][ni][j] *= fmaxf(g0[j], 1e-30f) / fmaxf(g1[j], 1e-30f);
        EPI_LOOP_END
      } else {
        EPI_LOOP_BEGIN
          const f32x4 g2 = ld_bf4(gt + (size_t)row * 3072 + 2048 + col);
          u32x2 o; o[0] = pack2(acc[mi][ni][0] * fmaxf(g2[0], 1e-30f), acc[mi][ni][1] * fmaxf(g2[1], 1e-30f)); o[1] = pack2(acc[mi][ni][2] * fmaxf(g2[2], 1e-30f), acc[mi][ni][3] * fmaxf(g2[3], 1e-30f));
          *(u32x2*)(mo + (size_t)row * D + col) = o;
        EPI_LOOP_END
      }
    }
  }
}
DI void resid_phase(const Params& p, int l, const bf16_t* A, int K, const bf16_t* W, int gate_off, float* dst, int MT, unsigned char* smem, bool first = false) {
  bf16_t* As = (bf16_t*)smem; bf16_t* Bs = As + 128 * LDT;
  const float* h = (const float*)(p.ws + OFF_H);
  const float* modv = (const float*)(p.ws + OFF_MODV) + (size_t)l * 5 * 6144;
  constexpr int NT = 8;
  for (int t = get_bid(); t < MT * NT; t += gridDim.x) {
    const int m0 = (t / NT) * 128, n0 = (t % NT) * 128;
    f32x4 acc[4][4]; zero_acc(acc);
    gemm_mainloop(acc, A + (size_t)m0 * K, K, W + (size_t)n0 * K, K, K, As, Bs);
    const int bb = m0 < NLAT ? m0 / SEQ : 4;
    EPI_LOOP_BEGIN
      const f32x4 gv = *(const f32x4*)(modv + bb * 6144 + gate_off + col);
      const f32x4 hv = *(const f32x4*)((first ? (row < NLAT ? p.x + (size_t)row * D : p.ctx + (size_t)(row - NLAT) * D) : h + (size_t)row * D) + col);
      *(f32x4*)(dst + (size_t)row * D + col) = hv + gv * acc[mi][ni];
    EPI_LOOP_END
  }
}
DI void ff1_phase(const Params& p, int MT, unsigned char* smem) {
  bf16_t* As = (bf16_t*)smem; bf16_t* Bs = As + 128 * LDT;
  const bf16_t* A = (const bf16_t*)(p.ws + OFF_ABUF); const bf16_t* W = (const bf16_t*)(p.ws + OFF_W_FF1); bf16_t* uo = (bf16_t*)(p.ws + OFF_U);
  constexpr int NT = DFF / 128;
  for (int t = get_bid(); t < MT * NT; t += gridDim.x) {
    const int m0 = (t / NT) * 128, n0 = (t % NT) * 128;
    f32x4 acc[4][4]; zero_acc(acc);
    gemm_mainloop<true>(acc, A + (size_t)m0 * D, D, W + (size_t)n0 * D, D, D, As, Bs);
    const int tid_ = get_tid(), lane_ = tid_ & 63, wid_ = tid_ >> 6, wr_ = wid_ >> 1, wc_ = wid_ & 1, lr_ = lane_ & 15, lg_ = lane_ >> 4;
#pragma unroll
    for (int mi = 0; mi < 4; ++mi) { const int row = m0 + wr_ * 64 + mi * 16 + lr_;
#pragma unroll
      for (int q = 0; q < 2; ++q) { const int col = n0 + wc_ * 64 + q * 32 + lg_ * 8;
        float r[8];
#pragma unroll
        for (int j = 0; j < 4; ++j) { const float v0 = fmaxf(acc[mi][2 * q][j], 0.f), v1 = fmaxf(acc[mi][2 * q + 1][j], 0.f); r[j] = v0 * v0; r[4 + j] = v1 * v1; }
        u32x4 o; o[0] = pack2(r[0], r[1]); o[1] = pack2(r[2], r[3]); o[2] = pack2(r[4], r[5]); o[3] = pack2(r[6], r[7]);
        *(u32x4*)(uo + (size_t)row * DFF + col) = o; } }
  }
}

#define XB_TMO      128
#define XB_XCNT(j)  (256  + 64 * (j))
#define XB_XSUB(j)  (1280 + 64 * (j))
#define XB_XGEN(j)  (2304 + 64 * (j))
#define XB_TOP      3328
#define XB_TOPGEN   3392
#define XCD_BAR_WORDS 3456
#define XB_SPIN_CAP (1u << 18)
#define XLAS __attribute__((address_space(3)))

__device__ __forceinline__ unsigned xb_ld(unsigned* p)              { return __hip_atomic_load(p, __ATOMIC_RELAXED, __HIP_MEMORY_SCOPE_AGENT); }
__device__ __forceinline__ unsigned xb_add(unsigned* p, unsigned v) { return __hip_atomic_fetch_add(p, v, __ATOMIC_RELAXED, __HIP_MEMORY_SCOPE_AGENT); }
__device__ __forceinline__ unsigned xb_xcc_id() { return (unsigned)__builtin_amdgcn_s_getreg((3 << 11) | 20) & 0xFu; }
#define XB_SPIN(cond, bar) do { unsigned _sp = 0; while (cond) { __builtin_amdgcn_s_sleep(1); \
    if ((++_sp & 255u) == 0u) { if (xb_ld(&(bar)[XB_TMO])) break; if (_sp > XB_SPIN_CAP) { atomicAdd(&(bar)[XB_TMO], 1u); break; } } } } while (0)

struct XcdBarrier {
    unsigned* bar; unsigned x;
    volatile XLAS unsigned* st;
};

__device__ __forceinline__ XcdBarrier xcd_barrier_post(unsigned* bar, volatile XLAS unsigned* st) {
    XcdBarrier b; b.bar = bar; b.x = xb_xcc_id(); b.st = st;
    if (threadIdx.x == 0) (void)xb_add(&bar[XB_XCNT(b.x)], 1u);
    return b;
}
__device__ __forceinline__ void xcd_barrier_complete(unsigned* bar, unsigned x, unsigned& nloc, unsigned& nx) {
    const unsigned G = gridDim.x * gridDim.y * gridDim.z;
    unsigned sum, cnt, mine, sp = 0u;
    for (;;) {
        sum = 0u; cnt = 0u; mine = 0u;
#pragma unroll
        for (unsigned j = 0; j < 16; ++j) { const unsigned c = xb_ld(&bar[XB_XCNT(j)]); sum += c; cnt += (c > 0u) ? 1u : 0u; mine = (j == x) ? c : mine; }
        if (sum == G) break;
        __builtin_amdgcn_s_sleep(1);
        if ((++sp & 255u) == 0u) { if (xb_ld(&bar[XB_TMO])) break; if (sp > XB_SPIN_CAP) { atomicAdd(&bar[XB_TMO], 1u); break; } }
    }
    nloc = mine > 0u ? mine : 1u; nx = cnt > 0u ? cnt : 1u;
}

__device__ __forceinline__ void xcd_barrier(const XcdBarrier& b) {
    asm volatile("s_waitcnt vmcnt(0)" ::: "memory");
    __syncthreads();
    if (threadIdx.x == 0) {
        unsigned* bar = b.bar;
        __builtin_amdgcn_s_waitcnt(0);
        unsigned nloc = b.st[0], nx = b.st[1];
        if (nloc == 0u) { xcd_barrier_complete(bar, b.x, nloc, nx); b.st[0] = nloc; b.st[1] = nx; }
        const unsigned old = xb_add(&bar[XB_XSUB(b.x)], 1u);
        const unsigned gen = old / nloc;
        if (old + 1u == (gen + 1u) * nloc) {
            __builtin_amdgcn_fence(__ATOMIC_RELEASE, "agent");
            asm volatile("s_waitcnt vmcnt(0)" ::: "memory");
            const unsigned og = xb_add(&bar[XB_TOP], 1u);
            const unsigned tg = og / nx;
            if (og + 1u == (tg + 1u) * nx) xb_add(&bar[XB_TOPGEN], 1u);
            else XB_SPIN(xb_ld(&bar[XB_TOPGEN]) == tg, bar);
            __builtin_amdgcn_fence(__ATOMIC_ACQUIRE, "agent");
            xb_add(&bar[XB_XGEN(b.x)], 1u);
            asm volatile("s_waitcnt vmcnt(0)" ::: "memory");
        } else {
            XB_SPIN(xb_ld(&bar[XB_XGEN(b.x)]) == gen, bar);
            __builtin_amdgcn_fence(__ATOMIC_ACQUIRE, "agent");
            asm volatile("s_waitcnt vmcnt(0)" ::: "memory");
        }
    }
    __syncthreads();
}


__global__ void __launch_bounds__(256, 2) fwd_megakernel(Params p) {
  __shared__ __attribute__((aligned(16))) unsigned char smem[SMEM_BYTES];
  __shared__ uint4 xb_words;
  cg::grid_group grid = cg::this_grid();
  unsigned char* ws = p.ws;
  if (threadIdx.x == 0) xb_words = make_uint4(0u, 0u, 0u, 0u);
  __syncthreads();
  const XcdBarrier xb = xcd_barrier_post((unsigned*)(ws + OFF_BAR), (volatile XLAS unsigned*)&xb_words);
  phase0_misc(p, smem);
  __syncthreads();
  convert_layer(p, 0, 0, smem);
  if (p.ws == nullptr) grid.sync();
  for (int l = 0; l < DEPTH; ++l) {
    const bool need_ctx = l < DEPTH - 1;
    const int MT = need_ctx ? NTOK / 128 : NLAT / 128;
    xcd_barrier(xb);
    if (l > 0) convert_layer(p, l, CONV_EARLY, smem);
    norm_phase(p, l, p.norm1_g + l * D, 0, 1024, NTOK, l == 0);
    xcd_barrier(xb);
    inproj_phase(p, l, smem);
    xcd_barrier(xb);
    mixer_phase(p, l, smem);
    xcd_barrier(xb);
    glu_phase(p, MT, smem);
    xcd_barrier(xb);
    merge_phase(p, MT, smem);
    xcd_barrier(xb);
    resid_phase(p, l, (const bf16_t*)(ws + OFF_M), D, (const bf16_t*)(ws + OFF_W_OUT), 2048, (float*)(ws + OFF_H), MT, smem, l == 0);
    xcd_barrier(xb);
    norm_phase(p, l, p.norm2_g + l * D, 3072, 4096, MT * 128);
    xcd_barrier(xb);
    ff1_phase(p, MT, smem);
    xcd_barrier(xb);
    resid_phase(p, l, (const bf16_t*)(ws + OFF_U), DFF, (const bf16_t*)(ws + OFF_W_FF2), 5120, need_ctx ? (float*)(ws + OFF_H) : p.out, MT, smem);
    if (need_ctx) convert_steal(p, l + 1, smem);
  }
}

extern "C" void kernel_launch(void* const* d_in, const int* in_sizes, int n_in, void* d_out, int out_size, void* d_ws, size_t ws_size, hipStream_t stream) {
  static int grid_blocks = 0;
  if (!grid_blocks) {
    int dev = 0, cus = 0, per_cu = 0;
    (void)hipGetDevice(&dev);
    (void)hipDeviceGetAttribute(&cus, hipDeviceAttributeMultiprocessorCount, dev);
    (void)hipOccupancyMaxActiveBlocksPerMultiprocessor(&per_cu, fwd_megakernel, 256, 0);
    if (per_cu > 2) per_cu = 2;
    if (per_cu < 1) per_cu = 1;
    grid_blocks = cus * per_cu;
  }
  if (ws_size < WS_NEED) { fprintf(stderr, "workspace too small: %zu < %zu\n", ws_size, (size_t)WS_NEED); return; }
  (void)hipMemsetAsync((unsigned char*)d_ws + OFF_BAR, 0, BAR_BYTES, stream);
  Params p{};
  const float* const* in = (const float* const*)d_in;
  p.x = in[0]; p.c = in[1]; p.ctx = in[2]; p.c_ctx = in[3]; p.w_mod = in[4]; p.b_mod = in[5]; p.norm1_g = in[6]; p.norm2_g = in[7]; p.w_in = in[8];
  p.dq_g = in[9]; p.dk_g = in[10]; p.lq1 = in[11]; p.lk1 = in[12]; p.lq2 = in[13]; p.lk2 = in[14]; p.dout_g = in[15];
  p.s5_lre = in[16]; p.s5_lim = in[17]; p.s5_ldt = in[18]; p.s5_bre = in[19]; p.s5_bim = in[20]; p.s5_cre = in[21]; p.s5_cim = in[22]; p.s5_d = in[23]; p.s5_wglu = in[24];
  p.wq_g = in[25]; p.wk_g = in[26]; p.w_sink = in[27];
  p.w_pd = in[28]; p.w_ps = in[29]; p.w_pw = in[30]; p.w_out = in[31]; p.w_ff1 = in[32]; p.w_ff2 = in[33];
  p.out = (float*)d_out; p.ws = (unsigned char*)d_ws;
  void* args[] = {&p};
  hipError_t e = hipLaunchCooperativeKernel((void*)fwd_megakernel, dim3(grid_blocks), dim3(256), args, 0, stream);
  if (e != hipSuccess) fprintf(stderr, "cooperative launch failed: %s (grid %d)\n", hipGetErrorString(e), grid_blocks);
}
```

```cpp
#include <hip/hip_runtime.h>
#include <hip/hip_cooperative_groups.h>
#include <cstdio>
#include <cstdint>
namespace cg = cooperative_groups;

typedef unsigned short bf16_t;
typedef short bf16x8 __attribute__((ext_vector_type(8)));
typedef short bf16x4 __attribute__((ext_vector_type(4)));
typedef float f32x4 __attribute__((ext_vector_type(4)));
typedef float f32x2 __attribute__((ext_vector_type(2)));
typedef unsigned u32x4 __attribute__((ext_vector_type(4)));
typedef unsigned u32x2 __attribute__((ext_vector_type(2)));
typedef __bf16 bf2_t __attribute__((ext_vector_type(2)));

#define DI __device__ __forceinline__
#define MFMA16(a, b, c) __builtin_amdgcn_mfma_f32_16x16x32_bf16((a), (b), (c), 0, 0, 0)

constexpr int D = 1024, NB = 4, SEQ = 4096, DEPTH = 4, CTX = 256, POS = CTX + SEQ  ;
constexpr int NLAT = NB * SEQ  , NCTX = NB * CTX  , NTOK = NLAT + NCTX  ;
constexpr int DIN = 5888, DFF = 4096;
constexpr float EPS = 1e-6f;
constexpr float LOG2E = 1.4426950408889634f;
constexpr int NCH = POS / 32;

constexpr size_t SZ_W_IN = (size_t)DIN * D * 2, SZ_W_GLU = 512 * 512 * 2, SZ_W_P = 1024 * 512 * 2, SZ_W_OUT = (size_t)D * D * 2, SZ_W_FF = (size_t)D * DFF * 2;
constexpr size_t OFF_W_IN = 0;
constexpr size_t OFF_W_GLU = OFF_W_IN + SZ_W_IN;
constexpr size_t OFF_W_PD = OFF_W_GLU + SZ_W_GLU;
constexpr size_t OFF_W_PS = OFF_W_PD + SZ_W_P;
constexpr size_t OFF_W_PW = OFF_W_PS + SZ_W_P;
constexpr size_t OFF_W_OUT = OFF_W_PW + SZ_W_P;
constexpr size_t OFF_W_FF1 = OFF_W_OUT + SZ_W_OUT;
constexpr size_t OFF_W_FF2 = OFF_W_FF1 + SZ_W_FF;
constexpr size_t OFF_MODV = OFF_W_FF2 + SZ_W_FF;
constexpr size_t OFF_ROPE = OFF_MODV + (size_t)DEPTH * 5 * 6144 * 4;
constexpr size_t OFF_LAM = OFF_ROPE + 8192;
constexpr size_t OFF_H = OFF_LAM + 256;
constexpr size_t OFF_ABUF = OFF_H + (size_t)NTOK * D * 4;
constexpr size_t OFF_R1 = OFF_ABUF + (size_t)NTOK * D * 2;
constexpr size_t SZ_HEADBUF = (size_t)NB * 8 * POS * 64 * 2;
constexpr size_t OFF_QD = OFF_R1;
constexpr size_t OFF_KD = OFF_QD + SZ_HEADBUF;
constexpr size_t OFF_VDT = OFF_KD + SZ_HEADBUF;
constexpr size_t OFF_SU = OFF_VDT + SZ_HEADBUF;
constexpr size_t OFF_QW = OFF_SU + (size_t)NTOK * 512 * 2;
constexpr size_t OFF_KW = OFF_QW + SZ_HEADBUF;
constexpr size_t OFF_VWT = OFF_KW + SZ_HEADBUF / 4;
constexpr size_t OFF_GATES = OFF_VWT + SZ_HEADBUF / 4;
constexpr size_t OFF_YD = OFF_GATES + (size_t)NTOK * 3072 * 2;
constexpr size_t OFF_YS = OFF_YD + (size_t)NTOK * 512 * 2;
constexpr size_t OFF_YW = OFF_YS + (size_t)NTOK * 512 * 2;
constexpr size_t OFF_GB = OFF_YW + (size_t)NTOK * 512 * 2;
constexpr size_t OFF_EB = OFF_GB + (size_t)NTOK * 512 * 2;
constexpr size_t OFF_END = OFF_EB + (size_t)NB * 32 * 2 * (NCH + 8) * 64 * 8;
constexpr size_t OFF_BAR = OFF_END;
constexpr size_t BAR_BYTES = 16384;
constexpr size_t WS_NEED = OFF_BAR + BAR_BYTES;
constexpr size_t OFF_M = OFF_QD;
constexpr size_t OFF_U = OFF_R1;
static_assert((size_t)NTOK * DFF * 2 <= OFF_END - OFF_R1, "u alias");

struct Params {
  const float *x, *c, *ctx, *c_ctx, *w_mod, *b_mod, *norm1_g, *norm2_g, *w_in;
  const float *dq_g, *dk_g, *lq1, *lk1, *lq2, *lk2, *dout_g;
  const float *s5_lre, *s5_lim, *s5_ldt, *s5_bre, *s5_bim, *s5_cre, *s5_cim, *s5_d, *s5_wglu;
  const float *wq_g, *wk_g, *w_sink;
  const float *w_pd, *w_ps, *w_pw, *w_out, *w_ff1, *w_ff2;
  float* out;
  unsigned char* ws;
};

DI int get_tid() { int t = threadIdx.x; asm volatile("" : "+v"(t)); return t; }
DI int get_bid() { int b = blockIdx.x; asm volatile("" : "+s"(b)); return b; }
DI unsigned pack2(float lo, float hi) { f32x2 v = {lo, hi}; bf2_t r = __builtin_convertvector(v, bf2_t); return __builtin_bit_cast(unsigned, r); }
DI float sigmoidf_(float x) { return __builtin_amdgcn_rcpf(1.0f + __expf(-x)); }
DI float gelu_tanh(float x) { const float z = 0.7978845608028654f * (x + 0.044715f * x * x * x); const float e = __expf(2.0f * z); const float t = 1.0f - 2.0f * __builtin_amdgcn_rcpf(e + 1.0f); return 0.5f * x * (1.0f + t); }
DI f32x4 ld_bf4(const bf16_t* p_) { const u32x2 r = *(const u32x2*)p_; f32x4 v; v[0] = __uint_as_float(r[0] << 16); v[1] = __uint_as_float(r[0] & 0xffff0000u); v[2] = __uint_as_float(r[1] << 16); v[3] = __uint_as_float(r[1] & 0xffff0000u); return v; }
DI float xshfl(float v, int m) { return __shfl_xor(v, m, 64); }

constexpr int SMEM_BYTES = 65552;
constexpr int LDT = 72;

DI u32x4 gload_async(const void* ptr) { u32x4 r; asm volatile("global_load_dwordx4 %0, %1, off" : "=v"(r) : "v"(ptr) : "memory"); return r; }
DI u32x4 gload_async_s(const void* sbase, unsigned voff) { u32x4 r; asm volatile("global_load_dwordx4 %0, %1, %2" : "=v"(r) : "v"(voff), "s"(sbase) : "memory"); return r; }
#define VM_WAIT8(N, R, Q) asm volatile("s_waitcnt vmcnt(" #N ")" : "+v"(R[0]), "+v"(R[1]), "+v"(R[2]), "+v"(R[3]), "+v"(Q[0]), "+v"(Q[1]), "+v"(Q[2]), "+v"(Q[3]) :: "memory")
template <bool PERM = false>
DI void gemm_mainloop(f32x4 (&acc)[4][4], const bf16_t* __restrict__ A, int lda, const bf16_t* __restrict__ B, int ldb, int K, bf16_t* As, bf16_t* Bs) {
  const int tid = get_tid(), lane = tid & 63, wid = tid >> 6, wr = wid >> 1, wc = wid & 1, lr = lane & 15, lg = lane >> 4;
  const int crow = tid >> 3, ckc = (tid & 7) * 8;
  constexpr int TB = 128 * 64;
  const int swc = (((tid & 7) ^ (crow & 7)) * 8);
  const int swcB = PERM ? (((tid & 7) ^ ((((crow >> 3) & 3) * 2 + ((crow & 7) >> 1)) & 7)) * 8) : swc;
  u32x4 ra0[4], rb0[4], ra1[4], rb1[4];
  unsigned aoff[4], boff[4];
#pragma unroll
  for (int i = 0; i < 4; ++i) { aoff[i] = (unsigned)(((crow + i * 32) * lda + ckc) * 2); boff[i] = (unsigned)(((crow + i * 32) * ldb + ckc) * 2); }
#define GM_LOAD(RA, RB, KOFF) do { const char* ab_ = (const char*)A + (size_t)(KOFF) * 2; const char* bb_ = (const char*)B + (size_t)(KOFF) * 2; \
    _Pragma("unroll") for (int i = 0; i < 4; ++i) { RA[i] = gload_async_s(ab_, aoff[i]); RB[i] = gload_async_s(bb_, boff[i]); } } while (0)
#define GM_STORE(RA, RB, BUF) do { _Pragma("unroll") for (int i = 0; i < 4; ++i) { *(u32x4*)(As + (BUF) * 2 * TB + (crow + i * 32) * 64 + swc) = RA[i]; *(u32x4*)(As + (BUF) * 2 * TB + TB + (crow + i * 32) * 64 + swcB) = RB[i]; } } while (0)
#define GM_COMPUTE(BUF) do { const bf16_t* as_ = As + (BUF) * 2 * TB; const bf16_t* bs_ = as_ + TB; \
    bf16x8 af[2][4], bfr[2][4];     \
    _Pragma("unroll") for (int ks = 0; ks < 2; ++ks) { const int co_ = ((ks * 4 + lg) ^ (lr & 7)) * 8; \
      _Pragma("unroll") for (int mi = 0; mi < 4; ++mi) af[ks][mi] = *(const bf16x8*)(as_ + (wr * 64 + mi * 16 + lr) * 64 + co_); \
      _Pragma("unroll") for (int ni = 0; ni < 4; ++ni) { \
        if (PERM) { const int rw_ = (ni & 1) * 4 + (lr & 3); const int key_ = ((lr >> 2) * 2 + (rw_ >> 1)) & 7; bfr[ks][ni] = *(const bf16x8*)(bs_ + (wc * 64 + (ni >> 1) * 32 + (lr >> 2) * 8 + rw_) * 64 + (((ks * 4 + lg) ^ key_) * 8)); } \
        else bfr[ks][ni] = *(const bf16x8*)(bs_ + (wc * 64 + ni * 16 + lr) * 64 + co_); } } \
    __builtin_amdgcn_sched_barrier(0); \
    __builtin_amdgcn_s_setprio(1); \
    _Pragma("unroll") for (int ks = 0; ks < 2; ++ks) _Pragma("unroll") for (int mi = 0; mi < 4; ++mi) _Pragma("unroll") for (int ni = 0; ni < 4; ++ni) acc[mi][ni] = MFMA16(bfr[ks][ni], af[ks][mi], acc[mi][ni]); \
    __builtin_amdgcn_s_setprio(0); \
    __builtin_amdgcn_sched_barrier(0); } while (0)
  asm volatile("s_waitcnt vmcnt(0)" ::: "memory");
  GM_LOAD(ra0, rb0, 0); GM_LOAD(ra1, rb1, 64);
  __syncthreads();
  VM_WAIT8(8, ra0, rb0); GM_STORE(ra0, rb0, 0); GM_LOAD(ra0, rb0, (128 < K ? 128 : 0));
  __syncthreads();
  for (int k0 = 0; k0 < K; k0 += 128) {
    const int kn1 = k0 + 192 < K ? k0 + 192 : 0, kn0 = k0 + 256 < K ? k0 + 256 : 0;
    VM_WAIT8(8, ra1, rb1); GM_STORE(ra1, rb1, 1); GM_LOAD(ra1, rb1, kn1);
    GM_COMPUTE(0); __syncthreads();
    VM_WAIT8(8, ra0, rb0); GM_STORE(ra0, rb0, 0); GM_LOAD(ra0, rb0, kn0);
    GM_COMPUTE(1); __syncthreads();
  }
  VM_WAIT8(0, ra0, rb0); VM_WAIT8(0, ra1, rb1);
#undef GM_LOAD
#undef GM_STORE
#undef GM_COMPUTE
}
DI void zero_acc(f32x4 (&acc)[4][4]) {
#pragma unroll
  for (int mi = 0; mi < 4; ++mi)
#pragma unroll
    for (int ni = 0; ni < 4; ++ni) acc[mi][ni] = (f32x4){0.f, 0.f, 0.f, 0.f};
}

DI void convert_tile(const float* __restrict__ src, int K, int N, bf16_t* __restrict__ dst, int kt, int nt, float* tile) {
  const int tid = get_tid();
  { const int r = tid >> 4, c4 = (tid & 15) * 4;
#pragma unroll
    for (int i = 0; i < 4; ++i) { const int k = r + i * 16; const f32x4 v = *(const f32x4*)(src + (size_t)(kt * 64 + k) * N + nt * 64 + c4);
      tile[k * 65 + c4 + 0] = v[0]; tile[k * 65 + c4 + 1] = v[1]; tile[k * 65 + c4 + 2] = v[2]; tile[k * 65 + c4 + 3] = v[3]; } }
  __syncthreads();
  { const int n = tid >> 2, kc = (tid & 3) * 16; u32x4 o0, o1;
#pragma unroll
    for (int q = 0; q < 4; ++q) { o0[q] = pack2(tile[(kc + 2 * q) * 65 + n], tile[(kc + 2 * q + 1) * 65 + n]); o1[q] = pack2(tile[(kc + 8 + 2 * q) * 65 + n], tile[(kc + 8 + 2 * q + 1) * 65 + n]); }
    bf16_t* d = dst + (size_t)(nt * 64 + n) * K + kt * 64 + kc; *(u32x4*)d = o0; *(u32x4*)(d + 8) = o1; }
  __syncthreads();
}
DI void convert_item(const Params& p, int l, int t, float* tile) {
  unsigned char* ws = p.ws;
  const float* src; bf16_t* dst; int K, N, idx;
  if (t < 1472) { idx = t; src = p.w_in + (size_t)l * D * DIN; K = D; N = DIN; dst = (bf16_t*)(ws + OFF_W_IN); }
  else if (t < 1536) { idx = t - 1472; src = p.s5_wglu + (size_t)l * 512 * 512; K = 512; N = 512; dst = (bf16_t*)(ws + OFF_W_GLU); }
  else if (t < 1664) { idx = t - 1536; src = p.w_pd + (size_t)l * 512 * D; K = 512; N = D; dst = (bf16_t*)(ws + OFF_W_PD); }
  else if (t < 1792) { idx = t - 1664; src = p.w_ps + (size_t)l * 512 * D; K = 512; N = D; dst = (bf16_t*)(ws + OFF_W_PS); }
  else if (t < 1920) { idx = t - 1792; src = p.w_pw + (size_t)l * 512 * D; K = 512; N = D; dst = (bf16_t*)(ws + OFF_W_PW); }
  else if (t < 2176) { idx = t - 1920; src = p.w_out + (size_t)l * D * D; K = D; N = D; dst = (bf16_t*)(ws + OFF_W_OUT); }
  else if (t < 3200) { idx = t - 2176; src = p.w_ff1 + (size_t)l * D * DFF; K = D; N = DFF; dst = (bf16_t*)(ws + OFF_W_FF1); }
  else { idx = t - 3200; src = p.w_ff2 + (size_t)l * DFF * D; K = DFF; N = D; dst = (bf16_t*)(ws + OFF_W_FF2); }
  const int nts = N / 64; convert_tile(src, K, N, dst, idx / nts, idx % nts, tile);
}
constexpr int CONV_EARLY = 3200, CONV_ALL = 4224;
DI void convert_layer(const Params& p, int l, int t_begin, unsigned char* smem) {
  float* tile = (float*)smem;
  for (int t = t_begin + get_bid(); t < CONV_ALL; t += gridDim.x) convert_item(p, l, t, tile);
}
DI void convert_steal(const Params& p, int l, unsigned char* smem) {
  float* tile = (float*)smem;
  volatile int* smw = (volatile int*)(smem + SMEM_BYTES - 16);
  unsigned* ctr = (unsigned*)(p.ws + OFF_LAM) + 48 + l;
  for (;;) {
    __syncthreads();
    if (get_tid() == 0) *smw = (int)atomicAdd(ctr, 1u);
    __syncthreads();
    int t = *smw; t = __builtin_amdgcn_readfirstlane(t);
    if (t >= CONV_EARLY) break;
    convert_item(p, l, t, tile);
  }
}

DI void phase0_misc(const Params& p, unsigned char* smem) {
  unsigned char* ws = p.ws;
  const int tid = get_tid();
  if (get_bid() == 0) {
    float* rope = (float*)(ws + OFF_ROPE);
    for (int i = tid; i < 1024; i += 256) { const int pos = i >> 4, f = i & 15; const float inv = powf(10000.0f, -(float)f / 16.0f); const float ang = (float)pos * inv; rope[i] = cosf(ang); rope[1024 + i] = sinf(ang); }
    if (tid < DEPTH) { const int l = tid; float s1 = 0.f, s2 = 0.f;
      for (int i = 0; i < 64; ++i) { s1 += p.lq1[l * 64 + i] * p.lk1[l * 64 + i]; s2 += p.lq2[l * 64 + i] * p.lk2[l * 64 + i]; }
      const float lam_init = 0.8f - 0.6f * expf(-0.3f * (float)l);
      ((float*)(ws + OFF_LAM))[l] = expf(s1) - expf(s2) + lam_init; }
    if (tid >= 64 && tid < 64 + DEPTH) { const int l = tid - 64; float a = 0.f, b2 = 0.f, c2 = 0.f, d2 = 0.f;
      for (int i = 0; i < 64; ++i) { a = fmaxf(a, fabsf(p.dq_g[l * 64 + i])); b2 = fmaxf(b2, fabsf(p.dk_g[l * 64 + i])); c2 = fmaxf(c2, fabsf(p.wq_g[l * 64 + i])); d2 = fmaxf(d2, fabsf(p.wk_g[l * 64 + i])); }
      ((float*)(ws + OFF_LAM))[4 + l] = 8.0f * LOG2E * 1.02f * a * b2;
      ((float*)(ws + OFF_LAM))[8 + l] = 8.0f * LOG2E * 1.02f * c2 * d2;
      for (int i = 0; i < 8; ++i) ((unsigned*)(ws + OFF_LAM))[16 + l * 8 + i] = 0u;
      ((unsigned*)(ws + OFF_LAM))[48 + l] = 0u; }
  }
  float* sc = (float*)smem;
  float* red = sc + 5 * 1024;
  for (int i = tid; i < 5 * 1024; i += 256) { const int bb = i >> 10, k = i & 1023; const float v = bb < 4 ? p.c[bb * 1024 + k] : p.c_ctx[k]; sc[i] = v / (1.0f + __expf(-v)); }
  __syncthreads();
  float* modv = (float*)(ws + OFF_MODV);
  for (int t = get_bid(); t < DEPTH * 96; t += gridDim.x) {
    const int l = t / 96, cb = t % 96, kq = tid >> 6, cl = tid & 63, col = cb * 64 + cl;
    const float* w = p.w_mod + (size_t)l * D * 6144 + col;
    float s[5] = {0.f, 0.f, 0.f, 0.f, 0.f};
    for (int k = kq * 256; k < kq * 256 + 256; ++k) { const float wv = w[(size_t)k * 6144];
#pragma unroll
      for (int bb = 0; bb < 5; ++bb) s[bb] += sc[bb * 1024 + k] * wv; }
#pragma unroll
    for (int bb = 0; bb < 5; ++bb) red[(kq * 5 + bb) * 64 + cl] = s[bb];
    __syncthreads();
    for (int i = tid; i < 5 * 64; i += 256) { const int bb = i >> 6, c2 = i & 63; const float v = red[(0 * 5 + bb) * 64 + c2] + red[(1 * 5 + bb) * 64 + c2] + red[(2 * 5 + bb) * 64 + c2] + red[(3 * 5 + bb) * 64 + c2];
      modv[((size_t)l * 5 + bb) * 6144 + cb * 64 + c2] = v + p.b_mod[l * 6144 + cb * 64 + c2]; }
    __syncthreads();
  }
}

DI void norm_phase(const Params& p, int l, const float* gvec, int sh_off, int sc_off, int nrows, bool first = false) {
  const int tid = get_tid(), lane = tid & 63, wid = tid >> 6;
  const float* h = (const float*)(p.ws + OFF_H); bf16_t* out = (bf16_t*)(p.ws + OFF_ABUF);
  const float* modv = (const float*)(p.ws + OFF_MODV) + (size_t)l * 5 * 6144;
  for (int t = get_bid(); t < nrows / 4; t += gridDim.x) {
    const int row = t * 4 + wid; const int bb = row < NLAT ? row / SEQ : 4;
    const float* hr = first ? (row < NLAT ? p.x + (size_t)row * D : p.ctx + (size_t)(row - NLAT) * D) : h + (size_t)row * D; const float* mv = modv + bb * 6144;
    f32x4 v[4]; float ss = 0.f;
#pragma unroll
    for (int it = 0; it < 4; ++it) { v[it] = *(const f32x4*)(hr + it * 256 + lane * 4); ss += v[it][0] * v[it][0] + v[it][1] * v[it][1] + v[it][2] * v[it][2] + v[it][3] * v[it][3]; }
#pragma unroll
    for (int m = 1; m < 64; m <<= 1) ss += xshfl(ss, m);
    const float rstd = rsqrtf(ss * (1.0f / 1024.0f) + EPS);
#pragma unroll
    for (int it = 0; it < 4; ++it) { const int idx = it * 256 + lane * 4;
      const f32x4 g = *(const f32x4*)(gvec + idx), s1 = *(const f32x4*)(mv + sc_off + idx), s0 = *(const f32x4*)(mv + sh_off + idx);
      float y[4];
#pragma unroll
      for (int j = 0; j < 4; ++j) y[j] = v[it][j] * rstd * g[j] * (1.0f + s1[j]) + s0[j];
      u32x2 o; o[0] = pack2(y[0], y[1]); o[1] = pack2(y[2], y[3]); *(u32x2*)(out + (size_t)row * D + idx) = o; }
  }
}

DI void inproj_epilogue(const Params& p, int l, const f32x4 (&acc)[4][4], int m0, int n0) {
  unsigned char* ws = p.ws;
  const int tid = get_tid(), lane = tid & 63, wid = tid >> 6, wr = wid >> 1, wc = wid & 1, lr = lane & 15, lg = lane >> 4;
  const bool is_lat = m0 < NLAT;
  int b, i0; if (is_lat) { b = m0 / SEQ; i0 = m0 % SEQ; } else { const int c0 = m0 - NLAT; b = c0 / CTX; i0 = c0 % CTX; }
  const int pos0 = is_lat ? CTX + i0 : i0;
  const int hc = n0 + wc * 64;
  int seg;
  if (n0 < 512) seg = 0; else if (n0 < 1024) seg = 1; else if (n0 < 1536) seg = 2; else if (n0 < 2048) seg = 3; else if (n0 < 2560) seg = 4; else if (n0 < 2688) seg = 5; else if (n0 < 2816) seg = 6; else seg = 7;
  if (seg == 0 || seg == 1 || seg == 4 || seg == 5) {
    const float* gv; bf16_t* dst; float qs = 1.0f;
    if (seg == 0) { const int c = hc; gv = p.dq_g + l * 64; dst = (bf16_t*)(ws + OFF_QD) + ((size_t)((b * 2 + c / 256) * 4 + (c % 256) / 64) * POS) * 64; qs = 0.125f * LOG2E; }
    else if (seg == 1) { const int c = hc - 512; gv = p.dk_g + l * 64; dst = (bf16_t*)(ws + OFF_KD) + ((size_t)((b * 2 + c / 256) * 4 + (c % 256) / 64) * POS) * 64; }
    else if (seg == 4) { const int c = hc - 2048; gv = p.wq_g + l * 64; dst = (bf16_t*)(ws + OFF_QW) + ((size_t)(b * 8 + c / 64) * POS) * 64; qs = 0.125f * LOG2E; }
    else { const int c = hc - 2560; gv = p.wk_g + l * 64; dst = (bf16_t*)(ws + OFF_KW) + ((size_t)(b * 2 + c / 64) * POS) * 64; }
    const float* rope = (const float*)(ws + OFF_ROPE);
    f32x4 gq[4];
#pragma unroll
    for (int ni = 0; ni < 4; ++ni) gq[ni] = *(const f32x4*)(gv + ni * 16 + lg * 4);
#pragma unroll
    for (int mi = 0; mi < 4; ++mi) {
      const int r = wr * 64 + mi * 16 + lr;
      float ss = 0.f;
#pragma unroll
      for (int ni = 0; ni < 4; ++ni)
#pragma unroll
        for (int j = 0; j < 4; ++j) ss += acc[mi][ni][j] * acc[mi][ni][j];
      ss += xshfl(ss, 16); ss += xshfl(ss, 32);
      const float rstd = rsqrtf(ss * (1.0f / 64.0f) + EPS);
      f32x4 v[4];
#pragma unroll
      for (int ni = 0; ni < 4; ++ni) v[ni] = acc[mi][ni] * rstd * gq[ni];
      if (is_lat) {
        const int li = i0 + r, gr = li >> 6, gc = li & 63;
#pragma unroll
        for (int ni = 0; ni < 2; ++ni) {
          const int pi = ni == 0 ? gr : gc;
          const f32x4 cs = *(const f32x4*)(rope + pi * 16 + lg * 4), sn = *(const f32x4*)(rope + 1024 + pi * 16 + lg * 4);
          const f32x4 x1 = v[ni], x2 = v[ni + 2];
          v[ni] = x1 * cs - x2 * sn; v[ni + 2] = x2 * cs + x1 * sn;
        }
      }
      bf16_t* drow = dst + (size_t)(pos0 + r) * 64 + lg * 4;
#pragma unroll
      for (int ni = 0; ni < 4; ++ni) { u32x2 o; o[0] = pack2(v[ni][0] * qs, v[ni][1] * qs); o[1] = pack2(v[ni][2] * qs, v[ni][3] * qs); *(u32x2*)(drow + ni * 16) = o; }
    }
  } else if (seg == 2 || seg == 6) {
#pragma unroll
    for (int mi = 0; mi < 4; ++mi) {
      const int pos = pos0 + wr * 64 + mi * 16 + lr;
#pragma unroll
      for (int ni = 0; ni < 4; ++ni)
#pragma unroll
        for (int j = 0; j < 4; ++j) {
          const int col = hc + ni * 16 + lg * 4 + j; bf16_t* dst;
          if (seg == 2) { const int c = col - 1024; dst = (bf16_t*)(ws + OFF_VDT) + ((size_t)(b * 4 + c / 128) * 128 + (c % 128)) * POS + pos; }
          else { const int c = col - 2688; dst = (bf16_t*)(ws + OFF_VWT) + ((size_t)(b * 2 + c / 64) * 64 + (c % 64)) * POS + pos; }
          *dst = (bf16_t)(pack2(acc[mi][ni][j], 0.f) & 0xffffu);
        }
    }
  } else if (seg == 3) {
    bf16_t* su = (bf16_t*)(ws + OFF_SU);
#pragma unroll
    for (int mi = 0; mi < 4; ++mi) { const int pos = pos0 + wr * 64 + mi * 16 + lr;
#pragma unroll
      for (int ni = 0; ni < 4; ++ni) { u32x2 o; o[0] = pack2(acc[mi][ni][0], acc[mi][ni][1]); o[1] = pack2(acc[mi][ni][2], acc[mi][ni][3]);
        *(u32x2*)(su + ((size_t)(b * 32 + (hc - 1536) / 16 + ni) * POS + pos) * 16 + lg * 4) = o; } }
  } else {
    bf16_t* gt = (bf16_t*)(ws + OFF_GATES);
#pragma unroll
    for (int mi = 0; mi < 4; ++mi) { const int row = m0 + wr * 64 + mi * 16 + lr;
#pragma unroll
      for (int ni = 0; ni < 4; ++ni) { u32x2 o; o[0] = pack2(sigmoidf_(acc[mi][ni][0]), sigmoidf_(acc[mi][ni][1])); o[1] = pack2(sigmoidf_(acc[mi][ni][2]), sigmoidf_(acc[mi][ni][3]));
        *(u32x2*)(gt + (size_t)row * 3072 + (hc - 2816) + ni * 16 + lg * 4) = o; } }
  }
}
DI void inproj_phase(const Params& p, int l, unsigned char* smem) {
  bf16_t* As = (bf16_t*)smem; bf16_t* Bs = As + 128 * LDT;
  const bf16_t* A = (const bf16_t*)(p.ws + OFF_ABUF); const bf16_t* W = (const bf16_t*)(p.ws + OFF_W_IN);
  constexpr int NT = DIN / 128, MT = NTOK / 128;
  for (int t = get_bid(); t < MT * NT; t += gridDim.x) {
    const int mt = t / NT, nt = t % NT;
    f32x4 acc[4][4]; zero_acc(acc);
    gemm_mainloop(acc, A + (size_t)mt * 128 * D, D, W + (size_t)nt * 128 * D, D, D, As, Bs);
    inproj_epilogue(p, l, acc, mt * 128, nt * 128);
  }
}

constexpr int NW = 4;
constexpr int NTHR = NW * 64;
constexpr int QU = NW * 32;
template <int DV, bool TWOK>
DI void attn_core_d1(f32x4 (&O)[2][DV / 16], float (&lsum)[2], const bf16x8 (&Qf)[2][2], float negm,
                  const bf16_t* __restrict__ Kp0, const bf16_t* __restrict__ Kp1, const bf16_t* __restrict__ Vt, int t0, int t1, int tm0, int tm1, int qlat0, unsigned char* smem) {
  constexpr int KB = TWOK ? 16384 : 8192, BUFB = KB + DV * 128;
  constexpr int NKL = (TWOK ? 16 : 8) / NW, NVL = DV / 8 / NW;
  const int tid = get_tid(), lane = tid & 63, wid = __builtin_amdgcn_readfirstlane(tid >> 6), lr = lane & 15, lg = lane >> 4;
  const int rl = lane >> 3, lc = (lane & 7) ^ rl;
  const int n0 = t1 - t0, ntl = n0 + (tm1 - tm0);
  u32x4 rk[NKL], rv[NVL];
#define ATTN_GLOAD(KEY0) do { const int key0_ = (KEY0); \
    _Pragma("unroll") for (int i = 0; i < NKL; ++i) { const int L = wid + i * NW; const bf16_t* kp_ = (i * NW >= 8) ? Kp1 : Kp0; rk[i] = *(const u32x4*)(kp_ + (size_t)(key0_ + (L & 7) * 8 + rl) * 64 + (((lane & 7) ^ ((((L & 3) * 2) + (rl >> 1)) & 7)) * 8)); } \
    _Pragma("unroll") for (int i = 0; i < NVL; ++i) { const int L = wid + i * NW; rv[i] = *(const u32x4*)(Vt + (size_t)(L * 8 + rl) * POS + key0_ + lc * 8); } } while (0)
#define ATTN_LSTORE(BUF) do { unsigned char* buf_ = (BUF); \
    _Pragma("unroll") for (int i = 0; i < NKL; ++i) *(u32x4*)(buf_ + (wid + i * NW) * 1024 + lane * 16) = rk[i]; \
    _Pragma("unroll") for (int i = 0; i < NVL; ++i) *(u32x4*)(buf_ + KB + (wid + i * NW) * 1024 + lane * 16) = rv[i]; } while (0)
  ATTN_GLOAD((n0 > 0 ? t0 : tm0) * 64);
  __syncthreads();
  ATTN_LSTORE(smem);
  const int sw = lr & 7;
  for (int it = 0; it < ntl; ++it) {
    const bool masked = it >= n0;
    const int key0 = (masked ? tm0 + (it - n0) : t0 + it) * 64;
    const unsigned char* Kb = smem + (it & 1) * BUFB; const unsigned char* Vb = Kb + KB;
    __syncthreads();
    if (it + 1 < ntl) ATTN_GLOAD(((it + 1) >= n0 ? tm0 + (it + 1 - n0) : t0 + it + 1) * 64);
    f32x4 s[4][2];
#pragma unroll
    for (int kt = 0; kt < 4; ++kt) {
      const unsigned char* kr = Kb + ((kt >> 1) * 32 + (lr >> 2) * 8 + (kt & 1) * 4 + (lr & 3)) * 128; const int kkey = ((lr >> 2) * 2 + (kt & 1) * 2 + ((lr & 3) >> 1)) & 7;
      if (!TWOK) {
        const bf16x8 k0f = *(const bf16x8*)(kr + ((lg ^ kkey) << 4)), k1f = *(const bf16x8*)(kr + (((4 + lg) ^ kkey) << 4));
#pragma unroll
        for (int qt = 0; qt < 2; ++qt) { f32x4 z = {negm, negm, negm, negm}; z = MFMA16(k0f, Qf[qt][0], z); s[kt][qt] = MFMA16(k1f, Qf[qt][1], z); }
      } else {
#pragma unroll
        for (int qt = 0; qt < 2; ++qt) {
          const bf16x8 k0f = *(const bf16x8*)(kr + qt * 8192 + ((lg ^ kkey) << 4)), k1f = *(const bf16x8*)(kr + qt * 8192 + (((4 + lg) ^ kkey) << 4));
          f32x4 z = {negm, negm, negm, negm}; z = MFMA16(k0f, Qf[qt][0], z); s[kt][qt] = MFMA16(k1f, Qf[qt][1], z); }
      }
    }
    if (masked) {
#pragma unroll
      for (int kt = 0; kt < 4; ++kt)
#pragma unroll
        for (int qt = 0; qt < 2; ++qt)
#pragma unroll
          for (int j = 0; j < 4; ++j) { const int kl = key0 - CTX + (kt >> 1) * 32 + lg * 8 + (kt & 1) * 4 + j, ql = qlat0 + qt * 16 + lr; const int rel = kl - ql; if (rel > 128 || rel < -128) s[kt][qt][j] = -INFINITY; }
    }
    bf16x8 pf[2][2];
#pragma unroll
    for (int qt = 0; qt < 2; ++qt) {
      float rs = 0.f;
#pragma unroll
      for (int kt = 0; kt < 4; ++kt)
#pragma unroll
        for (int j = 0; j < 4; ++j) { const float e = __builtin_amdgcn_exp2f(s[kt][qt][j]); s[kt][qt][j] = e; rs += e; }
      lsum[qt] += rs;
#pragma unroll
      for (int kk = 0; kk < 2; ++kk) {
        u32x4 w; w[0] = pack2(s[2 * kk][qt][0], s[2 * kk][qt][1]); w[1] = pack2(s[2 * kk][qt][2], s[2 * kk][qt][3]);
        w[2] = pack2(s[2 * kk + 1][qt][0], s[2 * kk + 1][qt][1]); w[3] = pack2(s[2 * kk + 1][qt][2], s[2 * kk + 1][qt][3]);
        pf[qt][kk] = __builtin_bit_cast(bf16x8, w);
      }
    }
#pragma unroll
    for (int et = 0; et < DV / 16; ++et)
#pragma unroll
      for (int kk = 0; kk < 2; ++kk) {
        const bf16x8 vf = *(const bf16x8*)(Vb + (et * 16 + lr) * 128 + (((kk * 4 + lg) ^ sw) << 4));
        O[0][et] = MFMA16(vf, pf[0][kk], O[0][et]);
        O[1][et] = MFMA16(vf, pf[1][kk], O[1][et]);
      }
    if (it + 1 < ntl) ATTN_LSTORE(smem + ((it + 1) & 1) * BUFB);
  }
#undef ATTN_GLOAD
#undef ATTN_LSTORE
}

#define VM_WAIT4(N, R, Q) asm volatile("s_waitcnt vmcnt(" #N ")" : "+v"(R[0]), "+v"(R[1]), "+v"(Q[0]), "+v"(Q[1]) :: "memory")
template <int DV, bool TWOK>
DI void attn_core(f32x4 (&O)[2][DV / 16], float (&lsum)[2], const bf16x8 (&Qf)[2][2], float negm,
                  const bf16_t* __restrict__ Kp0, const bf16_t* __restrict__ Kp1, const bf16_t* __restrict__ Vt, int t0, int t1, int tm0, int tm1, int qlat0, unsigned char* smem) {
  constexpr int KB = TWOK ? 16384 : 8192, BUFB = KB + DV * 128;
  constexpr int NKL = (TWOK ? 16 : 8) / NW, NVL = DV / 8 / NW;
  static_assert((NKL == 4 && NVL == 4) || (NKL == 2 && NVL == 2), "wait macros are written for 8 or 4 loads per set");
  const int tid = get_tid(), lane = tid & 63, wid = __builtin_amdgcn_readfirstlane(tid >> 6), lr = lane & 15, lg = lane >> 4;
  const int rl = lane >> 3, lc = (lane & 7) ^ rl;
  const int n0 = t1 - t0, ntl = n0 + (tm1 - tm0);
  u32x4 rk0[NKL], rv0[NVL], rk1[NKL], rv1[NVL];
#define ATTN_TILE(I) ({ int i_ = (I); i_ = i_ < ntl ? i_ : ntl - 1; (i_ < n0 ? t0 + i_ : tm0 + (i_ - n0)) * 64; })
#define ATTN_GLOAD(RK, RV, KEY0) do { const int key0_ = (KEY0); \
    _Pragma("unroll") for (int i = 0; i < NKL; ++i) { const int L = wid + i * NW; const bf16_t* kp_ = (i * NW >= 8) ? Kp1 : Kp0; RK[i] = gload_async(kp_ + (size_t)(key0_ + (L & 7) * 8 + rl) * 64 + (((lane & 7) ^ ((((L & 3) * 2) + (rl >> 1)) & 7)) * 8)); } \
    _Pragma("unroll") for (int i = 0; i < NVL; ++i) { const int L = wid + i * NW; RV[i] = gload_async(Vt + (size_t)(L * 8 + rl) * POS + key0_ + lc * 8); } } while (0)
#define ATTN_LSTORE(RK, RV, BUF) do { unsigned char* buf_ = (BUF); \
    _Pragma("unroll") for (int i = 0; i < NKL; ++i) *(u32x4*)(buf_ + (wid + i * NW) * 1024 + lane * 16) = RK[i]; \
    _Pragma("unroll") for (int i = 0; i < NVL; ++i) *(u32x4*)(buf_ + KB + (wid + i * NW) * 1024 + lane * 16) = RV[i]; } while (0)
#define ATTN_WAIT(RK, RV) do { if constexpr (NKL == 4) VM_WAIT8(8, RK, RV); else VM_WAIT4(4, RK, RV); } while (0)
#define ATTN_DRAIN(RK, RV) do { if constexpr (NKL == 4) VM_WAIT8(0, RK, RV); else VM_WAIT4(0, RK, RV); } while (0)
  const int sw = lr & 7;
#define ATTN_COMPUTE(IT, BUFP) do { const int it_ = (IT); const bool masked = it_ >= n0; const int key0 = (masked ? tm0 + (it_ - n0) : t0 + it_) * 64; \
    const unsigned char* Kb = (BUFP); const unsigned char* Vb = Kb + KB; \
    bf16x8 pf[2][2]; \
    _Pragma("unroll") for (int qt = 0; qt < 2; ++qt) { f32x4 s4[4]; \
      _Pragma("unroll") for (int kt = 0; kt < 4; ++kt) { const unsigned char* kq = Kb + ((kt >> 1) * 32 + (lr >> 2) * 8 + (kt & 1) * 4 + (lr & 3)) * 128 + (TWOK ? qt * 8192 : 0); const int kkey = ((lr >> 2) * 2 + (kt & 1) * 2 + ((lr & 3) >> 1)) & 7; \
        const bf16x8 k0f = *(const bf16x8*)(kq + ((lg ^ kkey) << 4)), k1f = *(const bf16x8*)(kq + (((4 + lg) ^ kkey) << 4)); \
        f32x4 z = {negm, negm, negm, negm}; z = MFMA16(k0f, Qf[qt][0], z); s4[kt] = MFMA16(k1f, Qf[qt][1], z); } \
      if (masked) { \
        _Pragma("unroll") for (int kt = 0; kt < 4; ++kt) _Pragma("unroll") for (int j = 0; j < 4; ++j) { \
          const int kl = key0 - CTX + (kt >> 1) * 32 + lg * 8 + (kt & 1) * 4 + j, ql = qlat0 + qt * 16 + lr; const int rel = kl - ql; if (rel > 128 || rel < -128) s4[kt][j] = -INFINITY; } } \
      float rs = 0.f; \
      _Pragma("unroll") for (int kt = 0; kt < 4; ++kt) _Pragma("unroll") for (int j = 0; j < 4; ++j) { const float e = __builtin_amdgcn_exp2f(s4[kt][j]); s4[kt][j] = e; rs += e; } \
      lsum[qt] += rs; \
      _Pragma("unroll") for (int kk = 0; kk < 2; ++kk) { u32x4 w; w[0] = pack2(s4[2 * kk][0], s4[2 * kk][1]); w[1] = pack2(s4[2 * kk][2], s4[2 * kk][3]); \
        w[2] = pack2(s4[2 * kk + 1][0], s4[2 * kk + 1][1]); w[3] = pack2(s4[2 * kk + 1][2], s4[2 * kk + 1][3]); pf[qt][kk] = __builtin_bit_cast(bf16x8, w); } } \
    _Pragma("unroll") for (int et = 0; et < DV / 16; ++et) _Pragma("unroll") for (int kk = 0; kk < 2; ++kk) { \
        const bf16x8 vf = *(const bf16x8*)(Vb + (et * 16 + lr) * 128 + (((kk * 4 + lg) ^ sw) << 4)); \
        O[0][et] = MFMA16(vf, pf[0][kk], O[0][et]); O[1][et] = MFMA16(vf, pf[1][kk], O[1][et]); } } while (0)
  asm volatile("s_waitcnt vmcnt(0)" ::: "memory");
  ATTN_GLOAD(rk0, rv0, ATTN_TILE(0)); ATTN_GLOAD(rk1, rv1, ATTN_TILE(1));
  __syncthreads();
  ATTN_WAIT(rk0, rv0); ATTN_LSTORE(rk0, rv0, smem); ATTN_GLOAD(rk0, rv0, ATTN_TILE(2));
  for (int it = 0; it < ntl; it += 2) {
    __syncthreads();
    ATTN_COMPUTE(it, smem);
    ATTN_WAIT(rk1, rv1); ATTN_LSTORE(rk1, rv1, smem + BUFB); ATTN_GLOAD(rk1, rv1, ATTN_TILE(it + 3));
    __syncthreads();
    ATTN_COMPUTE(it + 1, smem + BUFB);
    ATTN_WAIT(rk0, rv0); ATTN_LSTORE(rk0, rv0, smem); ATTN_GLOAD(rk0, rv0, ATTN_TILE(it + 4));
  }
  ATTN_DRAIN(rk0, rv0); ATTN_DRAIN(rk1, rv1);
#undef ATTN_TILE
#undef ATTN_GLOAD
#undef ATTN_LSTORE
#undef ATTN_WAIT
#undef ATTN_DRAIN
#undef ATTN_COMPUTE
}

constexpr int QUD = NW * 16;
DI void diff_unit(const Params& p, int l, int b, int hd, bool is_lat, int qi, unsigned char* smem) {
  unsigned char* ws = p.ws;
  const int tid = get_tid(), lane = tid & 63, wid = __builtin_amdgcn_readfirstlane(tid >> 6), lr = lane & 15, lg = lane >> 4;
  const int qpos0 = (is_lat ? CTX + qi * QUD : qi * QUD) + wid * 16;
  const int ntile = is_lat ? POS / 64 : CTX / 64;
  const float lam = ((const float*)(ws + OFF_LAM))[l];
  const float negm = -((const float*)(ws + OFF_LAM))[4 + l];
  const float lam_init = 0.8f - 0.6f * expf(-0.3f * (float)l);
  const size_t hoff0 = (size_t)((b * 2 + 0) * 4 + hd) * POS * 64, hoff1 = (size_t)((b * 2 + 1) * 4 + hd) * POS * 64;
  const bf16_t* Qd = (const bf16_t*)(ws + OFF_QD); const bf16_t* Kd = (const bf16_t*)(ws + OFF_KD);
  bf16x8 Qf[2][2];
#pragma unroll
  for (int ks = 0; ks < 2; ++ks) { Qf[0][ks] = *(const bf16x8*)(Qd + hoff0 + (size_t)(qpos0 + lr) * 64 + ks * 32 + lg * 8); Qf[1][ks] = *(const bf16x8*)(Qd + hoff1 + (size_t)(qpos0 + lr) * 64 + ks * 32 + lg * 8); }
  float lsum[2] = {0.f, 0.f};
  f32x4 O[2][8];
#pragma unroll
  for (int m = 0; m < 2; ++m)
#pragma unroll
    for (int et = 0; et < 8; ++et) O[m][et] = (f32x4){0.f, 0.f, 0.f, 0.f};
  attn_core_d1<128, true>(O, lsum, Qf, negm, Kd + hoff0, Kd + hoff1, (const bf16_t*)(ws + OFF_VDT) + (size_t)(b * 4 + hd) * 128 * POS, 0, ntile, 0, 0, 0, smem);
  float l0 = lsum[0], l1 = lsum[1];
  l0 += xshfl(l0, 16); l0 += xshfl(l0, 32); l1 += xshfl(l1, 16); l1 += xshfl(l1, 32);
  const float i0 = 1.0f / l0, i1 = lam / l1;
  float ss = 0.f;
#pragma unroll
  for (int et = 0; et < 8; ++et) { O[0][et] = O[0][et] * i0 - O[1][et] * i1;
#pragma unroll
    for (int j = 0; j < 4; ++j) ss += O[0][et][j] * O[0][et][j]; }
  ss += xshfl(ss, 16); ss += xshfl(ss, 32);
  const float rs = rsqrtf(ss * (1.0f / 128.0f) + EPS) * (1.0f - lam_init);
  const float* og = p.dout_g + l * 128; bf16_t* yd = (bf16_t*)(ws + OFF_YD);
  const int qpos = qpos0 + lr;
  const int row = is_lat ? b * SEQ + (qpos - CTX) : NLAT + b * CTX + qpos;
#pragma unroll
  for (int et = 0; et < 8; ++et) { const f32x4 g = *(const f32x4*)(og + et * 16 + lg * 4); const f32x4 y = O[0][et] * rs * g;
    u32x2 o; o[0] = pack2(y[0], y[1]); o[1] = pack2(y[2], y[3]); *(u32x2*)(yd + (size_t)row * 512 + hd * 128 + et * 16 + lg * 4) = o; }
}

DI void win_unit(const Params& p, int l, int b, int qh, bool is_lat, int qi, unsigned char* smem) {
  unsigned char* ws = p.ws;
  const int tid = get_tid(), lane = tid & 63, wid = __builtin_amdgcn_readfirstlane(tid >> 6), lr = lane & 15, lg = lane >> 4;
  const int qpos0 = (is_lat ? CTX + qi * QU : qi * QU) + wid * 32;
  const int kv = qh >> 2;
  const bf16_t* Qp = (const bf16_t*)(ws + OFF_QW) + ((size_t)(b * 8 + qh) * POS + qpos0) * 64;
  bf16x8 Qf[2][2];
#pragma unroll
  for (int qt = 0; qt < 2; ++qt)
#pragma unroll
    for (int ks = 0; ks < 2; ++ks) Qf[qt][ks] = *(const bf16x8*)(Qp + (qt * 16 + lr) * 64 + ks * 32 + lg * 8);
  const float sk = p.w_sink[l * 8 + qh] * LOG2E;
  const float mfix = fmaxf(((const float*)(ws + OFF_LAM))[8 + l], sk);
  const float l0 = lg == 0 ? __builtin_amdgcn_exp2f(sk - mfix) : 0.f;
  float lsum[2] = {l0, l0};
  f32x4 O[2][4];
#pragma unroll
  for (int qt = 0; qt < 2; ++qt)
#pragma unroll
    for (int et = 0; et < 4; ++et) O[qt][et] = (f32x4){0.f, 0.f, 0.f, 0.f};
  int tm0 = 0, tm1 = 0;
  if (is_lat) { const int q0 = qi * QU; tm0 = (q0 + 128) / 64; if (tm0 < 4) tm0 = 4; tm1 = (q0 + QU + 384) / 64; if (tm1 > POS / 64) tm1 = POS / 64; }
  attn_core<64, false>(O, lsum, Qf, -mfix, (const bf16_t*)(ws + OFF_KW) + (size_t)(b * 2 + kv) * POS * 64, nullptr, (const bf16_t*)(ws + OFF_VWT) + (size_t)(b * 2 + kv) * 64 * POS, 0, 4, tm0, tm1, qpos0 - CTX, smem);
  bf16_t* yw = (bf16_t*)(ws + OFF_YW);
#pragma unroll
  for (int qt = 0; qt < 2; ++qt) {
    float ls = lsum[qt]; ls += xshfl(ls, 16); ls += xshfl(ls, 32);
    const float inv = 1.0f / ls;
    const int qpos = qpos0 + qt * 16 + lr;
    const int row = is_lat ? b * SEQ + (qpos - CTX) : NLAT + b * CTX + qpos;
#pragma unroll
    for (int et = 0; et < 4; ++et) { const f32x4 y = O[qt][et] * inv; u32x2 o; o[0] = pack2(y[0], y[1]); o[1] = pack2(y[2], y[3]);
      *(u32x2*)(yw + (size_t)row * 512 + qh * 64 + et * 16 + lg * 4) = o; }
  }
}

constexpr int NR = NW / 2, CR = NCH / NR;
constexpr int BST = 20, SST = 136;
constexpr int S5_WAVE_LDS = 128 * BST * 4 + 16 * SST * 2;
constexpr int EB_PER_UNIT = 2 * (NCH + 8) * 64 * 2;
DI int s5_row(int b, int k, int t) { return k < 8 ? NLAT + b * CTX + k * 32 + t : b * SEQ + (k - 8) * 32 + t; }
DI int s5_cmap(int d, int k) { return d == 0 ? k : (k < 8 ? 7 - k : 143 - k); }
DI void s5_make_bf(const Params& p, int l, int d, int g, float fre, float fim, bf16x8 (&Bf)[8], int lr, int lg) {
#pragma unroll
  for (int q = 0; q < 8; ++q) {
    const int pp = 16 * (q & 3) + lr;
    const float fr = __shfl(fre, pp, 64), fi = __shfl(fim, pp, 64);
    u32x4 w = {0u, 0u, 0u, 0u};
    if (lg < 2) {
      const size_t bo = ((size_t)((l * 2 + d) * 32 + g) * 64 + pp) * 16 + lg * 8;
      const f32x4 br0 = *(const f32x4*)(p.s5_bre + bo), br1 = *(const f32x4*)(p.s5_bre + bo + 4), bi0 = *(const f32x4*)(p.s5_bim + bo), bi1 = *(const f32x4*)(p.s5_bim + bo + 4);
      f32x4 v0, v1;
      if (q < 4) { v0 = fr * br0 - fi * bi0; v1 = fr * br1 - fi * bi1; } else { v0 = fr * bi0 + fi * br0; v1 = fr * bi1 + fi * br1; }
      w[0] = pack2(v0[0], v0[1]); w[1] = pack2(v0[2], v0[3]); w[2] = pack2(v1[0], v1[1]); w[3] = pack2(v1[2], v1[3]);
    }
    Bf[q] = __builtin_bit_cast(bf16x8, w);
  }
}
DI u32x4 s5_load_uf(const bf16_t* sug, int k, int tt, int lr, int lg) { u32x4 uw = {0u, 0u, 0u, 0u}; if (lg < 2) uw = *(const u32x4*)(sug + (size_t)(k * 32 + tt * 16 + lr) * 16 + lg * 8); return uw; }
DI void s5_bu_tile(u32x4 uw, const bf16x8 (&Bf)[8], float* Bsm, int lr, int lg) {
  const bf16x8 uf = __builtin_bit_cast(bf16x8, uw);
#pragma unroll
  for (int q = 0; q < 8; ++q) { f32x4 z = {0.f, 0.f, 0.f, 0.f}; z = MFMA16(Bf[q], uf, z);
#pragma unroll
    for (int jj = 0; jj < 4; ++jj) Bsm[(q * 16 + lg * 4 + jj) * BST + lr] = z[jj]; }
}
#define S5_SCAN(D, AR, AI, WRITE) do { \
    _Pragma("unroll") for (int hb = 0; hb < 2; ++hb) { const int cb = ((D) ? 1 - hb : hb) * 2;     \
      const f32x4 br0_ = *(const f32x4*)(Bsm + lane * BST + cb * 4), br1_ = *(const f32x4*)(Bsm + lane * BST + cb * 4 + 4); \
      const f32x4 bi0_ = *(const f32x4*)(Bsm + (64 + lane) * BST + cb * 4), bi1_ = *(const f32x4*)(Bsm + (64 + lane) * BST + cb * 4 + 4); \
      _Pragma("unroll") for (int st = 0; st < 8; ++st) { const int t8 = (D) ? 7 - st : st; const int tl = cb * 4 + t8; \
        const float br = t8 < 4 ? br0_[t8 & 3] : br1_[t8 & 3], bi = t8 < 4 ? bi0_[t8 & 3] : bi1_[t8 & 3]; \
        const float nr = (AR) * sr - (AI) * si + br, ni = (AR) * si + (AI) * sr + bi; sr = nr; si = ni; \
        if (WRITE) { const unsigned pk = pack2(sr, si); Ssm[tl * SST + lane] = (bf16_t)(pk & 0xffffu); Ssm[tl * SST + 64 + lane] = (bf16_t)(pk >> 16); } } } } while (0)
DI void s5_unit(const Params& p, int l, int b, int g, unsigned char* smem) {
  unsigned char* ws = p.ws;
  const int tid = get_tid(), lane = tid & 63, wid = __builtin_amdgcn_readfirstlane(tid >> 6), lr = lane & 15, lg = lane >> 4;
  float* Bsm = (float*)(smem + wid * S5_WAVE_LDS);
  bf16_t* Ssm = (bf16_t*)(smem + wid * S5_WAVE_LDS + 128 * BST * 4);
  const bf16_t* sug = (const bf16_t*)(ws + OFF_SU) + (size_t)(b * 32 + g) * POS * 16;
  float* Eb = (float*)(ws + OFF_EB) + (size_t)(b * 32 + g) * EB_PER_UNIT;
  float are[2], aim[2], fre[2], fim[2];
#pragma unroll
  for (int d = 0; d < 2; ++d) {
    const int pi = ((l * 2 + d) * 32 + g) * 64 + lane;
    const float lre = p.s5_lre[pi], lim = p.s5_lim[pi], dt = expf(p.s5_ldt[(l * 2 + d) * 32 + g]);
    const float mag = expf(lre * dt), ang = lim * dt;
    are[d] = mag * cosf(ang); aim[d] = mag * sinf(ang);
    const float den = lre * lre + lim * lim, nre = are[d] - 1.0f;
    fre[d] = (nre * lre + aim[d] * lim) / den; fim[d] = (aim[d] * lre - nre * lim) / den;
  }
  bf16x8 Bf[2][8];
  s5_make_bf(p, l, 0, g, fre[0], fim[0], Bf[0], lr, lg);
  s5_make_bf(p, l, 1, g, fre[1], fim[1], Bf[1], lr, lg);
  {
    const int d = wid & 1, r = wid >> 1;
    const float ar = d ? are[1] : are[0], ai = d ? aim[1] : aim[0];
    float sr = 0.f, si = 0.f;
    for (int ci = 0; ci < CR; ++ci) {
      const int c = r * CR + ci, k = s5_cmap(d, c);
      { float* e_ = Eb + ((size_t)(d * (NCH + 8) + c) * 64 + lane) * 2; __hip_atomic_store(e_, sr, __ATOMIC_RELAXED, __HIP_MEMORY_SCOPE_AGENT); __hip_atomic_store(e_ + 1, si, __ATOMIC_RELAXED, __HIP_MEMORY_SCOPE_AGENT); }
      const u32x4 ua = s5_load_uf(sug, k, d ? 1 : 0, lr, lg), ub = s5_load_uf(sug, k, d ? 0 : 1, lr, lg);
#pragma unroll
      for (int hh = 0; hh < 2; ++hh) {
        const u32x4 uw = hh ? ub : ua;
        __builtin_amdgcn_wave_barrier();
        if (d) s5_bu_tile(uw, Bf[1], Bsm, lr, lg); else s5_bu_tile(uw, Bf[0], Bsm, lr, lg);
        __builtin_amdgcn_wave_barrier();
        if (d) S5_SCAN(1, ar, ai, false); else S5_SCAN(0, ar, ai, false);
      }
    }
    { float* e_ = Eb + ((size_t)(d * (NCH + 8) + NCH + r) * 64 + lane) * 2; __hip_atomic_store(e_, sr, __ATOMIC_RELAXED, __HIP_MEMORY_SCOPE_AGENT); __hip_atomic_store(e_ + 1, si, __ATOMIC_RELAXED, __HIP_MEMORY_SCOPE_AGENT); }
  }
  asm volatile("s_waitcnt vmcnt(0)" ::: "memory"); __syncthreads();
  bf16x8 Cf[2][4];
  float a32r[2], a32i[2], aCRr[2], aCRi[2];
#pragma unroll
  for (int d = 0; d < 2; ++d) {
#pragma unroll
    for (int ks = 0; ks < 4; ++ks) {
      const float* src = (ks < 2 ? p.s5_cre : p.s5_cim) + ((size_t)((l * 2 + d) * 32 + g) * 16 + lr) * 64 + (ks & 1) * 32 + lg * 8;
      const f32x4 v0 = *(const f32x4*)src, v1 = *(const f32x4*)(src + 4); const float sg = ks < 2 ? 1.0f : -1.0f;
      u32x4 w; w[0] = pack2(sg * v0[0], sg * v0[1]); w[1] = pack2(sg * v0[2], sg * v0[3]); w[2] = pack2(sg * v1[0], sg * v1[1]); w[3] = pack2(sg * v1[2], sg * v1[3]);
      Cf[d][ks] = __builtin_bit_cast(bf16x8, w);
    }
    float pr = are[d], pi_ = aim[d];
#pragma unroll
    for (int q = 0; q < 5; ++q) { const float nr = pr * pr - pi_ * pi_, ni = 2.0f * pr * pi_; pr = nr; pi_ = ni; }
    a32r[d] = pr; a32i[d] = pi_;
    float rr = 1.f, ri = 0.f, br_ = pr, bi_ = pi_;
#pragma unroll
    for (int bit = 0; bit < 7; ++bit) { if ((CR >> bit) & 1) { const float nr = rr * br_ - ri * bi_, ni = rr * bi_ + ri * br_; rr = nr; ri = ni; } const float nr = br_ * br_ - bi_ * bi_, ni = 2.0f * br_ * bi_; br_ = nr; bi_ = ni; }
    aCRr[d] = rr; aCRi[d] = ri;
  }
  const f32x4 dsk = *(const f32x4*)(p.s5_d + l * 512 + g * 16 + lg * 4);
  bf16_t* gb = (bf16_t*)(ws + OFF_GB);
  for (int k = wid; k < NCH; k += NW) {
    f32x4 acc[2] = {{0.f, 0.f, 0.f, 0.f}, {0.f, 0.f, 0.f, 0.f}};
    u32x4 uq[2]; uq[0] = s5_load_uf(sug, k, 0, lr, lg); uq[1] = s5_load_uf(sug, k, 1, lr, lg);
    u32x2 us[2]; us[0] = *(const u32x2*)(sug + (size_t)(k * 32 + lr) * 16 + lg * 4); us[1] = *(const u32x2*)(sug + (size_t)(k * 32 + 16 + lr) * 16 + lg * 4);
    float s0[2][2];
#pragma unroll
    for (int d = 0; d < 2; ++d) { const float* e_ = Eb + ((size_t)(d * (NCH + 8) + s5_cmap(d, k)) * 64 + lane) * 2;
      s0[d][0] = __hip_atomic_load(e_, __ATOMIC_RELAXED, __HIP_MEMORY_SCOPE_AGENT); s0[d][1] = __hip_atomic_load(e_ + 1, __ATOMIC_RELAXED, __HIP_MEMORY_SCOPE_AGENT); }
#pragma unroll
    for (int d = 0; d < 2; ++d) {
      const int c = s5_cmap(d, k), r = c / CR, j = c - r * CR;
      const float* Ed = Eb + (size_t)d * (NCH + 8) * 128 + lane * 2;
      float tr = 0.f, ti = 0.f;
#pragma unroll
      for (int r2 = 0; r2 < NR - 1; ++r2) if (r2 < r) {
        const float er = __hip_atomic_load(Ed + (size_t)(NCH + r2) * 128, __ATOMIC_RELAXED, __HIP_MEMORY_SCOPE_AGENT), ei = __hip_atomic_load(Ed + (size_t)(NCH + r2) * 128 + 1, __ATOMIC_RELAXED, __HIP_MEMORY_SCOPE_AGENT);
        const float nr = aCRr[d] * tr - aCRi[d] * ti + er, ni = aCRr[d] * ti + aCRi[d] * tr + ei; tr = nr; ti = ni; }
      float pr = 1.f, pi_ = 0.f, br_ = a32r[d], bi_ = a32i[d];
      for (int bit = 0; bit < 7; ++bit) { if ((j >> bit) & 1) { const float nr = pr * br_ - pi_ * bi_, ni = pr * bi_ + pi_ * br_; pr = nr; pi_ = ni; } const float nr = br_ * br_ - bi_ * bi_, ni = 2.0f * br_ * bi_; br_ = nr; bi_ = ni; }
      float sr = s0[d][0] + (pr * tr - pi_ * ti), si = s0[d][1] + (pr * ti + pi_ * tr);
#pragma unroll
      for (int hh = 0; hh < 2; ++hh) {
        const int tt = d ? 1 - hh : hh;
        __builtin_amdgcn_wave_barrier();
        s5_bu_tile(uq[tt], Bf[d], Bsm, lr, lg);
        __builtin_amdgcn_wave_barrier();
        if (d) S5_SCAN(1, are[1], aim[1], true); else S5_SCAN(0, are[0], aim[0], true);
        __builtin_amdgcn_wave_barrier();
#pragma unroll
        for (int ks = 0; ks < 4; ++ks) { const bf16x8 sf = *(const bf16x8*)(Ssm + lr * SST + ks * 32 + lg * 8); acc[tt] = MFMA16(Cf[d][ks], sf, acc[tt]); }
      }
    }
#pragma unroll
    for (int tt = 0; tt < 2; ++tt) { const int row = s5_row(b, k, tt * 16 + lr);
      f32x4 u; u[0] = __uint_as_float(us[tt][0] << 16); u[1] = __uint_as_float(us[tt][0] & 0xffff0000u); u[2] = __uint_as_float(us[tt][1] << 16); u[3] = __uint_as_float(us[tt][1] & 0xffff0000u);
      float y[4];
#pragma unroll
      for (int j = 0; j < 4; ++j) y[j] = gelu_tanh(acc[tt][j] + u[j] * dsk[j]);
      u32x2 o; o[0] = pack2(y[0], y[1]); o[1] = pack2(y[2], y[3]); *(u32x2*)(gb + (size_t)row * 512 + g * 16 + lg * 4) = o; }
  }
}

DI void mixer_phase(const Params& p, int l, unsigned char* smem) {
  const bool need_ctx = l < DEPTH - 1;
  volatile int* smw = (volatile int*)(smem + SMEM_BYTES - 16);
  constexpr int QL = SEQ / QU, QC = CTX / QU, QLD = SEQ / QUD, QCD = CTX / QUD;
  const int n_s5 = 16, n_dl = 2 * QLD, n_dc = need_ctx ? 2 * QCD : 0, n_wl = 4 * QL, n_wc = need_ctx ? 4 * QC : 0;
  const int total = n_dl + n_s5 + n_dc + n_wl + n_wc;
  const int x0 = get_bid() & 7;
  for (int dx = 0; dx < 8; ++dx) {
    const int xq = (x0 + dx) & 7;
    unsigned* ctr = (unsigned*)(p.ws + OFF_LAM) + 16 + l * 8 + xq;
    for (;;) {
      __syncthreads();
      if (get_tid() == 0) *smw = (int)atomicAdd(ctr, 1u);
      __syncthreads();
      int u = *smw;
      u = __builtin_amdgcn_readfirstlane(u);
      if (u >= total) break;
      int type, bq, hd, qi; bool is_lat = true;
      if (u < n_s5) { const int idx = xq * 16 + u; type = 1; bq = idx >> 5; hd = idx & 31; qi = 0; }
      else if ((u -= n_s5) < n_dl) { const int gidx = xq + 8 * (u / QLD); type = 0; bq = gidx >> 2; hd = gidx & 3; qi = u % QLD; }
      else if ((u -= n_dl) < n_dc) { const int gidx = xq + 8 * (u / QCD); type = 0; is_lat = false; bq = gidx >> 2; hd = gidx & 3; qi = u % QCD; }
      else if ((u -= n_dc) < n_wl) { type = 2; bq = xq >> 1; hd = (xq & 1) * 4 + (u & 3); qi = u >> 2; }
      else { u -= n_wl; type = 2; is_lat = false; bq = xq >> 1; hd = (xq & 1) * 4 + (u & 3); qi = u >> 2; }
      if (type == 0) diff_unit(p, l, bq, hd, is_lat, qi, smem);
      else if (type == 1) s5_unit(p, l, bq, hd, smem);
      else win_unit(p, l, bq, hd, is_lat, qi, smem);
    }
  }
}

#define EPI_LOOP_BEGIN { const int tid_ = get_tid(), lane_ = tid_ & 63, wid_ = tid_ >> 6, wr_ = wid_ >> 1, wc_ = wid_ & 1, lr_ = lane_ & 15, lg_ = lane_ >> 4; \
  _Pragma("unroll") for (int mi = 0; mi < 4; ++mi) { const int row = m0 + wr_ * 64 + mi * 16 + lr_; \
  _Pragma("unroll") for (int ni = 0; ni < 4; ++ni) { const int col = n0 + wc_ * 64 + ni * 16 + lg_ * 4;
#define EPI_LOOP_END } } }

DI void glu_phase(const Params& p, int MT, unsigned char* smem) {
  bf16_t* As = (bf16_t*)smem; bf16_t* Bs = As + 128 * LDT;
  const bf16_t* G = (const bf16_t*)(p.ws + OFF_GB); const bf16_t* W = (const bf16_t*)(p.ws + OFF_W_GLU); bf16_t* ys = (bf16_t*)(p.ws + OFF_YS);
  constexpr int NT = 4;
  for (int t = get_bid(); t < MT * NT; t += gridDim.x) {
    const int m0 = (t / NT) * 128, n0 = (t % NT) * 128;
    f32x4 acc[4][4]; zero_acc(acc);
    gemm_mainloop(acc, G + (size_t)m0 * 512, 512, W + (size_t)n0 * 512, 512, 512, As, Bs);
    EPI_LOOP_BEGIN
      const u32x2 gr = *(const u32x2*)(G + (size_t)row * 512 + col);
      const float g0 = __uint_as_float(gr[0] << 16), g1 = __uint_as_float(gr[0] & 0xffff0000u), g2 = __uint_as_float(gr[1] << 16), g3 = __uint_as_float(gr[1] & 0xffff0000u);
      u32x2 o; o[0] = pack2(g0 * sigmoidf_(acc[mi][ni][0]), g1 * sigmoidf_(acc[mi][ni][1])); o[1] = pack2(g2 * sigmoidf_(acc[mi][ni][2]), g3 * sigmoidf_(acc[mi][ni][3]));
      *(u32x2*)(ys + (size_t)row * 512 + col) = o;
    EPI_LOOP_END
  }
}
DI void merge_phase(const Params& p, int MT, unsigned char* smem) {
  bf16_t* As = (bf16_t*)smem; bf16_t* Bs = As + 128 * LDT;
  const bf16_t* gt = (const bf16_t*)(p.ws + OFF_GATES); bf16_t* mo = (bf16_t*)(p.ws + OFF_M);
  constexpr int NT = 8;
  for (int t = get_bid(); t < MT * NT; t += gridDim.x) {
    const int m0 = (t / NT) * 128, n0 = (t % NT) * 128;
    f32x4 acc[4][4]; zero_acc(acc);
#pragma unroll 1
    for (int br = 0; br < 3; ++br) {
      const bf16_t* Y = (const bf16_t*)(p.ws + (br == 0 ? OFF_YD : br == 1 ? OFF_YS : OFF_YW));
      const bf16_t* W = (const bf16_t*)(p.ws + (br == 0 ? OFF_W_PD : br == 1 ? OFF_W_PS : OFF_W_PW));
      gemm_mainloop(acc, Y + (size_t)m0 * 512, 512, W + (size_t)n0 * 512, 512, 512, As, Bs);
      if (br < 2) {
        EPI_LOOP_BEGIN
          const f32x4 g0 = ld_bf4(gt + (size_t)row * 3072 + br * 1024 + col), g1 = ld_bf4(gt + (size_t)row * 3072 + (br + 1) * 1024 + col);
#pragma unroll
          for (int j = 0; j < 4; ++j) acc[mi][ni][j] *= fmaxf(g0[j], 1e-30f) * __builtin_amdgcn_rcpf(fmaxf(g1[j], 1e-30f));
        EPI_LOOP_END
      } else {
        EPI_LOOP_BEGIN
          const f32x4 g2 = ld_bf4(gt + (size_t)row * 3072 + 2048 + col);
          u32x2 o; o[0] = pack2(acc[mi][ni][0] * fmaxf(g2[0], 1e-30f), acc[mi][ni][1] * fmaxf(g2[1], 1e-30f)); o[1] = pack2(acc[mi][ni][2] * fmaxf(g2[2], 1e-30f), acc[mi][ni][3] * fmaxf(g2[3], 1e-30f));
          *(u32x2*)(mo + (size_t)row * D + col) = o;
        EPI_LOOP_END
      }
    }
  }
}
DI void resid_phase(const Params& p, int l, const bf16_t* A, int K, const bf16_t* W, int gate_off, float* dst, int MT, unsigned char* smem, bool first = false) {
  bf16_t* As = (bf16_t*)smem; bf16_t* Bs = As + 128 * LDT;
  const float* h = (const float*)(p.ws + OFF_H);
  const float* modv = (const float*)(p.ws + OFF_MODV) + (size_t)l * 5 * 6144;
  constexpr int NT = 8;
  for (int t = get_bid(); t < MT * NT; t += gridDim.x) {
    const int m0 = (t / NT) * 128, n0 = (t % NT) * 128;
    f32x4 acc[4][4]; zero_acc(acc);
    gemm_mainloop(acc, A + (size_t)m0 * K, K, W + (size_t)n0 * K, K, K, As, Bs);
    const int bb = m0 < NLAT ? m0 / SEQ : 4;
    EPI_LOOP_BEGIN
      const f32x4 gv = *(const f32x4*)(modv + bb * 6144 + gate_off + col);
      const f32x4 hv = *(const f32x4*)((first ? (row < NLAT ? p.x + (size_t)row * D : p.ctx + (size_t)(row - NLAT) * D) : h + (size_t)row * D) + col);
      *(f32x4*)(dst + (size_t)row * D + col) = hv + gv * acc[mi][ni];
    EPI_LOOP_END
  }
}
DI void ff1_phase(const Params& p, int MT, unsigned char* smem) {
  bf16_t* As = (bf16_t*)smem; bf16_t* Bs = As + 128 * LDT;
  const bf16_t* A = (const bf16_t*)(p.ws + OFF_ABUF); const bf16_t* W = (const bf16_t*)(p.ws + OFF_W_FF1); bf16_t* uo = (bf16_t*)(p.ws + OFF_U);
  constexpr int NT = DFF / 128;
  for (int t = get_bid(); t < MT * NT; t += gridDim.x) {
    const int m0 = (t / NT) * 128, n0 = (t % NT) * 128;
    f32x4 acc[4][4]; zero_acc(acc);
    gemm_mainloop<true>(acc, A + (size_t)m0 * D, D, W + (size_t)n0 * D, D, D, As, Bs);
    const int tid_ = get_tid(), lane_ = tid_ & 63, wid_ = tid_ >> 6, wr_ = wid_ >> 1, wc_ = wid_ & 1, lr_ = lane_ & 15, lg_ = lane_ >> 4;
#pragma unroll
    for (int mi = 0; mi < 4; ++mi) { const int row = m0 + wr_ * 64 + mi * 16 + lr_;
#pragma unroll
      for (int q = 0; q < 2; ++q) { const int col = n0 + wc_ * 64 + q * 32 + lg_ * 8;
        float r[8];
#pragma unroll
        for (int j = 0; j < 4; ++j) { const float v0 = fmaxf(acc[mi][2 * q][j], 0.f), v1 = fmaxf(acc[mi][2 * q + 1][j], 0.f); r[j] = v0 * v0; r[4 + j] = v1 * v1; }
        u32x4 o; o[0] = pack2(r[0], r[1]); o[1] = pack2(r[2], r[3]); o[2] = pack2(r[4], r[5]); o[3] = pack2(r[6], r[7]);
        *(u32x4*)(uo + (size_t)row * DFF + col) = o; } }
  }
}

#define XB_TMO      128
#define XB_XCNT(j)  (256  + 64 * (j))
#define XB_XSUB(j)  (1280 + 64 * (j))
#define XB_XGEN(j)  (2304 + 64 * (j))
#define XB_TOP      3328
#define XB_TOPGEN   3392
#define XCD_BAR_WORDS 3456
#define XB_SPIN_CAP (1u << 18)
#define XLAS __attribute__((address_space(3)))

__device__ __forceinline__ unsigned xb_ld(unsigned* p)              { return __hip_atomic_load(p, __ATOMIC_RELAXED, __HIP_MEMORY_SCOPE_AGENT); }
__device__ __forceinline__ unsigned xb_add(unsigned* p, unsigned v) { return __hip_atomic_fetch_add(p, v, __ATOMIC_RELAXED, __HIP_MEMORY_SCOPE_AGENT); }
__device__ __forceinline__ unsigned xb_xcc_id() { return (unsigned)__builtin_amdgcn_s_getreg((3 << 11) | 20) & 0xFu; }
#define XB_SPIN(cond, bar) do { unsigned _sp = 0; while (cond) { __builtin_amdgcn_s_sleep(1); \
    if ((++_sp & 255u) == 0u) { if (xb_ld(&(bar)[XB_TMO])) break; if (_sp > XB_SPIN_CAP) { atomicAdd(&(bar)[XB_TMO], 1u); break; } } } } while (0)

struct XcdBarrier {
    unsigned* bar; unsigned x;
    volatile XLAS unsigned* st;
};

__device__ __forceinline__ XcdBarrier xcd_barrier_post(unsigned* bar, volatile XLAS unsigned* st) {
    XcdBarrier b; b.bar = bar; b.x = xb_xcc_id(); b.st = st;
    if (threadIdx.x == 0) (void)xb_add(&bar[XB_XCNT(b.x)], 1u);
    return b;
}
__device__ __forceinline__ void xcd_barrier_complete(unsigned* bar, unsigned x, unsigned& nloc, unsigned& nx) {
    const unsigned G = gridDim.x * gridDim.y * gridDim.z;
    unsigned sum, cnt, mine, sp = 0u;
    for (;;) {
        sum = 0u; cnt = 0u; mine = 0u;
#pragma unroll
        for (unsigned j = 0; j < 16; ++j) { const unsigned c = xb_ld(&bar[XB_XCNT(j)]); sum += c; cnt += (c > 0u) ? 1u : 0u; mine = (j == x) ? c : mine; }
        if (sum == G) break;
        __builtin_amdgcn_s_sleep(1);
        if ((++sp & 255u) == 0u) { if (xb_ld(&bar[XB_TMO])) break; if (sp > XB_SPIN_CAP) { atomicAdd(&bar[XB_TMO], 1u); break; } }
    }
    nloc = mine > 0u ? mine : 1u; nx = cnt > 0u ? cnt : 1u;
}

__device__ __forceinline__ void xcd_barrier(const XcdBarrier& b) {
    asm volatile("s_waitcnt vmcnt(0)" ::: "memory");
    __syncthreads();
    if (threadIdx.x == 0) {
        unsigned* bar = b.bar;
        __builtin_amdgcn_s_waitcnt(0);
        unsigned nloc = b.st[0], nx = b.st[1];
        if (nloc == 0u) { xcd_barrier_complete(bar, b.x, nloc, nx); b.st[0] = nloc; b.st[1] = nx; }
        const unsigned old = xb_add(&bar[XB_XSUB(b.x)], 1u);
        const unsigned gen = old / nloc;
        if (old + 1u == (gen + 1u) * nloc) {
            __builtin_amdgcn_fence(__ATOMIC_RELEASE, "agent");
            asm volatile("s_waitcnt vmcnt(0)" ::: "memory");
            const unsigned og = xb_add(&bar[XB_TOP], 1u);
            const unsigned tg = og / nx;
            if (og + 1u == (tg + 1u) * nx) xb_add(&bar[XB_TOPGEN], 1u);
            else XB_SPIN(xb_ld(&bar[XB_TOPGEN]) == tg, bar);
            __builtin_amdgcn_fence(__ATOMIC_ACQUIRE, "agent");
            xb_add(&bar[XB_XGEN(b.x)], 1u);
            asm volatile("s_waitcnt vmcnt(0)" ::: "memory");
        } else {
            XB_SPIN(xb_ld(&bar[XB_XGEN(b.x)]) == gen, bar);
            __builtin_amdgcn_fence(__ATOMIC_ACQUIRE, "agent");
            asm volatile("s_waitcnt vmcnt(0)" ::: "memory");
        }
    }
    __syncthreads();
}


__global__ void __launch_bounds__(256, 2) fwd_megakernel(Params p) {
  __shared__ __attribute__((aligned(16))) unsigned char smem[SMEM_BYTES];
  __shared__ uint4 xb_words;
  cg::grid_group grid = cg::this_grid();
  unsigned char* ws = p.ws;
  if (threadIdx.x == 0) xb_words = make_uint4(0u, 0u, 0u, 0u);
  __syncthreads();
  const XcdBarrier xb = xcd_barrier_post((unsigned*)(ws + OFF_BAR), (volatile XLAS unsigned*)&xb_words);
  phase0_misc(p, smem);
  __syncthreads();
  convert_layer(p, 0, 0, smem);
  if (p.ws == nullptr) grid.sync();
  for (int l = 0; l < DEPTH; ++l) {
    const bool need_ctx = l < DEPTH - 1;
    const int MT = need_ctx ? NTOK / 128 : NLAT / 128;
    xcd_barrier(xb);
    if (l > 0) convert_layer(p, l, CONV_EARLY, smem);
    norm_phase(p, l, p.norm1_g + l * D, 0, 1024, NTOK, l == 0);
    xcd_barrier(xb);
    inproj_phase(p, l, smem);
    xcd_barrier(xb);
    mixer_phase(p, l, smem);
    xcd_barrier(xb);
    glu_phase(p, MT, smem);
    xcd_barrier(xb);
    merge_phase(p, MT, smem);
    xcd_barrier(xb);
    resid_phase(p, l, (const bf16_t*)(ws + OFF_M), D, (const bf16_t*)(ws + OFF_W_OUT), 2048, (float*)(ws + OFF_H), MT, smem, l == 0);
    xcd_barrier(xb);
    norm_phase(p, l, p.norm2_g + l * D, 3072, 4096, MT * 128);
    xcd_barrier(xb);
    ff1_phase(p, MT, smem);
    xcd_barrier(xb);
    resid_phase(p, l, (const bf16_t*)(ws + OFF_U), DFF, (const bf16_t*)(ws + OFF_W_FF2), 5120, need_ctx ? (float*)(ws + OFF_H) : p.out, MT, smem);
    if (need_ctx) convert_steal(p, l + 1, smem);
  }
}

extern "C" void kernel_launch(void* const* d_in, const int* in_sizes, int n_in, void* d_out, int out_size, void* d_ws, size_t ws_size, hipStream_t stream) {
  static int grid_blocks = 0;
  if (!grid_blocks) {
    int dev = 0, cus = 0, per_cu = 0;
    (void)hipGetDevice(&dev);
    (void)hipDeviceGetAttribute(&cus, hipDeviceAttributeMultiprocessorCount, dev);
    (void)hipOccupancyMaxActiveBlocksPerMultiprocessor(&per_cu, fwd_megakernel, 256, 0);
    if (per_cu > 2) per_cu = 2;
    if (per_cu < 1) per_cu = 1;
    grid_blocks = cus * per_cu;
  }
  if (ws_size < WS_NEED) { fprintf(stderr, "workspace too small: %zu < %zu\n", ws_size, (size_t)WS_NEED); return; }
  (void)hipMemsetAsync((unsigned char*)d_ws + OFF_BAR, 0, BAR_BYTES, stream);
  Params p{};
  const float* const* in = (const float* const*)d_in;
  p.x = in[0]; p.c = in[1]; p.ctx = in[2]; p.c_ctx = in[3]; p.w_mod = in[4]; p.b_mod = in[5]; p.norm1_g = in[6]; p.norm2_g = in[7]; p.w_in = in[8];
  p.dq_g = in[9]; p.dk_g = in[10]; p.lq1 = in[11]; p.lk1 = in[12]; p.lq2 = in[13]; p.lk2 = in[14]; p.dout_g = in[15];
  p.s5_lre = in[16]; p.s5_lim = in[17]; p.s5_ldt = in[18]; p.s5_bre = in[19]; p.s5_bim = in[20]; p.s5_cre = in[21]; p.s5_cim = in[22]; p.s5_d = in[23]; p.s5_wglu = in[24];
  p.wq_g = in[25]; p.wk_g = in[26]; p.w_sink = in[27];
  p.w_pd = in[28]; p.w_ps = in[29]; p.w_pw = in[30]; p.w_out = in[31]; p.w_ff1 = in[32]; p.w_ff2 = in[33];
  p.out = (float*)d_out; p.ws = (unsigned char*)d_ws;
  void* args[] = {&p};
  hipError_t e = hipLaunchCooperativeKernel((void*)fwd_megakernel, dim3(grid_blocks), dim3(256), args, 0, stream);
  if (e != hipSuccess) fprintf(stderr, "cooperative launch failed: %s (grid %d)\n", hipGetErrorString(e), grid_blocks);
}
```

```cpp
#include <hip/hip_runtime.h>
#include <hip/hip_cooperative_groups.h>
#include <cstdio>
#include <cstdint>
namespace cg = cooperative_groups;

typedef unsigned short bf16_t;
typedef short bf16x8 __attribute__((ext_vector_type(8)));
typedef short bf16x4 __attribute__((ext_vector_type(4)));
typedef float f32x4 __attribute__((ext_vector_type(4)));
typedef float f32x2 __attribute__((ext_vector_type(2)));
typedef unsigned u32x4 __attribute__((ext_vector_type(4)));
typedef unsigned u32x2 __attribute__((ext_vector_type(2)));
typedef __bf16 bf2_t __attribute__((ext_vector_type(2)));

#define DI __device__ __forceinline__
#define MFMA16(a, b, c) __builtin_amdgcn_mfma_f32_16x16x32_bf16((a), (b), (c), 0, 0, 0)

constexpr int D = 1024, NB = 4, SEQ = 4096, DEPTH = 4, CTX = 256, POS = CTX + SEQ  ;
constexpr int NLAT = NB * SEQ  , NCTX = NB * CTX  , NTOK = NLAT + NCTX  ;
constexpr int DIN = 5888, DFF = 4096;
constexpr float EPS = 1e-6f;
constexpr float LOG2E = 1.4426950408889634f;
constexpr int NCH = POS / 32;

constexpr size_t SZ_W_IN = (size_t)DIN * D * 2, SZ_W_GLU = 512 * 512 * 2, SZ_W_P = 1024 * 512 * 2, SZ_W_OUT = (size_t)D * D * 2, SZ_W_FF = (size_t)D * DFF * 2;
constexpr size_t OFF_W_IN = 0;
constexpr size_t OFF_W_GLU = OFF_W_IN + SZ_W_IN;
constexpr size_t OFF_W_PD = OFF_W_GLU + SZ_W_GLU;
constexpr size_t OFF_W_PS = OFF_W_PD + SZ_W_P;
constexpr size_t OFF_W_PW = OFF_W_PS + SZ_W_P;
constexpr size_t OFF_W_OUT = OFF_W_PW + SZ_W_P;
constexpr size_t OFF_W_FF1 = OFF_W_OUT + SZ_W_OUT;
constexpr size_t OFF_W_FF2 = OFF_W_FF1 + SZ_W_FF;
constexpr size_t OFF_MODV = OFF_W_FF2 + SZ_W_FF;
constexpr size_t OFF_ROPE = OFF_MODV + (size_t)DEPTH * 5 * 6144 * 4;
constexpr size_t OFF_LAM = OFF_ROPE + 8192;
constexpr size_t OFF_H = OFF_LAM + 256;
constexpr size_t OFF_ABUF = OFF_H + (size_t)NTOK * D * 4;
constexpr size_t OFF_R1 = OFF_ABUF + (size_t)NTOK * D * 2;
constexpr size_t SZ_HEADBUF = (size_t)NB * 8 * POS * 64 * 2;
constexpr size_t OFF_QD = OFF_R1;
constexpr size_t OFF_KD = OFF_QD + SZ_HEADBUF;
constexpr size_t OFF_VDT = OFF_KD + SZ_HEADBUF;
constexpr size_t OFF_SU = OFF_VDT + SZ_HEADBUF;
constexpr size_t OFF_QW = OFF_SU + (size_t)NTOK * 512 * 2;
constexpr size_t OFF_KW = OFF_QW + SZ_HEADBUF;
constexpr size_t OFF_VWT = OFF_KW + SZ_HEADBUF / 4;
constexpr size_t OFF_GATES = OFF_VWT + SZ_HEADBUF / 4;
constexpr size_t OFF_YD = OFF_GATES + (size_t)NTOK * 3072 * 2;
constexpr size_t OFF_YS = OFF_YD + (size_t)NTOK * 512 * 2;
constexpr size_t OFF_YW = OFF_YS + (size_t)NTOK * 512 * 2;
constexpr size_t OFF_GB = OFF_YW + (size_t)NTOK * 512 * 2;
constexpr size_t OFF_EB = OFF_GB + (size_t)NTOK * 512 * 2;
constexpr size_t OFF_END = OFF_EB + (size_t)NB * 32 * 2 * (NCH + 8) * 64 * 8;
constexpr size_t OFF_BAR = OFF_END;
constexpr size_t BAR_BYTES = 16384;
constexpr size_t WS_NEED = OFF_BAR + BAR_BYTES;
constexpr size_t OFF_M = OFF_QD;
constexpr size_t OFF_U = OFF_R1;
static_assert((size_t)NTOK * DFF * 2 <= OFF_END - OFF_R1, "u alias");

struct Params {
  const float *x, *c, *ctx, *c_ctx, *w_mod, *b_mod, *norm1_g, *norm2_g, *w_in;
  const float *dq_g, *dk_g, *lq1, *lk1, *lq2, *lk2, *dout_g;
  const float *s5_lre, *s5_lim, *s5_ldt, *s5_bre, *s5_bim, *s5_cre, *s5_cim, *s5_d, *s5_wglu;
  const float *wq_g, *wk_g, *w_sink;
  const float *w_pd, *w_ps, *w_pw, *w_out, *w_ff1, *w_ff2;
  float* out;
  unsigned char* ws;
};

DI int get_tid() { int t = threadIdx.x; asm volatile("" : "+v"(t)); return t; }
DI int get_bid() { int b = blockIdx.x; asm volatile("" : "+s"(b)); return b; }
DI unsigned pack2(float lo, float hi) { f32x2 v = {lo, hi}; bf2_t r = __builtin_convertvector(v, bf2_t); return __builtin_bit_cast(unsigned, r); }
DI float sigmoidf_(float x) { return __builtin_amdgcn_rcpf(1.0f + __expf(-x)); }
DI float gelu_tanh(float x) { const float z = 0.7978845608028654f * (x + 0.044715f * x * x * x); const float e = __expf(2.0f * z); const float t = 1.0f - 2.0f * __builtin_amdgcn_rcpf(e + 1.0f); return 0.5f * x * (1.0f + t); }
DI f32x4 ld_bf4(const bf16_t* p_) { const u32x2 r = *(const u32x2*)p_; f32x4 v; v[0] = __uint_as_float(r[0] << 16); v[1] = __uint_as_float(r[0] & 0xffff0000u); v[2] = __uint_as_float(r[1] << 16); v[3] = __uint_as_float(r[1] & 0xffff0000u); return v; }
DI float xshfl(float v, int m) { return __shfl_xor(v, m, 64); }

constexpr int SMEM_BYTES = 65552;
constexpr int LDT = 72;

DI u32x4 gload_async(const void* ptr) { u32x4 r; asm volatile("global_load_dwordx4 %0, %1, off" : "=v"(r) : "v"(ptr) : "memory"); return r; }
DI u32x4 gload_async_s(const void* sbase, unsigned voff) { u32x4 r; asm volatile("global_load_dwordx4 %0, %1, %2" : "=v"(r) : "v"(voff), "s"(sbase) : "memory"); return r; }
#define VM_WAIT8(N, R, Q) asm volatile("s_waitcnt vmcnt(" #N ")" : "+v"(R[0]), "+v"(R[1]), "+v"(R[2]), "+v"(R[3]), "+v"(Q[0]), "+v"(Q[1]), "+v"(Q[2]), "+v"(Q[3]) :: "memory")
template <bool PERM = false, bool SWAP = false>
DI void gemm_mainloop(f32x4 (&acc)[4][4], const bf16_t* __restrict__ A, int lda, const bf16_t* __restrict__ B, int ldb, int K, bf16_t* As, bf16_t* Bs) {
  const int tid = get_tid(), lane = tid & 63, wid = tid >> 6, wr = wid >> 1, wc = wid & 1, lr = lane & 15, lg = lane >> 4;
  const int crow = tid >> 3, ckc = (tid & 7) * 8;
  constexpr int TB = 128 * 64;
  const int swc = (((tid & 7) ^ (crow & 7)) * 8);
  const int swcB = PERM ? (((tid & 7) ^ ((((crow >> 3) & 3) * 2 + ((crow & 7) >> 1)) & 7)) * 8) : swc;
  u32x4 ra0[4], rb0[4], ra1[4], rb1[4];
  unsigned aoff[4], boff[4];
#pragma unroll
  for (int i = 0; i < 4; ++i) { aoff[i] = (unsigned)(((crow + i * 32) * lda + ckc) * 2); boff[i] = (unsigned)(((crow + i * 32) * ldb + ckc) * 2); }
#define GM_LOAD(RA, RB, KOFF) do { const char* ab_ = (const char*)A + (size_t)(KOFF) * 2; const char* bb_ = (const char*)B + (size_t)(KOFF) * 2; \
    _Pragma("unroll") for (int i = 0; i < 4; ++i) { RA[i] = gload_async_s(ab_, aoff[i]); RB[i] = gload_async_s(bb_, boff[i]); } } while (0)
#define GM_STORE(RA, RB, BUF) do { _Pragma("unroll") for (int i = 0; i < 4; ++i) { *(u32x4*)(As + (BUF) * 2 * TB + (crow + i * 32) * 64 + swc) = RA[i]; *(u32x4*)(As + (BUF) * 2 * TB + TB + (crow + i * 32) * 64 + swcB) = RB[i]; } } while (0)
#define GM_COMPUTE(BUF) do { const bf16_t* as_ = As + (BUF) * 2 * TB; const bf16_t* bs_ = as_ + TB; \
    bf16x8 af[2][4], bfr[2][4];     \
    _Pragma("unroll") for (int ks = 0; ks < 2; ++ks) { const int co_ = ((ks * 4 + lg) ^ (lr & 7)) * 8; \
      _Pragma("unroll") for (int mi = 0; mi < 4; ++mi) af[ks][mi] = *(const bf16x8*)(as_ + (wr * 64 + mi * 16 + lr) * 64 + co_); \
      _Pragma("unroll") for (int ni = 0; ni < 4; ++ni) { \
        if (PERM) { const int rw_ = (ni & 1) * 4 + (lr & 3); const int key_ = ((lr >> 2) * 2 + (rw_ >> 1)) & 7; bfr[ks][ni] = *(const bf16x8*)(bs_ + (wc * 64 + (ni >> 1) * 32 + (lr >> 2) * 8 + rw_) * 64 + (((ks * 4 + lg) ^ key_) * 8)); } \
        else bfr[ks][ni] = *(const bf16x8*)(bs_ + (wc * 64 + ni * 16 + lr) * 64 + co_); } } \
    __builtin_amdgcn_sched_barrier(0); \
    __builtin_amdgcn_s_setprio(1); \
    _Pragma("unroll") for (int ks = 0; ks < 2; ++ks) _Pragma("unroll") for (int mi = 0; mi < 4; ++mi) _Pragma("unroll") for (int ni = 0; ni < 4; ++ni) acc[mi][ni] = SWAP ? MFMA16(af[ks][mi], bfr[ks][ni], acc[mi][ni]) : MFMA16(bfr[ks][ni], af[ks][mi], acc[mi][ni]); \
    __builtin_amdgcn_s_setprio(0); \
    __builtin_amdgcn_sched_barrier(0); } while (0)
  asm volatile("s_waitcnt vmcnt(0)" ::: "memory");
  GM_LOAD(ra0, rb0, 0); GM_LOAD(ra1, rb1, 64);
  __syncthreads();
  VM_WAIT8(8, ra0, rb0); GM_STORE(ra0, rb0, 0); GM_LOAD(ra0, rb0, (128 < K ? 128 : 0));
  __syncthreads();
  for (int k0 = 0; k0 < K; k0 += 128) {
    const int kn1 = k0 + 192 < K ? k0 + 192 : 0, kn0 = k0 + 256 < K ? k0 + 256 : 0;
    VM_WAIT8(8, ra1, rb1); GM_STORE(ra1, rb1, 1); GM_LOAD(ra1, rb1, kn1);
    GM_COMPUTE(0); __syncthreads();
    VM_WAIT8(8, ra0, rb0); GM_STORE(ra0, rb0, 0); GM_LOAD(ra0, rb0, kn0);
    GM_COMPUTE(1); __syncthreads();
  }
  VM_WAIT8(0, ra0, rb0); VM_WAIT8(0, ra1, rb1);
#undef GM_LOAD
#undef GM_STORE
#undef GM_COMPUTE
}
DI void zero_acc(f32x4 (&acc)[4][4]) {
#pragma unroll
  for (int mi = 0; mi < 4; ++mi)
#pragma unroll
    for (int ni = 0; ni < 4; ++ni) acc[mi][ni] = (f32x4){0.f, 0.f, 0.f, 0.f};
}

DI void convert_tile(const float* __restrict__ src, int K, int N, bf16_t* __restrict__ dst, int kt, int nt, float* tile) {
  const int tid = get_tid();
  { const int r = tid >> 4, c4 = (tid & 15) * 4;
#pragma unroll
    for (int i = 0; i < 4; ++i) { const int k = r + i * 16; const f32x4 v = *(const f32x4*)(src + (size_t)(kt * 64 + k) * N + nt * 64 + c4);
      tile[k * 65 + c4 + 0] = v[0]; tile[k * 65 + c4 + 1] = v[1]; tile[k * 65 + c4 + 2] = v[2]; tile[k * 65 + c4 + 3] = v[3]; } }
  __syncthreads();
  { const int n = tid >> 2, kc = (tid & 3) * 16; u32x4 o0, o1;
#pragma unroll
    for (int q = 0; q < 4; ++q) { o0[q] = pack2(tile[(kc + 2 * q) * 65 + n], tile[(kc + 2 * q + 1) * 65 + n]); o1[q] = pack2(tile[(kc + 8 + 2 * q) * 65 + n], tile[(kc + 8 + 2 * q + 1) * 65 + n]); }
    bf16_t* d = dst + (size_t)(nt * 64 + n) * K + kt * 64 + kc; *(u32x4*)d = o0; *(u32x4*)(d + 8) = o1; }
  __syncthreads();
}
DI void convert_item(const Params& p, int l, int t, float* tile) {
  unsigned char* ws = p.ws;
  const float* src; bf16_t* dst; int K, N, idx;
  if (t < 1472) { idx = t; src = p.w_in + (size_t)l * D * DIN; K = D; N = DIN; dst = (bf16_t*)(ws + OFF_W_IN); }
  else if (t < 1536) { idx = t - 1472; src = p.s5_wglu + (size_t)l * 512 * 512; K = 512; N = 512; dst = (bf16_t*)(ws + OFF_W_GLU); }
  else if (t < 1664) { idx = t - 1536; src = p.w_pd + (size_t)l * 512 * D; K = 512; N = D; dst = (bf16_t*)(ws + OFF_W_PD); }
  else if (t < 1792) { idx = t - 1664; src = p.w_ps + (size_t)l * 512 * D; K = 512; N = D; dst = (bf16_t*)(ws + OFF_W_PS); }
  else if (t < 1920) { idx = t - 1792; src = p.w_pw + (size_t)l * 512 * D; K = 512; N = D; dst = (bf16_t*)(ws + OFF_W_PW); }
  else if (t < 2176) { idx = t - 1920; src = p.w_out + (size_t)l * D * D; K = D; N = D; dst = (bf16_t*)(ws + OFF_W_OUT); }
  else if (t < 3200) { idx = t - 2176; src = p.w_ff1 + (size_t)l * D * DFF; K = D; N = DFF; dst = (bf16_t*)(ws + OFF_W_FF1); }
  else { idx = t - 3200; src = p.w_ff2 + (size_t)l * DFF * D; K = DFF; N = D; dst = (bf16_t*)(ws + OFF_W_FF2); }
  const int nts = N / 64; convert_tile(src, K, N, dst, idx / nts, idx % nts, tile);
}
constexpr int CONV_EARLY = 3200, CONV_ALL = 4224;
DI void convert_layer(const Params& p, int l, int t_begin, unsigned char* smem) {
  float* tile = (float*)smem;
  for (int t = t_begin + get_bid(); t < CONV_ALL; t += gridDim.x) convert_item(p, l, t, tile);
}
DI void convert_steal(const Params& p, int l, unsigned char* smem) {
  float* tile = (float*)smem;
  volatile int* smw = (volatile int*)(smem + SMEM_BYTES - 16);
  unsigned* ctr = (unsigned*)(p.ws + OFF_LAM) + 48 + l;
  for (;;) {
    __syncthreads();
    if (get_tid() == 0) *smw = (int)atomicAdd(ctr, 1u);
    __syncthreads();
    int t = *smw; t = __builtin_amdgcn_readfirstlane(t);
    if (t >= CONV_EARLY) break;
    convert_item(p, l, t, tile);
  }
}

DI void phase0_misc(const Params& p, unsigned char* smem) {
  unsigned char* ws = p.ws;
  const int tid = get_tid();
  if (get_bid() == 0) {
    float* rope = (float*)(ws + OFF_ROPE);
    for (int i = tid; i < 1024; i += 256) { const int pos = i >> 4, f = i & 15; const float inv = powf(10000.0f, -(float)f / 16.0f); const float ang = (float)pos * inv; rope[i] = cosf(ang); rope[1024 + i] = sinf(ang); }
    if (tid < DEPTH) { const int l = tid; float s1 = 0.f, s2 = 0.f;
      for (int i = 0; i < 64; ++i) { s1 += p.lq1[l * 64 + i] * p.lk1[l * 64 + i]; s2 += p.lq2[l * 64 + i] * p.lk2[l * 64 + i]; }
      const float lam_init = 0.8f - 0.6f * expf(-0.3f * (float)l);
      ((float*)(ws + OFF_LAM))[l] = expf(s1) - expf(s2) + lam_init; }
    if (tid >= 64 && tid < 64 + DEPTH) { const int l = tid - 64; float a = 0.f, b2 = 0.f, c2 = 0.f, d2 = 0.f;
      for (int i = 0; i < 64; ++i) { a = fmaxf(a, fabsf(p.dq_g[l * 64 + i])); b2 = fmaxf(b2, fabsf(p.dk_g[l * 64 + i])); c2 = fmaxf(c2, fabsf(p.wq_g[l * 64 + i])); d2 = fmaxf(d2, fabsf(p.wk_g[l * 64 + i])); }
      ((float*)(ws + OFF_LAM))[4 + l] = 8.0f * LOG2E * 1.02f * a * b2;
      ((float*)(ws + OFF_LAM))[8 + l] = 8.0f * LOG2E * 1.02f * c2 * d2;
      for (int i = 0; i < 8; ++i) ((unsigned*)(ws + OFF_LAM))[16 + l * 8 + i] = 0u;
      ((unsigned*)(ws + OFF_LAM))[48 + l] = 0u; }
  }
  float* sc = (float*)smem;
  float* red = sc + 5 * 1024;
  for (int i = tid; i < 5 * 1024; i += 256) { const int bb = i >> 10, k = i & 1023; const float v = bb < 4 ? p.c[bb * 1024 + k] : p.c_ctx[k]; sc[i] = v / (1.0f + __expf(-v)); }
  __syncthreads();
  float* modv = (float*)(ws + OFF_MODV);
  for (int t = get_bid(); t < DEPTH * 96; t += gridDim.x) {
    const int l = t / 96, cb = t % 96, kq = tid >> 6, cl = tid & 63, col = cb * 64 + cl;
    const float* w = p.w_mod + (size_t)l * D * 6144 + col;
    float s[5] = {0.f, 0.f, 0.f, 0.f, 0.f};
    for (int k = kq * 256; k < kq * 256 + 256; ++k) { const float wv = w[(size_t)k * 6144];
#pragma unroll
      for (int bb = 0; bb < 5; ++bb) s[bb] += sc[bb * 1024 + k] * wv; }
#pragma unroll
    for (int bb = 0; bb < 5; ++bb) red[(kq * 5 + bb) * 64 + cl] = s[bb];
    __syncthreads();
    for (int i = tid; i < 5 * 64; i += 256) { const int bb = i >> 6, c2 = i & 63; const float v = red[(0 * 5 + bb) * 64 + c2] + red[(1 * 5 + bb) * 64 + c2] + red[(2 * 5 + bb) * 64 + c2] + red[(3 * 5 + bb) * 64 + c2];
      modv[((size_t)l * 5 + bb) * 6144 + cb * 64 + c2] = v + p.b_mod[l * 6144 + cb * 64 + c2]; }
    __syncthreads();
  }
}

DI void norm_phase(const Params& p, int l, const float* gvec, int sh_off, int sc_off, int nrows, bool first = false) {
  const int tid = get_tid(), lane = tid & 63, wid = tid >> 6;
  const float* h = (const float*)(p.ws + OFF_H); bf16_t* out = (bf16_t*)(p.ws + OFF_ABUF);
  const float* modv = (const float*)(p.ws + OFF_MODV) + (size_t)l * 5 * 6144;
  for (int t = get_bid(); t < nrows / 4; t += gridDim.x) {
    const int row = t * 4 + wid; const int bb = row < NLAT ? row / SEQ : 4;
    const float* hr = first ? (row < NLAT ? p.x + (size_t)row * D : p.ctx + (size_t)(row - NLAT) * D) : h + (size_t)row * D; const float* mv = modv + bb * 6144;
    f32x4 v[4]; float ss = 0.f;
#pragma unroll
    for (int it = 0; it < 4; ++it) { v[it] = *(const f32x4*)(hr + it * 256 + lane * 4); ss += v[it][0] * v[it][0] + v[it][1] * v[it][1] + v[it][2] * v[it][2] + v[it][3] * v[it][3]; }
#pragma unroll
    for (int m = 1; m < 64; m <<= 1) ss += xshfl(ss, m);
    const float rstd = rsqrtf(ss * (1.0f / 1024.0f) + EPS);
#pragma unroll
    for (int it = 0; it < 4; ++it) { const int idx = it * 256 + lane * 4;
      const f32x4 g = *(const f32x4*)(gvec + idx), s1 = *(const f32x4*)(mv + sc_off + idx), s0 = *(const f32x4*)(mv + sh_off + idx);
      float y[4];
#pragma unroll
      for (int j = 0; j < 4; ++j) y[j] = v[it][j] * rstd * g[j] * (1.0f + s1[j]) + s0[j];
      u32x2 o; o[0] = pack2(y[0], y[1]); o[1] = pack2(y[2], y[3]); *(u32x2*)(out + (size_t)row * D + idx) = o; }
  }
}

DI void inproj_epilogue(const Params& p, int l, const f32x4 (&acc)[4][4], int m0, int n0) {
  unsigned char* ws = p.ws;
  const int tid = get_tid(), lane = tid & 63, wid = tid >> 6, wr = wid >> 1, wc = wid & 1, lr = lane & 15, lg = lane >> 4;
  const bool is_lat = m0 < NLAT;
  int b, i0; if (is_lat) { b = m0 / SEQ; i0 = m0 % SEQ; } else { const int c0 = m0 - NLAT; b = c0 / CTX; i0 = c0 % CTX; }
  const int pos0 = is_lat ? CTX + i0 : i0;
  const int hc = n0 + wc * 64;
  int seg;
  if (n0 < 512) seg = 0; else if (n0 < 1024) seg = 1; else if (n0 < 1536) seg = 2; else if (n0 < 2048) seg = 3; else if (n0 < 2560) seg = 4; else if (n0 < 2688) seg = 5; else if (n0 < 2816) seg = 6; else seg = 7;
  if (seg == 0 || seg == 1 || seg == 4 || seg == 5) {
    const float* gv; bf16_t* dst; float qs = 1.0f;
    if (seg == 0) { const int c = hc; gv = p.dq_g + l * 64; dst = (bf16_t*)(ws + OFF_QD) + ((size_t)((b * 2 + c / 256) * 4 + (c % 256) / 64) * POS) * 64; qs = 0.125f * LOG2E; }
    else if (seg == 1) { const int c = hc - 512; gv = p.dk_g + l * 64; dst = (bf16_t*)(ws + OFF_KD) + ((size_t)((b * 2 + c / 256) * 4 + (c % 256) / 64) * POS) * 64; }
    else if (seg == 4) { const int c = hc - 2048; gv = p.wq_g + l * 64; dst = (bf16_t*)(ws + OFF_QW) + ((size_t)(b * 8 + c / 64) * POS) * 64; qs = 0.125f * LOG2E; }
    else { const int c = hc - 2560; gv = p.wk_g + l * 64; dst = (bf16_t*)(ws + OFF_KW) + ((size_t)(b * 2 + c / 64) * POS) * 64; }
    const float* rope = (const float*)(ws + OFF_ROPE);
    f32x4 gq[4];
#pragma unroll
    for (int ni = 0; ni < 4; ++ni) gq[ni] = *(const f32x4*)(gv + ni * 16 + lg * 4);
#pragma unroll
    for (int mi = 0; mi < 4; ++mi) {
      const int r = wr * 64 + mi * 16 + lr;
      float ss = 0.f;
#pragma unroll
      for (int ni = 0; ni < 4; ++ni)
#pragma unroll
        for (int j = 0; j < 4; ++j) ss += acc[mi][ni][j] * acc[mi][ni][j];
      ss += xshfl(ss, 16); ss += xshfl(ss, 32);
      const float rstd = rsqrtf(ss * (1.0f / 64.0f) + EPS);
      f32x4 v[4];
#pragma unroll
      for (int ni = 0; ni < 4; ++ni) v[ni] = acc[mi][ni] * rstd * gq[ni];
      if (is_lat) {
        const int li = i0 + r, gr = li >> 6, gc = li & 63;
#pragma unroll
        for (int ni = 0; ni < 2; ++ni) {
          const int pi = ni == 0 ? gr : gc;
          const f32x4 cs = *(const f32x4*)(rope + pi * 16 + lg * 4), sn = *(const f32x4*)(rope + 1024 + pi * 16 + lg * 4);
          const f32x4 x1 = v[ni], x2 = v[ni + 2];
          v[ni] = x1 * cs - x2 * sn; v[ni + 2] = x2 * cs + x1 * sn;
        }
      }
      bf16_t* drow = dst + (size_t)(pos0 + r) * 64 + lg * 4;
#pragma unroll
      for (int ni = 0; ni < 4; ++ni) { u32x2 o; o[0] = pack2(v[ni][0] * qs, v[ni][1] * qs); o[1] = pack2(v[ni][2] * qs, v[ni][3] * qs); *(u32x2*)(drow + ni * 16) = o; }
    }
  } else if (seg == 2 || seg == 6) {
#pragma unroll
    for (int mi = 0; mi < 4; ++mi) {
      const int pos = pos0 + wr * 64 + mi * 16 + lr;
#pragma unroll
      for (int ni = 0; ni < 4; ++ni)
#pragma unroll
        for (int j = 0; j < 4; ++j) {
          const int col = hc + ni * 16 + lg * 4 + j; bf16_t* dst;
          if (seg == 2) { const int c = col - 1024; dst = (bf16_t*)(ws + OFF_VDT) + ((size_t)(b * 4 + c / 128) * 128 + (c % 128)) * POS + pos; }
          else { const int c = col - 2688; dst = (bf16_t*)(ws + OFF_VWT) + ((size_t)(b * 2 + c / 64) * 64 + (c % 64)) * POS + pos; }
          *dst = (bf16_t)(pack2(acc[mi][ni][j], 0.f) & 0xffffu);
        }
    }
  } else if (seg == 3) {
    bf16_t* su = (bf16_t*)(ws + OFF_SU);
#pragma unroll
    for (int mi = 0; mi < 4; ++mi) { const int pos = pos0 + wr * 64 + mi * 16 + lr;
#pragma unroll
      for (int ni = 0; ni < 4; ++ni) { u32x2 o; o[0] = pack2(acc[mi][ni][0], acc[mi][ni][1]); o[1] = pack2(acc[mi][ni][2], acc[mi][ni][3]);
        *(u32x2*)(su + ((size_t)(b * 32 + (hc - 1536) / 16 + ni) * POS + pos) * 16 + lg * 4) = o; } }
  } else {
    bf16_t* gt = (bf16_t*)(ws + OFF_GATES);
#pragma unroll
    for (int mi = 0; mi < 4; ++mi) { const int row = m0 + wr * 64 + mi * 16 + lr;
#pragma unroll
      for (int ni = 0; ni < 4; ++ni) { u32x2 o; o[0] = pack2(sigmoidf_(acc[mi][ni][0]), sigmoidf_(acc[mi][ni][1])); o[1] = pack2(sigmoidf_(acc[mi][ni][2]), sigmoidf_(acc[mi][ni][3]));
        *(u32x2*)(gt + (size_t)row * 3072 + (hc - 2816) + ni * 16 + lg * 4) = o; } }
  }
}
DI void inproj_phase(const Params& p, int l, unsigned char* smem) {
  bf16_t* As = (bf16_t*)smem; bf16_t* Bs = As + 128 * LDT;
  const bf16_t* A = (const bf16_t*)(p.ws + OFF_ABUF); const bf16_t* W = (const bf16_t*)(p.ws + OFF_W_IN);
  constexpr int NT = DIN / 128, MT = NTOK / 128;
  for (int t = get_bid(); t < MT * NT; t += gridDim.x) {
    const int mt = t / NT, nt = t % NT;
    f32x4 acc[4][4]; zero_acc(acc);
    const int n0v = nt * 128;
    if ((n0v >= 1024 && n0v < 1536) || (n0v >= 2688 && n0v < 2816)) {
      gemm_mainloop<false, true>(acc, A + (size_t)mt * 128 * D, D, W + (size_t)nt * 128 * D, D, D, As, Bs);
      const int tid_ = get_tid(), lane_ = tid_ & 63, wid_ = tid_ >> 6, wr_ = wid_ >> 1, wc_ = wid_ & 1, lr_ = lane_ & 15, lg_ = lane_ >> 4;
      const int m0 = mt * 128; const bool is_lat = m0 < NLAT;
      int b, i0; if (is_lat) { b = m0 / SEQ; i0 = m0 % SEQ; } else { const int c0 = m0 - NLAT; b = c0 / CTX; i0 = c0 % CTX; }
      const int pos0 = is_lat ? CTX + i0 : i0;
#pragma unroll
      for (int ni = 0; ni < 4; ++ni) {
        const int col = n0v + wc_ * 64 + ni * 16 + lr_;
        bf16_t* drow;
        if (n0v < 1536) { const int c = col - 1024; drow = (bf16_t*)(p.ws + OFF_VDT) + ((size_t)(b * 4 + c / 128) * 128 + (c % 128)) * POS; }
        else { const int c = col - 2688; drow = (bf16_t*)(p.ws + OFF_VWT) + ((size_t)(b * 2 + c / 64) * 64 + (c % 64)) * POS; }
#pragma unroll
        for (int mi = 0; mi < 4; ++mi) { u32x2 o; o[0] = pack2(acc[mi][ni][0], acc[mi][ni][1]); o[1] = pack2(acc[mi][ni][2], acc[mi][ni][3]);
          *(u32x2*)(drow + pos0 + wr_ * 64 + mi * 16 + lg_ * 4) = o; }
      }
    } else {
      gemm_mainloop(acc, A + (size_t)mt * 128 * D, D, W + (size_t)nt * 128 * D, D, D, As, Bs);
      inproj_epilogue(p, l, acc, mt * 128, nt * 128);
    }
  }
}

constexpr int NW = 4;
constexpr int NTHR = NW * 64;
constexpr int QU = NW * 32;
template <int DV, bool TWOK>
DI void attn_core_d1(f32x4 (&O)[2][DV / 16], float (&lsum)[2], const bf16x8 (&Qf)[2][2], float negm,
                  const bf16_t* __restrict__ Kp0, const bf16_t* __restrict__ Kp1, const bf16_t* __restrict__ Vt, int t0, int t1, int tm0, int tm1, int qlat0, unsigned char* smem) {
  constexpr int KB = TWOK ? 16384 : 8192, BUFB = KB + DV * 128;
  constexpr int NKL = (TWOK ? 16 : 8) / NW, NVL = DV / 8 / NW;
  const int tid = get_tid(), lane = tid & 63, wid = __builtin_amdgcn_readfirstlane(tid >> 6), lr = lane & 15, lg = lane >> 4;
  const int rl = lane >> 3, lc = (lane & 7) ^ rl;
  const int n0 = t1 - t0, ntl = n0 + (tm1 - tm0);
  u32x4 rk[NKL], rv[NVL];
#define ATTN_GLOAD(KEY0) do { const int key0_ = (KEY0); \
    _Pragma("unroll") for (int i = 0; i < NKL; ++i) { const int L = wid + i * NW; const bf16_t* kp_ = (i * NW >= 8) ? Kp1 : Kp0; rk[i] = *(const u32x4*)(kp_ + (size_t)(key0_ + (L & 7) * 8 + rl) * 64 + (((lane & 7) ^ ((((L & 3) * 2) + (rl >> 1)) & 7)) * 8)); } \
    _Pragma("unroll") for (int i = 0; i < NVL; ++i) { const int L = wid + i * NW; rv[i] = *(const u32x4*)(Vt + (size_t)(L * 8 + rl) * POS + key0_ + lc * 8); } } while (0)
#define ATTN_LSTORE(BUF) do { unsigned char* buf_ = (BUF); \
    _Pragma("unroll") for (int i = 0; i < NKL; ++i) *(u32x4*)(buf_ + (wid + i * NW) * 1024 + lane * 16) = rk[i]; \
    _Pragma("unroll") for (int i = 0; i < NVL; ++i) *(u32x4*)(buf_ + KB + (wid + i * NW) * 1024 + lane * 16) = rv[i]; } while (0)
  ATTN_GLOAD((n0 > 0 ? t0 : tm0) * 64);
  __syncthreads();
  ATTN_LSTORE(smem);
  const int sw = lr & 7;
  for (int it = 0; it < ntl; ++it) {
    const bool masked = it >= n0;
    const int key0 = (masked ? tm0 + (it - n0) : t0 + it) * 64;
    const unsigned char* Kb = smem + (it & 1) * BUFB; const unsigned char* Vb = Kb + KB;
    __syncthreads();
    if (it + 1 < ntl) ATTN_GLOAD(((it + 1) >= n0 ? tm0 + (it + 1 - n0) : t0 + it + 1) * 64);
    f32x4 s[4][2];
#pragma unroll
    for (int kt = 0; kt < 4; ++kt) {
      const unsigned char* kr = Kb + ((kt >> 1) * 32 + (lr >> 2) * 8 + (kt & 1) * 4 + (lr & 3)) * 128; const int kkey = ((lr >> 2) * 2 + (kt & 1) * 2 + ((lr & 3) >> 1)) & 7;
      if (!TWOK) {
        const bf16x8 k0f = *(const bf16x8*)(kr + ((lg ^ kkey) << 4)), k1f = *(const bf16x8*)(kr + (((4 + lg) ^ kkey) << 4));
#pragma unroll
        for (int qt = 0; qt < 2; ++qt) { f32x4 z = {negm, negm, negm, negm}; z = MFMA16(k0f, Qf[qt][0], z); s[kt][qt] = MFMA16(k1f, Qf[qt][1], z); }
      } else {
#pragma unroll
        for (int qt = 0; qt < 2; ++qt) {
          const bf16x8 k0f = *(const bf16x8*)(kr + qt * 8192 + ((lg ^ kkey) << 4)), k1f = *(const bf16x8*)(kr + qt * 8192 + (((4 + lg) ^ kkey) << 4));
          f32x4 z = {negm, negm, negm, negm}; z = MFMA16(k0f, Qf[qt][0], z); s[kt][qt] = MFMA16(k1f, Qf[qt][1], z); }
      }
    }
    if (masked) {
#pragma unroll
      for (int kt = 0; kt < 4; ++kt)
#pragma unroll
        for (int qt = 0; qt < 2; ++qt)
#pragma unroll
          for (int j = 0; j < 4; ++j) { const int kl = key0 - CTX + (kt >> 1) * 32 + lg * 8 + (kt & 1) * 4 + j, ql = qlat0 + qt * 16 + lr; const int rel = kl - ql; if (rel > 128 || rel < -128) s[kt][qt][j] = -INFINITY; }
    }
    bf16x8 pf[2][2];
#pragma unroll
    for (int qt = 0; qt < 2; ++qt) {
      float rs = 0.f;
#pragma unroll
      for (int kt = 0; kt < 4; ++kt)
#pragma unroll
        for (int j = 0; j < 4; ++j) { const float e = __builtin_amdgcn_exp2f(s[kt][qt][j]); s[kt][qt][j] = e; rs += e; }
      lsum[qt] += rs;
#pragma unroll
      for (int kk = 0; kk < 2; ++kk) {
        u32x4 w; w[0] = pack2(s[2 * kk][qt][0], s[2 * kk][qt][1]); w[1] = pack2(s[2 * kk][qt][2], s[2 * kk][qt][3]);
        w[2] = pack2(s[2 * kk + 1][qt][0], s[2 * kk + 1][qt][1]); w[3] = pack2(s[2 * kk + 1][qt][2], s[2 * kk + 1][qt][3]);
        pf[qt][kk] = __builtin_bit_cast(bf16x8, w);
      }
    }
#pragma unroll
    for (int et = 0; et < DV / 16; ++et)
#pragma unroll
      for (int kk = 0; kk < 2; ++kk) {
        const bf16x8 vf = *(const bf16x8*)(Vb + (et * 16 + lr) * 128 + (((kk * 4 + lg) ^ sw) << 4));
        O[0][et] = MFMA16(vf, pf[0][kk], O[0][et]);
        O[1][et] = MFMA16(vf, pf[1][kk], O[1][et]);
      }
    if (it + 1 < ntl) ATTN_LSTORE(smem + ((it + 1) & 1) * BUFB);
  }
#undef ATTN_GLOAD
#undef ATTN_LSTORE
}

#define VM_WAIT4(N, R, Q) asm volatile("s_waitcnt vmcnt(" #N ")" : "+v"(R[0]), "+v"(R[1]), "+v"(Q[0]), "+v"(Q[1]) :: "memory")
template <int DV, bool TWOK>
DI void attn_core(f32x4 (&O)[2][DV / 16], float (&lsum)[2], const bf16x8 (&Qf)[2][2], float negm,
                  const bf16_t* __restrict__ Kp0, const bf16_t* __restrict__ Kp1, const bf16_t* __restrict__ Vt, int t0, int t1, int tm0, int tm1, int qlat0, unsigned char* smem) {
  constexpr int KB = TWOK ? 16384 : 8192, BUFB = KB + DV * 128;
  constexpr int NKL = (TWOK ? 16 : 8) / NW, NVL = DV / 8 / NW;
  static_assert((NKL == 4 && NVL == 4) || (NKL == 2 && NVL == 2), "wait macros are written for 8 or 4 loads per set");
  const int tid = get_tid(), lane = tid & 63, wid = __builtin_amdgcn_readfirstlane(tid >> 6), lr = lane & 15, lg = lane >> 4;
  const int rl = lane >> 3, lc = (lane & 7) ^ rl;
  const int n0 = t1 - t0, ntl = n0 + (tm1 - tm0);
  u32x4 rk0[NKL], rv0[NVL], rk1[NKL], rv1[NVL];
#define ATTN_TILE(I) ({ int i_ = (I); i_ = i_ < ntl ? i_ : ntl - 1; (i_ < n0 ? t0 + i_ : tm0 + (i_ - n0)) * 64; })
#define ATTN_GLOAD(RK, RV, KEY0) do { const int key0_ = (KEY0); \
    _Pragma("unroll") for (int i = 0; i < NKL; ++i) { const int L = wid + i * NW; const bf16_t* kp_ = (i * NW >= 8) ? Kp1 : Kp0; RK[i] = gload_async(kp_ + (size_t)(key0_ + (L & 7) * 8 + rl) * 64 + (((lane & 7) ^ ((((L & 3) * 2) + (rl >> 1)) & 7)) * 8)); } \
    _Pragma("unroll") for (int i = 0; i < NVL; ++i) { const int L = wid + i * NW; RV[i] = gload_async(Vt + (size_t)(L * 8 + rl) * POS + key0_ + lc * 8); } } while (0)
#define ATTN_LSTORE(RK, RV, BUF) do { unsigned char* buf_ = (BUF); \
    _Pragma("unroll") for (int i = 0; i < NKL; ++i) *(u32x4*)(buf_ + (wid + i * NW) * 1024 + lane * 16) = RK[i]; \
    _Pragma("unroll") for (int i = 0; i < NVL; ++i) *(u32x4*)(buf_ + KB + (wid + i * NW) * 1024 + lane * 16) = RV[i]; } while (0)
#define ATTN_WAIT(RK, RV) do { if constexpr (NKL == 4) VM_WAIT8(8, RK, RV); else VM_WAIT4(4, RK, RV); } while (0)
#define ATTN_DRAIN(RK, RV) do { if constexpr (NKL == 4) VM_WAIT8(0, RK, RV); else VM_WAIT4(0, RK, RV); } while (0)
  const int sw = lr & 7;
#define ATTN_COMPUTE(IT, BUFP) do { const int it_ = (IT); const bool masked = it_ >= n0; const int key0 = (masked ? tm0 + (it_ - n0) : t0 + it_) * 64; \
    const unsigned char* Kb = (BUFP); const unsigned char* Vb = Kb + KB; \
    bf16x8 pf[2][2]; \
    _Pragma("unroll") for (int qt = 0; qt < 2; ++qt) { f32x4 s4[4]; \
      _Pragma("unroll") for (int kt = 0; kt < 4; ++kt) { const unsigned char* kq = Kb + ((kt >> 1) * 32 + (lr >> 2) * 8 + (kt & 1) * 4 + (lr & 3)) * 128 + (TWOK ? qt * 8192 : 0); const int kkey = ((lr >> 2) * 2 + (kt & 1) * 2 + ((lr & 3) >> 1)) & 7; \
        const bf16x8 k0f = *(const bf16x8*)(kq + ((lg ^ kkey) << 4)), k1f = *(const bf16x8*)(kq + (((4 + lg) ^ kkey) << 4)); \
        f32x4 z = {negm, negm, negm, negm}; z = MFMA16(k0f, Qf[qt][0], z); s4[kt] = MFMA16(k1f, Qf[qt][1], z); } \
      if (masked) { \
        _Pragma("unroll") for (int kt = 0; kt < 4; ++kt) _Pragma("unroll") for (int j = 0; j < 4; ++j) { \
          const int kl = key0 - CTX + (kt >> 1) * 32 + lg * 8 + (kt & 1) * 4 + j, ql = qlat0 + qt * 16 + lr; const int rel = kl - ql; if (rel > 128 || rel < -128) s4[kt][j] = -INFINITY; } } \
      float rs = 0.f; \
      _Pragma("unroll") for (int kt = 0; kt < 4; ++kt) _Pragma("unroll") for (int j = 0; j < 4; ++j) { const float e = __builtin_amdgcn_exp2f(s4[kt][j]); s4[kt][j] = e; rs += e; } \
      lsum[qt] += rs; \
      _Pragma("unroll") for (int kk = 0; kk < 2; ++kk) { u32x4 w; w[0] = pack2(s4[2 * kk][0], s4[2 * kk][1]); w[1] = pack2(s4[2 * kk][2], s4[2 * kk][3]); \
        w[2] = pack2(s4[2 * kk + 1][0], s4[2 * kk + 1][1]); w[3] = pack2(s4[2 * kk + 1][2], s4[2 * kk + 1][3]); pf[qt][kk] = __builtin_bit_cast(bf16x8, w); } } \
    _Pragma("unroll") for (int et = 0; et < DV / 16; ++et) _Pragma("unroll") for (int kk = 0; kk < 2; ++kk) { \
        const bf16x8 vf = *(const bf16x8*)(Vb + (et * 16 + lr) * 128 + (((kk * 4 + lg) ^ sw) << 4)); \
        O[0][et] = MFMA16(vf, pf[0][kk], O[0][et]); O[1][et] = MFMA16(vf, pf[1][kk], O[1][et]); } } while (0)
  asm volatile("s_waitcnt vmcnt(0)" ::: "memory");
  ATTN_GLOAD(rk0, rv0, ATTN_TILE(0)); ATTN_GLOAD(rk1, rv1, ATTN_TILE(1));
  __syncthreads();
  ATTN_WAIT(rk0, rv0); ATTN_LSTORE(rk0, rv0, smem); ATTN_GLOAD(rk0, rv0, ATTN_TILE(2));
  for (int it = 0; it < ntl; it += 2) {
    __syncthreads();
    ATTN_COMPUTE(it, smem);
    ATTN_WAIT(rk1, rv1); ATTN_LSTORE(rk1, rv1, smem + BUFB); ATTN_GLOAD(rk1, rv1, ATTN_TILE(it + 3));
    __syncthreads();
    ATTN_COMPUTE(it + 1, smem + BUFB);
    ATTN_WAIT(rk0, rv0); ATTN_LSTORE(rk0, rv0, smem); ATTN_GLOAD(rk0, rv0, ATTN_TILE(it + 4));
  }
  ATTN_DRAIN(rk0, rv0); ATTN_DRAIN(rk1, rv1);
#undef ATTN_TILE
#undef ATTN_GLOAD
#undef ATTN_LSTORE
#undef ATTN_WAIT
#undef ATTN_DRAIN
#undef ATTN_COMPUTE
}

constexpr int QUD = NW * 16;
DI void diff_unit(const Params& p, int l, int b, int hd, bool is_lat, int qi, unsigned char* smem) {
  unsigned char* ws = p.ws;
  const int tid = get_tid(), lane = tid & 63, wid = __builtin_amdgcn_readfirstlane(tid >> 6), lr = lane & 15, lg = lane >> 4;
  const int qpos0 = (is_lat ? CTX + qi * QUD : qi * QUD) + wid * 16;
  const int ntile = is_lat ? POS / 64 : CTX / 64;
  const float lam = ((const float*)(ws + OFF_LAM))[l];
  const float negm = -((const float*)(ws + OFF_LAM))[4 + l];
  const float lam_init = 0.8f - 0.6f * expf(-0.3f * (float)l);
  const size_t hoff0 = (size_t)((b * 2 + 0) * 4 + hd) * POS * 64, hoff1 = (size_t)((b * 2 + 1) * 4 + hd) * POS * 64;
  const bf16_t* Qd = (const bf16_t*)(ws + OFF_QD); const bf16_t* Kd = (const bf16_t*)(ws + OFF_KD);
  bf16x8 Qf[2][2];
#pragma unroll
  for (int ks = 0; ks < 2; ++ks) { Qf[0][ks] = *(const bf16x8*)(Qd + hoff0 + (size_t)(qpos0 + lr) * 64 + ks * 32 + lg * 8); Qf[1][ks] = *(const bf16x8*)(Qd + hoff1 + (size_t)(qpos0 + lr) * 64 + ks * 32 + lg * 8); }
  float lsum[2] = {0.f, 0.f};
  f32x4 O[2][8];
#pragma unroll
  for (int m = 0; m < 2; ++m)
#pragma unroll
    for (int et = 0; et < 8; ++et) O[m][et] = (f32x4){0.f, 0.f, 0.f, 0.f};
  attn_core_d1<128, true>(O, lsum, Qf, negm, Kd + hoff0, Kd + hoff1, (const bf16_t*)(ws + OFF_VDT) + (size_t)(b * 4 + hd) * 128 * POS, 0, ntile, 0, 0, 0, smem);
  float l0 = lsum[0], l1 = lsum[1];
  l0 += xshfl(l0, 16); l0 += xshfl(l0, 32); l1 += xshfl(l1, 16); l1 += xshfl(l1, 32);
  const float i0 = 1.0f / l0, i1 = lam / l1;
  float ss = 0.f;
#pragma unroll
  for (int et = 0; et < 8; ++et) { O[0][et] = O[0][et] * i0 - O[1][et] * i1;
#pragma unroll
    for (int j = 0; j < 4; ++j) ss += O[0][et][j] * O[0][et][j]; }
  ss += xshfl(ss, 16); ss += xshfl(ss, 32);
  const float rs = rsqrtf(ss * (1.0f / 128.0f) + EPS) * (1.0f - lam_init);
  const float* og = p.dout_g + l * 128; bf16_t* yd = (bf16_t*)(ws + OFF_YD);
  const int qpos = qpos0 + lr;
  const int row = is_lat ? b * SEQ + (qpos - CTX) : NLAT + b * CTX + qpos;
#pragma unroll
  for (int et = 0; et < 8; ++et) { const f32x4 g = *(const f32x4*)(og + et * 16 + lg * 4); const f32x4 y = O[0][et] * rs * g;
    u32x2 o; o[0] = pack2(y[0], y[1]); o[1] = pack2(y[2], y[3]); *(u32x2*)(yd + (size_t)row * 512 + hd * 128 + et * 16 + lg * 4) = o; }
}

DI void win_unit(const Params& p, int l, int b, int qh, bool is_lat, int qi, unsigned char* smem) {
  unsigned char* ws = p.ws;
  const int tid = get_tid(), lane = tid & 63, wid = __builtin_amdgcn_readfirstlane(tid >> 6), lr = lane & 15, lg = lane >> 4;
  const int qpos0 = (is_lat ? CTX + qi * QU : qi * QU) + wid * 32;
  const int kv = qh >> 2;
  const bf16_t* Qp = (const bf16_t*)(ws + OFF_QW) + ((size_t)(b * 8 + qh) * POS + qpos0) * 64;
  bf16x8 Qf[2][2];
#pragma unroll
  for (int qt = 0; qt < 2; ++qt)
#pragma unroll
    for (int ks = 0; ks < 2; ++ks) Qf[qt][ks] = *(const bf16x8*)(Qp + (qt * 16 + lr) * 64 + ks * 32 + lg * 8);
  const float sk = p.w_sink[l * 8 + qh] * LOG2E;
  const float mfix = fmaxf(((const float*)(ws + OFF_LAM))[8 + l], sk);
  const float l0 = lg == 0 ? __builtin_amdgcn_exp2f(sk - mfix) : 0.f;
  float lsum[2] = {l0, l0};
  f32x4 O[2][4];
#pragma unroll
  for (int qt = 0; qt < 2; ++qt)
#pragma unroll
    for (int et = 0; et < 4; ++et) O[qt][et] = (f32x4){0.f, 0.f, 0.f, 0.f};
  int tm0 = 0, tm1 = 0;
  if (is_lat) { const int q0 = qi * QU; tm0 = (q0 + 128) / 64; if (tm0 < 4) tm0 = 4; tm1 = (q0 + QU + 384) / 64; if (tm1 > POS / 64) tm1 = POS / 64; }
  attn_core<64, false>(O, lsum, Qf, -mfix, (const bf16_t*)(ws + OFF_KW) + (size_t)(b * 2 + kv) * POS * 64, nullptr, (const bf16_t*)(ws + OFF_VWT) + (size_t)(b * 2 + kv) * 64 * POS, 0, 4, tm0, tm1, qpos0 - CTX, smem);
  bf16_t* yw = (bf16_t*)(ws + OFF_YW);
#pragma unroll
  for (int qt = 0; qt < 2; ++qt) {
    float ls = lsum[qt]; ls += xshfl(ls, 16); ls += xshfl(ls, 32);
    const float inv = 1.0f / ls;
    const int qpos = qpos0 + qt * 16 + lr;
    const int row = is_lat ? b * SEQ + (qpos - CTX) : NLAT + b * CTX + qpos;
#pragma unroll
    for (int et = 0; et < 4; ++et) { const f32x4 y = O[qt][et] * inv; u32x2 o; o[0] = pack2(y[0], y[1]); o[1] = pack2(y[2], y[3]);
      *(u32x2*)(yw + (size_t)row * 512 + qh * 64 + et * 16 + lg * 4) = o; }
  }
}

constexpr int NR = NW / 2, CR = NCH / NR;
constexpr int BST = 20, SST = 136;
constexpr int S5_WAVE_LDS = 128 * BST * 4 + 16 * SST * 2;
constexpr int EB_PER_UNIT = 2 * (NCH + 8) * 64 * 2;
DI int s5_row(int b, int k, int t) { return k < 8 ? NLAT + b * CTX + k * 32 + t : b * SEQ + (k - 8) * 32 + t; }
DI int s5_cmap(int d, int k) { return d == 0 ? k : (k < 8 ? 7 - k : 143 - k); }
DI void s5_make_bf(const Params& p, int l, int d, int g, float fre, float fim, bf16x8 (&Bf)[8], int lr, int lg) {
#pragma unroll
  for (int q = 0; q < 8; ++q) {
    const int pp = 16 * (q & 3) + lr;
    const float fr = __shfl(fre, pp, 64), fi = __shfl(fim, pp, 64);
    u32x4 w = {0u, 0u, 0u, 0u};
    if (lg < 2) {
      const size_t bo = ((size_t)((l * 2 + d) * 32 + g) * 64 + pp) * 16 + lg * 8;
      const f32x4 br0 = *(const f32x4*)(p.s5_bre + bo), br1 = *(const f32x4*)(p.s5_bre + bo + 4), bi0 = *(const f32x4*)(p.s5_bim + bo), bi1 = *(const f32x4*)(p.s5_bim + bo + 4);
      f32x4 v0, v1;
      if (q < 4) { v0 = fr * br0 - fi * bi0; v1 = fr * br1 - fi * bi1; } else { v0 = fr * bi0 + fi * br0; v1 = fr * bi1 + fi * br1; }
      w[0] = pack2(v0[0], v0[1]); w[1] = pack2(v0[2], v0[3]); w[2] = pack2(v1[0], v1[1]); w[3] = pack2(v1[2], v1[3]);
    }
    Bf[q] = __builtin_bit_cast(bf16x8, w);
  }
}
DI u32x4 s5_load_uf(const bf16_t* sug, int k, int tt, int lr, int lg) { u32x4 uw = {0u, 0u, 0u, 0u}; if (lg < 2) uw = *(const u32x4*)(sug + (size_t)(k * 32 + tt * 16 + lr) * 16 + lg * 8); return uw; }
DI void s5_bu_tile(u32x4 uw, const bf16x8 (&Bf)[8], float* Bsm, int lr, int lg) {
  const bf16x8 uf = __builtin_bit_cast(bf16x8, uw);
#pragma unroll
  for (int q = 0; q < 8; ++q) { f32x4 z = {0.f, 0.f, 0.f, 0.f}; z = MFMA16(Bf[q], uf, z);
#pragma unroll
    for (int jj = 0; jj < 4; ++jj) Bsm[(q * 16 + lg * 4 + jj) * BST + lr] = z[jj]; }
}
#define S5_SCAN(D, AR, AI, WRITE) do { \
    _Pragma("unroll") for (int hb = 0; hb < 2; ++hb) { const int cb = ((D) ? 1 - hb : hb) * 2;     \
      const f32x4 br0_ = *(const f32x4*)(Bsm + lane * BST + cb * 4), br1_ = *(const f32x4*)(Bsm + lane * BST + cb * 4 + 4); \
      const f32x4 bi0_ = *(const f32x4*)(Bsm + (64 + lane) * BST + cb * 4), bi1_ = *(const f32x4*)(Bsm + (64 + lane) * BST + cb * 4 + 4); \
      _Pragma("unroll") for (int st = 0; st < 8; ++st) { const int t8 = (D) ? 7 - st : st; const int tl = cb * 4 + t8; \
        const float br = t8 < 4 ? br0_[t8 & 3] : br1_[t8 & 3], bi = t8 < 4 ? bi0_[t8 & 3] : bi1_[t8 & 3]; \
        const float nr = (AR) * sr - (AI) * si + br, ni = (AR) * si + (AI) * sr + bi; sr = nr; si = ni; \
        if (WRITE) { const unsigned pk = pack2(sr, si); Ssm[tl * SST + lane] = (bf16_t)(pk & 0xffffu); Ssm[tl * SST + 64 + lane] = (bf16_t)(pk >> 16); } } } } while (0)
DI void s5_unit(const Params& p, int l, int b, int g, unsigned char* smem) {
  unsigned char* ws = p.ws;
  const int tid = get_tid(), lane = tid & 63, wid = __builtin_amdgcn_readfirstlane(tid >> 6), lr = lane & 15, lg = lane >> 4;
  float* Bsm = (float*)(smem + wid * S5_WAVE_LDS);
  bf16_t* Ssm = (bf16_t*)(smem + wid * S5_WAVE_LDS + 128 * BST * 4);
  const bf16_t* sug = (const bf16_t*)(ws + OFF_SU) + (size_t)(b * 32 + g) * POS * 16;
  float* Eb = (float*)(ws + OFF_EB) + (size_t)(b * 32 + g) * EB_PER_UNIT;
  float are[2], aim[2], fre[2], fim[2];
#pragma unroll
  for (int d = 0; d < 2; ++d) {
    const int pi = ((l * 2 + d) * 32 + g) * 64 + lane;
    const float lre = p.s5_lre[pi], lim = p.s5_lim[pi], dt = expf(p.s5_ldt[(l * 2 + d) * 32 + g]);
    const float mag = expf(lre * dt), ang = lim * dt;
    are[d] = mag * cosf(ang); aim[d] = mag * sinf(ang);
    const float den = lre * lre + lim * lim, nre = are[d] - 1.0f;
    fre[d] = (nre * lre + aim[d] * lim) / den; fim[d] = (aim[d] * lre - nre * lim) / den;
  }
  bf16x8 Bf[2][8];
  s5_make_bf(p, l, 0, g, fre[0], fim[0], Bf[0], lr, lg);
  s5_make_bf(p, l, 1, g, fre[1], fim[1], Bf[1], lr, lg);
  {
    const int d = wid & 1, r = wid >> 1;
    const float ar = d ? are[1] : are[0], ai = d ? aim[1] : aim[0];
    float sr = 0.f, si = 0.f;
    for (int ci = 0; ci < CR; ++ci) {
      const int c = r * CR + ci, k = s5_cmap(d, c);
      { float* e_ = Eb + ((size_t)(d * (NCH + 8) + c) * 64 + lane) * 2; __hip_atomic_store(e_, sr, __ATOMIC_RELAXED, __HIP_MEMORY_SCOPE_AGENT); __hip_atomic_store(e_ + 1, si, __ATOMIC_RELAXED, __HIP_MEMORY_SCOPE_AGENT); }
      const u32x4 ua = s5_load_uf(sug, k, d ? 1 : 0, lr, lg), ub = s5_load_uf(sug, k, d ? 0 : 1, lr, lg);
#pragma unroll
      for (int hh = 0; hh < 2; ++hh) {
        const u32x4 uw = hh ? ub : ua;
        __builtin_amdgcn_wave_barrier();
        if (d) s5_bu_tile(uw, Bf[1], Bsm, lr, lg); else s5_bu_tile(uw, Bf[0], Bsm, lr, lg);
        __builtin_amdgcn_wave_barrier();
        if (d) S5_SCAN(1, ar, ai, false); else S5_SCAN(0, ar, ai, false);
      }
    }
    { float* e_ = Eb + ((size_t)(d * (NCH + 8) + NCH + r) * 64 + lane) * 2; __hip_atomic_store(e_, sr, __ATOMIC_RELAXED, __HIP_MEMORY_SCOPE_AGENT); __hip_atomic_store(e_ + 1, si, __ATOMIC_RELAXED, __HIP_MEMORY_SCOPE_AGENT); }
  }
  asm volatile("s_waitcnt vmcnt(0)" ::: "memory"); __syncthreads();
  bf16x8 Cf[2][4];
  float a32r[2], a32i[2], aCRr[2], aCRi[2];
#pragma unroll
  for (int d = 0; d < 2; ++d) {
#pragma unroll
    for (int ks = 0; ks < 4; ++ks) {
      const float* src = (ks < 2 ? p.s5_cre : p.s5_cim) + ((size_t)((l * 2 + d) * 32 + g) * 16 + lr) * 64 + (ks & 1) * 32 + lg * 8;
      const f32x4 v0 = *(const f32x4*)src, v1 = *(const f32x4*)(src + 4); const float sg = ks < 2 ? 1.0f : -1.0f;
      u32x4 w; w[0] = pack2(sg * v0[0], sg * v0[1]); w[1] = pack2(sg * v0[2], sg * v0[3]); w[2] = pack2(sg * v1[0], sg * v1[1]); w[3] = pack2(sg * v1[2], sg * v1[3]);
      Cf[d][ks] = __builtin_bit_cast(bf16x8, w);
    }
    float pr = are[d], pi_ = aim[d];
#pragma unroll
    for (int q = 0; q < 5; ++q) { const float nr = pr * pr - pi_ * pi_, ni = 2.0f * pr * pi_; pr = nr; pi_ = ni; }
    a32r[d] = pr; a32i[d] = pi_;
    float rr = 1.f, ri = 0.f, br_ = pr, bi_ = pi_;
#pragma unroll
    for (int bit = 0; bit < 7; ++bit) { if ((CR >> bit) & 1) { const float nr = rr * br_ - ri * bi_, ni = rr * bi_ + ri * br_; rr = nr; ri = ni; } const float nr = br_ * br_ - bi_ * bi_, ni = 2.0f * br_ * bi_; br_ = nr; bi_ = ni; }
    aCRr[d] = rr; aCRi[d] = ri;
  }
  const f32x4 dsk = *(const f32x4*)(p.s5_d + l * 512 + g * 16 + lg * 4);
  bf16_t* gb = (bf16_t*)(ws + OFF_GB);
  for (int k = wid; k < NCH; k += NW) {
    f32x4 acc[2] = {{0.f, 0.f, 0.f, 0.f}, {0.f, 0.f, 0.f, 0.f}};
    u32x4 uq[2]; uq[0] = s5_load_uf(sug, k, 0, lr, lg); uq[1] = s5_load_uf(sug, k, 1, lr, lg);
    u32x2 us[2]; us[0] = *(const u32x2*)(sug + (size_t)(k * 32 + lr) * 16 + lg * 4); us[1] = *(const u32x2*)(sug + (size_t)(k * 32 + 16 + lr) * 16 + lg * 4);
    float s0[2][2];
#pragma unroll
    for (int d = 0; d < 2; ++d) { const float* e_ = Eb + ((size_t)(d * (NCH + 8) + s5_cmap(d, k)) * 64 + lane) * 2;
      s0[d][0] = __hip_atomic_load(e_, __ATOMIC_RELAXED, __HIP_MEMORY_SCOPE_AGENT); s0[d][1] = __hip_atomic_load(e_ + 1, __ATOMIC_RELAXED, __HIP_MEMORY_SCOPE_AGENT); }
#pragma unroll
    for (int d = 0; d < 2; ++d) {
      const int c = s5_cmap(d, k), r = c / CR, j = c - r * CR;
      const float* Ed = Eb + (size_t)d * (NCH + 8) * 128 + lane * 2;
      float tr = 0.f, ti = 0.f;
#pragma unroll
      for (int r2 = 0; r2 < NR - 1; ++r2) if (r2 < r) {
        const float er = __hip_atomic_load(Ed + (size_t)(NCH + r2) * 128, __ATOMIC_RELAXED, __HIP_MEMORY_SCOPE_AGENT), ei = __hip_atomic_load(Ed + (size_t)(NCH + r2) * 128 + 1, __ATOMIC_RELAXED, __HIP_MEMORY_SCOPE_AGENT);
        const float nr = aCRr[d] * tr - aCRi[d] * ti + er, ni = aCRr[d] * ti + aCRi[d] * tr + ei; tr = nr; ti = ni; }
      float pr = 1.f, pi_ = 0.f, br_ = a32r[d], bi_ = a32i[d];
      for (int bit = 0; bit < 7; ++bit) { if ((j >> bit) & 1) { const float nr = pr * br_ - pi_ * bi_, ni = pr * bi_ + pi_ * br_; pr = nr; pi_ = ni; } const float nr = br_ * br_ - bi_ * bi_, ni = 2.0f * br_ * bi_; br_ = nr; bi_ = ni; }
      float sr = s0[d][0] + (pr * tr - pi_ * ti), si = s0[d][1] + (pr * ti + pi_ * tr);
#pragma unroll
      for (int hh = 0; hh < 2; ++hh) {
        const int tt = d ? 1 - hh : hh;
        __builtin_amdgcn_wave_barrier();
        s5_bu_tile(uq[tt], Bf[d], Bsm, lr, lg);
        __builtin_amdgcn_wave_barrier();
        if (d) S5_SCAN(1, are[1], aim[1], true); else S5_SCAN(0, are[0], aim[0], true);
        __builtin_amdgcn_wave_barrier();
#pragma unroll
        for (int ks = 0; ks < 4; ++ks) { const bf16x8 sf = *(const bf16x8*)(Ssm + lr * SST + ks * 32 + lg * 8); acc[tt] = MFMA16(Cf[d][ks], sf, acc[tt]); }
      }
    }
#pragma unroll
    for (int tt = 0; tt < 2; ++tt) { const int row = s5_row(b, k, tt * 16 + lr);
      f32x4 u; u[0] = __uint_as_float(us[tt][0] << 16); u[1] = __uint_as_float(us[tt][0] & 0xffff0000u); u[2] = __uint_as_float(us[tt][1] << 16); u[3] = __uint_as_float(us[tt][1] & 0xffff0000u);
      float y[4];
#pragma unroll
      for (int j = 0; j < 4; ++j) y[j] = gelu_tanh(acc[tt][j] + u[j] * dsk[j]);
      u32x2 o; o[0] = pack2(y[0], y[1]); o[1] = pack2(y[2], y[3]); *(u32x2*)(gb + (size_t)row * 512 + g * 16 + lg * 4) = o; }
  }
}

DI void mixer_phase(const Params& p, int l, unsigned char* smem) {
  const bool need_ctx = l < DEPTH - 1;
  volatile int* smw = (volatile int*)(smem + SMEM_BYTES - 16);
  constexpr int QL = SEQ / QU, QC = CTX / QU, QLD = SEQ / QUD, QCD = CTX / QUD;
  const int n_s5 = 16, n_dl = 2 * QLD, n_dc = need_ctx ? 2 * QCD : 0, n_wl = 4 * QL, n_wc = need_ctx ? 4 * QC : 0;
  const int total = n_dl + n_s5 + n_dc + n_wl + n_wc;
  const int x0 = get_bid() & 7;
  for (int dx = 0; dx < 8; ++dx) {
    const int xq = (x0 + dx) & 7;
    unsigned* ctr = (unsigned*)(p.ws + OFF_LAM) + 16 + l * 8 + xq;
    for (;;) {
      __syncthreads();
      if (get_tid() == 0) *smw = (int)atomicAdd(ctr, 1u);
      __syncthreads();
      int u = *smw;
      u = __builtin_amdgcn_readfirstlane(u);
      if (u >= total) break;
      int type, bq, hd, qi; bool is_lat = true;
      if (u < n_s5) { const int idx = xq * 16 + u; type = 1; bq = idx >> 5; hd = idx & 31; qi = 0; }
      else if ((u -= n_s5) < n_dl) { const int gidx = xq + 8 * (u / QLD); type = 0; bq = gidx >> 2; hd = gidx & 3; qi = u % QLD; }
      else if ((u -= n_dl) < n_dc) { const int gidx = xq + 8 * (u / QCD); type = 0; is_lat = false; bq = gidx >> 2; hd = gidx & 3; qi = u % QCD; }
      else if ((u -= n_dc) < n_wl) { type = 2; bq = xq >> 1; hd = (xq & 1) * 4 + (u & 3); qi = u >> 2; }
      else { u -= n_wl; type = 2; is_lat = false; bq = xq >> 1; hd = (xq & 1) * 4 + (u & 3); qi = u >> 2; }
      if (type == 0) diff_unit(p, l, bq, hd, is_lat, qi, smem);
      else if (type == 1) s5_unit(p, l, bq, hd, smem);
      else win_unit(p, l, bq, hd, is_lat, qi, smem);
    }
  }
}

#define EPI_LOOP_BEGIN { const int tid_ = get_tid(), lane_ = tid_ & 63, wid_ = tid_ >> 6, wr_ = wid_ >> 1, wc_ = wid_ & 1, lr_ = lane_ & 15, lg_ = lane_ >> 4; \
  _Pragma("unroll") for (int mi = 0; mi < 4; ++mi) { const int row = m0 + wr_ * 64 + mi * 16 + lr_; \
  _Pragma("unroll") for (int ni = 0; ni < 4; ++ni) { const int col = n0 + wc_ * 64 + ni * 16 + lg_ * 4;
#define EPI_LOOP_END } } }

DI void glu_phase(const Params& p, int MT, unsigned char* smem) {
  bf16_t* As = (bf16_t*)smem; bf16_t* Bs = As + 128 * LDT;
  const bf16_t* G = (const bf16_t*)(p.ws + OFF_GB); const bf16_t* W = (const bf16_t*)(p.ws + OFF_W_GLU); bf16_t* ys = (bf16_t*)(p.ws + OFF_YS);
  constexpr int NT = 4;
  for (int t = get_bid(); t < MT * NT; t += gridDim.x) {
    const int m0 = (t / NT) * 128, n0 = (t % NT) * 128;
    f32x4 acc[4][4]; zero_acc(acc);
    gemm_mainloop(acc, G + (size_t)m0 * 512, 512, W + (size_t)n0 * 512, 512, 512, As, Bs);
    EPI_LOOP_BEGIN
      const u32x2 gr = *(const u32x2*)(G + (size_t)row * 512 + col);
      const float g0 = __uint_as_float(gr[0] << 16), g1 = __uint_as_float(gr[0] & 0xffff0000u), g2 = __uint_as_float(gr[1] << 16), g3 = __uint_as_float(gr[1] & 0xffff0000u);
      u32x2 o; o[0] = pack2(g0 * sigmoidf_(acc[mi][ni][0]), g1 * sigmoidf_(acc[mi][ni][1])); o[1] = pack2(g2 * sigmoidf_(acc[mi][ni][2]), g3 * sigmoidf_(acc[mi][ni][3]));
      *(u32x2*)(ys + (size_t)row * 512 + col) = o;
    EPI_LOOP_END
  }
}
DI void merge_phase(const Params& p, int MT, unsigned char* smem) {
  bf16_t* As = (bf16_t*)smem; bf16_t* Bs = As + 128 * LDT;
  const bf16_t* gt = (const bf16_t*)(p.ws + OFF_GATES); bf16_t* mo = (bf16_t*)(p.ws + OFF_M);
  constexpr int NT = 8;
  for (int t = get_bid(); t < MT * NT; t += gridDim.x) {
    const int m0 = (t / NT) * 128, n0 = (t % NT) * 128;
    f32x4 acc[4][4]; zero_acc(acc);
#pragma unroll 1
    for (int br = 0; br < 3; ++br) {
      const bf16_t* Y = (const bf16_t*)(p.ws + (br == 0 ? OFF_YD : br == 1 ? OFF_YS : OFF_YW));
      const bf16_t* W = (const bf16_t*)(p.ws + (br == 0 ? OFF_W_PD : br == 1 ? OFF_W_PS : OFF_W_PW));
      gemm_mainloop(acc, Y + (size_t)m0 * 512, 512, W + (size_t)n0 * 512, 512, 512, As, Bs);
      if (br < 2) {
        EPI_LOOP_BEGIN
          const f32x4 g0 = ld_bf4(gt + (size_t)row * 3072 + br * 1024 + col), g1 = ld_bf4(gt + (size_t)row * 3072 + (br + 1) * 1024 + col);
#pragma unroll
          for (int j = 0; j < 4; ++j) acc[mi][ni][j] *= fmaxf(g0[j], 1e-30f) * __builtin_amdgcn_rcpf(fmaxf(g1[j], 1e-30f));
        EPI_LOOP_END
      } else {
        EPI_LOOP_BEGIN
          const f32x4 g2 = ld_bf4(gt + (size_t)row * 3072 + 2048 + col);
          u32x2 o; o[0] = pack2(acc[mi][ni][0] * fmaxf(g2[0], 1e-30f), acc[mi][ni][1] * fmaxf(g2[1], 1e-30f)); o[1] = pack2(acc[mi][ni][2] * fmaxf(g2[2], 1e-30f), acc[mi][ni][3] * fmaxf(g2[3], 1e-30f));
          *(u32x2*)(mo + (size_t)row * D + col) = o;
        EPI_LOOP_END
      }
    }
  }
}
DI void resid_phase(const Params& p, int l, const bf16_t* A, int K, const bf16_t* W, int gate_off, float* dst, int MT, unsigned char* smem, bool first = false) {
  bf16_t* As = (bf16_t*)smem; bf16_t* Bs = As + 128 * LDT;
  const float* h = (const float*)(p.ws + OFF_H);
  const float* modv = (const float*)(p.ws + OFF_MODV) + (size_t)l * 5 * 6144;
  constexpr int NT = 8;
  for (int t = get_bid(); t < MT * NT; t += gridDim.x) {
    const int m0 = (t / NT) * 128, n0 = (t % NT) * 128;
    f32x4 acc[4][4]; zero_acc(acc);
    gemm_mainloop(acc, A + (size_t)m0 * K, K, W + (size_t)n0 * K, K, K, As, Bs);
    const int bb = m0 < NLAT ? m0 / SEQ : 4;
    EPI_LOOP_BEGIN
      const f32x4 gv = *(const f32x4*)(modv + bb * 6144 + gate_off + col);
      const f32x4 hv = *(const f32x4*)((first ? (row < NLAT ? p.x + (size_t)row * D : p.ctx + (size_t)(row - NLAT) * D) : h + (size_t)row * D) + col);
      *(f32x4*)(dst + (size_t)row * D + col) = hv + gv * acc[mi][ni];
    EPI_LOOP_END
  }
}
DI void ff1_phase(const Params& p, int MT, unsigned char* smem) {
  bf16_t* As = (bf16_t*)smem; bf16_t* Bs = As + 128 * LDT;
  const bf16_t* A = (const bf16_t*)(p.ws + OFF_ABUF); const bf16_t* W = (const bf16_t*)(p.ws + OFF_W_FF1); bf16_t* uo = (bf16_t*)(p.ws + OFF_U);
  constexpr int NT = DFF / 128;
  for (int t = get_bid(); t < MT * NT; t += gridDim.x) {
    const int m0 = (t / NT) * 128, n0 = (t % NT) * 128;
    f32x4 acc[4][4]; zero_acc(acc);
    gemm_mainloop<true>(acc, A + (size_t)m0 * D, D, W + (size_t)n0 * D, D, D, As, Bs);
    const int tid_ = get_tid(), lane_ = tid_ & 63, wid_ = tid_ >> 6, wr_ = wid_ >> 1, wc_ = wid_ & 1, lr_ = lane_ & 15, lg_ = lane_ >> 4;
#pragma unroll
    for (int mi = 0; mi < 4; ++mi) { const int row = m0 + wr_ * 64 + mi * 16 + lr_;
#pragma unroll
      for (int q = 0; q < 2; ++q) { const int col = n0 + wc_ * 64 + q * 32 + lg_ * 8;
        float r[8];
#pragma unroll
        for (int j = 0; j < 4; ++j) { const float v0 = fmaxf(acc[mi][2 * q][j], 0.f), v1 = fmaxf(acc[mi][2 * q + 1][j], 0.f); r[j] = v0 * v0; r[4 + j] = v1 * v1; }
        u32x4 o; o[0] = pack2(r[0], r[1]); o[1] = pack2(r[2], r[3]); o[2] = pack2(r[4], r[5]); o[3] = pack2(r[6], r[7]);
        *(u32x4*)(uo + (size_t)row * DFF + col) = o; } }
  }
}

#define XB_TMO      128
#define XB_XCNT(j)  (256  + 64 * (j))
#define XB_XSUB(j)  (1280 + 64 * (j))
#define XB_XGEN(j)  (2304 + 64 * (j))
#define XB_TOP      3328
#define XB_TOPGEN   3392
#define XCD_BAR_WORDS 3456
#define XB_SPIN_CAP (1u << 18)
#define XLAS __attribute__((address_space(3)))

__device__ __forceinline__ unsigned xb_ld(unsigned* p)              { return __hip_atomic_load(p, __ATOMIC_RELAXED, __HIP_MEMORY_SCOPE_AGENT); }
__device__ __forceinline__ unsigned xb_add(unsigned* p, unsigned v) { return __hip_atomic_fetch_add(p, v, __ATOMIC_RELAXED, __HIP_MEMORY_SCOPE_AGENT); }
__device__ __forceinline__ unsigned xb_xcc_id() { return (unsigned)__builtin_amdgcn_s_getreg((3 << 11) | 20) & 0xFu; }
#define XB_SPIN(cond, bar) do { unsigned _sp = 0; while (cond) { __builtin_amdgcn_s_sleep(1); \
    if ((++_sp & 255u) == 0u) { if (xb_ld(&(bar)[XB_TMO])) break; if (_sp > XB_SPIN_CAP) { atomicAdd(&(bar)[XB_TMO], 1u); break; } } } } while (0)

struct XcdBarrier {
    unsigned* bar; unsigned x;
    volatile XLAS unsigned* st;
};

__device__ __forceinline__ XcdBarrier xcd_barrier_post(unsigned* bar, volatile XLAS unsigned* st) {
    XcdBarrier b; b.bar = bar; b.x = xb_xcc_id(); b.st = st;
    if (threadIdx.x == 0) (void)xb_add(&bar[XB_XCNT(b.x)], 1u);
    return b;
}
__device__ __forceinline__ void xcd_barrier_complete(unsigned* bar, unsigned x, unsigned& nloc, unsigned& nx) {
    const unsigned G = gridDim.x * gridDim.y * gridDim.z;
    unsigned sum, cnt, mine, sp = 0u;
    for (;;) {
        sum = 0u; cnt = 0u; mine = 0u;
#pragma unroll
        for (unsigned j = 0; j < 16; ++j) { const unsigned c = xb_ld(&bar[XB_XCNT(j)]); sum += c; cnt += (c > 0u) ? 1u : 0u; mine = (j == x) ? c : mine; }
        if (sum == G) break;
        __builtin_amdgcn_s_sleep(1);
        if ((++sp & 255u) == 0u) { if (xb_ld(&bar[XB_TMO])) break; if (sp > XB_SPIN_CAP) { atomicAdd(&bar[XB_TMO], 1u); break; } }
    }
    nloc = mine > 0u ? mine : 1u; nx = cnt > 0u ? cnt : 1u;
}

__device__ __forceinline__ void xcd_barrier(const XcdBarrier& b) {
    asm volatile("s_waitcnt vmcnt(0)" ::: "memory");
    __syncthreads();
    if (threadIdx.x == 0) {
        unsigned* bar = b.bar;
        __builtin_amdgcn_s_waitcnt(0);
        unsigned nloc = b.st[0], nx = b.st[1];
        if (nloc == 0u) { xcd_barrier_complete(bar, b.x, nloc, nx); b.st[0] = nloc; b.st[1] = nx; }
        const unsigned old = xb_add(&bar[XB_XSUB(b.x)], 1u);
        const unsigned gen = old / nloc;
        if (old + 1u == (gen + 1u) * nloc) {
            __builtin_amdgcn_fence(__ATOMIC_RELEASE, "agent");
            asm volatile("s_waitcnt vmcnt(0)" ::: "memory");
            const unsigned og = xb_add(&bar[XB_TOP], 1u);
            const unsigned tg = og / nx;
            if (og + 1u == (tg + 1u) * nx) xb_add(&bar[XB_TOPGEN], 1u);
            else XB_SPIN(xb_ld(&bar[XB_TOPGEN]) == tg, bar);
            __builtin_amdgcn_fence(__ATOMIC_ACQUIRE, "agent");
            xb_add(&bar[XB_XGEN(b.x)], 1u);
            asm volatile("s_waitcnt vmcnt(0)" ::: "memory");
        } else {
            XB_SPIN(xb_ld(&bar[XB_XGEN(b.x)]) == gen, bar);
            __builtin_amdgcn_fence(__ATOMIC_ACQUIRE, "agent");
            asm volatile("s_waitcnt vmcnt(0)" ::: "memory");
        }
    }
    __syncthreads();
}


__global__ void __launch_bounds__(256, 2) fwd_megakernel(Params p) {
  __shared__ __attribute__((aligned(16))) unsigned char smem[SMEM_BYTES];
  __shared__ uint4 xb_words;
  cg::grid_group grid = cg::this_grid();
  unsigned char* ws = p.ws;
  if (threadIdx.x == 0) xb_words = make_uint4(0u, 0u, 0u, 0u);
  __syncthreads();
  const XcdBarrier xb = xcd_barrier_post((unsigned*)(ws + OFF_BAR), (volatile XLAS unsigned*)&xb_words);
  phase0_misc(p, smem);
  __syncthreads();
  convert_layer(p, 0, 0, smem);
  if (p.ws == nullptr) grid.sync();
  for (int l = 0; l < DEPTH; ++l) {
    const bool need_ctx = l < DEPTH - 1;
    const int MT = need_ctx ? NTOK / 128 : NLAT / 128;
    xcd_barrier(xb);
    if (l > 0) convert_layer(p, l, CONV_EARLY, smem);
    norm_phase(p, l, p.norm1_g + l * D, 0, 1024, NTOK, l == 0);
    xcd_barrier(xb);
    inproj_phase(p, l, smem);
    xcd_barrier(xb);
    mixer_phase(p, l, smem);
    xcd_barrier(xb);
    glu_phase(p, MT, smem);
    xcd_barrier(xb);
    merge_phase(p, MT, smem);
    xcd_barrier(xb);
    resid_phase(p, l, (const bf16_t*)(ws + OFF_M), D, (const bf16_t*)(ws + OFF_W_OUT), 2048, (float*)(ws + OFF_H), MT, smem, l == 0);
    xcd_barrier(xb);
    norm_phase(p, l, p.norm2_g + l * D, 3072, 4096, MT * 128);
    xcd_barrier(xb);
    ff1_phase(p, MT, smem);
    xcd_barrier(xb);
    resid_phase(p, l, (const bf16_t*)(ws + OFF_U), DFF, (const bf16_t*)(ws + OFF_W_FF2), 5120, need_ctx ? (float*)(ws + OFF_H) : p.out, MT, smem);
    if (need_ctx) convert_steal(p, l + 1, smem);
  }
}

extern "C" void kernel_launch(void* const* d_in, const int* in_sizes, int n_in, void* d_out, int out_size, void* d_ws, size_t ws_size, hipStream_t stream) {
  static int grid_blocks = 0;
  if (!grid_blocks) {
    int dev = 0, cus = 0, per_cu = 0;
    (void)hipGetDevice(&dev);
    (void)hipDeviceGetAttribute(&cus, hipDeviceAttributeMultiprocessorCount, dev);
    (void)hipOccupancyMaxActiveBlocksPerMultiprocessor(&per_cu, fwd_megakernel, 256, 0);
    if (per_cu > 2) per_cu = 2;
    if (per_cu < 1) per_cu = 1;
    grid_blocks = cus * per_cu;
  }
  if (ws_size < WS_NEED) { fprintf(stderr, "workspace too small: %zu < %zu\n", ws_size, (size_t)WS_NEED); return; }
  (void)hipMemsetAsync((unsigned char*)d_ws + OFF_BAR, 0, BAR_BYTES, stream);
  Params p{};
  const float* const* in = (const float* const*)d_in;
  p.x = in[0]; p.c = in[1]; p.ctx = in[2]; p.c_ctx = in[3]; p.w_mod = in[4]; p.b_mod = in[5]; p.norm1_g = in[6]; p.norm2_g = in[7]; p.w_in = in[8];
  p.dq_g = in[9]; p.dk_g = in[10]; p.lq1 = in[11]; p.lk1 = in[12]; p.lq2 = in[13]; p.lk2 = in[14]; p.dout_g = in[15];
  p.s5_lre = in[16]; p.s5_lim = in[17]; p.s5_ldt = in[18]; p.s5_bre = in[19]; p.s5_bim = in[20]; p.s5_cre = in[21]; p.s5_cim = in[22]; p.s5_d = in[23]; p.s5_wglu = in[24];
  p.wq_g = in[25]; p.wk_g = in[26]; p.w_sink = in[27];
  p.w_pd = in[28]; p.w_ps = in[29]; p.w_pw = in[30]; p.w_out = in[31]; p.w_ff1 = in[32]; p.w_ff2 = in[33];
  p.out = (float*)d_out; p.ws = (unsigned char*)d_ws;
  void* args[] = {&p};
  hipError_t e = hipLaunchCooperativeKernel((void*)fwd_megakernel, dim3(grid_blocks), dim3(256), args, 0, stream);
  if (e != hipSuccess) fprintf(stderr, "cooperative launch failed: %s (grid %d)\n", hipGetErrorString(e), grid_blocks);
}
```

```cpp
#include <hip/hip_runtime.h>
#include <hip/hip_cooperative_groups.h>
#include <cstdio>
#include <cstdint>
namespace cg = cooperative_groups;

typedef unsigned short bf16_t;
typedef short bf16x8 __attribute__((ext_vector_type(8)));
typedef short bf16x4 __attribute__((ext_vector_type(4)));
typedef float f32x4 __attribute__((ext_vector_type(4)));
typedef float f32x2 __attribute__((ext_vector_type(2)));
typedef unsigned u32x4 __attribute__((ext_vector_type(4)));
typedef unsigned u32x2 __attribute__((ext_vector_type(2)));
typedef __bf16 bf2_t __attribute__((ext_vector_type(2)));

#define DI __device__ __forceinline__
#define MFMA16(a, b, c) __builtin_amdgcn_mfma_f32_16x16x32_bf16((a), (b), (c), 0, 0, 0)

constexpr int D = 1024, NB = 4, SEQ = 4096, DEPTH = 4, CTX = 256, POS = CTX + SEQ  ;
constexpr int NLAT = NB * SEQ  , NCTX = NB * CTX  , NTOK = NLAT + NCTX  ;
constexpr int DIN = 5888, DFF = 4096;
constexpr float EPS = 1e-6f;
constexpr float LOG2E = 1.4426950408889634f;
constexpr int NCH = POS / 32;

constexpr size_t SZ_W_IN = (size_t)DIN * D * 2, SZ_W_GLU = 512 * 512 * 2, SZ_W_P = 1024 * 512 * 2, SZ_W_OUT = (size_t)D * D * 2, SZ_W_FF = (size_t)D * DFF * 2;
constexpr size_t OFF_W_IN = 0;
constexpr size_t OFF_W_GLU = OFF_W_IN + SZ_W_IN;
constexpr size_t OFF_W_PD = OFF_W_GLU + SZ_W_GLU;
constexpr size_t OFF_W_PS = OFF_W_PD + SZ_W_P;
constexpr size_t OFF_W_PW = OFF_W_PS + SZ_W_P;
constexpr size_t OFF_W_OUT = OFF_W_PW + SZ_W_P;
constexpr size_t OFF_W_FF1 = OFF_W_OUT + SZ_W_OUT;
constexpr size_t OFF_W_FF2 = OFF_W_FF1 + SZ_W_FF;
constexpr size_t OFF_MODV = OFF_W_FF2 + SZ_W_FF;
constexpr size_t OFF_ROPE = OFF_MODV + (size_t)DEPTH * 5 * 6144 * 4;
constexpr size_t OFF_LAM = OFF_ROPE + 8192;
constexpr size_t OFF_H = OFF_LAM + 256;
constexpr size_t OFF_ABUF = OFF_H + (size_t)NTOK * D * 4;
constexpr size_t OFF_R1 = OFF_ABUF + (size_t)NTOK * D * 2;
constexpr size_t SZ_HEADBUF = (size_t)NB * 8 * POS * 64 * 2;
constexpr size_t OFF_QD = OFF_R1;
constexpr size_t OFF_KD = OFF_QD + SZ_HEADBUF;
constexpr size_t OFF_VDT = OFF_KD + SZ_HEADBUF;
constexpr size_t OFF_SU = OFF_VDT + SZ_HEADBUF;
constexpr size_t OFF_QW = OFF_SU + (size_t)NTOK * 512 * 2;
constexpr size_t OFF_KW = OFF_QW + SZ_HEADBUF;
constexpr size_t OFF_VWT = OFF_KW + SZ_HEADBUF / 4;
constexpr size_t OFF_GATES = OFF_VWT + SZ_HEADBUF / 4;
constexpr size_t OFF_YD = OFF_GATES + (size_t)NTOK * 3072 * 2;
constexpr size_t OFF_YS = OFF_YD + (size_t)NTOK * 512 * 2;
constexpr size_t OFF_YW = OFF_YS + (size_t)NTOK * 512 * 2;
constexpr size_t OFF_GB = OFF_YW + (size_t)NTOK * 512 * 2;
constexpr size_t OFF_EB = OFF_GB + (size_t)NTOK * 512 * 2;
constexpr size_t OFF_END = OFF_EB + (size_t)NB * 32 * 2 * (NCH + 8) * 64 * 8;
constexpr size_t OFF_BAR = OFF_END;
constexpr size_t BAR_BYTES = 16384;
constexpr size_t WS_NEED = OFF_BAR + BAR_BYTES;
constexpr size_t OFF_M = OFF_QD;
constexpr size_t OFF_U = OFF_R1;
static_assert((size_t)NTOK * DFF * 2 <= OFF_END - OFF_R1, "u alias");

struct Params {
  const float *x, *c, *ctx, *c_ctx, *w_mod, *b_mod, *norm1_g, *norm2_g, *w_in;
  const float *dq_g, *dk_g, *lq1, *lk1, *lq2, *lk2, *dout_g;
  const float *s5_lre, *s5_lim, *s5_ldt, *s5_bre, *s5_bim, *s5_cre, *s5_cim, *s5_d, *s5_wglu;
  const float *wq_g, *wk_g, *w_sink;
  const float *w_pd, *w_ps, *w_pw, *w_out, *w_ff1, *w_ff2;
  float* out;
  unsigned char* ws;
};

DI int get_tid() { int t = threadIdx.x; asm volatile("" : "+v"(t)); return t; }
DI int get_bid() { int b = blockIdx.x; asm volatile("" : "+s"(b)); return b; }
DI unsigned pack2(float lo, float hi) { f32x2 v = {lo, hi}; bf2_t r = __builtin_convertvector(v, bf2_t); return __builtin_bit_cast(unsigned, r); }
DI float sigmoidf_(float x) { return __builtin_amdgcn_rcpf(1.0f + __expf(-x)); }
DI float gelu_tanh(float x) { const float z = 0.7978845608028654f * (x + 0.044715f * x * x * x); const float e = __expf(2.0f * z); const float t = 1.0f - 2.0f * __builtin_amdgcn_rcpf(e + 1.0f); return 0.5f * x * (1.0f + t); }
DI f32x4 ld_bf4(const bf16_t* p_) { const u32x2 r = *(const u32x2*)p_; f32x4 v; v[0] = __uint_as_float(r[0] << 16); v[1] = __uint_as_float(r[0] & 0xffff0000u); v[2] = __uint_as_float(r[1] << 16); v[3] = __uint_as_float(r[1] & 0xffff0000u); return v; }
DI float xshfl(float v, int m) { return __shfl_xor(v, m, 64); }

constexpr int SMEM_BYTES = 65552;
constexpr int LDT = 72;

DI u32x4 gload_async(const void* ptr) { u32x4 r; asm volatile("global_load_dwordx4 %0, %1, off" : "=v"(r) : "v"(ptr) : "memory"); return r; }
DI u32x4 gload_async_s(const void* sbase, unsigned voff) { u32x4 r; asm volatile("global_load_dwordx4 %0, %1, %2" : "=v"(r) : "v"(voff), "s"(sbase) : "memory"); return r; }
#define VM_WAIT8(N, R, Q) asm volatile("s_waitcnt vmcnt(" #N ")" : "+v"(R[0]), "+v"(R[1]), "+v"(R[2]), "+v"(R[3]), "+v"(Q[0]), "+v"(Q[1]), "+v"(Q[2]), "+v"(Q[3]) :: "memory")
template <bool PERM = false, bool SWAP = false>
DI void gemm_mainloop(f32x4 (&acc)[4][4], const bf16_t* __restrict__ A, int lda, const bf16_t* __restrict__ B, int ldb, int K, bf16_t* As, bf16_t* Bs) {
  const int tid = get_tid(), lane = tid & 63, wid = tid >> 6, wr = wid >> 1, wc = wid & 1, lr = lane & 15, lg = lane >> 4;
  const int crow = tid >> 3, ckc = (tid & 7) * 8;
  constexpr int TB = 128 * 64;
  const int swc = (((tid & 7) ^ (crow & 7)) * 8);
  const int swcB = PERM ? (((tid & 7) ^ ((((crow >> 3) & 3) * 2 + ((crow & 7) >> 1)) & 7)) * 8) : swc;
  u32x4 ra0[4], rb0[4], ra1[4], rb1[4];
  unsigned aoff[4], boff[4];
#pragma unroll
  for (int i = 0; i < 4; ++i) { aoff[i] = (unsigned)(((crow + i * 32) * lda + ckc) * 2); boff[i] = (unsigned)(((crow + i * 32) * ldb + ckc) * 2); }
#define GM_LOAD(RA, RB, KOFF) do { const char* ab_ = (const char*)A + (size_t)(KOFF) * 2; const char* bb_ = (const char*)B + (size_t)(KOFF) * 2; \
    _Pragma("unroll") for (int i = 0; i < 4; ++i) { RA[i] = gload_async_s(ab_, aoff[i]); RB[i] = gload_async_s(bb_, boff[i]); } } while (0)
#define GM_STORE(RA, RB, BUF) do { _Pragma("unroll") for (int i = 0; i < 4; ++i) { *(u32x4*)(As + (BUF) * 2 * TB + (crow + i * 32) * 64 + swc) = RA[i]; *(u32x4*)(As + (BUF) * 2 * TB + TB + (crow + i * 32) * 64 + swcB) = RB[i]; } } while (0)
#define GM_COMPUTE(BUF) do { const bf16_t* as_ = As + (BUF) * 2 * TB; const bf16_t* bs_ = as_ + TB; \
    bf16x8 af[2][4], bfr[2][4];     \
    _Pragma("unroll") for (int ks = 0; ks < 2; ++ks) { const int co_ = ((ks * 4 + lg) ^ (lr & 7)) * 8; \
      _Pragma("unroll") for (int mi = 0; mi < 4; ++mi) af[ks][mi] = *(const bf16x8*)(as_ + (wr * 64 + mi * 16 + lr) * 64 + co_); \
      _Pragma("unroll") for (int ni = 0; ni < 4; ++ni) { \
        if (PERM) { const int rw_ = (ni & 1) * 4 + (lr & 3); const int key_ = ((lr >> 2) * 2 + (rw_ >> 1)) & 7; bfr[ks][ni] = *(const bf16x8*)(bs_ + (wc * 64 + (ni >> 1) * 32 + (lr >> 2) * 8 + rw_) * 64 + (((ks * 4 + lg) ^ key_) * 8)); } \
        else bfr[ks][ni] = *(const bf16x8*)(bs_ + (wc * 64 + ni * 16 + lr) * 64 + co_); } } \
    __builtin_amdgcn_sched_barrier(0); \
    __builtin_amdgcn_s_setprio(1); \
    _Pragma("unroll") for (int ks = 0; ks < 2; ++ks) _Pragma("unroll") for (int mi = 0; mi < 4; ++mi) _Pragma("unroll") for (int ni = 0; ni < 4; ++ni) acc[mi][ni] = SWAP ? MFMA16(af[ks][mi], bfr[ks][ni], acc[mi][ni]) : MFMA16(bfr[ks][ni], af[ks][mi], acc[mi][ni]); \
    __builtin_amdgcn_s_setprio(0); \
    __builtin_amdgcn_sched_barrier(0); } while (0)
  asm volatile("s_waitcnt vmcnt(0)" ::: "memory");
  GM_LOAD(ra0, rb0, 0); GM_LOAD(ra1, rb1, 64);
  __syncthreads();
  VM_WAIT8(8, ra0, rb0); GM_STORE(ra0, rb0, 0); GM_LOAD(ra0, rb0, (128 < K ? 128 : 0));
  __syncthreads();
  for (int k0 = 0; k0 < K; k0 += 128) {
    const int kn1 = k0 + 192 < K ? k0 + 192 : 0, kn0 = k0 + 256 < K ? k0 + 256 : 0;
    VM_WAIT8(8, ra1, rb1); GM_STORE(ra1, rb1, 1); GM_LOAD(ra1, rb1, kn1);
    GM_COMPUTE(0); __syncthreads();
    VM_WAIT8(8, ra0, rb0); GM_STORE(ra0, rb0, 0); GM_LOAD(ra0, rb0, kn0);
    GM_COMPUTE(1); __syncthreads();
  }
  VM_WAIT8(0, ra0, rb0); VM_WAIT8(0, ra1, rb1);
#undef GM_LOAD
#undef GM_STORE
#undef GM_COMPUTE
}
DI void zero_acc(f32x4 (&acc)[4][4]) {
#pragma unroll
  for (int mi = 0; mi < 4; ++mi)
#pragma unroll
    for (int ni = 0; ni < 4; ++ni) acc[mi][ni] = (f32x4){0.f, 0.f, 0.f, 0.f};
}

DI void convert_tile(const float* __restrict__ src, int K, int N, bf16_t* __restrict__ dst, int kt, int nt, float* tile) {
  const int tid = get_tid();
  { const int r = tid >> 4, c4 = (tid & 15) * 4;
#pragma unroll
    for (int i = 0; i < 4; ++i) { const int k = r + i * 16; const f32x4 v = *(const f32x4*)(src + (size_t)(kt * 64 + k) * N + nt * 64 + c4);
      tile[k * 65 + c4 + 0] = v[0]; tile[k * 65 + c4 + 1] = v[1]; tile[k * 65 + c4 + 2] = v[2]; tile[k * 65 + c4 + 3] = v[3]; } }
  __syncthreads();
  { const int n = tid >> 2, kc = (tid & 3) * 16; u32x4 o0, o1;
#pragma unroll
    for (int q = 0; q < 4; ++q) { o0[q] = pack2(tile[(kc + 2 * q) * 65 + n], tile[(kc + 2 * q + 1) * 65 + n]); o1[q] = pack2(tile[(kc + 8 + 2 * q) * 65 + n], tile[(kc + 8 + 2 * q + 1) * 65 + n]); }
    bf16_t* d = dst + (size_t)(nt * 64 + n) * K + kt * 64 + kc; *(u32x4*)d = o0; *(u32x4*)(d + 8) = o1; }
  __syncthreads();
}
DI void convert_item(const Params& p, int l, int t, float* tile) {
  unsigned char* ws = p.ws;
  const float* src; bf16_t* dst; int K, N, idx;
  if (t < 1472) { idx = t; src = p.w_in + (size_t)l * D * DIN; K = D; N = DIN; dst = (bf16_t*)(ws + OFF_W_IN); }
  else if (t < 1536) { idx = t - 1472; src = p.s5_wglu + (size_t)l * 512 * 512; K = 512; N = 512; dst = (bf16_t*)(ws + OFF_W_GLU); }
  else if (t < 1664) { idx = t - 1536; src = p.w_pd + (size_t)l * 512 * D; K = 512; N = D; dst = (bf16_t*)(ws + OFF_W_PD); }
  else if (t < 1792) { idx = t - 1664; src = p.w_ps + (size_t)l * 512 * D; K = 512; N = D; dst = (bf16_t*)(ws + OFF_W_PS); }
  else if (t < 1920) { idx = t - 1792; src = p.w_pw + (size_t)l * 512 * D; K = 512; N = D; dst = (bf16_t*)(ws + OFF_W_PW); }
  else if (t < 2176) { idx = t - 1920; src = p.w_out + (size_t)l * D * D; K = D; N = D; dst = (bf16_t*)(ws + OFF_W_OUT); }
  else if (t < 3200) { idx = t - 2176; src = p.w_ff1 + (size_t)l * D * DFF; K = D; N = DFF; dst = (bf16_t*)(ws + OFF_W_FF1); }
  else { idx = t - 3200; src = p.w_ff2 + (size_t)l * DFF * D; K = DFF; N = D; dst = (bf16_t*)(ws + OFF_W_FF2); }
  const int nts = N / 64; convert_tile(src, K, N, dst, idx / nts, idx % nts, tile);
}
constexpr int CONV_EARLY = 3200, CONV_ALL = 4224;
DI void convert_layer(const Params& p, int l, int t_begin, unsigned char* smem) {
  float* tile = (float*)smem;
  for (int t = t_begin + get_bid(); t < CONV_ALL; t += gridDim.x) convert_item(p, l, t, tile);
}
DI void convert_steal(const Params& p, int l, unsigned char* smem) {
  float* tile = (float*)smem;
  volatile int* smw = (volatile int*)(smem + SMEM_BYTES - 16);
  unsigned* ctr = (unsigned*)(p.ws + OFF_LAM) + 48 + l;
  for (;;) {
    __syncthreads();
    if (get_tid() == 0) *smw = (int)atomicAdd(ctr, 1u);
    __syncthreads();
    int t = *smw; t = __builtin_amdgcn_readfirstlane(t);
    if (t >= CONV_EARLY) break;
    convert_item(p, l, t, tile);
  }
}

DI void phase0_misc(const Params& p, unsigned char* smem) {
  unsigned char* ws = p.ws;
  const int tid = get_tid();
  if (get_bid() == 0) {
    float* rope = (float*)(ws + OFF_ROPE);
    for (int i = tid; i < 1024; i += 256) { const int pos = i >> 4, f = i & 15; const float inv = powf(10000.0f, -(float)f / 16.0f); const float ang = (float)pos * inv; rope[i] = cosf(ang); rope[1024 + i] = sinf(ang); }
    if (tid < DEPTH) { const int l = tid; float s1 = 0.f, s2 = 0.f;
      for (int i = 0; i < 64; ++i) { s1 += p.lq1[l * 64 + i] * p.lk1[l * 64 + i]; s2 += p.lq2[l * 64 + i] * p.lk2[l * 64 + i]; }
      const float lam_init = 0.8f - 0.6f * expf(-0.3f * (float)l);
      ((float*)(ws + OFF_LAM))[l] = expf(s1) - expf(s2) + lam_init; }
    if (tid >= 64 && tid < 64 + DEPTH) { const int l = tid - 64; float a = 0.f, b2 = 0.f, c2 = 0.f, d2 = 0.f;
      for (int i = 0; i < 64; ++i) { a = fmaxf(a, fabsf(p.dq_g[l * 64 + i])); b2 = fmaxf(b2, fabsf(p.dk_g[l * 64 + i])); c2 = fmaxf(c2, fabsf(p.wq_g[l * 64 + i])); d2 = fmaxf(d2, fabsf(p.wk_g[l * 64 + i])); }
      ((float*)(ws + OFF_LAM))[4 + l] = 8.0f * LOG2E * 1.02f * a * b2;
      ((float*)(ws + OFF_LAM))[8 + l] = 8.0f * LOG2E * 1.02f * c2 * d2;
      for (int i = 0; i < 8; ++i) ((unsigned*)(ws + OFF_LAM))[16 + l * 8 + i] = 0u;
      ((unsigned*)(ws + OFF_LAM))[48 + l] = 0u; }
  }
  float* sc = (float*)smem;
  float* red = sc + 5 * 1024;
  for (int i = tid; i < 5 * 1024; i += 256) { const int bb = i >> 10, k = i & 1023; const float v = bb < 4 ? p.c[bb * 1024 + k] : p.c_ctx[k]; sc[i] = v / (1.0f + __expf(-v)); }
  __syncthreads();
  float* modv = (float*)(ws + OFF_MODV);
  for (int t = get_bid(); t < DEPTH * 96; t += gridDim.x) {
    const int l = t / 96, cb = t % 96, kq = tid >> 6, cl = tid & 63, col = cb * 64 + cl;
    const float* w = p.w_mod + (size_t)l * D * 6144 + col;
    float s[5] = {0.f, 0.f, 0.f, 0.f, 0.f};
    for (int k = kq * 256; k < kq * 256 + 256; ++k) { const float wv = w[(size_t)k * 6144];
#pragma unroll
      for (int bb = 0; bb < 5; ++bb) s[bb] += sc[bb * 1024 + k] * wv; }
#pragma unroll
    for (int bb = 0; bb < 5; ++bb) red[(kq * 5 + bb) * 64 + cl] = s[bb];
    __syncthreads();
    for (int i = tid; i < 5 * 64; i += 256) { const int bb = i >> 6, c2 = i & 63; const float v = red[(0 * 5 + bb) * 64 + c2] + red[(1 * 5 + bb) * 64 + c2] + red[(2 * 5 + bb) * 64 + c2] + red[(3 * 5 + bb) * 64 + c2];
      modv[((size_t)l * 5 + bb) * 6144 + cb * 64 + c2] = v + p.b_mod[l * 6144 + cb * 64 + c2]; }
    __syncthreads();
  }
}

DI void norm_phase(const Params& p, int l, const float* gvec, int sh_off, int sc_off, int nrows, bool first = false) {
  const int tid = get_tid(), lane = tid & 63, wid = tid >> 6;
  const float* h = (const float*)(p.ws + OFF_H); bf16_t* out = (bf16_t*)(p.ws + OFF_ABUF);
  const float* modv = (const float*)(p.ws + OFF_MODV) + (size_t)l * 5 * 6144;
  constexpr int RPW = 4;
  for (int t = get_bid(); t < nrows / (4 * RPW); t += gridDim.x) {
    const int row0 = t * (4 * RPW) + wid * RPW;
    const int bb = row0 < NLAT ? row0 / SEQ : 4;
    const float* mv = modv + bb * 6144;
    f32x4 v[RPW][4];
#pragma unroll
    for (int r = 0; r < RPW; ++r) { const int row = row0 + r;
      const float* hr = first ? (row < NLAT ? p.x + (size_t)row * D : p.ctx + (size_t)(row - NLAT) * D) : h + (size_t)row * D;
#pragma unroll
      for (int it = 0; it < 4; ++it) v[r][it] = *(const f32x4*)(hr + it * 256 + lane * 4); }
    f32x4 gm[4], s0[4];
#pragma unroll
    for (int it = 0; it < 4; ++it) { const int idx = it * 256 + lane * 4;
      const f32x4 g = *(const f32x4*)(gvec + idx), s1 = *(const f32x4*)(mv + sc_off + idx); s0[it] = *(const f32x4*)(mv + sh_off + idx);
      gm[it] = g * (1.0f + s1); }
    float ss[RPW];
#pragma unroll
    for (int r = 0; r < RPW; ++r) { float a = 0.f;
#pragma unroll
      for (int it = 0; it < 4; ++it) a += v[r][it][0] * v[r][it][0] + v[r][it][1] * v[r][it][1] + v[r][it][2] * v[r][it][2] + v[r][it][3] * v[r][it][3];
      ss[r] = a; }
#pragma unroll
    for (int m = 1; m < 64; m <<= 1)
#pragma unroll
      for (int r = 0; r < RPW; ++r) ss[r] += xshfl(ss[r], m);
#pragma unroll
    for (int r = 0; r < RPW; ++r) { const float rstd = rsqrtf(ss[r] * (1.0f / 1024.0f) + EPS);
#pragma unroll
      for (int it = 0; it < 4; ++it) { const int idx = it * 256 + lane * 4;
        const f32x4 y = v[r][it] * rstd * gm[it] + s0[it];
        u32x2 o; o[0] = pack2(y[0], y[1]); o[1] = pack2(y[2], y[3]); *(u32x2*)(out + (size_t)(row0 + r) * D + idx) = o; } }
  }
}

DI void inproj_epilogue(const Params& p, int l, const f32x4 (&acc)[4][4], int m0, int n0) {
  unsigned char* ws = p.ws;
  const int tid = get_tid(), lane = tid & 63, wid = tid >> 6, wr = wid >> 1, wc = wid & 1, lr = lane & 15, lg = lane >> 4;
  const bool is_lat = m0 < NLAT;
  int b, i0; if (is_lat) { b = m0 / SEQ; i0 = m0 % SEQ; } else { const int c0 = m0 - NLAT; b = c0 / CTX; i0 = c0 % CTX; }
  const int pos0 = is_lat ? CTX + i0 : i0;
  const int hc = n0 + wc * 64;
  int seg;
  if (n0 < 512) seg = 0; else if (n0 < 1024) seg = 1; else if (n0 < 1536) seg = 2; else if (n0 < 2048) seg = 3; else if (n0 < 2560) seg = 4; else if (n0 < 2688) seg = 5; else if (n0 < 2816) seg = 6; else seg = 7;
  if (seg == 0 || seg == 1 || seg == 4 || seg == 5) {
    const float* gv; bf16_t* dst; float qs = 1.0f;
    if (seg == 0) { const int c = hc; gv = p.dq_g + l * 64; dst = (bf16_t*)(ws + OFF_QD) + ((size_t)((b * 2 + c / 256) * 4 + (c % 256) / 64) * POS) * 64; qs = 0.125f * LOG2E; }
    else if (seg == 1) { const int c = hc - 512; gv = p.dk_g + l * 64; dst = (bf16_t*)(ws + OFF_KD) + ((size_t)((b * 2 + c / 256) * 4 + (c % 256) / 64) * POS) * 64; }
    else if (seg == 4) { const int c = hc - 2048; gv = p.wq_g + l * 64; dst = (bf16_t*)(ws + OFF_QW) + ((size_t)(b * 8 + c / 64) * POS) * 64; qs = 0.125f * LOG2E; }
    else { const int c = hc - 2560; gv = p.wk_g + l * 64; dst = (bf16_t*)(ws + OFF_KW) + ((size_t)(b * 2 + c / 64) * POS) * 64; }
    const float* rope = (const float*)(ws + OFF_ROPE);
    f32x4 gq[4];
#pragma unroll
    for (int ni = 0; ni < 4; ++ni) gq[ni] = *(const f32x4*)(gv + ni * 16 + lg * 4);
#pragma unroll
    for (int mi = 0; mi < 4; ++mi) {
      const int r = wr * 64 + mi * 16 + lr;
      float ss = 0.f;
#pragma unroll
      for (int ni = 0; ni < 4; ++ni)
#pragma unroll
        for (int j = 0; j < 4; ++j) ss += acc[mi][ni][j] * acc[mi][ni][j];
      ss += xshfl(ss, 16); ss += xshfl(ss, 32);
      const float rstd = rsqrtf(ss * (1.0f / 64.0f) + EPS);
      f32x4 v[4];
#pragma unroll
      for (int ni = 0; ni < 4; ++ni) v[ni] = acc[mi][ni] * rstd * gq[ni];
      if (is_lat) {
        const int li = i0 + r, gr = li >> 6, gc = li & 63;
#pragma unroll
        for (int ni = 0; ni < 2; ++ni) {
          const int pi = ni == 0 ? gr : gc;
          const f32x4 cs = *(const f32x4*)(rope + pi * 16 + lg * 4), sn = *(const f32x4*)(rope + 1024 + pi * 16 + lg * 4);
          const f32x4 x1 = v[ni], x2 = v[ni + 2];
          v[ni] = x1 * cs - x2 * sn; v[ni + 2] = x2 * cs + x1 * sn;
        }
      }
      bf16_t* drow = dst + (size_t)(pos0 + r) * 64 + lg * 4;
#pragma unroll
      for (int ni = 0; ni < 4; ++ni) { u32x2 o; o[0] = pack2(v[ni][0] * qs, v[ni][1] * qs); o[1] = pack2(v[ni][2] * qs, v[ni][3] * qs); *(u32x2*)(drow + ni * 16) = o; }
    }
  } else if (seg == 2 || seg == 6) {
#pragma unroll
    for (int mi = 0; mi < 4; ++mi) {
      const int pos = pos0 + wr * 64 + mi * 16 + lr;
#pragma unroll
      for (int ni = 0; ni < 4; ++ni)
#pragma unroll
        for (int j = 0; j < 4; ++j) {
          const int col = hc + ni * 16 + lg * 4 + j; bf16_t* dst;
          if (seg == 2) { const int c = col - 1024; dst = (bf16_t*)(ws + OFF_VDT) + ((size_t)(b * 4 + c / 128) * 128 + (c % 128)) * POS + pos; }
          else { const int c = col - 2688; dst = (bf16_t*)(ws + OFF_VWT) + ((size_t)(b * 2 + c / 64) * 64 + (c % 64)) * POS + pos; }
          *dst = (bf16_t)(pack2(acc[mi][ni][j], 0.f) & 0xffffu);
        }
    }
  } else if (seg == 3) {
    bf16_t* su = (bf16_t*)(ws + OFF_SU);
#pragma unroll
    for (int mi = 0; mi < 4; ++mi) { const int pos = pos0 + wr * 64 + mi * 16 + lr;
#pragma unroll
      for (int ni = 0; ni < 4; ++ni) { u32x2 o; o[0] = pack2(acc[mi][ni][0], acc[mi][ni][1]); o[1] = pack2(acc[mi][ni][2], acc[mi][ni][3]);
        *(u32x2*)(su + ((size_t)(b * 32 + (hc - 1536) / 16 + ni) * POS + pos) * 16 + lg * 4) = o; } }
  } else {
    bf16_t* gt = (bf16_t*)(ws + OFF_GATES);
#pragma unroll
    for (int mi = 0; mi < 4; ++mi) { const int row = m0 + wr * 64 + mi * 16 + lr;
#pragma unroll
      for (int ni = 0; ni < 4; ++ni) { u32x2 o; o[0] = pack2(sigmoidf_(acc[mi][ni][0]), sigmoidf_(acc[mi][ni][1])); o[1] = pack2(sigmoidf_(acc[mi][ni][2]), sigmoidf_(acc[mi][ni][3]));
        *(u32x2*)(gt + (size_t)row * 3072 + (hc - 2816) + ni * 16 + lg * 4) = o; } }
  }
}
DI void inproj_phase(const Params& p, int l, unsigned char* smem) {
  bf16_t* As = (bf16_t*)smem; bf16_t* Bs = As + 128 * LDT;
  const bf16_t* A = (const bf16_t*)(p.ws + OFF_ABUF); const bf16_t* W = (const bf16_t*)(p.ws + OFF_W_IN);
  constexpr int NT = DIN / 128, MT = NTOK / 128;
  for (int t = get_bid(); t < MT * NT; t += gridDim.x) {
    const int mt = t / NT, nt = t % NT;
    f32x4 acc[4][4]; zero_acc(acc);
    const int n0v = nt * 128;
    if ((n0v >= 1024 && n0v < 1536) || (n0v >= 2688 && n0v < 2816)) {
      gemm_mainloop<false, true>(acc, A + (size_t)mt * 128 * D, D, W + (size_t)nt * 128 * D, D, D, As, Bs);
      const int tid_ = get_tid(), lane_ = tid_ & 63, wid_ = tid_ >> 6, wr_ = wid_ >> 1, wc_ = wid_ & 1, lr_ = lane_ & 15, lg_ = lane_ >> 4;
      const int m0 = mt * 128; const bool is_lat = m0 < NLAT;
      int b, i0; if (is_lat) { b = m0 / SEQ; i0 = m0 % SEQ; } else { const int c0 = m0 - NLAT; b = c0 / CTX; i0 = c0 % CTX; }
      const int pos0 = is_lat ? CTX + i0 : i0;
#pragma unroll
      for (int ni = 0; ni < 4; ++ni) {
        const int col = n0v + wc_ * 64 + ni * 16 + lr_;
        bf16_t* drow;
        if (n0v < 1536) { const int c = col - 1024; drow = (bf16_t*)(p.ws + OFF_VDT) + ((size_t)(b * 4 + c / 128) * 128 + (c % 128)) * POS; }
        else { const int c = col - 2688; drow = (bf16_t*)(p.ws + OFF_VWT) + ((size_t)(b * 2 + c / 64) * 64 + (c % 64)) * POS; }
#pragma unroll
        for (int mi = 0; mi < 4; ++mi) { u32x2 o; o[0] = pack2(acc[mi][ni][0], acc[mi][ni][1]); o[1] = pack2(acc[mi][ni][2], acc[mi][ni][3]);
          *(u32x2*)(drow + pos0 + wr_ * 64 + mi * 16 + lg_ * 4) = o; }
      }
    } else {
      gemm_mainloop(acc, A + (size_t)mt * 128 * D, D, W + (size_t)nt * 128 * D, D, D, As, Bs);
      inproj_epilogue(p, l, acc, mt * 128, nt * 128);
    }
  }
}

constexpr int NW = 4;
constexpr int NTHR = NW * 64;
constexpr int QU = NW * 32;
template <int DV, bool TWOK>
DI void attn_core_d1(f32x4 (&O)[2][DV / 16], float (&lsum)[2], const bf16x8 (&Qf)[2][2], float negm,
                  const bf16_t* __restrict__ Kp0, const bf16_t* __restrict__ Kp1, const bf16_t* __restrict__ Vt, int t0, int t1, int tm0, int tm1, int qlat0, unsigned char* smem) {
  constexpr int KB = TWOK ? 16384 : 8192, BUFB = KB + DV * 128;
  constexpr int NKL = (TWOK ? 16 : 8) / NW, NVL = DV / 8 / NW;
  const int tid = get_tid(), lane = tid & 63, wid = __builtin_amdgcn_readfirstlane(tid >> 6), lr = lane & 15, lg = lane >> 4;
  const int rl = lane >> 3, lc = (lane & 7) ^ rl;
  const int n0 = t1 - t0, ntl = n0 + (tm1 - tm0);
  u32x4 rk[NKL], rv[NVL];
#define ATTN_GLOAD(KEY0) do { const int key0_ = (KEY0); \
    _Pragma("unroll") for (int i = 0; i < NKL; ++i) { const int L = wid + i * NW; const bf16_t* kp_ = (i * NW >= 8) ? Kp1 : Kp0; rk[i] = *(const u32x4*)(kp_ + (size_t)(key0_ + (L & 7) * 8 + rl) * 64 + (((lane & 7) ^ ((((L & 3) * 2) + (rl >> 1)) & 7)) * 8)); } \
    _Pragma("unroll") for (int i = 0; i < NVL; ++i) { const int L = wid + i * NW; rv[i] = *(const u32x4*)(Vt + (size_t)(L * 8 + rl) * POS + key0_ + lc * 8); } } while (0)
#define ATTN_LSTORE(BUF) do { unsigned char* buf_ = (BUF); \
    _Pragma("unroll") for (int i = 0; i < NKL; ++i) *(u32x4*)(buf_ + (wid + i * NW) * 1024 + lane * 16) = rk[i]; \
    _Pragma("unroll") for (int i = 0; i < NVL; ++i) *(u32x4*)(buf_ + KB + (wid + i * NW) * 1024 + lane * 16) = rv[i]; } while (0)
  ATTN_GLOAD((n0 > 0 ? t0 : tm0) * 64);
  __syncthreads();
  ATTN_LSTORE(smem);
  const int sw = lr & 7;
  for (int it = 0; it < ntl; ++it) {
    const bool masked = it >= n0;
    const int key0 = (masked ? tm0 + (it - n0) : t0 + it) * 64;
    const unsigned char* Kb = smem + (it & 1) * BUFB; const unsigned char* Vb = Kb + KB;
    __syncthreads();
    if (it + 1 < ntl) ATTN_GLOAD(((it + 1) >= n0 ? tm0 + (it + 1 - n0) : t0 + it + 1) * 64);
    f32x4 s[4][2];
#pragma unroll
    for (int kt = 0; kt < 4; ++kt) {
      const unsigned char* kr = Kb + ((kt >> 1) * 32 + (lr >> 2) * 8 + (kt & 1) * 4 + (lr & 3)) * 128; const int kkey = ((lr >> 2) * 2 + (kt & 1) * 2 + ((lr & 3) >> 1)) & 7;
      if (!TWOK) {
        const bf16x8 k0f = *(const bf16x8*)(kr + ((lg ^ kkey) << 4)), k1f = *(const bf16x8*)(kr + (((4 + lg) ^ kkey) << 4));
#pragma unroll
        for (int qt = 0; qt < 2; ++qt) { f32x4 z = {negm, negm, negm, negm}; z = MFMA16(k0f, Qf[qt][0], z); s[kt][qt] = MFMA16(k1f, Qf[qt][1], z); }
      } else {
#pragma unroll
        for (int qt = 0; qt < 2; ++qt) {
          const bf16x8 k0f = *(const bf16x8*)(kr + qt * 8192 + ((lg ^ kkey) << 4)), k1f = *(const bf16x8*)(kr + qt * 8192 + (((4 + lg) ^ kkey) << 4));
          f32x4 z = {negm, negm, negm, negm}; z = MFMA16(k0f, Qf[qt][0], z); s[kt][qt] = MFMA16(k1f, Qf[qt][1], z); }
      }
    }
    if (masked) {
#pragma unroll
      for (int kt = 0; kt < 4; ++kt)
#pragma unroll
        for (int qt = 0; qt < 2; ++qt)
#pragma unroll
          for (int j = 0; j < 4; ++j) { const int kl = key0 - CTX + (kt >> 1) * 32 + lg * 8 + (kt & 1) * 4 + j, ql = qlat0 + qt * 16 + lr; const int rel = kl - ql; if (rel > 128 || rel < -128) s[kt][qt][j] = -INFINITY; }
    }
    bf16x8 pf[2][2];
#pragma unroll
    for (int qt = 0; qt < 2; ++qt) {
      float rs = 0.f;
#pragma unroll
      for (int kt = 0; kt < 4; ++kt)
#pragma unroll
        for (int j = 0; j < 4; ++j) { const float e = __builtin_amdgcn_exp2f(s[kt][qt][j]); s[kt][qt][j] = e; rs += e; }
      lsum[qt] += rs;
#pragma unroll
      for (int kk = 0; kk < 2; ++kk) {
        u32x4 w; w[0] = pack2(s[2 * kk][qt][0], s[2 * kk][qt][1]); w[1] = pack2(s[2 * kk][qt][2], s[2 * kk][qt][3]);
        w[2] = pack2(s[2 * kk + 1][qt][0], s[2 * kk + 1][qt][1]); w[3] = pack2(s[2 * kk + 1][qt][2], s[2 * kk + 1][qt][3]);
        pf[qt][kk] = __builtin_bit_cast(bf16x8, w);
      }
    }
#pragma unroll
    for (int et = 0; et < DV / 16; ++et)
#pragma unroll
      for (int kk = 0; kk < 2; ++kk) {
        const bf16x8 vf = *(const bf16x8*)(Vb + (et * 16 + lr) * 128 + (((kk * 4 + lg) ^ sw) << 4));
        O[0][et] = MFMA16(vf, pf[0][kk], O[0][et]);
        O[1][et] = MFMA16(vf, pf[1][kk], O[1][et]);
      }
    if (it + 1 < ntl) ATTN_LSTORE(smem + ((it + 1) & 1) * BUFB);
  }
#undef ATTN_GLOAD
#undef ATTN_LSTORE
}

#define VM_WAIT4(N, R, Q) asm volatile("s_waitcnt vmcnt(" #N ")" : "+v"(R[0]), "+v"(R[1]), "+v"(Q[0]), "+v"(Q[1]) :: "memory")
template <int DV, bool TWOK>
DI void attn_core(f32x4 (&O)[2][DV / 16], float (&lsum)[2], const bf16x8 (&Qf)[2][2], float negm,
                  const bf16_t* __restrict__ Kp0, const bf16_t* __restrict__ Kp1, const bf16_t* __restrict__ Vt, int t0, int t1, int tm0, int tm1, int qlat0, unsigned char* smem) {
  constexpr int KB = TWOK ? 16384 : 8192, BUFB = KB + DV * 128;
  constexpr int NKL = (TWOK ? 16 : 8) / NW, NVL = DV / 8 / NW;
  static_assert((NKL == 4 && NVL == 4) || (NKL == 2 && NVL == 2), "wait macros are written for 8 or 4 loads per set");
  const int tid = get_tid(), lane = tid & 63, wid = __builtin_amdgcn_readfirstlane(tid >> 6), lr = lane & 15, lg = lane >> 4;
  const int rl = lane >> 3, lc = (lane & 7) ^ rl;
  const int n0 = t1 - t0, ntl = n0 + (tm1 - tm0);
  u32x4 rk0[NKL], rv0[NVL], rk1[NKL], rv1[NVL];
#define ATTN_TILE(I) ({ int i_ = (I); i_ = i_ < ntl ? i_ : ntl - 1; (i_ < n0 ? t0 + i_ : tm0 + (i_ - n0)) * 64; })
#define ATTN_GLOAD(RK, RV, KEY0) do { const int key0_ = (KEY0); \
    _Pragma("unroll") for (int i = 0; i < NKL; ++i) { const int L = wid + i * NW; const bf16_t* kp_ = (i * NW >= 8) ? Kp1 : Kp0; RK[i] = gload_async(kp_ + (size_t)(key0_ + (L & 7) * 8 + rl) * 64 + (((lane & 7) ^ ((((L & 3) * 2) + (rl >> 1)) & 7)) * 8)); } \
    _Pragma("unroll") for (int i = 0; i < NVL; ++i) { const int L = wid + i * NW; RV[i] = gload_async(Vt + (size_t)(L * 8 + rl) * POS + key0_ + lc * 8); } } while (0)
#define ATTN_LSTORE(RK, RV, BUF) do { unsigned char* buf_ = (BUF); \
    _Pragma("unroll") for (int i = 0; i < NKL; ++i) *(u32x4*)(buf_ + (wid + i * NW) * 1024 + lane * 16) = RK[i]; \
    _Pragma("unroll") for (int i = 0; i < NVL; ++i) *(u32x4*)(buf_ + KB + (wid + i * NW) * 1024 + lane * 16) = RV[i]; } while (0)
#define ATTN_WAIT(RK, RV) do { if constexpr (NKL == 4) VM_WAIT8(8, RK, RV); else VM_WAIT4(4, RK, RV); } while (0)
#define ATTN_DRAIN(RK, RV) do { if constexpr (NKL == 4) VM_WAIT8(0, RK, RV); else VM_WAIT4(0, RK, RV); } while (0)
  const int sw = lr & 7;
#define ATTN_COMPUTE(IT, BUFP) do { const int it_ = (IT); const bool masked = it_ >= n0; const int key0 = (masked ? tm0 + (it_ - n0) : t0 + it_) * 64; \
    const unsigned char* Kb = (BUFP); const unsigned char* Vb = Kb + KB; \
    bf16x8 pf[2][2]; \
    _Pragma("unroll") for (int qt = 0; qt < 2; ++qt) { f32x4 s4[4]; \
      _Pragma("unroll") for (int kt = 0; kt < 4; ++kt) { const unsigned char* kq = Kb + ((kt >> 1) * 32 + (lr >> 2) * 8 + (kt & 1) * 4 + (lr & 3)) * 128 + (TWOK ? qt * 8192 : 0); const int kkey = ((lr >> 2) * 2 + (kt & 1) * 2 + ((lr & 3) >> 1)) & 7; \
        const bf16x8 k0f = *(const bf16x8*)(kq + ((lg ^ kkey) << 4)), k1f = *(const bf16x8*)(kq + (((4 + lg) ^ kkey) << 4)); \
        f32x4 z = {negm, negm, negm, negm}; z = MFMA16(k0f, Qf[qt][0], z); s4[kt] = MFMA16(k1f, Qf[qt][1], z); } \
      if (masked) { \
        _Pragma("unroll") for (int kt = 0; kt < 4; ++kt) _Pragma("unroll") for (int j = 0; j < 4; ++j) { \
          const int kl = key0 - CTX + (kt >> 1) * 32 + lg * 8 + (kt & 1) * 4 + j, ql = qlat0 + qt * 16 + lr; const int rel = kl - ql; if (rel > 128 || rel < -128) s4[kt][j] = -INFINITY; } } \
      float rs = 0.f; \
      _Pragma("unroll") for (int kt = 0; kt < 4; ++kt) _Pragma("unroll") for (int j = 0; j < 4; ++j) { const float e = __builtin_amdgcn_exp2f(s4[kt][j]); s4[kt][j] = e; rs += e; } \
      lsum[qt] += rs; \
      _Pragma("unroll") for (int kk = 0; kk < 2; ++kk) { u32x4 w; w[0] = pack2(s4[2 * kk][0], s4[2 * kk][1]); w[1] = pack2(s4[2 * kk][2], s4[2 * kk][3]); \
        w[2] = pack2(s4[2 * kk + 1][0], s4[2 * kk + 1][1]); w[3] = pack2(s4[2 * kk + 1][2], s4[2 * kk + 1][3]); pf[qt][kk] = __builtin_bit_cast(bf16x8, w); } } \
    _Pragma("unroll") for (int et = 0; et < DV / 16; ++et) _Pragma("unroll") for (int kk = 0; kk < 2; ++kk) { \
        const bf16x8 vf = *(const bf16x8*)(Vb + (et * 16 + lr) * 128 + (((kk * 4 + lg) ^ sw) << 4)); \
        O[0][et] = MFMA16(vf, pf[0][kk], O[0][et]); O[1][et] = MFMA16(vf, pf[1][kk], O[1][et]); } } while (0)
  asm volatile("s_waitcnt vmcnt(0)" ::: "memory");
  ATTN_GLOAD(rk0, rv0, ATTN_TILE(0)); ATTN_GLOAD(rk1, rv1, ATTN_TILE(1));
  __syncthreads();
  ATTN_WAIT(rk0, rv0); ATTN_LSTORE(rk0, rv0, smem); ATTN_GLOAD(rk0, rv0, ATTN_TILE(2));
  for (int it = 0; it < ntl; it += 2) {
    __syncthreads();
    ATTN_COMPUTE(it, smem);
    ATTN_WAIT(rk1, rv1); ATTN_LSTORE(rk1, rv1, smem + BUFB); ATTN_GLOAD(rk1, rv1, ATTN_TILE(it + 3));
    __syncthreads();
    ATTN_COMPUTE(it + 1, smem + BUFB);
    ATTN_WAIT(rk0, rv0); ATTN_LSTORE(rk0, rv0, smem); ATTN_GLOAD(rk0, rv0, ATTN_TILE(it + 4));
  }
  ATTN_DRAIN(rk0, rv0); ATTN_DRAIN(rk1, rv1);
#undef ATTN_TILE
#undef ATTN_GLOAD
#undef ATTN_LSTORE
#undef ATTN_WAIT
#undef ATTN_DRAIN
#undef ATTN_COMPUTE
}

constexpr int QUD = NW * 16;
DI void diff_unit(const Params& p, int l, int b, int hd, bool is_lat, int qi, unsigned char* smem) {
  unsigned char* ws = p.ws;
  const int tid = get_tid(), lane = tid & 63, wid = __builtin_amdgcn_readfirstlane(tid >> 6), lr = lane & 15, lg = lane >> 4;
  const int qpos0 = (is_lat ? CTX + qi * QUD : qi * QUD) + wid * 16;
  const int ntile = is_lat ? POS / 64 : CTX / 64;
  const float lam = ((const float*)(ws + OFF_LAM))[l];
  const float negm = -((const float*)(ws + OFF_LAM))[4 + l];
  const float lam_init = 0.8f - 0.6f * expf(-0.3f * (float)l);
  const size_t hoff0 = (size_t)((b * 2 + 0) * 4 + hd) * POS * 64, hoff1 = (size_t)((b * 2 + 1) * 4 + hd) * POS * 64;
  const bf16_t* Qd = (const bf16_t*)(ws + OFF_QD); const bf16_t* Kd = (const bf16_t*)(ws + OFF_KD);
  bf16x8 Qf[2][2];
#pragma unroll
  for (int ks = 0; ks < 2; ++ks) { Qf[0][ks] = *(const bf16x8*)(Qd + hoff0 + (size_t)(qpos0 + lr) * 64 + ks * 32 + lg * 8); Qf[1][ks] = *(const bf16x8*)(Qd + hoff1 + (size_t)(qpos0 + lr) * 64 + ks * 32 + lg * 8); }
  float lsum[2] = {0.f, 0.f};
  f32x4 O[2][8];
#pragma unroll
  for (int m = 0; m < 2; ++m)
#pragma unroll
    for (int et = 0; et < 8; ++et) O[m][et] = (f32x4){0.f, 0.f, 0.f, 0.f};
  attn_core_d1<128, true>(O, lsum, Qf, negm, Kd + hoff0, Kd + hoff1, (const bf16_t*)(ws + OFF_VDT) + (size_t)(b * 4 + hd) * 128 * POS, 0, ntile, 0, 0, 0, smem);
  float l0 = lsum[0], l1 = lsum[1];
  l0 += xshfl(l0, 16); l0 += xshfl(l0, 32); l1 += xshfl(l1, 16); l1 += xshfl(l1, 32);
  const float i0 = 1.0f / l0, i1 = lam / l1;
  float ss = 0.f;
#pragma unroll
  for (int et = 0; et < 8; ++et) { O[0][et] = O[0][et] * i0 - O[1][et] * i1;
#pragma unroll
    for (int j = 0; j < 4; ++j) ss += O[0][et][j] * O[0][et][j]; }
  ss += xshfl(ss, 16); ss += xshfl(ss, 32);
  const float rs = rsqrtf(ss * (1.0f / 128.0f) + EPS) * (1.0f - lam_init);
  const float* og = p.dout_g + l * 128; bf16_t* yd = (bf16_t*)(ws + OFF_YD);
  const int qpos = qpos0 + lr;
  const int row = is_lat ? b * SEQ + (qpos - CTX) : NLAT + b * CTX + qpos;
#pragma unroll
  for (int et = 0; et < 8; ++et) { const f32x4 g = *(const f32x4*)(og + et * 16 + lg * 4); const f32x4 y = O[0][et] * rs * g;
    u32x2 o; o[0] = pack2(y[0], y[1]); o[1] = pack2(y[2], y[3]); *(u32x2*)(yd + (size_t)row * 512 + hd * 128 + et * 16 + lg * 4) = o; }
}

DI void win_unit(const Params& p, int l, int b, int qh, bool is_lat, int qi, unsigned char* smem) {
  unsigned char* ws = p.ws;
  const int tid = get_tid(), lane = tid & 63, wid = __builtin_amdgcn_readfirstlane(tid >> 6), lr = lane & 15, lg = lane >> 4;
  const int qpos0 = (is_lat ? CTX + qi * QU : qi * QU) + wid * 32;
  const int kv = qh >> 2;
  const bf16_t* Qp = (const bf16_t*)(ws + OFF_QW) + ((size_t)(b * 8 + qh) * POS + qpos0) * 64;
  bf16x8 Qf[2][2];
#pragma unroll
  for (int qt = 0; qt < 2; ++qt)
#pragma unroll
    for (int ks = 0; ks < 2; ++ks) Qf[qt][ks] = *(const bf16x8*)(Qp + (qt * 16 + lr) * 64 + ks * 32 + lg * 8);
  const float sk = p.w_sink[l * 8 + qh] * LOG2E;
  const float mfix = fmaxf(((const float*)(ws + OFF_LAM))[8 + l], sk);
  const float l0 = lg == 0 ? __builtin_amdgcn_exp2f(sk - mfix) : 0.f;
  float lsum[2] = {l0, l0};
  f32x4 O[2][4];
#pragma unroll
  for (int qt = 0; qt < 2; ++qt)
#pragma unroll
    for (int et = 0; et < 4; ++et) O[qt][et] = (f32x4){0.f, 0.f, 0.f, 0.f};
  int tm0 = 0, tm1 = 0;
  if (is_lat) { const int q0 = qi * QU; tm0 = (q0 + 128) / 64; if (tm0 < 4) tm0 = 4; tm1 = (q0 + QU + 384) / 64; if (tm1 > POS / 64) tm1 = POS / 64; }
  attn_core<64, false>(O, lsum, Qf, -mfix, (const bf16_t*)(ws + OFF_KW) + (size_t)(b * 2 + kv) * POS * 64, nullptr, (const bf16_t*)(ws + OFF_VWT) + (size_t)(b * 2 + kv) * 64 * POS, 0, 4, tm0, tm1, qpos0 - CTX, smem);
  bf16_t* yw = (bf16_t*)(ws + OFF_YW);
#pragma unroll
  for (int qt = 0; qt < 2; ++qt) {
    float ls = lsum[qt]; ls += xshfl(ls, 16); ls += xshfl(ls, 32);
    const float inv = 1.0f / ls;
    const int qpos = qpos0 + qt * 16 + lr;
    const int row = is_lat ? b * SEQ + (qpos - CTX) : NLAT + b * CTX + qpos;
#pragma unroll
    for (int et = 0; et < 4; ++et) { const f32x4 y = O[qt][et] * inv; u32x2 o; o[0] = pack2(y[0], y[1]); o[1] = pack2(y[2], y[3]);
      *(u32x2*)(yw + (size_t)row * 512 + qh * 64 + et * 16 + lg * 4) = o; }
  }
}

constexpr int NR = NW / 2, CR = NCH / NR;
constexpr int BST = 20, SST = 136;
constexpr int S5_WAVE_LDS = 128 * BST * 4 + 16 * SST * 2;
constexpr int EB_PER_UNIT = 2 * (NCH + 8) * 64 * 2;
DI int s5_row(int b, int k, int t) { return k < 8 ? NLAT + b * CTX + k * 32 + t : b * SEQ + (k - 8) * 32 + t; }
DI int s5_cmap(int d, int k) { return d == 0 ? k : (k < 8 ? 7 - k : 143 - k); }
DI void s5_make_bf(const Params& p, int l, int d, int g, float fre, float fim, bf16x8 (&Bf)[8], int lr, int lg) {
#pragma unroll
  for (int q = 0; q < 8; ++q) {
    const int pp = 16 * (q & 3) + lr;
    const float fr = __shfl(fre, pp, 64), fi = __shfl(fim, pp, 64);
    u32x4 w = {0u, 0u, 0u, 0u};
    if (lg < 2) {
      const size_t bo = ((size_t)((l * 2 + d) * 32 + g) * 64 + pp) * 16 + lg * 8;
      const f32x4 br0 = *(const f32x4*)(p.s5_bre + bo), br1 = *(const f32x4*)(p.s5_bre + bo + 4), bi0 = *(const f32x4*)(p.s5_bim + bo), bi1 = *(const f32x4*)(p.s5_bim + bo + 4);
      f32x4 v0, v1;
      if (q < 4) { v0 = fr * br0 - fi * bi0; v1 = fr * br1 - fi * bi1; } else { v0 = fr * bi0 + fi * br0; v1 = fr * bi1 + fi * br1; }
      w[0] = pack2(v0[0], v0[1]); w[1] = pack2(v0[2], v0[3]); w[2] = pack2(v1[0], v1[1]); w[3] = pack2(v1[2], v1[3]);
    }
    Bf[q] = __builtin_bit_cast(bf16x8, w);
  }
}
DI u32x4 s5_load_uf(const bf16_t* sug, int k, int tt, int lr, int lg) { u32x4 uw = {0u, 0u, 0u, 0u}; if (lg < 2) uw = *(const u32x4*)(sug + (size_t)(k * 32 + tt * 16 + lr) * 16 + lg * 8); return uw; }
DI void s5_bu_tile(u32x4 uw, const bf16x8 (&Bf)[8], float* Bsm, int lr, int lg) {
  const bf16x8 uf = __builtin_bit_cast(bf16x8, uw);
#pragma unroll
  for (int q = 0; q < 8; ++q) { f32x4 z = {0.f, 0.f, 0.f, 0.f}; z = MFMA16(Bf[q], uf, z);
#pragma unroll
    for (int jj = 0; jj < 4; ++jj) Bsm[(q * 16 + lg * 4 + jj) * BST + lr] = z[jj]; }
}
#define S5_SCAN(D, AR, AI, WRITE) do { \
    _Pragma("unroll") for (int hb = 0; hb < 2; ++hb) { const int cb = ((D) ? 1 - hb : hb) * 2;     \
      const f32x4 br0_ = *(const f32x4*)(Bsm + lane * BST + cb * 4), br1_ = *(const f32x4*)(Bsm + lane * BST + cb * 4 + 4); \
      const f32x4 bi0_ = *(const f32x4*)(Bsm + (64 + lane) * BST + cb * 4), bi1_ = *(const f32x4*)(Bsm + (64 + lane) * BST + cb * 4 + 4); \
      _Pragma("unroll") for (int st = 0; st < 8; ++st) { const int t8 = (D) ? 7 - st : st; const int tl = cb * 4 + t8; \
        const float br = t8 < 4 ? br0_[t8 & 3] : br1_[t8 & 3], bi = t8 < 4 ? bi0_[t8 & 3] : bi1_[t8 & 3]; \
        const float nr = (AR) * sr - (AI) * si + br, ni = (AR) * si + (AI) * sr + bi; sr = nr; si = ni; \
        if (WRITE) { const unsigned pk = pack2(sr, si); Ssm[tl * SST + lane] = (bf16_t)(pk & 0xffffu); Ssm[tl * SST + 64 + lane] = (bf16_t)(pk >> 16); } } } } while (0)
DI void s5_unit(const Params& p, int l, int b, int g, unsigned char* smem) {
  unsigned char* ws = p.ws;
  const int tid = get_tid(), lane = tid & 63, wid = __builtin_amdgcn_readfirstlane(tid >> 6), lr = lane & 15, lg = lane >> 4;
  float* Bsm = (float*)(smem + wid * S5_WAVE_LDS);
  bf16_t* Ssm = (bf16_t*)(smem + wid * S5_WAVE_LDS + 128 * BST * 4);
  const bf16_t* sug = (const bf16_t*)(ws + OFF_SU) + (size_t)(b * 32 + g) * POS * 16;
  float* Eb = (float*)(ws + OFF_EB) + (size_t)(b * 32 + g) * EB_PER_UNIT;
  float are[2], aim[2], fre[2], fim[2];
#pragma unroll
  for (int d = 0; d < 2; ++d) {
    const int pi = ((l * 2 + d) * 32 + g) * 64 + lane;
    const float lre = p.s5_lre[pi], lim = p.s5_lim[pi], dt = expf(p.s5_ldt[(l * 2 + d) * 32 + g]);
    const float mag = expf(lre * dt), ang = lim * dt;
    are[d] = mag * cosf(ang); aim[d] = mag * sinf(ang);
    const float den = lre * lre + lim * lim, nre = are[d] - 1.0f;
    fre[d] = (nre * lre + aim[d] * lim) / den; fim[d] = (aim[d] * lre - nre * lim) / den;
  }
  bf16x8 Bf[2][8];
  s5_make_bf(p, l, 0, g, fre[0], fim[0], Bf[0], lr, lg);
  s5_make_bf(p, l, 1, g, fre[1], fim[1], Bf[1], lr, lg);
  {
    const int d = wid & 1, r = wid >> 1;
    const float ar = d ? are[1] : are[0], ai = d ? aim[1] : aim[0];
    float sr = 0.f, si = 0.f;
    for (int ci = 0; ci < CR; ++ci) {
      const int c = r * CR + ci, k = s5_cmap(d, c);
      { float* e_ = Eb + ((size_t)(d * (NCH + 8) + c) * 64 + lane) * 2; __hip_atomic_store(e_, sr, __ATOMIC_RELAXED, __HIP_MEMORY_SCOPE_AGENT); __hip_atomic_store(e_ + 1, si, __ATOMIC_RELAXED, __HIP_MEMORY_SCOPE_AGENT); }
      const u32x4 ua = s5_load_uf(sug, k, d ? 1 : 0, lr, lg), ub = s5_load_uf(sug, k, d ? 0 : 1, lr, lg);
#pragma unroll
      for (int hh = 0; hh < 2; ++hh) {
        const u32x4 uw = hh ? ub : ua;
        __builtin_amdgcn_wave_barrier();
        if (d) s5_bu_tile(uw, Bf[1], Bsm, lr, lg); else s5_bu_tile(uw, Bf[0], Bsm, lr, lg);
        __builtin_amdgcn_wave_barrier();
        if (d) S5_SCAN(1, ar, ai, false); else S5_SCAN(0, ar, ai, false);
      }
    }
    { float* e_ = Eb + ((size_t)(d * (NCH + 8) + NCH + r) * 64 + lane) * 2; __hip_atomic_store(e_, sr, __ATOMIC_RELAXED, __HIP_MEMORY_SCOPE_AGENT); __hip_atomic_store(e_ + 1, si, __ATOMIC_RELAXED, __HIP_MEMORY_SCOPE_AGENT); }
  }
  asm volatile("s_waitcnt vmcnt(0)" ::: "memory"); __syncthreads();
  bf16x8 Cf[2][4];
  float a32r[2], a32i[2], aCRr[2], aCRi[2];
#pragma unroll
  for (int d = 0; d < 2; ++d) {
#pragma unroll
    for (int ks = 0; ks < 4; ++ks) {
      const float* src = (ks < 2 ? p.s5_cre : p.s5_cim) + ((size_t)((l * 2 + d) * 32 + g) * 16 + lr) * 64 + (ks & 1) * 32 + lg * 8;
      const f32x4 v0 = *(const f32x4*)src, v1 = *(const f32x4*)(src + 4); const float sg = ks < 2 ? 1.0f : -1.0f;
      u32x4 w; w[0] = pack2(sg * v0[0], sg * v0[1]); w[1] = pack2(sg * v0[2], sg * v0[3]); w[2] = pack2(sg * v1[0], sg * v1[1]); w[3] = pack2(sg * v1[2], sg * v1[3]);
      Cf[d][ks] = __builtin_bit_cast(bf16x8, w);
    }
    float pr = are[d], pi_ = aim[d];
#pragma unroll
    for (int q = 0; q < 5; ++q) { const float nr = pr * pr - pi_ * pi_, ni = 2.0f * pr * pi_; pr = nr; pi_ = ni; }
    a32r[d] = pr; a32i[d] = pi_;
    float rr = 1.f, ri = 0.f, br_ = pr, bi_ = pi_;
#pragma unroll
    for (int bit = 0; bit < 7; ++bit) { if ((CR >> bit) & 1) { const float nr = rr * br_ - ri * bi_, ni = rr * bi_ + ri * br_; rr = nr; ri = ni; } const float nr = br_ * br_ - bi_ * bi_, ni = 2.0f * br_ * bi_; br_ = nr; bi_ = ni; }
    aCRr[d] = rr; aCRi[d] = ri;
  }
  const f32x4 dsk = *(const f32x4*)(p.s5_d + l * 512 + g * 16 + lg * 4);
  bf16_t* gb = (bf16_t*)(ws + OFF_GB);
  for (int k = wid; k < NCH; k += NW) {
    f32x4 acc[2] = {{0.f, 0.f, 0.f, 0.f}, {0.f, 0.f, 0.f, 0.f}};
    u32x4 uq[2]; uq[0] = s5_load_uf(sug, k, 0, lr, lg); uq[1] = s5_load_uf(sug, k, 1, lr, lg);
    u32x2 us[2]; us[0] = *(const u32x2*)(sug + (size_t)(k * 32 + lr) * 16 + lg * 4); us[1] = *(const u32x2*)(sug + (size_t)(k * 32 + 16 + lr) * 16 + lg * 4);
    float s0[2][2];
#pragma unroll
    for (int d = 0; d < 2; ++d) { const float* e_ = Eb + ((size_t)(d * (NCH + 8) + s5_cmap(d, k)) * 64 + lane) * 2;
      s0[d][0] = __hip_atomic_load(e_, __ATOMIC_RELAXED, __HIP_MEMORY_SCOPE_AGENT); s0[d][1] = __hip_atomic_load(e_ + 1, __ATOMIC_RELAXED, __HIP_MEMORY_SCOPE_AGENT); }
#pragma unroll
    for (int d = 0; d < 2; ++d) {
      const int c = s5_cmap(d, k), r = c / CR, j = c - r * CR;
      const float* Ed = Eb + (size_t)d * (NCH + 8) * 128 + lane * 2;
      float tr = 0.f, ti = 0.f;
#pragma unroll
      for (int r2 = 0; r2 < NR - 1; ++r2) if (r2 < r) {
        const float er = __hip_atomic_load(Ed + (size_t)(NCH + r2) * 128, __ATOMIC_RELAXED, __HIP_MEMORY_SCOPE_AGENT), ei = __hip_atomic_load(Ed + (size_t)(NCH + r2) * 128 + 1, __ATOMIC_RELAXED, __HIP_MEMORY_SCOPE_AGENT);
        const float nr = aCRr[d] * tr - aCRi[d] * ti + er, ni = aCRr[d] * ti + aCRi[d] * tr + ei; tr = nr; ti = ni; }
      float pr = 1.f, pi_ = 0.f, br_ = a32r[d], bi_ = a32i[d];
      for (int bit = 0; bit < 7; ++bit) { if ((j >> bit) & 1) { const float nr = pr * br_ - pi_ * bi_, ni = pr * bi_ + pi_ * br_; pr = nr; pi_ = ni; } const float nr = br_ * br_ - bi_ * bi_, ni = 2.0f * br_ * bi_; br_ = nr; bi_ = ni; }
      float sr = s0[d][0] + (pr * tr - pi_ * ti), si = s0[d][1] + (pr * ti + pi_ * tr);
#pragma unroll
      for (int hh = 0; hh < 2; ++hh) {
        const int tt = d ? 1 - hh : hh;
        __builtin_amdgcn_wave_barrier();
        s5_bu_tile(uq[tt], Bf[d], Bsm, lr, lg);
        __builtin_amdgcn_wave_barrier();
        if (d) S5_SCAN(1, are[1], aim[1], true); else S5_SCAN(0, are[0], aim[0], true);
        __builtin_amdgcn_wave_barrier();
#pragma unroll
        for (int ks = 0; ks < 4; ++ks) { const bf16x8 sf = *(const bf16x8*)(Ssm + lr * SST + ks * 32 + lg * 8); acc[tt] = MFMA16(Cf[d][ks], sf, acc[tt]); }
      }
    }
#pragma unroll
    for (int tt = 0; tt < 2; ++tt) { const int row = s5_row(b, k, tt * 16 + lr);
      f32x4 u; u[0] = __uint_as_float(us[tt][0] << 16); u[1] = __uint_as_float(us[tt][0] & 0xffff0000u); u[2] = __uint_as_float(us[tt][1] << 16); u[3] = __uint_as_float(us[tt][1] & 0xffff0000u);
      float y[4];
#pragma unroll
      for (int j = 0; j < 4; ++j) y[j] = gelu_tanh(acc[tt][j] + u[j] * dsk[j]);
      u32x2 o; o[0] = pack2(y[0], y[1]); o[1] = pack2(y[2], y[3]); *(u32x2*)(gb + (size_t)row * 512 + g * 16 + lg * 4) = o; }
  }
}

DI void mixer_phase(const Params& p, int l, unsigned char* smem) {
  const bool need_ctx = l < DEPTH - 1;
  volatile int* smw = (volatile int*)(smem + SMEM_BYTES - 16);
  constexpr int QL = SEQ / QU, QC = CTX / QU, QLD = SEQ / QUD, QCD = CTX / QUD;
  const int n_s5 = 16, n_dl = 2 * QLD, n_dc = need_ctx ? 2 * QCD : 0, n_wl = 4 * QL, n_wc = need_ctx ? 4 * QC : 0;
  const int total = n_dl + n_s5 + n_dc + n_wl + n_wc;
  const int x0 = get_bid() & 7;
  for (int dx = 0; dx < 8; ++dx) {
    const int xq = (x0 + dx) & 7;
    unsigned* ctr = (unsigned*)(p.ws + OFF_LAM) + 16 + l * 8 + xq;
    for (;;) {
      __syncthreads();
      if (get_tid() == 0) *smw = (int)atomicAdd(ctr, 1u);
      __syncthreads();
      int u = *smw;
      u = __builtin_amdgcn_readfirstlane(u);
      if (u >= total) break;
      int type, bq, hd, qi; bool is_lat = true;
      if (u < n_s5) { const int idx = xq * 16 + u; type = 1; bq = idx >> 5; hd = idx & 31; qi = 0; }
      else if ((u -= n_s5) < n_dl) { const int gidx = xq + 8 * (u / QLD); type = 0; bq = gidx >> 2; hd = gidx & 3; qi = u % QLD; }
      else if ((u -= n_dl) < n_dc) { const int gidx = xq + 8 * (u / QCD); type = 0; is_lat = false; bq = gidx >> 2; hd = gidx & 3; qi = u % QCD; }
      else if ((u -= n_dc) < n_wl) { type = 2; bq = xq >> 1; hd = (xq & 1) * 4 + (u & 3); qi = u >> 2; }
      else { u -= n_wl; type = 2; is_lat = false; bq = xq >> 1; hd = (xq & 1) * 4 + (u & 3); qi = u >> 2; }
      if (type == 0) diff_unit(p, l, bq, hd, is_lat, qi, smem);
      else if (type == 1) s5_unit(p, l, bq, hd, smem);
      else win_unit(p, l, bq, hd, is_lat, qi, smem);
    }
  }
}

#define EPI_LOOP_BEGIN { const int tid_ = get_tid(), lane_ = tid_ & 63, wid_ = tid_ >> 6, wr_ = wid_ >> 1, wc_ = wid_ & 1, lr_ = lane_ & 15, lg_ = lane_ >> 4; \
  _Pragma("unroll") for (int mi = 0; mi < 4; ++mi) { const int row = m0 + wr_ * 64 + mi * 16 + lr_; \
  _Pragma("unroll") for (int ni = 0; ni < 4; ++ni) { const int col = n0 + wc_ * 64 + ni * 16 + lg_ * 4;
#define EPI_LOOP_END } } }

DI void glu_phase(const Params& p, int MT, unsigned char* smem) {
  bf16_t* As = (bf16_t*)smem; bf16_t* Bs = As + 128 * LDT;
  const bf16_t* G = (const bf16_t*)(p.ws + OFF_GB); const bf16_t* W = (const bf16_t*)(p.ws + OFF_W_GLU); bf16_t* ys = (bf16_t*)(p.ws + OFF_YS);
  constexpr int NT = 4;
  for (int t = get_bid(); t < MT * NT; t += gridDim.x) {
    const int m0 = (t / NT) * 128, n0 = (t % NT) * 128;
    f32x4 acc[4][4]; zero_acc(acc);
    gemm_mainloop(acc, G + (size_t)m0 * 512, 512, W + (size_t)n0 * 512, 512, 512, As, Bs);
    EPI_LOOP_BEGIN
      const u32x2 gr = *(const u32x2*)(G + (size_t)row * 512 + col);
      const float g0 = __uint_as_float(gr[0] << 16), g1 = __uint_as_float(gr[0] & 0xffff0000u), g2 = __uint_as_float(gr[1] << 16), g3 = __uint_as_float(gr[1] & 0xffff0000u);
      u32x2 o; o[0] = pack2(g0 * sigmoidf_(acc[mi][ni][0]), g1 * sigmoidf_(acc[mi][ni][1])); o[1] = pack2(g2 * sigmoidf_(acc[mi][ni][2]), g3 * sigmoidf_(acc[mi][ni][3]));
      *(u32x2*)(ys + (size_t)row * 512 + col) = o;
    EPI_LOOP_END
  }
}
DI void merge_phase(const Params& p, int MT, unsigned char* smem) {
  bf16_t* As = (bf16_t*)smem; bf16_t* Bs = As + 128 * LDT;
  const bf16_t* gt = (const bf16_t*)(p.ws + OFF_GATES); bf16_t* mo = (bf16_t*)(p.ws + OFF_M);
  constexpr int NT = 8;
  for (int t = get_bid(); t < MT * NT; t += gridDim.x) {
    const int m0 = (t / NT) * 128, n0 = (t % NT) * 128;
    f32x4 acc[4][4]; zero_acc(acc);
#pragma unroll 1
    for (int br = 0; br < 3; ++br) {
      const bf16_t* Y = (const bf16_t*)(p.ws + (br == 0 ? OFF_YD : br == 1 ? OFF_YS : OFF_YW));
      const bf16_t* W = (const bf16_t*)(p.ws + (br == 0 ? OFF_W_PD : br == 1 ? OFF_W_PS : OFF_W_PW));
      gemm_mainloop(acc, Y + (size_t)m0 * 512, 512, W + (size_t)n0 * 512, 512, 512, As, Bs);
      if (br < 2) {
        EPI_LOOP_BEGIN
          const f32x4 g0 = ld_bf4(gt + (size_t)row * 3072 + br * 1024 + col), g1 = ld_bf4(gt + (size_t)row * 3072 + (br + 1) * 1024 + col);
#pragma unroll
          for (int j = 0; j < 4; ++j) acc[mi][ni][j] *= fmaxf(g0[j], 1e-30f) * __builtin_amdgcn_rcpf(fmaxf(g1[j], 1e-30f));
        EPI_LOOP_END
      } else {
        EPI_LOOP_BEGIN
          const f32x4 g2 = ld_bf4(gt + (size_t)row * 3072 + 2048 + col);
          u32x2 o; o[0] = pack2(acc[mi][ni][0] * fmaxf(g2[0], 1e-30f), acc[mi][ni][1] * fmaxf(g2[1], 1e-30f)); o[1] = pack2(acc[mi][ni][2] * fmaxf(g2[2], 1e-30f), acc[mi][ni][3] * fmaxf(g2[3], 1e-30f));
          *(u32x2*)(mo + (size_t)row * D + col) = o;
        EPI_LOOP_END
      }
    }
  }
}
DI void resid_phase(const Params& p, int l, const bf16_t* A, int K, const bf16_t* W, int gate_off, float* dst, int MT, unsigned char* smem, bool first = false) {
  bf16_t* As = (bf16_t*)smem; bf16_t* Bs = As + 128 * LDT;
  const float* h = (const float*)(p.ws + OFF_H);
  const float* modv = (const float*)(p.ws + OFF_MODV) + (size_t)l * 5 * 6144;
  constexpr int NT = 8;
  for (int t = get_bid(); t < MT * NT; t += gridDim.x) {
    const int m0 = (t / NT) * 128, n0 = (t % NT) * 128;
    f32x4 acc[4][4]; zero_acc(acc);
    gemm_mainloop(acc, A + (size_t)m0 * K, K, W + (size_t)n0 * K, K, K, As, Bs);
    const int bb = m0 < NLAT ? m0 / SEQ : 4;
    EPI_LOOP_BEGIN
      const f32x4 gv = *(const f32x4*)(modv + bb * 6144 + gate_off + col);
      const f32x4 hv = *(const f32x4*)((first ? (row < NLAT ? p.x + (size_t)row * D : p.ctx + (size_t)(row - NLAT) * D) : h + (size_t)row * D) + col);
      *(f32x4*)(dst + (size_t)row * D + col) = hv + gv * acc[mi][ni];
    EPI_LOOP_END
  }
}
DI void ff1_phase(const Params& p, int MT, unsigned char* smem) {
  bf16_t* As = (bf16_t*)smem; bf16_t* Bs = As + 128 * LDT;
  const bf16_t* A = (const bf16_t*)(p.ws + OFF_ABUF); const bf16_t* W = (const bf16_t*)(p.ws + OFF_W_FF1); bf16_t* uo = (bf16_t*)(p.ws + OFF_U);
  constexpr int NT = DFF / 128;
  for (int t = get_bid(); t < MT * NT; t += gridDim.x) {
    const int m0 = (t / NT) * 128, n0 = (t % NT) * 128;
    f32x4 acc[4][4]; zero_acc(acc);
    gemm_mainloop<true>(acc, A + (size_t)m0 * D, D, W + (size_t)n0 * D, D, D, As, Bs);
    const int tid_ = get_tid(), lane_ = tid_ & 63, wid_ = tid_ >> 6, wr_ = wid_ >> 1, wc_ = wid_ & 1, lr_ = lane_ & 15, lg_ = lane_ >> 4;
#pragma unroll
    for (int mi = 0; mi < 4; ++mi) { const int row = m0 + wr_ * 64 + mi * 16 + lr_;
#pragma unroll
      for (int q = 0; q < 2; ++q) { const int col = n0 + wc_ * 64 + q * 32 + lg_ * 8;
        float r[8];
#pragma unroll
        for (int j = 0; j < 4; ++j) { const float v0 = fmaxf(acc[mi][2 * q][j], 0.f), v1 = fmaxf(acc[mi][2 * q + 1][j], 0.f); r[j] = v0 * v0; r[4 + j] = v1 * v1; }
        u32x4 o; o[0] = pack2(r[0], r[1]); o[1] = pack2(r[2], r[3]); o[2] = pack2(r[4], r[5]); o[3] = pack2(r[6], r[7]);
        *(u32x4*)(uo + (size_t)row * DFF + col) = o; } }
  }
}

#define XB_TMO      128
#define XB_XCNT(j)  (256  + 64 * (j))
#define XB_XSUB(j)  (1280 + 64 * (j))
#define XB_XGEN(j)  (2304 + 64 * (j))
#define XB_TOP      3328
#define XB_TOPGEN   3392
#define XCD_BAR_WORDS 3456
#define XB_SPIN_CAP (1u << 18)
#define XLAS __attribute__((address_space(3)))

__device__ __forceinline__ unsigned xb_ld(unsigned* p)              { return __hip_atomic_load(p, __ATOMIC_RELAXED, __HIP_MEMORY_SCOPE_AGENT); }
__device__ __forceinline__ unsigned xb_add(unsigned* p, unsigned v) { return __hip_atomic_fetch_add(p, v, __ATOMIC_RELAXED, __HIP_MEMORY_SCOPE_AGENT); }
__device__ __forceinline__ unsigned xb_xcc_id() { return (unsigned)__builtin_amdgcn_s_getreg((3 << 11) | 20) & 0xFu; }
#define XB_SPIN(cond, bar) do { unsigned _sp = 0; while (cond) { __builtin_amdgcn_s_sleep(1); \
    if ((++_sp & 255u) == 0u) { if (xb_ld(&(bar)[XB_TMO])) break; if (_sp > XB_SPIN_CAP) { atomicAdd(&(bar)[XB_TMO], 1u); break; } } } } while (0)

struct XcdBarrier {
    unsigned* bar; unsigned x;
    volatile XLAS unsigned* st;
};

__device__ __forceinline__ XcdBarrier xcd_barrier_post(unsigned* bar, volatile XLAS unsigned* st) {
    XcdBarrier b; b.bar = bar; b.x = xb_xcc_id(); b.st = st;
    if (threadIdx.x == 0) (void)xb_add(&bar[XB_XCNT(b.x)], 1u);
    return b;
}
__device__ __forceinline__ void xcd_barrier_complete(unsigned* bar, unsigned x, unsigned& nloc, unsigned& nx) {
    const unsigned G = gridDim.x * gridDim.y * gridDim.z;
    unsigned sum, cnt, mine, sp = 0u;
    for (;;) {
        sum = 0u; cnt = 0u; mine = 0u;
#pragma unroll
        for (unsigned j = 0; j < 16; ++j) { const unsigned c = xb_ld(&bar[XB_XCNT(j)]); sum += c; cnt += (c > 0u) ? 1u : 0u; mine = (j == x) ? c : mine; }
        if (sum == G) break;
        __builtin_amdgcn_s_sleep(1);
        if ((++sp & 255u) == 0u) { if (xb_ld(&bar[XB_TMO])) break; if (sp > XB_SPIN_CAP) { atomicAdd(&bar[XB_TMO], 1u); break; } }
    }
    nloc = mine > 0u ? mine : 1u; nx = cnt > 0u ? cnt : 1u;
}

__device__ __forceinline__ void xcd_barrier(const XcdBarrier& b) {
    asm volatile("s_waitcnt vmcnt(0)" ::: "memory");
    __syncthreads();
    if (threadIdx.x == 0) {
        unsigned* bar = b.bar;
        __builtin_amdgcn_s_waitcnt(0);
        unsigned nloc = b.st[0], nx = b.st[1];
        if (nloc == 0u) { xcd_barrier_complete(bar, b.x, nloc, nx); b.st[0] = nloc; b.st[1] = nx; }
        const unsigned old = xb_add(&bar[XB_XSUB(b.x)], 1u);
        const unsigned gen = old / nloc;
        if (old + 1u == (gen + 1u) * nloc) {
            __builtin_amdgcn_fence(__ATOMIC_RELEASE, "agent");
            asm volatile("s_waitcnt vmcnt(0)" ::: "memory");
            const unsigned og = xb_add(&bar[XB_TOP], 1u);
            const unsigned tg = og / nx;
            if (og + 1u == (tg + 1u) * nx) xb_add(&bar[XB_TOPGEN], 1u);
            else XB_SPIN(xb_ld(&bar[XB_TOPGEN]) == tg, bar);
            __builtin_amdgcn_fence(__ATOMIC_ACQUIRE, "agent");
            xb_add(&bar[XB_XGEN(b.x)], 1u);
            asm volatile("s_waitcnt vmcnt(0)" ::: "memory");
        } else {
            XB_SPIN(xb_ld(&bar[XB_XGEN(b.x)]) == gen, bar);
            __builtin_amdgcn_fence(__ATOMIC_ACQUIRE, "agent");
            asm volatile("s_waitcnt vmcnt(0)" ::: "memory");
        }
    }
    __syncthreads();
}


__global__ void __launch_bounds__(256, 2) fwd_megakernel(Params p) {
  __shared__ __attribute__((aligned(16))) unsigned char smem[SMEM_BYTES];
  __shared__ uint4 xb_words;
  cg::grid_group grid = cg::this_grid();
  unsigned char* ws = p.ws;
  if (threadIdx.x == 0) xb_words = make_uint4(0u, 0u, 0u, 0u);
  __syncthreads();
  const XcdBarrier xb = xcd_barrier_post((unsigned*)(ws + OFF_BAR), (volatile XLAS unsigned*)&xb_words);
  phase0_misc(p, smem);
  __syncthreads();
  convert_layer(p, 0, 0, smem);
  if (p.ws == nullptr) grid.sync();
  for (int l = 0; l < DEPTH; ++l) {
    const bool need_ctx = l < DEPTH - 1;
    const int MT = need_ctx ? NTOK / 128 : NLAT / 128;
    xcd_barrier(xb);
    if (l > 0) convert_layer(p, l, CONV_EARLY, smem);
    norm_phase(p, l, p.norm1_g + l * D, 0, 1024, NTOK, l == 0);
    xcd_barrier(xb);
    inproj_phase(p, l, smem);
    xcd_barrier(xb);
    mixer_phase(p, l, smem);
    xcd_barrier(xb);
    glu_phase(p, MT, smem);
    xcd_barrier(xb);
    merge_phase(p, MT, smem);
    xcd_barrier(xb);
    resid_phase(p, l, (const bf16_t*)(ws + OFF_M), D, (const bf16_t*)(ws + OFF_W_OUT), 2048, (float*)(ws + OFF_H), MT, smem, l == 0);
    xcd_barrier(xb);
    norm_phase(p, l, p.norm2_g + l * D, 3072, 4096, MT * 128);
    xcd_barrier(xb);
    ff1_phase(p, MT, smem);
    xcd_barrier(xb);
    resid_phase(p, l, (const bf16_t*)(ws + OFF_U), DFF, (const bf16_t*)(ws + OFF_W_FF2), 5120, need_ctx ? (float*)(ws + OFF_H) : p.out, MT, smem);
    if (need_ctx) convert_steal(p, l + 1, smem);
  }
}

extern "C" void kernel_launch(void* const* d_in, const int* in_sizes, int n_in, void* d_out, int out_size, void* d_ws, size_t ws_size, hipStream_t stream) {
  static int grid_blocks = 0;
  if (!grid_blocks) {
    int dev = 0, cus = 0, per_cu = 0;
    (void)hipGetDevice(&dev);
    (void)hipDeviceGetAttribute(&cus, hipDeviceAttributeMultiprocessorCount, dev);
    (void)hipOccupancyMaxActiveBlocksPerMultiprocessor(&per_cu, fwd_megakernel, 256, 0);
    if (per_cu > 2) per_cu = 2;
    if (per_cu < 1) per_cu = 1;
    grid_blocks = cus * per_cu;
  }
  if (ws_size < WS_NEED) { fprintf(stderr, "workspace too small: %zu < %zu\n", ws_size, (size_t)WS_NEED); return; }
  (void)hipMemsetAsync((unsigned char*)d_ws + OFF_BAR, 0, BAR_BYTES, stream);
  Params p{};
  const float* const* in = (const float* const*)d_in;
  p.x = in[0]; p.c = in[1]; p.ctx = in[2]; p.c_ctx = in[3]; p.w_mod = in[4]; p.b_mod = in[5]; p.norm1_g = in[6]; p.norm2_g = in[7]; p.w_in = in[8];
  p.dq_g = in[9]; p.dk_g = in[10]; p.lq1 = in[11]; p.lk1 = in[12]; p.lq2 = in[13]; p.lk2 = in[14]; p.dout_g = in[15];
  p.s5_lre = in[16]; p.s5_lim = in[17]; p.s5_ldt = in[18]; p.s5_bre = in[19]; p.s5_bim = in[20]; p.s5_cre = in[21]; p.s5_cim = in[22]; p.s5_d = in[23]; p.s5_wglu = in[24];
  p.wq_g = in[25]; p.wk_g = in[26]; p.w_sink = in[27];
  p.w_pd = in[28]; p.w_ps = in[29]; p.w_pw = in[30]; p.w_out = in[31]; p.w_ff1 = in[32]; p.w_ff2 = in[33];
  p.out = (float*)d_out; p.ws = (unsigned char*)d_ws;
  void* args[] = {&p};
  hipError_t e = hipLaunchCooperativeKernel((void*)fwd_megakernel, dim3(grid_blocks), dim3(256), args, 0, stream);
  if (e != hipSuccess) fprintf(stderr, "cooperative launch failed: %s (grid %d)\n", hipGetErrorString(e), grid_blocks);
}
```

```cpp
#include <hip/hip_runtime.h>
#include <hip/hip_cooperative_groups.h>
#include <cstdio>
#include <cstdint>
namespace cg = cooperative_groups;

typedef unsigned short bf16_t;
typedef short bf16x8 __attribute__((ext_vector_type(8)));
typedef short bf16x4 __attribute__((ext_vector_type(4)));
typedef float f32x4 __attribute__((ext_vector_type(4)));
typedef float f32x2 __attribute__((ext_vector_type(2)));
typedef unsigned u32x4 __attribute__((ext_vector_type(4)));
typedef unsigned u32x2 __attribute__((ext_vector_type(2)));
typedef __bf16 bf2_t __attribute__((ext_vector_type(2)));

#define DI __device__ __forceinline__
#define MFMA16(a, b, c) __builtin_amdgcn_mfma_f32_16x16x32_bf16((a), (b), (c), 0, 0, 0)

constexpr int D = 1024, NB = 4, SEQ = 4096, DEPTH = 4, CTX = 256, POS = CTX + SEQ  ;
constexpr int NLAT = NB * SEQ  , NCTX = NB * CTX  , NTOK = NLAT + NCTX  ;
constexpr int DIN = 5888, DFF = 4096;
constexpr float EPS = 1e-6f;
constexpr float LOG2E = 1.4426950408889634f;
constexpr int NCH = POS / 32;

constexpr size_t SZ_W_IN = (size_t)DIN * D * 2, SZ_W_GLU = 512 * 512 * 2, SZ_W_P = 1024 * 512 * 2, SZ_W_OUT = (size_t)D * D * 2, SZ_W_FF = (size_t)D * DFF * 2;
constexpr size_t OFF_W_IN = 0;
constexpr size_t OFF_W_GLU = OFF_W_IN + SZ_W_IN;
constexpr size_t OFF_W_PD = OFF_W_GLU + SZ_W_GLU;
constexpr size_t OFF_W_PS = OFF_W_PD + SZ_W_P;
constexpr size_t OFF_W_PW = OFF_W_PS + SZ_W_P;
constexpr size_t OFF_W_OUT = OFF_W_PW + SZ_W_P;
constexpr size_t OFF_W_FF1 = OFF_W_OUT + SZ_W_OUT;
constexpr size_t OFF_W_FF2 = OFF_W_FF1 + SZ_W_FF;
constexpr size_t OFF_MODV = OFF_W_FF2 + SZ_W_FF;
constexpr size_t OFF_ROPE = OFF_MODV + (size_t)DEPTH * 5 * 6144 * 4;
constexpr size_t OFF_LAM = OFF_ROPE + 8192;
constexpr size_t OFF_H = OFF_LAM + 256;
constexpr size_t OFF_ABUF = OFF_H + (size_t)NTOK * D * 4;
constexpr size_t OFF_R1 = OFF_ABUF + (size_t)NTOK * D * 2;
constexpr size_t SZ_HEADBUF = (size_t)NB * 8 * POS * 64 * 2;
constexpr size_t OFF_QD = OFF_R1;
constexpr size_t OFF_KD = OFF_QD + SZ_HEADBUF;
constexpr size_t OFF_VDT = OFF_KD + SZ_HEADBUF;
constexpr size_t OFF_SU = OFF_VDT + SZ_HEADBUF;
constexpr size_t OFF_QW = OFF_SU + (size_t)NTOK * 512 * 2;
constexpr size_t OFF_KW = OFF_QW + SZ_HEADBUF;
constexpr size_t OFF_VWT = OFF_KW + SZ_HEADBUF / 4;
constexpr size_t OFF_GATES = OFF_VWT + SZ_HEADBUF / 4;
constexpr size_t OFF_YD = OFF_GATES + (size_t)NTOK * 3072 * 2;
constexpr size_t OFF_YS = OFF_YD + (size_t)NTOK * 512 * 2;
constexpr size_t OFF_YW = OFF_YS + (size_t)NTOK * 512 * 2;
constexpr size_t OFF_GB = OFF_YW + (size_t)NTOK * 512 * 2;
constexpr size_t OFF_EB = OFF_GB + (size_t)NTOK * 512 * 2;
constexpr size_t OFF_END = OFF_EB + (size_t)NB * 32 * 2 * (NCH + 8) * 64 * 8;
constexpr size_t OFF_BAR = OFF_END;
constexpr size_t BAR_BYTES = 16384;
constexpr size_t WS_NEED = OFF_BAR + BAR_BYTES;
constexpr size_t OFF_M = OFF_QD;
constexpr size_t OFF_U = OFF_R1;
static_assert((size_t)NTOK * DFF * 2 <= OFF_END - OFF_R1, "u alias");

struct Params {
  const float *x, *c, *ctx, *c_ctx, *w_mod, *b_mod, *norm1_g, *norm2_g, *w_in;
  const float *dq_g, *dk_g, *lq1, *lk1, *lq2, *lk2, *dout_g;
  const float *s5_lre, *s5_lim, *s5_ldt, *s5_bre, *s5_bim, *s5_cre, *s5_cim, *s5_d, *s5_wglu;
  const float *wq_g, *wk_g, *w_sink;
  const float *w_pd, *w_ps, *w_pw, *w_out, *w_ff1, *w_ff2;
  float* out;
  unsigned char* ws;
};

DI int get_tid() { int t = threadIdx.x; asm volatile("" : "+v"(t)); return t; }
DI int get_bid() { int b = blockIdx.x; asm volatile("" : "+s"(b)); return b; }
DI unsigned pack2(float lo, float hi) { f32x2 v = {lo, hi}; bf2_t r = __builtin_convertvector(v, bf2_t); return __builtin_bit_cast(unsigned, r); }
DI float sigmoidf_(float x) { return __builtin_amdgcn_rcpf(1.0f + __expf(-x)); }
DI float gelu_tanh(float x) { const float z = 0.7978845608028654f * (x + 0.044715f * x * x * x); const float e = __expf(2.0f * z); const float t = 1.0f - 2.0f * __builtin_amdgcn_rcpf(e + 1.0f); return 0.5f * x * (1.0f + t); }
DI f32x4 ld_bf4(const bf16_t* p_) { const u32x2 r = *(const u32x2*)p_; f32x4 v; v[0] = __uint_as_float(r[0] << 16); v[1] = __uint_as_float(r[0] & 0xffff0000u); v[2] = __uint_as_float(r[1] << 16); v[3] = __uint_as_float(r[1] & 0xffff0000u); return v; }
DI float xshfl(float v, int m) { return __shfl_xor(v, m, 64); }

constexpr int SMEM_BYTES = 65552;
constexpr int LDT = 72;

DI u32x4 gload_async(const void* ptr) { u32x4 r; asm volatile("global_load_dwordx4 %0, %1, off" : "=v"(r) : "v"(ptr) : "memory"); return r; }
DI u32x4 gload_async_s(const void* sbase, unsigned voff) { u32x4 r; asm volatile("global_load_dwordx4 %0, %1, %2" : "=v"(r) : "v"(voff), "s"(sbase) : "memory"); return r; }
#define VM_WAIT8(N, R, Q) asm volatile("s_waitcnt vmcnt(" #N ")" : "+v"(R[0]), "+v"(R[1]), "+v"(R[2]), "+v"(R[3]), "+v"(Q[0]), "+v"(Q[1]), "+v"(Q[2]), "+v"(Q[3]) :: "memory")
template <bool PERM = false, bool SWAP = false>
DI void gemm_mainloop(f32x4 (&acc)[4][4], const bf16_t* __restrict__ A, int lda, const bf16_t* __restrict__ B, int ldb, int K, bf16_t* As, bf16_t* Bs) {
  const int tid = get_tid(), lane = tid & 63, wid = tid >> 6, wr = wid >> 1, wc = wid & 1, lr = lane & 15, lg = lane >> 4;
  const int crow = tid >> 3, ckc = (tid & 7) * 8;
  constexpr int TB = 128 * 64;
  const int swc = (((tid & 7) ^ (crow & 7)) * 8);
  const int swcB = PERM ? (((tid & 7) ^ ((((crow >> 3) & 3) * 2 + ((crow & 7) >> 1)) & 7)) * 8) : swc;
  u32x4 ra0[4], rb0[4], ra1[4], rb1[4];
  unsigned aoff[4], boff[4];
#pragma unroll
  for (int i = 0; i < 4; ++i) { aoff[i] = (unsigned)(((crow + i * 32) * lda + ckc) * 2); boff[i] = (unsigned)(((crow + i * 32) * ldb + ckc) * 2); }
#define GM_LOAD(RA, RB, KOFF) do { const char* ab_ = (const char*)A + (size_t)(KOFF) * 2; const char* bb_ = (const char*)B + (size_t)(KOFF) * 2; \
    _Pragma("unroll") for (int i = 0; i < 4; ++i) { RA[i] = gload_async_s(ab_, aoff[i]); RB[i] = gload_async_s(bb_, boff[i]); } } while (0)
#define GM_STORE(RA, RB, BUF) do { _Pragma("unroll") for (int i = 0; i < 4; ++i) { *(u32x4*)(As + (BUF) * 2 * TB + (crow + i * 32) * 64 + swc) = RA[i]; *(u32x4*)(As + (BUF) * 2 * TB + TB + (crow + i * 32) * 64 + swcB) = RB[i]; } } while (0)
#define GM_COMPUTE(BUF) do { const bf16_t* as_ = As + (BUF) * 2 * TB; const bf16_t* bs_ = as_ + TB; \
    bf16x8 af[2][4], bfr[2][4];     \
    _Pragma("unroll") for (int ks = 0; ks < 2; ++ks) { const int co_ = ((ks * 4 + lg) ^ (lr & 7)) * 8; \
      _Pragma("unroll") for (int mi = 0; mi < 4; ++mi) af[ks][mi] = *(const bf16x8*)(as_ + (wr * 64 + mi * 16 + lr) * 64 + co_); \
      _Pragma("unroll") for (int ni = 0; ni < 4; ++ni) { \
        if (PERM) { const int rw_ = (ni & 1) * 4 + (lr & 3); const int key_ = ((lr >> 2) * 2 + (rw_ >> 1)) & 7; bfr[ks][ni] = *(const bf16x8*)(bs_ + (wc * 64 + (ni >> 1) * 32 + (lr >> 2) * 8 + rw_) * 64 + (((ks * 4 + lg) ^ key_) * 8)); } \
        else bfr[ks][ni] = *(const bf16x8*)(bs_ + (wc * 64 + ni * 16 + lr) * 64 + co_); } } \
    __builtin_amdgcn_sched_barrier(0); \
    __builtin_amdgcn_s_setprio(1); \
    _Pragma("unroll") for (int ks = 0; ks < 2; ++ks) _Pragma("unroll") for (int mi = 0; mi < 4; ++mi) _Pragma("unroll") for (int ni = 0; ni < 4; ++ni) acc[mi][ni] = SWAP ? MFMA16(af[ks][mi], bfr[ks][ni], acc[mi][ni]) : MFMA16(bfr[ks][ni], af[ks][mi], acc[mi][ni]); \
    __builtin_amdgcn_s_setprio(0); \
    __builtin_amdgcn_sched_barrier(0); } while (0)
  asm volatile("s_waitcnt vmcnt(0)" ::: "memory");
  GM_LOAD(ra0, rb0, 0); GM_LOAD(ra1, rb1, 64);
  __syncthreads();
  VM_WAIT8(8, ra0, rb0); GM_STORE(ra0, rb0, 0); GM_LOAD(ra0, rb0, (128 < K ? 128 : 0));
  __syncthreads();
  for (int k0 = 0; k0 < K; k0 += 128) {
    const int kn1 = k0 + 192 < K ? k0 + 192 : 0, kn0 = k0 + 256 < K ? k0 + 256 : 0;
    VM_WAIT8(8, ra1, rb1); GM_STORE(ra1, rb1, 1); GM_LOAD(ra1, rb1, kn1);
    GM_COMPUTE(0); __syncthreads();
    VM_WAIT8(8, ra0, rb0); GM_STORE(ra0, rb0, 0); GM_LOAD(ra0, rb0, kn0);
    GM_COMPUTE(1); __syncthreads();
  }
  VM_WAIT8(0, ra0, rb0); VM_WAIT8(0, ra1, rb1);
#undef GM_LOAD
#undef GM_STORE
#undef GM_COMPUTE
}
DI void zero_acc(f32x4 (&acc)[4][4]) {
#pragma unroll
  for (int mi = 0; mi < 4; ++mi)
#pragma unroll
    for (int ni = 0; ni < 4; ++ni) acc[mi][ni] = (f32x4){0.f, 0.f, 0.f, 0.f};
}

template <int KC, bool PERM, class Epi>
DI void gemm_stream(const bf16_t* __restrict__ A, const bf16_t* __restrict__ W, int ntiles, int NT, bf16_t* As, const Epi& epi) {
  const int G = gridDim.x, bid = get_bid();
  if (bid >= ntiles) return;
  constexpr int KT = KC / 64;
  const int T = (ntiles - bid + G - 1) / G, total = T * KT;
  const int tid = get_tid(), lane = tid & 63, wid = tid >> 6, wr = wid >> 1, wc = wid & 1, lr = lane & 15, lg = lane >> 4;
  const int crow = tid >> 3, ckc = (tid & 7) * 8;
  constexpr int TB = 128 * 64;
  const int swc = (((tid & 7) ^ (crow & 7)) * 8);
  const int swcB = PERM ? (((tid & 7) ^ ((((crow >> 3) & 3) * 2 + ((crow & 7) >> 1)) & 7)) * 8) : swc;
  unsigned aoff[4];
#pragma unroll
  for (int i = 0; i < 4; ++i) aoff[i] = (unsigned)(((crow + i * 32) * KC + ckc) * 2);
  u32x4 ra0[4], rb0[4], ra1[4], rb1[4];
  bf16x8 af[2][4], bfr[2][4];
  f32x4 acc[4][4]; zero_acc(acc);
#define GS_LOAD(RA, RB, I) do { int i_ = (I); int ti_ = i_ / KT; const int ko_ = (i_ - ti_ * KT) * 64; ti_ = ti_ < T ? ti_ : T - 1; const int t_ = bid + ti_ * G; const int mt_ = t_ / NT, nt_ = t_ - mt_ * NT; \
    const char* ab_ = (const char*)(A + (size_t)mt_ * 128 * KC + ko_); const char* bb_ = (const char*)(W + (size_t)nt_ * 128 * KC + ko_); \
    _Pragma("unroll") for (int i = 0; i < 4; ++i) { RA[i] = gload_async_s(ab_, aoff[i]); RB[i] = gload_async_s(bb_, aoff[i]); } } while (0)
#define GS_STORE(RA, RB, BUF) do { _Pragma("unroll") for (int i = 0; i < 4; ++i) { *(u32x4*)(As + (BUF) * 2 * TB + (crow + i * 32) * 64 + swc) = RA[i]; *(u32x4*)(As + (BUF) * 2 * TB + TB + (crow + i * 32) * 64 + swcB) = RB[i]; } } while (0)
#define GS_COMPUTE(BUF) do { const bf16_t* as_ = As + (BUF) * 2 * TB; const bf16_t* bs_ = as_ + TB; \
    _Pragma("unroll") for (int ks = 0; ks < 2; ++ks) { const int co_ = ((ks * 4 + lg) ^ (lr & 7)) * 8; \
      _Pragma("unroll") for (int mi = 0; mi < 4; ++mi) af[ks][mi] = *(const bf16x8*)(as_ + (wr * 64 + mi * 16 + lr) * 64 + co_); \
      _Pragma("unroll") for (int ni = 0; ni < 4; ++ni) { \
        if (PERM) { const int rw_ = (ni & 1) * 4 + (lr & 3); const int key_ = ((lr >> 2) * 2 + (rw_ >> 1)) & 7; bfr[ks][ni] = *(const bf16x8*)(bs_ + (wc * 64 + (ni >> 1) * 32 + (lr >> 2) * 8 + rw_) * 64 + (((ks * 4 + lg) ^ key_) * 8)); } \
        else bfr[ks][ni] = *(const bf16x8*)(bs_ + (wc * 64 + ni * 16 + lr) * 64 + co_); } } \
    __builtin_amdgcn_sched_barrier(0); __builtin_amdgcn_s_setprio(1); \
    _Pragma("unroll") for (int ks = 0; ks < 2; ++ks) _Pragma("unroll") for (int mi = 0; mi < 4; ++mi) _Pragma("unroll") for (int ni = 0; ni < 4; ++ni) acc[mi][ni] = MFMA16(bfr[ks][ni], af[ks][mi], acc[mi][ni]); \
    __builtin_amdgcn_s_setprio(0); __builtin_amdgcn_sched_barrier(0); } while (0)
  asm volatile("s_waitcnt vmcnt(0)" ::: "memory");
  GS_LOAD(ra0, rb0, 0); GS_LOAD(ra1, rb1, 1);
  __syncthreads();
  VM_WAIT8(8, ra0, rb0); GS_STORE(ra0, rb0, 0); GS_LOAD(ra0, rb0, 2);
  __syncthreads();
  for (int sidx = 0; sidx < total; sidx += 2) {
    VM_WAIT8(8, ra1, rb1); GS_STORE(ra1, rb1, 1); GS_LOAD(ra1, rb1, sidx + 3);
    GS_COMPUTE(0); __syncthreads();
    VM_WAIT8(8, ra0, rb0); GS_STORE(ra0, rb0, 0); GS_LOAD(ra0, rb0, sidx + 4);
    GS_COMPUTE(1); __syncthreads();
    if (((sidx + 2) & (KT - 1)) == 0) {
      const int t_ = bid + (sidx / KT) * G; const int mt_ = t_ / NT, nt_ = t_ - mt_ * NT;
      epi(acc, mt_ * 128, nt_ * 128);
      zero_acc(acc);
    }
  }
  VM_WAIT8(0, ra0, rb0); VM_WAIT8(0, ra1, rb1);
#undef GS_LOAD
#undef GS_STORE
#undef GS_COMPUTE
}

DI void convert_tile(const float* __restrict__ src, int K, int N, bf16_t* __restrict__ dst, int kt, int nt, float* tile) {
  const int tid = get_tid();
  { const int r = tid >> 4, c4 = (tid & 15) * 4;
#pragma unroll
    for (int i = 0; i < 4; ++i) { const int k = r + i * 16; const f32x4 v = *(const f32x4*)(src + (size_t)(kt * 64 + k) * N + nt * 64 + c4);
      tile[k * 65 + c4 + 0] = v[0]; tile[k * 65 + c4 + 1] = v[1]; tile[k * 65 + c4 + 2] = v[2]; tile[k * 65 + c4 + 3] = v[3]; } }
  __syncthreads();
  { const int n = tid >> 2, kc = (tid & 3) * 16; u32x4 o0, o1;
#pragma unroll
    for (int q = 0; q < 4; ++q) { o0[q] = pack2(tile[(kc + 2 * q) * 65 + n], tile[(kc + 2 * q + 1) * 65 + n]); o1[q] = pack2(tile[(kc + 8 + 2 * q) * 65 + n], tile[(kc + 8 + 2 * q + 1) * 65 + n]); }
    bf16_t* d = dst + (size_t)(nt * 64 + n) * K + kt * 64 + kc; *(u32x4*)d = o0; *(u32x4*)(d + 8) = o1; }
  __syncthreads();
}
DI void convert_item(const Params& p, int l, int t, float* tile) {
  unsigned char* ws = p.ws;
  const float* src; bf16_t* dst; int K, N, idx;
  if (t < 1472) { idx = t; src = p.w_in + (size_t)l * D * DIN; K = D; N = DIN; dst = (bf16_t*)(ws + OFF_W_IN); }
  else if (t < 1536) { idx = t - 1472; src = p.s5_wglu + (size_t)l * 512 * 512; K = 512; N = 512; dst = (bf16_t*)(ws + OFF_W_GLU); }
  else if (t < 1664) { idx = t - 1536; src = p.w_pd + (size_t)l * 512 * D; K = 512; N = D; dst = (bf16_t*)(ws + OFF_W_PD); }
  else if (t < 1792) { idx = t - 1664; src = p.w_ps + (size_t)l * 512 * D; K = 512; N = D; dst = (bf16_t*)(ws + OFF_W_PS); }
  else if (t < 1920) { idx = t - 1792; src = p.w_pw + (size_t)l * 512 * D; K = 512; N = D; dst = (bf16_t*)(ws + OFF_W_PW); }
  else if (t < 2176) { idx = t - 1920; src = p.w_out + (size_t)l * D * D; K = D; N = D; dst = (bf16_t*)(ws + OFF_W_OUT); }
  else if (t < 3200) { idx = t - 2176; src = p.w_ff1 + (size_t)l * D * DFF; K = D; N = DFF; dst = (bf16_t*)(ws + OFF_W_FF1); }
  else { idx = t - 3200; src = p.w_ff2 + (size_t)l * DFF * D; K = DFF; N = D; dst = (bf16_t*)(ws + OFF_W_FF2); }
  const int nts = N / 64; convert_tile(src, K, N, dst, idx / nts, idx % nts, tile);
}
constexpr int CONV_EARLY = 3200, CONV_ALL = 4224;
DI void convert_layer(const Params& p, int l, int t_begin, unsigned char* smem) {
  float* tile = (float*)smem;
  for (int t = t_begin + get_bid(); t < CONV_ALL; t += gridDim.x) convert_item(p, l, t, tile);
}
DI void convert_steal(const Params& p, int l, unsigned char* smem) {
  float* tile = (float*)smem;
  volatile int* smw = (volatile int*)(smem + SMEM_BYTES - 16);
  unsigned* ctr = (unsigned*)(p.ws + OFF_LAM) + 48 + l;
  for (;;) {
    __syncthreads();
    if (get_tid() == 0) *smw = (int)atomicAdd(ctr, 1u);
    __syncthreads();
    int t = *smw; t = __builtin_amdgcn_readfirstlane(t);
    if (t >= CONV_EARLY) break;
    convert_item(p, l, t, tile);
  }
}

DI void phase0_misc(const Params& p, unsigned char* smem) {
  unsigned char* ws = p.ws;
  const int tid = get_tid();
  if (get_bid() == 0) {
    float* rope = (float*)(ws + OFF_ROPE);
    for (int i = tid; i < 1024; i += 256) { const int pos = i >> 4, f = i & 15; const float inv = powf(10000.0f, -(float)f / 16.0f); const float ang = (float)pos * inv; rope[i] = cosf(ang); rope[1024 + i] = sinf(ang); }
    if (tid < DEPTH) { const int l = tid; float s1 = 0.f, s2 = 0.f;
      for (int i = 0; i < 64; ++i) { s1 += p.lq1[l * 64 + i] * p.lk1[l * 64 + i]; s2 += p.lq2[l * 64 + i] * p.lk2[l * 64 + i]; }
      const float lam_init = 0.8f - 0.6f * expf(-0.3f * (float)l);
      ((float*)(ws + OFF_LAM))[l] = expf(s1) - expf(s2) + lam_init; }
    if (tid >= 64 && tid < 64 + DEPTH) { const int l = tid - 64; float a = 0.f, b2 = 0.f, c2 = 0.f, d2 = 0.f;
      for (int i = 0; i < 64; ++i) { a = fmaxf(a, fabsf(p.dq_g[l * 64 + i])); b2 = fmaxf(b2, fabsf(p.dk_g[l * 64 + i])); c2 = fmaxf(c2, fabsf(p.wq_g[l * 64 + i])); d2 = fmaxf(d2, fabsf(p.wk_g[l * 64 + i])); }
      ((float*)(ws + OFF_LAM))[4 + l] = 8.0f * LOG2E * 1.02f * a * b2;
      ((float*)(ws + OFF_LAM))[8 + l] = 8.0f * LOG2E * 1.02f * c2 * d2;
      for (int i = 0; i < 8; ++i) ((unsigned*)(ws + OFF_LAM))[16 + l * 8 + i] = 0u;
      ((unsigned*)(ws + OFF_LAM))[48 + l] = 0u; }
  }
  float* sc = (float*)smem;
  float* red = sc + 5 * 1024;
  for (int i = tid; i < 5 * 1024; i += 256) { const int bb = i >> 10, k = i & 1023; const float v = bb < 4 ? p.c[bb * 1024 + k] : p.c_ctx[k]; sc[i] = v / (1.0f + __expf(-v)); }
  __syncthreads();
  float* modv = (float*)(ws + OFF_MODV);
  for (int t = get_bid(); t < DEPTH * 96; t += gridDim.x) {
    const int l = t / 96, cb = t % 96, kq = tid >> 6, cl = tid & 63, col = cb * 64 + cl;
    const float* w = p.w_mod + (size_t)l * D * 6144 + col;
    float s[5] = {0.f, 0.f, 0.f, 0.f, 0.f};
    for (int k = kq * 256; k < kq * 256 + 256; ++k) { const float wv = w[(size_t)k * 6144];
#pragma unroll
      for (int bb = 0; bb < 5; ++bb) s[bb] += sc[bb * 1024 + k] * wv; }
#pragma unroll
    for (int bb = 0; bb < 5; ++bb) red[(kq * 5 + bb) * 64 + cl] = s[bb];
    __syncthreads();
    for (int i = tid; i < 5 * 64; i += 256) { const int bb = i >> 6, c2 = i & 63; const float v = red[(0 * 5 + bb) * 64 + c2] + red[(1 * 5 + bb) * 64 + c2] + red[(2 * 5 + bb) * 64 + c2] + red[(3 * 5 + bb) * 64 + c2];
      modv[((size_t)l * 5 + bb) * 6144 + cb * 64 + c2] = v + p.b_mod[l * 6144 + cb * 64 + c2]; }
    __syncthreads();
  }
}

DI void norm_phase(const Params& p, int l, const float* gvec, int sh_off, int sc_off, int nrows, bool first = false) {
  const int tid = get_tid(), lane = tid & 63, wid = tid >> 6;
  const float* h = (const float*)(p.ws + OFF_H); bf16_t* out = (bf16_t*)(p.ws + OFF_ABUF);
  const float* modv = (const float*)(p.ws + OFF_MODV) + (size_t)l * 5 * 6144;
  constexpr int RPW = 4;
  for (int t = get_bid(); t < nrows / (4 * RPW); t += gridDim.x) {
    const int row0 = t * (4 * RPW) + wid * RPW;
    const int bb = row0 < NLAT ? row0 / SEQ : 4;
    const float* mv = modv + bb * 6144;
    f32x4 v[RPW][4];
#pragma unroll
    for (int r = 0; r < RPW; ++r) { const int row = row0 + r;
      const float* hr = first ? (row < NLAT ? p.x + (size_t)row * D : p.ctx + (size_t)(row - NLAT) * D) : h + (size_t)row * D;
#pragma unroll
      for (int it = 0; it < 4; ++it) v[r][it] = *(const f32x4*)(hr + it * 256 + lane * 4); }
    f32x4 gm[4], s0[4];
#pragma unroll
    for (int it = 0; it < 4; ++it) { const int idx = it * 256 + lane * 4;
      const f32x4 g = *(const f32x4*)(gvec + idx), s1 = *(const f32x4*)(mv + sc_off + idx); s0[it] = *(const f32x4*)(mv + sh_off + idx);
      gm[it] = g * (1.0f + s1); }
    float ss[RPW];
#pragma unroll
    for (int r = 0; r < RPW; ++r) { float a = 0.f;
#pragma unroll
      for (int it = 0; it < 4; ++it) a += v[r][it][0] * v[r][it][0] + v[r][it][1] * v[r][it][1] + v[r][it][2] * v[r][it][2] + v[r][it][3] * v[r][it][3];
      ss[r] = a; }
#pragma unroll
    for (int m = 1; m < 64; m <<= 1)
#pragma unroll
      for (int r = 0; r < RPW; ++r) ss[r] += xshfl(ss[r], m);
#pragma unroll
    for (int r = 0; r < RPW; ++r) { const float rstd = rsqrtf(ss[r] * (1.0f / 1024.0f) + EPS);
#pragma unroll
      for (int it = 0; it < 4; ++it) { const int idx = it * 256 + lane * 4;
        const f32x4 y = v[r][it] * rstd * gm[it] + s0[it];
        u32x2 o; o[0] = pack2(y[0], y[1]); o[1] = pack2(y[2], y[3]); *(u32x2*)(out + (size_t)(row0 + r) * D + idx) = o; } }
  }
}

DI void inproj_epilogue(const Params& p, int l, const f32x4 (&acc)[4][4], int m0, int n0) {
  unsigned char* ws = p.ws;
  const int tid = get_tid(), lane = tid & 63, wid = tid >> 6, wr = wid >> 1, wc = wid & 1, lr = lane & 15, lg = lane >> 4;
  const bool is_lat = m0 < NLAT;
  int b, i0; if (is_lat) { b = m0 / SEQ; i0 = m0 % SEQ; } else { const int c0 = m0 - NLAT; b = c0 / CTX; i0 = c0 % CTX; }
  const int pos0 = is_lat ? CTX + i0 : i0;
  const int hc = n0 + wc * 64;
  int seg;
  if (n0 < 512) seg = 0; else if (n0 < 1024) seg = 1; else if (n0 < 1536) seg = 2; else if (n0 < 2048) seg = 3; else if (n0 < 2560) seg = 4; else if (n0 < 2688) seg = 5; else if (n0 < 2816) seg = 6; else seg = 7;
  if (seg == 0 || seg == 1 || seg == 4 || seg == 5) {
    const float* gv; bf16_t* dst; float qs = 1.0f;
    if (seg == 0) { const int c = hc; gv = p.dq_g + l * 64; dst = (bf16_t*)(ws + OFF_QD) + ((size_t)((b * 2 + c / 256) * 4 + (c % 256) / 64) * POS) * 64; qs = 0.125f * LOG2E; }
    else if (seg == 1) { const int c = hc - 512; gv = p.dk_g + l * 64; dst = (bf16_t*)(ws + OFF_KD) + ((size_t)((b * 2 + c / 256) * 4 + (c % 256) / 64) * POS) * 64; }
    else if (seg == 4) { const int c = hc - 2048; gv = p.wq_g + l * 64; dst = (bf16_t*)(ws + OFF_QW) + ((size_t)(b * 8 + c / 64) * POS) * 64; qs = 0.125f * LOG2E; }
    else { const int c = hc - 2560; gv = p.wk_g + l * 64; dst = (bf16_t*)(ws + OFF_KW) + ((size_t)(b * 2 + c / 64) * POS) * 64; }
    const float* rope = (const float*)(ws + OFF_ROPE);
    f32x4 gq[4];
#pragma unroll
    for (int ni = 0; ni < 4; ++ni) gq[ni] = *(const f32x4*)(gv + ni * 16 + lg * 4);
#pragma unroll
    for (int mi = 0; mi < 4; ++mi) {
      const int r = wr * 64 + mi * 16 + lr;
      float ss = 0.f;
#pragma unroll
      for (int ni = 0; ni < 4; ++ni)
#pragma unroll
        for (int j = 0; j < 4; ++j) ss += acc[mi][ni][j] * acc[mi][ni][j];
      ss += xshfl(ss, 16); ss += xshfl(ss, 32);
      const float rstd = rsqrtf(ss * (1.0f / 64.0f) + EPS);
      f32x4 v[4];
#pragma unroll
      for (int ni = 0; ni < 4; ++ni) v[ni] = acc[mi][ni] * rstd * gq[ni];
      if (is_lat) {
        const int li = i0 + r, gr = li >> 6, gc = li & 63;
#pragma unroll
        for (int ni = 0; ni < 2; ++ni) {
          const int pi = ni == 0 ? gr : gc;
          const f32x4 cs = *(const f32x4*)(rope + pi * 16 + lg * 4), sn = *(const f32x4*)(rope + 1024 + pi * 16 + lg * 4);
          const f32x4 x1 = v[ni], x2 = v[ni + 2];
          v[ni] = x1 * cs - x2 * sn; v[ni + 2] = x2 * cs + x1 * sn;
        }
      }
      bf16_t* drow = dst + (size_t)(pos0 + r) * 64 + lg * 4;
#pragma unroll
      for (int ni = 0; ni < 4; ++ni) { u32x2 o; o[0] = pack2(v[ni][0] * qs, v[ni][1] * qs); o[1] = pack2(v[ni][2] * qs, v[ni][3] * qs); *(u32x2*)(drow + ni * 16) = o; }
    }
  } else if (seg == 2 || seg == 6) {
#pragma unroll
    for (int mi = 0; mi < 4; ++mi) {
      const int pos = pos0 + wr * 64 + mi * 16 + lr;
#pragma unroll
      for (int ni = 0; ni < 4; ++ni)
#pragma unroll
        for (int j = 0; j < 4; ++j) {
          const int col = hc + ni * 16 + lg * 4 + j; bf16_t* dst;
          if (seg == 2) { const int c = col - 1024; dst = (bf16_t*)(ws + OFF_VDT) + ((size_t)(b * 4 + c / 128) * 128 + (c % 128)) * POS + pos; }
          else { const int c = col - 2688; dst = (bf16_t*)(ws + OFF_VWT) + ((size_t)(b * 2 + c / 64) * 64 + (c % 64)) * POS + pos; }
          *dst = (bf16_t)(pack2(acc[mi][ni][j], 0.f) & 0xffffu);
        }
    }
  } else if (seg == 3) {
    bf16_t* su = (bf16_t*)(ws + OFF_SU);
#pragma unroll
    for (int mi = 0; mi < 4; ++mi) { const int pos = pos0 + wr * 64 + mi * 16 + lr;
#pragma unroll
      for (int ni = 0; ni < 4; ++ni) { u32x2 o; o[0] = pack2(acc[mi][ni][0], acc[mi][ni][1]); o[1] = pack2(acc[mi][ni][2], acc[mi][ni][3]);
        *(u32x2*)(su + ((size_t)(b * 32 + (hc - 1536) / 16 + ni) * POS + pos) * 16 + lg * 4) = o; } }
  } else {
    bf16_t* gt = (bf16_t*)(ws + OFF_GATES);
#pragma unroll
    for (int mi = 0; mi < 4; ++mi) { const int row = m0 + wr * 64 + mi * 16 + lr;
#pragma unroll
      for (int ni = 0; ni < 4; ++ni) { u32x2 o; o[0] = pack2(sigmoidf_(acc[mi][ni][0]), sigmoidf_(acc[mi][ni][1])); o[1] = pack2(sigmoidf_(acc[mi][ni][2]), sigmoidf_(acc[mi][ni][3]));
        *(u32x2*)(gt + (size_t)row * 3072 + (hc - 2816) + ni * 16 + lg * 4) = o; } }
  }
}
DI void inproj_phase(const Params& p, int l, unsigned char* smem) {
  bf16_t* As = (bf16_t*)smem; bf16_t* Bs = As + 128 * LDT;
  const bf16_t* A = (const bf16_t*)(p.ws + OFF_ABUF); const bf16_t* W = (const bf16_t*)(p.ws + OFF_W_IN);
  constexpr int NT = DIN / 128, MT = NTOK / 128;
  for (int t = get_bid(); t < MT * NT; t += gridDim.x) {
    const int mt = t / NT, nt = t % NT;
    f32x4 acc[4][4]; zero_acc(acc);
    const int n0v = nt * 128;
    if ((n0v >= 1024 && n0v < 1536) || (n0v >= 2688 && n0v < 2816)) {
      gemm_mainloop<false, true>(acc, A + (size_t)mt * 128 * D, D, W + (size_t)nt * 128 * D, D, D, As, Bs);
      const int tid_ = get_tid(), lane_ = tid_ & 63, wid_ = tid_ >> 6, wr_ = wid_ >> 1, wc_ = wid_ & 1, lr_ = lane_ & 15, lg_ = lane_ >> 4;
      const int m0 = mt * 128; const bool is_lat = m0 < NLAT;
      int b, i0; if (is_lat) { b = m0 / SEQ; i0 = m0 % SEQ; } else { const int c0 = m0 - NLAT; b = c0 / CTX; i0 = c0 % CTX; }
      const int pos0 = is_lat ? CTX + i0 : i0;
#pragma unroll
      for (int ni = 0; ni < 4; ++ni) {
        const int col = n0v + wc_ * 64 + ni * 16 + lr_;
        bf16_t* drow;
        if (n0v < 1536) { const int c = col - 1024; drow = (bf16_t*)(p.ws + OFF_VDT) + ((size_t)(b * 4 + c / 128) * 128 + (c % 128)) * POS; }
        else { const int c = col - 2688; drow = (bf16_t*)(p.ws + OFF_VWT) + ((size_t)(b * 2 + c / 64) * 64 + (c % 64)) * POS; }
#pragma unroll
        for (int mi = 0; mi < 4; ++mi) { u32x2 o; o[0] = pack2(acc[mi][ni][0], acc[mi][ni][1]); o[1] = pack2(acc[mi][ni][2], acc[mi][ni][3]);
          *(u32x2*)(drow + pos0 + wr_ * 64 + mi * 16 + lg_ * 4) = o; }
      }
    } else {
      gemm_mainloop(acc, A + (size_t)mt * 128 * D, D, W + (size_t)nt * 128 * D, D, D, As, Bs);
      inproj_epilogue(p, l, acc, mt * 128, nt * 128);
    }
  }
}

constexpr int NW = 4;
constexpr int NTHR = NW * 64;
constexpr int QU = NW * 32;
template <int DV, bool TWOK>
DI void attn_core_d1(f32x4 (&O)[2][DV / 16], float (&lsum)[2], const bf16x8 (&Qf)[2][2], float negm,
                  const bf16_t* __restrict__ Kp0, const bf16_t* __restrict__ Kp1, const bf16_t* __restrict__ Vt, int t0, int t1, int tm0, int tm1, int qlat0, unsigned char* smem) {
  constexpr int KB = TWOK ? 16384 : 8192, BUFB = KB + DV * 128;
  constexpr int NKL = (TWOK ? 16 : 8) / NW, NVL = DV / 8 / NW;
  const int tid = get_tid(), lane = tid & 63, wid = __builtin_amdgcn_readfirstlane(tid >> 6), lr = lane & 15, lg = lane >> 4;
  const int rl = lane >> 3, lc = (lane & 7) ^ rl;
  const int n0 = t1 - t0, ntl = n0 + (tm1 - tm0);
  u32x4 rk[NKL], rv[NVL];
#define ATTN_GLOAD(KEY0) do { const int key0_ = (KEY0); \
    _Pragma("unroll") for (int i = 0; i < NKL; ++i) { const int L = wid + i * NW; const bf16_t* kp_ = (i * NW >= 8) ? Kp1 : Kp0; rk[i] = *(const u32x4*)(kp_ + (size_t)(key0_ + (L & 7) * 8 + rl) * 64 + (((lane & 7) ^ ((((L & 3) * 2) + (rl >> 1)) & 7)) * 8)); } \
    _Pragma("unroll") for (int i = 0; i < NVL; ++i) { const int L = wid + i * NW; rv[i] = *(const u32x4*)(Vt + (size_t)(L * 8 + rl) * POS + key0_ + lc * 8); } } while (0)
#define ATTN_LSTORE(BUF) do { unsigned char* buf_ = (BUF); \
    _Pragma("unroll") for (int i = 0; i < NKL; ++i) *(u32x4*)(buf_ + (wid + i * NW) * 1024 + lane * 16) = rk[i]; \
    _Pragma("unroll") for (int i = 0; i < NVL; ++i) *(u32x4*)(buf_ + KB + (wid + i * NW) * 1024 + lane * 16) = rv[i]; } while (0)
  ATTN_GLOAD((n0 > 0 ? t0 : tm0) * 64);
  __syncthreads();
  ATTN_LSTORE(smem);
  const int sw = lr & 7;
  for (int it = 0; it < ntl; ++it) {
    const bool masked = it >= n0;
    const int key0 = (masked ? tm0 + (it - n0) : t0 + it) * 64;
    const unsigned char* Kb = smem + (it & 1) * BUFB; const unsigned char* Vb = Kb + KB;
    __syncthreads();
    if (it + 1 < ntl) ATTN_GLOAD(((it + 1) >= n0 ? tm0 + (it + 1 - n0) : t0 + it + 1) * 64);
    f32x4 s[4][2];
#pragma unroll
    for (int kt = 0; kt < 4; ++kt) {
      const unsigned char* kr = Kb + ((kt >> 1) * 32 + (lr >> 2) * 8 + (kt & 1) * 4 + (lr & 3)) * 128; const int kkey = ((lr >> 2) * 2 + (kt & 1) * 2 + ((lr & 3) >> 1)) & 7;
      if (!TWOK) {
        const bf16x8 k0f = *(const bf16x8*)(kr + ((lg ^ kkey) << 4)), k1f = *(const bf16x8*)(kr + (((4 + lg) ^ kkey) << 4));
#pragma unroll
        for (int qt = 0; qt < 2; ++qt) { f32x4 z = {negm, negm, negm, negm}; z = MFMA16(k0f, Qf[qt][0], z); s[kt][qt] = MFMA16(k1f, Qf[qt][1], z); }
      } else {
#pragma unroll
        for (int qt = 0; qt < 2; ++qt) {
          const bf16x8 k0f = *(const bf16x8*)(kr + qt * 8192 + ((lg ^ kkey) << 4)), k1f = *(const bf16x8*)(kr + qt * 8192 + (((4 + lg) ^ kkey) << 4));
          f32x4 z = {negm, negm, negm, negm}; z = MFMA16(k0f, Qf[qt][0], z); s[kt][qt] = MFMA16(k1f, Qf[qt][1], z); }
      }
    }
    if (masked) {
#pragma unroll
      for (int kt = 0; kt < 4; ++kt)
#pragma unroll
        for (int qt = 0; qt < 2; ++qt)
#pragma unroll
          for (int j = 0; j < 4; ++j) { const int kl = key0 - CTX + (kt >> 1) * 32 + lg * 8 + (kt & 1) * 4 + j, ql = qlat0 + qt * 16 + lr; const int rel = kl - ql; if (rel > 128 || rel < -128) s[kt][qt][j] = -INFINITY; }
    }
    bf16x8 pf[2][2];
#pragma unroll
    for (int qt = 0; qt < 2; ++qt) {
      float rs = 0.f;
#pragma unroll
      for (int kt = 0; kt < 4; ++kt)
#pragma unroll
        for (int j = 0; j < 4; ++j) { const float e = __builtin_amdgcn_exp2f(s[kt][qt][j]); s[kt][qt][j] = e; rs += e; }
      lsum[qt] += rs;
#pragma unroll
      for (int kk = 0; kk < 2; ++kk) {
        u32x4 w; w[0] = pack2(s[2 * kk][qt][0], s[2 * kk][qt][1]); w[1] = pack2(s[2 * kk][qt][2], s[2 * kk][qt][3]);
        w[2] = pack2(s[2 * kk + 1][qt][0], s[2 * kk + 1][qt][1]); w[3] = pack2(s[2 * kk + 1][qt][2], s[2 * kk + 1][qt][3]);
        pf[qt][kk] = __builtin_bit_cast(bf16x8, w);
      }
    }
#pragma unroll
    for (int et = 0; et < DV / 16; ++et)
#pragma unroll
      for (int kk = 0; kk < 2; ++kk) {
        const bf16x8 vf = *(const bf16x8*)(Vb + (et * 16 + lr) * 128 + (((kk * 4 + lg) ^ sw) << 4));
        O[0][et] = MFMA16(vf, pf[0][kk], O[0][et]);
        O[1][et] = MFMA16(vf, pf[1][kk], O[1][et]);
      }
    if (it + 1 < ntl) ATTN_LSTORE(smem + ((it + 1) & 1) * BUFB);
  }
#undef ATTN_GLOAD
#undef ATTN_LSTORE
}

#define VM_WAIT4(N, R, Q) asm volatile("s_waitcnt vmcnt(" #N ")" : "+v"(R[0]), "+v"(R[1]), "+v"(Q[0]), "+v"(Q[1]) :: "memory")
template <int DV, bool TWOK>
DI void attn_core(f32x4 (&O)[2][DV / 16], float (&lsum)[2], const bf16x8 (&Qf)[2][2], float negm,
                  const bf16_t* __restrict__ Kp0, const bf16_t* __restrict__ Kp1, const bf16_t* __restrict__ Vt, int t0, int t1, int tm0, int tm1, int qlat0, unsigned char* smem) {
  constexpr int KB = TWOK ? 16384 : 8192, BUFB = KB + DV * 128;
  constexpr int NKL = (TWOK ? 16 : 8) / NW, NVL = DV / 8 / NW;
  static_assert((NKL == 4 && NVL == 4) || (NKL == 2 && NVL == 2), "wait macros are written for 8 or 4 loads per set");
  const int tid = get_tid(), lane = tid & 63, wid = __builtin_amdgcn_readfirstlane(tid >> 6), lr = lane & 15, lg = lane >> 4;
  const int rl = lane >> 3, lc = (lane & 7) ^ rl;
  const int n0 = t1 - t0, ntl = n0 + (tm1 - tm0);
  u32x4 rk0[NKL], rv0[NVL], rk1[NKL], rv1[NVL];
#define ATTN_TILE(I) ({ int i_ = (I); i_ = i_ < ntl ? i_ : ntl - 1; (i_ < n0 ? t0 + i_ : tm0 + (i_ - n0)) * 64; })
#define ATTN_GLOAD(RK, RV, KEY0) do { const int key0_ = (KEY0); \
    _Pragma("unroll") for (int i = 0; i < NKL; ++i) { const int L = wid + i * NW; const bf16_t* kp_ = (i * NW >= 8) ? Kp1 : Kp0; RK[i] = gload_async(kp_ + (size_t)(key0_ + (L & 7) * 8 + rl) * 64 + (((lane & 7) ^ ((((L & 3) * 2) + (rl >> 1)) & 7)) * 8)); } \
    _Pragma("unroll") for (int i = 0; i < NVL; ++i) { const int L = wid + i * NW; RV[i] = gload_async(Vt + (size_t)(L * 8 + rl) * POS + key0_ + lc * 8); } } while (0)
#define ATTN_LSTORE(RK, RV, BUF) do { unsigned char* buf_ = (BUF); \
    _Pragma("unroll") for (int i = 0; i < NKL; ++i) *(u32x4*)(buf_ + (wid + i * NW) * 1024 + lane * 16) = RK[i]; \
    _Pragma("unroll") for (int i = 0; i < NVL; ++i) *(u32x4*)(buf_ + KB + (wid + i * NW) * 1024 + lane * 16) = RV[i]; } while (0)
#define ATTN_WAIT(RK, RV) do { if constexpr (NKL == 4) VM_WAIT8(8, RK, RV); else VM_WAIT4(4, RK, RV); } while (0)
#define ATTN_DRAIN(RK, RV) do { if constexpr (NKL == 4) VM_WAIT8(0, RK, RV); else VM_WAIT4(0, RK, RV); } while (0)
  const int sw = lr & 7;
#define ATTN_COMPUTE(IT, BUFP) do { const int it_ = (IT); const bool masked = it_ >= n0; const int key0 = (masked ? tm0 + (it_ - n0) : t0 + it_) * 64; \
    const unsigned char* Kb = (BUFP); const unsigned char* Vb = Kb + KB; \
    bf16x8 pf[2][2]; \
    _Pragma("unroll") for (int qt = 0; qt < 2; ++qt) { f32x4 s4[4]; \
      _Pragma("unroll") for (int kt = 0; kt < 4; ++kt) { const unsigned char* kq = Kb + ((kt >> 1) * 32 + (lr >> 2) * 8 + (kt & 1) * 4 + (lr & 3)) * 128 + (TWOK ? qt * 8192 : 0); const int kkey = ((lr >> 2) * 2 + (kt & 1) * 2 + ((lr & 3) >> 1)) & 7; \
        const bf16x8 k0f = *(const bf16x8*)(kq + ((lg ^ kkey) << 4)), k1f = *(const bf16x8*)(kq + (((4 + lg) ^ kkey) << 4)); \
        f32x4 z = {negm, negm, negm, negm}; z = MFMA16(k0f, Qf[qt][0], z); s4[kt] = MFMA16(k1f, Qf[qt][1], z); } \
      if (masked) { \
        _Pragma("unroll") for (int kt = 0; kt < 4; ++kt) _Pragma("unroll") for (int j = 0; j < 4; ++j) { \
          const int kl = key0 - CTX + (kt >> 1) * 32 + lg * 8 + (kt & 1) * 4 + j, ql = qlat0 + qt * 16 + lr; const int rel = kl - ql; if (rel > 128 || rel < -128) s4[kt][j] = -INFINITY; } } \
      float rs = 0.f; \
      _Pragma("unroll") for (int kt = 0; kt < 4; ++kt) _Pragma("unroll") for (int j = 0; j < 4; ++j) { const float e = __builtin_amdgcn_exp2f(s4[kt][j]); s4[kt][j] = e; rs += e; } \
      lsum[qt] += rs; \
      _Pragma("unroll") for (int kk = 0; kk < 2; ++kk) { u32x4 w; w[0] = pack2(s4[2 * kk][0], s4[2 * kk][1]); w[1] = pack2(s4[2 * kk][2], s4[2 * kk][3]); \
        w[2] = pack2(s4[2 * kk + 1][0], s4[2 * kk + 1][1]); w[3] = pack2(s4[2 * kk + 1][2], s4[2 * kk + 1][3]); pf[qt][kk] = __builtin_bit_cast(bf16x8, w); } } \
    _Pragma("unroll") for (int et = 0; et < DV / 16; ++et) _Pragma("unroll") for (int kk = 0; kk < 2; ++kk) { \
        const bf16x8 vf = *(const bf16x8*)(Vb + (et * 16 + lr) * 128 + (((kk * 4 + lg) ^ sw) << 4)); \
        O[0][et] = MFMA16(vf, pf[0][kk], O[0][et]); O[1][et] = MFMA16(vf, pf[1][kk], O[1][et]); } } while (0)
  asm volatile("s_waitcnt vmcnt(0)" ::: "memory");
  ATTN_GLOAD(rk0, rv0, ATTN_TILE(0)); ATTN_GLOAD(rk1, rv1, ATTN_TILE(1));
  __syncthreads();
  ATTN_WAIT(rk0, rv0); ATTN_LSTORE(rk0, rv0, smem); ATTN_GLOAD(rk0, rv0, ATTN_TILE(2));
  for (int it = 0; it < ntl; it += 2) {
    __syncthreads();
    ATTN_COMPUTE(it, smem);
    ATTN_WAIT(rk1, rv1); ATTN_LSTORE(rk1, rv1, smem + BUFB); ATTN_GLOAD(rk1, rv1, ATTN_TILE(it + 3));
    __syncthreads();
    ATTN_COMPUTE(it + 1, smem + BUFB);
    ATTN_WAIT(rk0, rv0); ATTN_LSTORE(rk0, rv0, smem); ATTN_GLOAD(rk0, rv0, ATTN_TILE(it + 4));
  }
  ATTN_DRAIN(rk0, rv0); ATTN_DRAIN(rk1, rv1);
#undef ATTN_TILE
#undef ATTN_GLOAD
#undef ATTN_LSTORE
#undef ATTN_WAIT
#undef ATTN_DRAIN
#undef ATTN_COMPUTE
}

constexpr int QUD = NW * 16;
DI void diff_unit(const Params& p, int l, int b, int hd, bool is_lat, int qi, unsigned char* smem) {
  unsigned char* ws = p.ws;
  const int tid = get_tid(), lane = tid & 63, wid = __builtin_amdgcn_readfirstlane(tid >> 6), lr = lane & 15, lg = lane >> 4;
  const int qpos0 = (is_lat ? CTX + qi * QUD : qi * QUD) + wid * 16;
  const int ntile = is_lat ? POS / 64 : CTX / 64;
  const float lam = ((const float*)(ws + OFF_LAM))[l];
  const float negm = -((const float*)(ws + OFF_LAM))[4 + l];
  const float lam_init = 0.8f - 0.6f * expf(-0.3f * (float)l);
  const size_t hoff0 = (size_t)((b * 2 + 0) * 4 + hd) * POS * 64, hoff1 = (size_t)((b * 2 + 1) * 4 + hd) * POS * 64;
  const bf16_t* Qd = (const bf16_t*)(ws + OFF_QD); const bf16_t* Kd = (const bf16_t*)(ws + OFF_KD);
  bf16x8 Qf[2][2];
#pragma unroll
  for (int ks = 0; ks < 2; ++ks) { Qf[0][ks] = *(const bf16x8*)(Qd + hoff0 + (size_t)(qpos0 + lr) * 64 + ks * 32 + lg * 8); Qf[1][ks] = *(const bf16x8*)(Qd + hoff1 + (size_t)(qpos0 + lr) * 64 + ks * 32 + lg * 8); }
  float lsum[2] = {0.f, 0.f};
  f32x4 O[2][8];
#pragma unroll
  for (int m = 0; m < 2; ++m)
#pragma unroll
    for (int et = 0; et < 8; ++et) O[m][et] = (f32x4){0.f, 0.f, 0.f, 0.f};
  attn_core_d1<128, true>(O, lsum, Qf, negm, Kd + hoff0, Kd + hoff1, (const bf16_t*)(ws + OFF_VDT) + (size_t)(b * 4 + hd) * 128 * POS, 0, ntile, 0, 0, 0, smem);
  float l0 = lsum[0], l1 = lsum[1];
  l0 += xshfl(l0, 16); l0 += xshfl(l0, 32); l1 += xshfl(l1, 16); l1 += xshfl(l1, 32);
  const float i0 = 1.0f / l0, i1 = lam / l1;
  float ss = 0.f;
#pragma unroll
  for (int et = 0; et < 8; ++et) { O[0][et] = O[0][et] * i0 - O[1][et] * i1;
#pragma unroll
    for (int j = 0; j < 4; ++j) ss += O[0][et][j] * O[0][et][j]; }
  ss += xshfl(ss, 16); ss += xshfl(ss, 32);
  const float rs = rsqrtf(ss * (1.0f / 128.0f) + EPS) * (1.0f - lam_init);
  const float* og = p.dout_g + l * 128; bf16_t* yd = (bf16_t*)(ws + OFF_YD);
  const int qpos = qpos0 + lr;
  const int row = is_lat ? b * SEQ + (qpos - CTX) : NLAT + b * CTX + qpos;
#pragma unroll
  for (int et = 0; et < 8; ++et) { const f32x4 g = *(const f32x4*)(og + et * 16 + lg * 4); const f32x4 y = O[0][et] * rs * g;
    u32x2 o; o[0] = pack2(y[0], y[1]); o[1] = pack2(y[2], y[3]); *(u32x2*)(yd + (size_t)row * 512 + hd * 128 + et * 16 + lg * 4) = o; }
}

DI void win_unit(const Params& p, int l, int b, int qh, bool is_lat, int qi, unsigned char* smem) {
  unsigned char* ws = p.ws;
  const int tid = get_tid(), lane = tid & 63, wid = __builtin_amdgcn_readfirstlane(tid >> 6), lr = lane & 15, lg = lane >> 4;
  const int qpos0 = (is_lat ? CTX + qi * QU : qi * QU) + wid * 32;
  const int kv = qh >> 2;
  const bf16_t* Qp = (const bf16_t*)(ws + OFF_QW) + ((size_t)(b * 8 + qh) * POS + qpos0) * 64;
  bf16x8 Qf[2][2];
#pragma unroll
  for (int qt = 0; qt < 2; ++qt)
#pragma unroll
    for (int ks = 0; ks < 2; ++ks) Qf[qt][ks] = *(const bf16x8*)(Qp + (qt * 16 + lr) * 64 + ks * 32 + lg * 8);
  const float sk = p.w_sink[l * 8 + qh] * LOG2E;
  const float mfix = fmaxf(((const float*)(ws + OFF_LAM))[8 + l], sk);
  const float l0 = lg == 0 ? __builtin_amdgcn_exp2f(sk - mfix) : 0.f;
  float lsum[2] = {l0, l0};
  f32x4 O[2][4];
#pragma unroll
  for (int qt = 0; qt < 2; ++qt)
#pragma unroll
    for (int et = 0; et < 4; ++et) O[qt][et] = (f32x4){0.f, 0.f, 0.f, 0.f};
  int tm0 = 0, tm1 = 0;
  if (is_lat) { const int q0 = qi * QU; tm0 = (q0 + 128) / 64; if (tm0 < 4) tm0 = 4; tm1 = (q0 + QU + 384) / 64; if (tm1 > POS / 64) tm1 = POS / 64; }
  attn_core<64, false>(O, lsum, Qf, -mfix, (const bf16_t*)(ws + OFF_KW) + (size_t)(b * 2 + kv) * POS * 64, nullptr, (const bf16_t*)(ws + OFF_VWT) + (size_t)(b * 2 + kv) * 64 * POS, 0, 4, tm0, tm1, qpos0 - CTX, smem);
  bf16_t* yw = (bf16_t*)(ws + OFF_YW);
#pragma unroll
  for (int qt = 0; qt < 2; ++qt) {
    float ls = lsum[qt]; ls += xshfl(ls, 16); ls += xshfl(ls, 32);
    const float inv = 1.0f / ls;
    const int qpos = qpos0 + qt * 16 + lr;
    const int row = is_lat ? b * SEQ + (qpos - CTX) : NLAT + b * CTX + qpos;
#pragma unroll
    for (int et = 0; et < 4; ++et) { const f32x4 y = O[qt][et] * inv; u32x2 o; o[0] = pack2(y[0], y[1]); o[1] = pack2(y[2], y[3]);
      *(u32x2*)(yw + (size_t)row * 512 + qh * 64 + et * 16 + lg * 4) = o; }
  }
}

constexpr int NR = NW / 2, CR = NCH / NR;
constexpr int BST = 20, SST = 136;
constexpr int S5_WAVE_LDS = 128 * BST * 4 + 16 * SST * 2;
constexpr int EB_PER_UNIT = 2 * (NCH + 8) * 64 * 2;
DI int s5_row(int b, int k, int t) { return k < 8 ? NLAT + b * CTX + k * 32 + t : b * SEQ + (k - 8) * 32 + t; }
DI int s5_cmap(int d, int k) { return d == 0 ? k : (k < 8 ? 7 - k : 143 - k); }
DI void s5_make_bf(const Params& p, int l, int d, int g, float fre, float fim, bf16x8 (&Bf)[8], int lr, int lg) {
#pragma unroll
  for (int q = 0; q < 8; ++q) {
    const int pp = 16 * (q & 3) + lr;
    const float fr = __shfl(fre, pp, 64), fi = __shfl(fim, pp, 64);
    u32x4 w = {0u, 0u, 0u, 0u};
    if (lg < 2) {
      const size_t bo = ((size_t)((l * 2 + d) * 32 + g) * 64 + pp) * 16 + lg * 8;
      const f32x4 br0 = *(const f32x4*)(p.s5_bre + bo), br1 = *(const f32x4*)(p.s5_bre + bo + 4), bi0 = *(const f32x4*)(p.s5_bim + bo), bi1 = *(const f32x4*)(p.s5_bim + bo + 4);
      f32x4 v0, v1;
      if (q < 4) { v0 = fr * br0 - fi * bi0; v1 = fr * br1 - fi * bi1; } else { v0 = fr * bi0 + fi * br0; v1 = fr * bi1 + fi * br1; }
      w[0] = pack2(v0[0], v0[1]); w[1] = pack2(v0[2], v0[3]); w[2] = pack2(v1[0], v1[1]); w[3] = pack2(v1[2], v1[3]);
    }
    Bf[q] = __builtin_bit_cast(bf16x8, w);
  }
}
DI u32x4 s5_load_uf(const bf16_t* sug, int k, int tt, int lr, int lg) { u32x4 uw = {0u, 0u, 0u, 0u}; if (lg < 2) uw = *(const u32x4*)(sug + (size_t)(k * 32 + tt * 16 + lr) * 16 + lg * 8); return uw; }
DI void s5_bu_tile(u32x4 uw, const bf16x8 (&Bf)[8], float* Bsm, int lr, int lg) {
  const bf16x8 uf = __builtin_bit_cast(bf16x8, uw);
#pragma unroll
  for (int q = 0; q < 8; ++q) { f32x4 z = {0.f, 0.f, 0.f, 0.f}; z = MFMA16(Bf[q], uf, z);
#pragma unroll
    for (int jj = 0; jj < 4; ++jj) Bsm[(q * 16 + lg * 4 + jj) * BST + lr] = z[jj]; }
}
#define S5_SCAN(D, AR, AI, WRITE) do { \
    _Pragma("unroll") for (int hb = 0; hb < 2; ++hb) { const int cb = ((D) ? 1 - hb : hb) * 2;     \
      const f32x4 br0_ = *(const f32x4*)(Bsm + lane * BST + cb * 4), br1_ = *(const f32x4*)(Bsm + lane * BST + cb * 4 + 4); \
      const f32x4 bi0_ = *(const f32x4*)(Bsm + (64 + lane) * BST + cb * 4), bi1_ = *(const f32x4*)(Bsm + (64 + lane) * BST + cb * 4 + 4); \
      _Pragma("unroll") for (int st = 0; st < 8; ++st) { const int t8 = (D) ? 7 - st : st; const int tl = cb * 4 + t8; \
        const float br = t8 < 4 ? br0_[t8 & 3] : br1_[t8 & 3], bi = t8 < 4 ? bi0_[t8 & 3] : bi1_[t8 & 3]; \
        const float nr = (AR) * sr - (AI) * si + br, ni = (AR) * si + (AI) * sr + bi; sr = nr; si = ni; \
        if (WRITE) { const unsigned pk = pack2(sr, si); Ssm[tl * SST + lane] = (bf16_t)(pk & 0xffffu); Ssm[tl * SST + 64 + lane] = (bf16_t)(pk >> 16); } } } } while (0)
DI void s5_unit(const Params& p, int l, int b, int g, unsigned char* smem) {
  unsigned char* ws = p.ws;
  const int tid = get_tid(), lane = tid & 63, wid = __builtin_amdgcn_readfirstlane(tid >> 6), lr = lane & 15, lg = lane >> 4;
  float* Bsm = (float*)(smem + wid * S5_WAVE_LDS);
  bf16_t* Ssm = (bf16_t*)(smem + wid * S5_WAVE_LDS + 128 * BST * 4);
  const bf16_t* sug = (const bf16_t*)(ws + OFF_SU) + (size_t)(b * 32 + g) * POS * 16;
  float* Eb = (float*)(ws + OFF_EB) + (size_t)(b * 32 + g) * EB_PER_UNIT;
  float are[2], aim[2], fre[2], fim[2];
#pragma unroll
  for (int d = 0; d < 2; ++d) {
    const int pi = ((l * 2 + d) * 32 + g) * 64 + lane;
    const float lre = p.s5_lre[pi], lim = p.s5_lim[pi], dt = expf(p.s5_ldt[(l * 2 + d) * 32 + g]);
    const float mag = expf(lre * dt), ang = lim * dt;
    are[d] = mag * cosf(ang); aim[d] = mag * sinf(ang);
    const float den = lre * lre + lim * lim, nre = are[d] - 1.0f;
    fre[d] = (nre * lre + aim[d] * lim) / den; fim[d] = (aim[d] * lre - nre * lim) / den;
  }
  bf16x8 Bf[2][8];
  s5_make_bf(p, l, 0, g, fre[0], fim[0], Bf[0], lr, lg);
  s5_make_bf(p, l, 1, g, fre[1], fim[1], Bf[1], lr, lg);
  {
    const int d = wid & 1, r = wid >> 1;
    const float ar = d ? are[1] : are[0], ai = d ? aim[1] : aim[0];
    float sr = 0.f, si = 0.f;
    for (int ci = 0; ci < CR; ++ci) {
      const int c = r * CR + ci, k = s5_cmap(d, c);
      { float* e_ = Eb + ((size_t)(d * (NCH + 8) + c) * 64 + lane) * 2; __hip_atomic_store(e_, sr, __ATOMIC_RELAXED, __HIP_MEMORY_SCOPE_AGENT); __hip_atomic_store(e_ + 1, si, __ATOMIC_RELAXED, __HIP_MEMORY_SCOPE_AGENT); }
      const u32x4 ua = s5_load_uf(sug, k, d ? 1 : 0, lr, lg), ub = s5_load_uf(sug, k, d ? 0 : 1, lr, lg);
#pragma unroll
      for (int hh = 0; hh < 2; ++hh) {
        const u32x4 uw = hh ? ub : ua;
        __builtin_amdgcn_wave_barrier();
        if (d) s5_bu_tile(uw, Bf[1], Bsm, lr, lg); else s5_bu_tile(uw, Bf[0], Bsm, lr, lg);
        __builtin_amdgcn_wave_barrier();
        if (d) S5_SCAN(1, ar, ai, false); else S5_SCAN(0, ar, ai, false);
      }
    }
    { float* e_ = Eb + ((size_t)(d * (NCH + 8) + NCH + r) * 64 + lane) * 2; __hip_atomic_store(e_, sr, __ATOMIC_RELAXED, __HIP_MEMORY_SCOPE_AGENT); __hip_atomic_store(e_ + 1, si, __ATOMIC_RELAXED, __HIP_MEMORY_SCOPE_AGENT); }
  }
  asm volatile("s_waitcnt vmcnt(0)" ::: "memory"); __syncthreads();
  bf16x8 Cf[2][4];
  float a32r[2], a32i[2], aCRr[2], aCRi[2];
#pragma unroll
  for (int d = 0; d < 2; ++d) {
#pragma unroll
    for (int ks = 0; ks < 4; ++ks) {
      const float* src = (ks < 2 ? p.s5_cre : p.s5_cim) + ((size_t)((l * 2 + d) * 32 + g) * 16 + lr) * 64 + (ks & 1) * 32 + lg * 8;
      const f32x4 v0 = *(const f32x4*)src, v1 = *(const f32x4*)(src + 4); const float sg = ks < 2 ? 1.0f : -1.0f;
      u32x4 w; w[0] = pack2(sg * v0[0], sg * v0[1]); w[1] = pack2(sg * v0[2], sg * v0[3]); w[2] = pack2(sg * v1[0], sg * v1[1]); w[3] = pack2(sg * v1[2], sg * v1[3]);
      Cf[d][ks] = __builtin_bit_cast(bf16x8, w);
    }
    float pr = are[d], pi_ = aim[d];
#pragma unroll
    for (int q = 0; q < 5; ++q) { const float nr = pr * pr - pi_ * pi_, ni = 2.0f * pr * pi_; pr = nr; pi_ = ni; }
    a32r[d] = pr; a32i[d] = pi_;
    float rr = 1.f, ri = 0.f, br_ = pr, bi_ = pi_;
#pragma unroll
    for (int bit = 0; bit < 7; ++bit) { if ((CR >> bit) & 1) { const float nr = rr * br_ - ri * bi_, ni = rr * bi_ + ri * br_; rr = nr; ri = ni; } const float nr = br_ * br_ - bi_ * bi_, ni = 2.0f * br_ * bi_; br_ = nr; bi_ = ni; }
    aCRr[d] = rr; aCRi[d] = ri;
  }
  const f32x4 dsk = *(const f32x4*)(p.s5_d + l * 512 + g * 16 + lg * 4);
  bf16_t* gb = (bf16_t*)(ws + OFF_GB);
  for (int k = wid; k < NCH; k += NW) {
    f32x4 acc[2] = {{0.f, 0.f, 0.f, 0.f}, {0.f, 0.f, 0.f, 0.f}};
    u32x4 uq[2]; uq[0] = s5_load_uf(sug, k, 0, lr, lg); uq[1] = s5_load_uf(sug, k, 1, lr, lg);
    u32x2 us[2]; us[0] = *(const u32x2*)(sug + (size_t)(k * 32 + lr) * 16 + lg * 4); us[1] = *(const u32x2*)(sug + (size_t)(k * 32 + 16 + lr) * 16 + lg * 4);
    float s0[2][2];
#pragma unroll
    for (int d = 0; d < 2; ++d) { const float* e_ = Eb + ((size_t)(d * (NCH + 8) + s5_cmap(d, k)) * 64 + lane) * 2;
      s0[d][0] = __hip_atomic_load(e_, __ATOMIC_RELAXED, __HIP_MEMORY_SCOPE_AGENT); s0[d][1] = __hip_atomic_load(e_ + 1, __ATOMIC_RELAXED, __HIP_MEMORY_SCOPE_AGENT); }
#pragma unroll
    for (int d = 0; d < 2; ++d) {
      const int c = s5_cmap(d, k), r = c / CR, j = c - r * CR;
      const float* Ed = Eb + (size_t)d * (NCH + 8) * 128 + lane * 2;
      float tr = 0.f, ti = 0.f;
#pragma unroll
      for (int r2 = 0; r2 < NR - 1; ++r2) if (r2 < r) {
        const float er = __hip_atomic_load(Ed + (size_t)(NCH + r2) * 128, __ATOMIC_RELAXED, __HIP_MEMORY_SCOPE_AGENT), ei = __hip_atomic_load(Ed + (size_t)(NCH + r2) * 128 + 1, __ATOMIC_RELAXED, __HIP_MEMORY_SCOPE_AGENT);
        const float nr = aCRr[d] * tr - aCRi[d] * ti + er, ni = aCRr[d] * ti + aCRi[d] * tr + ei; tr = nr; ti = ni; }
      float pr = 1.f, pi_ = 0.f, br_ = a32r[d], bi_ = a32i[d];
      for (int bit = 0; bit < 7; ++bit) { if ((j >> bit) & 1) { const float nr = pr * br_ - pi_ * bi_, ni = pr * bi_ + pi_ * br_; pr = nr; pi_ = ni; } const float nr = br_ * br_ - bi_ * bi_, ni = 2.0f * br_ * bi_; br_ = nr; bi_ = ni; }
      float sr = s0[d][0] + (pr * tr - pi_ * ti), si = s0[d][1] + (pr * ti + pi_ * tr);
#pragma unroll
      for (int hh = 0; hh < 2; ++hh) {
        const int tt = d ? 1 - hh : hh;
        __builtin_amdgcn_wave_barrier();
        s5_bu_tile(uq[tt], Bf[d], Bsm, lr, lg);
        __builtin_amdgcn_wave_barrier();
        if (d) S5_SCAN(1, are[1], aim[1], true); else S5_SCAN(0, are[0], aim[0], true);
        __builtin_amdgcn_wave_barrier();
#pragma unroll
        for (int ks = 0; ks < 4; ++ks) { const bf16x8 sf = *(const bf16x8*)(Ssm + lr * SST + ks * 32 + lg * 8); acc[tt] = MFMA16(Cf[d][ks], sf, acc[tt]); }
      }
    }
#pragma unroll
    for (int tt = 0; tt < 2; ++tt) { const int row = s5_row(b, k, tt * 16 + lr);
      f32x4 u; u[0] = __uint_as_float(us[tt][0] << 16); u[1] = __uint_as_float(us[tt][0] & 0xffff0000u); u[2] = __uint_as_float(us[tt][1] << 16); u[3] = __uint_as_float(us[tt][1] & 0xffff0000u);
      float y[4];
#pragma unroll
      for (int j = 0; j < 4; ++j) y[j] = gelu_tanh(acc[tt][j] + u[j] * dsk[j]);
      u32x2 o; o[0] = pack2(y[0], y[1]); o[1] = pack2(y[2], y[3]); *(u32x2*)(gb + (size_t)row * 512 + g * 16 + lg * 4) = o; }
  }
}

DI void mixer_phase(const Params& p, int l, unsigned char* smem) {
  const bool need_ctx = l < DEPTH - 1;
  volatile int* smw = (volatile int*)(smem + SMEM_BYTES - 16);
  constexpr int QL = SEQ / QU, QC = CTX / QU, QLD = SEQ / QUD, QCD = CTX / QUD;
  const int n_s5 = 16, n_dl = 2 * QLD, n_dc = need_ctx ? 2 * QCD : 0, n_wl = 4 * QL, n_wc = need_ctx ? 4 * QC : 0;
  const int total = n_dl + n_s5 + n_dc + n_wl + n_wc;
  const int x0 = get_bid() & 7;
  for (int dx = 0; dx < 8; ++dx) {
    const int xq = (x0 + dx) & 7;
    unsigned* ctr = (unsigned*)(p.ws + OFF_LAM) + 16 + l * 8 + xq;
    for (;;) {
      __syncthreads();
      if (get_tid() == 0) *smw = (int)atomicAdd(ctr, 1u);
      __syncthreads();
      int u = *smw;
      u = __builtin_amdgcn_readfirstlane(u);
      if (u >= total) break;
      int type, bq, hd, qi; bool is_lat = true;
      if (u < n_s5) { const int idx = xq * 16 + u; type = 1; bq = idx >> 5; hd = idx & 31; qi = 0; }
      else if ((u -= n_s5) < n_dl) { const int gidx = xq + 8 * (u / QLD); type = 0; bq = gidx >> 2; hd = gidx & 3; qi = u % QLD; }
      else if ((u -= n_dl) < n_dc) { const int gidx = xq + 8 * (u / QCD); type = 0; is_lat = false; bq = gidx >> 2; hd = gidx & 3; qi = u % QCD; }
      else if ((u -= n_dc) < n_wl) { type = 2; bq = xq >> 1; hd = (xq & 1) * 4 + (u & 3); qi = u >> 2; }
      else { u -= n_wl; type = 2; is_lat = false; bq = xq >> 1; hd = (xq & 1) * 4 + (u & 3); qi = u >> 2; }
      if (type == 0) diff_unit(p, l, bq, hd, is_lat, qi, smem);
      else if (type == 1) s5_unit(p, l, bq, hd, smem);
      else win_unit(p, l, bq, hd, is_lat, qi, smem);
    }
  }
}

#define EPI_LOOP_BEGIN { const int tid_ = get_tid(), lane_ = tid_ & 63, wid_ = tid_ >> 6, wr_ = wid_ >> 1, wc_ = wid_ & 1, lr_ = lane_ & 15, lg_ = lane_ >> 4; \
  _Pragma("unroll") for (int mi = 0; mi < 4; ++mi) { const int row = m0 + wr_ * 64 + mi * 16 + lr_; \
  _Pragma("unroll") for (int ni = 0; ni < 4; ++ni) { const int col = n0 + wc_ * 64 + ni * 16 + lg_ * 4;
#define EPI_LOOP_END } } }

DI void glu_phase(const Params& p, int MT, unsigned char* smem) {
  bf16_t* As = (bf16_t*)smem; bf16_t* Bs = As + 128 * LDT;
  const bf16_t* G = (const bf16_t*)(p.ws + OFF_GB); const bf16_t* W = (const bf16_t*)(p.ws + OFF_W_GLU); bf16_t* ys = (bf16_t*)(p.ws + OFF_YS);
  constexpr int NT = 4;
  for (int t = get_bid(); t < MT * NT; t += gridDim.x) {
    const int m0 = (t / NT) * 128, n0 = (t % NT) * 128;
    f32x4 acc[4][4]; zero_acc(acc);
    gemm_mainloop(acc, G + (size_t)m0 * 512, 512, W + (size_t)n0 * 512, 512, 512, As, Bs);
    EPI_LOOP_BEGIN
      const u32x2 gr = *(const u32x2*)(G + (size_t)row * 512 + col);
      const float g0 = __uint_as_float(gr[0] << 16), g1 = __uint_as_float(gr[0] & 0xffff0000u), g2 = __uint_as_float(gr[1] << 16), g3 = __uint_as_float(gr[1] & 0xffff0000u);
      u32x2 o; o[0] = pack2(g0 * sigmoidf_(acc[mi][ni][0]), g1 * sigmoidf_(acc[mi][ni][1])); o[1] = pack2(g2 * sigmoidf_(acc[mi][ni][2]), g3 * sigmoidf_(acc[mi][ni][3]));
      *(u32x2*)(ys + (size_t)row * 512 + col) = o;
    EPI_LOOP_END
  }
}
DI void merge_phase(const Params& p, int MT, unsigned char* smem) {
  bf16_t* As = (bf16_t*)smem; bf16_t* Bs = As + 128 * LDT;
  const bf16_t* gt = (const bf16_t*)(p.ws + OFF_GATES); bf16_t* mo = (bf16_t*)(p.ws + OFF_M);
  constexpr int NT = 8;
  for (int t = get_bid(); t < MT * NT; t += gridDim.x) {
    const int m0 = (t / NT) * 128, n0 = (t % NT) * 128;
    f32x4 acc[4][4]; zero_acc(acc);
#pragma unroll 1
    for (int br = 0; br < 3; ++br) {
      const bf16_t* Y = (const bf16_t*)(p.ws + (br == 0 ? OFF_YD : br == 1 ? OFF_YS : OFF_YW));
      const bf16_t* W = (const bf16_t*)(p.ws + (br == 0 ? OFF_W_PD : br == 1 ? OFF_W_PS : OFF_W_PW));
      gemm_mainloop(acc, Y + (size_t)m0 * 512, 512, W + (size_t)n0 * 512, 512, 512, As, Bs);
      if (br < 2) {
        EPI_LOOP_BEGIN
          const f32x4 g0 = ld_bf4(gt + (size_t)row * 3072 + br * 1024 + col), g1 = ld_bf4(gt + (size_t)row * 3072 + (br + 1) * 1024 + col);
#pragma unroll
          for (int j = 0; j < 4; ++j) acc[mi][ni][j] *= fmaxf(g0[j], 1e-30f) * __builtin_amdgcn_rcpf(fmaxf(g1[j], 1e-30f));
        EPI_LOOP_END
      } else {
        EPI_LOOP_BEGIN
          const f32x4 g2 = ld_bf4(gt + (size_t)row * 3072 + 2048 + col);
          u32x2 o; o[0] = pack2(acc[mi][ni][0] * fmaxf(g2[0], 1e-30f), acc[mi][ni][1] * fmaxf(g2[1], 1e-30f)); o[1] = pack2(acc[mi][ni][2] * fmaxf(g2[2], 1e-30f), acc[mi][ni][3] * fmaxf(g2[3], 1e-30f));
          *(u32x2*)(mo + (size_t)row * D + col) = o;
        EPI_LOOP_END
      }
    }
  }
}
DI void resid_phase(const Params& p, int l, const bf16_t* A, int K, const bf16_t* W, int gate_off, float* dst, int MT, unsigned char* smem, bool first = false) {
  bf16_t* As = (bf16_t*)smem; bf16_t* Bs = As + 128 * LDT;
  const float* h = (const float*)(p.ws + OFF_H);
  const float* modv = (const float*)(p.ws + OFF_MODV) + (size_t)l * 5 * 6144;
  constexpr int NT = 8;
  for (int t = get_bid(); t < MT * NT; t += gridDim.x) {
    const int m0 = (t / NT) * 128, n0 = (t % NT) * 128;
    f32x4 acc[4][4]; zero_acc(acc);
    gemm_mainloop(acc, A + (size_t)m0 * K, K, W + (size_t)n0 * K, K, K, As, Bs);
    const int bb = m0 < NLAT ? m0 / SEQ : 4;
    EPI_LOOP_BEGIN
      const f32x4 gv = *(const f32x4*)(modv + bb * 6144 + gate_off + col);
      const f32x4 hv = *(const f32x4*)((first ? (row < NLAT ? p.x + (size_t)row * D : p.ctx + (size_t)(row - NLAT) * D) : h + (size_t)row * D) + col);
      *(f32x4*)(dst + (size_t)row * D + col) = hv + gv * acc[mi][ni];
    EPI_LOOP_END
  }
}
DI void ff1_phase(const Params& p, int MT, unsigned char* smem) {
  const bf16_t* A = (const bf16_t*)(p.ws + OFF_ABUF); const bf16_t* W = (const bf16_t*)(p.ws + OFF_W_FF1); bf16_t* uo = (bf16_t*)(p.ws + OFF_U);
  constexpr int NT = DFF / 128;
  gemm_stream<D, true>(A, W, MT * NT, NT, (bf16_t*)smem, [&](const f32x4 (&acc)[4][4], int m0, int n0) {
    const int tid_ = get_tid(), lane_ = tid_ & 63, wid_ = tid_ >> 6, wr_ = wid_ >> 1, wc_ = wid_ & 1, lr_ = lane_ & 15, lg_ = lane_ >> 4;
#pragma unroll
    for (int mi = 0; mi < 4; ++mi) { const int row = m0 + wr_ * 64 + mi * 16 + lr_;
#pragma unroll
      for (int q = 0; q < 2; ++q) { const int col = n0 + wc_ * 64 + q * 32 + lg_ * 8;
        float r[8];
#pragma unroll
        for (int j = 0; j < 4; ++j) { const float v0 = fmaxf(acc[mi][2 * q][j], 0.f), v1 = fmaxf(acc[mi][2 * q + 1][j], 0.f); r[j] = v0 * v0; r[4 + j] = v1 * v1; }
        u32x4 o; o[0] = pack2(r[0], r[1]); o[1] = pack2(r[2], r[3]); o[2] = pack2(r[4], r[5]); o[3] = pack2(r[6], r[7]);
        *(u32x4*)(uo + (size_t)row * DFF + col) = o; } }
  });
}

#define XB_TMO      128
#define XB_XCNT(j)  (256  + 64 * (j))
#define XB_XSUB(j)  (1280 + 64 * (j))
#define XB_XGEN(j)  (2304 + 64 * (j))
#define XB_TOP      3328
#define XB_TOPGEN   3392
#define XCD_BAR_WORDS 3456
#define XB_SPIN_CAP (1u << 18)
#define XLAS __attribute__((address_space(3)))

__device__ __forceinline__ unsigned xb_ld(unsigned* p)              { return __hip_atomic_load(p, __ATOMIC_RELAXED, __HIP_MEMORY_SCOPE_AGENT); }
__device__ __forceinline__ unsigned xb_add(unsigned* p, unsigned v) { return __hip_atomic_fetch_add(p, v, __ATOMIC_RELAXED, __HIP_MEMORY_SCOPE_AGENT); }
__device__ __forceinline__ unsigned xb_xcc_id() { return (unsigned)__builtin_amdgcn_s_getreg((3 << 11) | 20) & 0xFu; }
#define XB_SPIN(cond, bar) do { unsigned _sp = 0; while (cond) { __builtin_amdgcn_s_sleep(1); \
    if ((++_sp & 255u) == 0u) { if (xb_ld(&(bar)[XB_TMO])) break; if (_sp > XB_SPIN_CAP) { atomicAdd(&(bar)[XB_TMO], 1u); break; } } } } while (0)

struct XcdBarrier {
    unsigned* bar; unsigned x;
    volatile XLAS unsigned* st;
};

__device__ __forceinline__ XcdBarrier xcd_barrier_post(unsigned* bar, volatile XLAS unsigned* st) {
    XcdBarrier b; b.bar = bar; b.x = xb_xcc_id(); b.st = st;
    if (threadIdx.x == 0) (void)xb_add(&bar[XB_XCNT(b.x)], 1u);
    return b;
}
__device__ __forceinline__ void xcd_barrier_complete(unsigned* bar, unsigned x, unsigned& nloc, unsigned& nx) {
    const unsigned G = gridDim.x * gridDim.y * gridDim.z;
    unsigned sum, cnt, mine, sp = 0u;
    for (;;) {
        sum = 0u; cnt = 0u; mine = 0u;
#pragma unroll
        for (unsigned j = 0; j < 16; ++j) { const unsigned c = xb_ld(&bar[XB_XCNT(j)]); sum += c; cnt += (c > 0u) ? 1u : 0u; mine = (j == x) ? c : mine; }
        if (sum == G) break;
        __builtin_amdgcn_s_sleep(1);
        if ((++sp & 255u) == 0u) { if (xb_ld(&bar[XB_TMO])) break; if (sp > XB_SPIN_CAP) { atomicAdd(&bar[XB_TMO], 1u); break; } }
    }
    nloc = mine > 0u ? mine : 1u; nx = cnt > 0u ? cnt : 1u;
}

__device__ __forceinline__ void xcd_barrier(const XcdBarrier& b) {
    asm volatile("s_waitcnt vmcnt(0)" ::: "memory");
    __syncthreads();
    if (threadIdx.x == 0) {
        unsigned* bar = b.bar;
        __builtin_amdgcn_s_waitcnt(0);
        unsigned nloc = b.st[0], nx = b.st[1];
        if (nloc == 0u) { xcd_barrier_complete(bar, b.x, nloc, nx); b.st[0] = nloc; b.st[1] = nx; }
        const unsigned old = xb_add(&bar[XB_XSUB(b.x)], 1u);
        const unsigned gen = old / nloc;
        if (old + 1u == (gen + 1u) * nloc) {
            __builtin_amdgcn_fence(__ATOMIC_RELEASE, "agent");
            asm volatile("s_waitcnt vmcnt(0)" ::: "memory");
            const unsigned og = xb_add(&bar[XB_TOP], 1u);
            const unsigned tg = og / nx;
            if (og + 1u == (tg + 1u) * nx) xb_add(&bar[XB_TOPGEN], 1u);
            else XB_SPIN(xb_ld(&bar[XB_TOPGEN]) == tg, bar);
            __builtin_amdgcn_fence(__ATOMIC_ACQUIRE, "agent");
            xb_add(&bar[XB_XGEN(b.x)], 1u);
            asm volatile("s_waitcnt vmcnt(0)" ::: "memory");
        } else {
            XB_SPIN(xb_ld(&bar[XB_XGEN(b.x)]) == gen, bar);
            __builtin_amdgcn_fence(__ATOMIC_ACQUIRE, "agent");
            asm volatile("s_waitcnt vmcnt(0)" ::: "memory");
        }
    }
    __syncthreads();
}


__global__ void __launch_bounds__(256, 2) fwd_megakernel(Params p) {
  __shared__ __attribute__((aligned(16))) unsigned char smem[SMEM_BYTES];
  __shared__ uint4 xb_words;
  cg::grid_group grid = cg::this_grid();
  unsigned char* ws = p.ws;
  if (threadIdx.x == 0) xb_words = make_uint4(0u, 0u, 0u, 0u);
  __syncthreads();
  const XcdBarrier xb = xcd_barrier_post((unsigned*)(ws + OFF_BAR), (volatile XLAS unsigned*)&xb_words);
  phase0_misc(p, smem);
  __syncthreads();
  convert_layer(p, 0, 0, smem);
  if (p.ws == nullptr) grid.sync();
  for (int l = 0; l < DEPTH; ++l) {
    const bool need_ctx = l < DEPTH - 1;
    const int MT = need_ctx ? NTOK / 128 : NLAT / 128;
    xcd_barrier(xb);
    if (l > 0) convert_layer(p, l, CONV_EARLY, smem);
    norm_phase(p, l, p.norm1_g + l * D, 0, 1024, NTOK, l == 0);
    xcd_barrier(xb);
    inproj_phase(p, l, smem);
    xcd_barrier(xb);
    mixer_phase(p, l, smem);
    xcd_barrier(xb);
    glu_phase(p, MT, smem);
    xcd_barrier(xb);
    merge_phase(p, MT, smem);
    xcd_barrier(xb);
    resid_phase(p, l, (const bf16_t*)(ws + OFF_M), D, (const bf16_t*)(ws + OFF_W_OUT), 2048, (float*)(ws + OFF_H), MT, smem, l == 0);
    xcd_barrier(xb);
    norm_phase(p, l, p.norm2_g + l * D, 3072, 4096, MT * 128);
    xcd_barrier(xb);
    ff1_phase(p, MT, smem);
    xcd_barrier(xb);
    resid_phase(p, l, (const bf16_t*)(ws + OFF_U), DFF, (const bf16_t*)(ws + OFF_W_FF2), 5120, need_ctx ? (float*)(ws + OFF_H) : p.out, MT, smem);
    if (need_ctx) convert_steal(p, l + 1, smem);
  }
}

extern "C" void kernel_launch(void* const* d_in, const int* in_sizes, int n_in, void* d_out, int out_size, void* d_ws, size_t ws_size, hipStream_t stream) {
  static int grid_blocks = 0;
  if (!grid_blocks) {
    int dev = 0, cus = 0, per_cu = 0;
    (void)hipGetDevice(&dev);
    (void)hipDeviceGetAttribute(&cus, hipDeviceAttributeMultiprocessorCount, dev);
    (void)hipOccupancyMaxActiveBlocksPerMultiprocessor(&per_cu, fwd_megakernel, 256, 0);
    if (per_cu > 2) per_cu = 2;
    if (per_cu < 1) per_cu = 1;
    grid_blocks = cus * per_cu;
  }
  if (ws_size < WS_NEED) { fprintf(stderr, "workspace too small: %zu < %zu\n", ws_size, (size_t)WS_NEED); return; }
  (void)hipMemsetAsync((unsigned char*)d_ws + OFF_BAR, 0, BAR_BYTES, stream);
  Params p{};
  const float* const* in = (const float* const*)d_in;
  p.x = in[0]; p.c = in[1]; p.ctx = in[2]; p.c_ctx = in[3]; p.w_mod = in[4]; p.b_mod = in[5]; p.norm1_g = in[6]; p.norm2_g = in[7]; p.w_in = in[8];
  p.dq_g = in[9]; p.dk_g = in[10]; p.lq1 = in[11]; p.lk1 = in[12]; p.lq2 = in[13]; p.lk2 = in[14]; p.dout_g = in[15];
  p.s5_lre = in[16]; p.s5_lim = in[17]; p.s5_ldt = in[18]; p.s5_bre = in[19]; p.s5_bim = in[20]; p.s5_cre = in[21]; p.s5_cim = in[22]; p.s5_d = in[23]; p.s5_wglu = in[24];
  p.wq_g = in[25]; p.wk_g = in[26]; p.w_sink = in[27];
  p.w_pd = in[28]; p.w_ps = in[29]; p.w_pw = in[30]; p.w_out = in[31]; p.w_ff1 = in[32]; p.w_ff2 = in[33];
  p.out = (float*)d_out; p.ws = (unsigned char*)d_ws;
  void* args[] = {&p};
  hipError_t e = hipLaunchCooperativeKernel((void*)fwd_megakernel, dim3(grid_blocks), dim3(256), args, 0, stream);
  if (e != hipSuccess) fprintf(stderr, "cooperative launch failed: %s (grid %d)\n", hipGetErrorString(e), grid_blocks);
}
```

```cpp
#include <hip/hip_runtime.h>
#include <hip/hip_cooperative_groups.h>
#include <cstdio>
#include <cstdint>
namespace cg = cooperative_groups;

typedef unsigned short bf16_t;
typedef short bf16x8 __attribute__((ext_vector_type(8)));
typedef short bf16x4 __attribute__((ext_vector_type(4)));
typedef float f32x4 __attribute__((ext_vector_type(4)));
typedef float f32x2 __attribute__((ext_vector_type(2)));
typedef unsigned u32x4 __attribute__((ext_vector_type(4)));
typedef unsigned u32x2 __attribute__((ext_vector_type(2)));
typedef __bf16 bf2_t __attribute__((ext_vector_type(2)));

#define DI __device__ __forceinline__
#define MFMA16(a, b, c) __builtin_amdgcn_mfma_f32_16x16x32_bf16((a), (b), (c), 0, 0, 0)

constexpr int D = 1024, NB = 4, SEQ = 4096, DEPTH = 4, CTX = 256, POS = CTX + SEQ  ;
constexpr int NLAT = NB * SEQ  , NCTX = NB * CTX  , NTOK = NLAT + NCTX  ;
constexpr int DIN = 5888, DFF = 4096;
constexpr float EPS = 1e-6f;
constexpr float LOG2E = 1.4426950408889634f;
constexpr int NCH = POS / 32;

constexpr size_t SZ_W_IN = (size_t)DIN * D * 2, SZ_W_GLU = 512 * 512 * 2, SZ_W_P = 1024 * 512 * 2, SZ_W_OUT = (size_t)D * D * 2, SZ_W_FF = (size_t)D * DFF * 2;
constexpr size_t OFF_W_IN = 0;
constexpr size_t OFF_W_GLU = OFF_W_IN + SZ_W_IN;
constexpr size_t OFF_W_PD = OFF_W_GLU + SZ_W_GLU;
constexpr size_t OFF_W_PS = OFF_W_PD + SZ_W_P;
constexpr size_t OFF_W_PW = OFF_W_PS + SZ_W_P;
constexpr size_t OFF_W_OUT = OFF_W_PW + SZ_W_P;
constexpr size_t OFF_W_FF1 = OFF_W_OUT + SZ_W_OUT;
constexpr size_t OFF_W_FF2 = OFF_W_FF1 + SZ_W_FF;
constexpr size_t OFF_MODV = OFF_W_FF2 + SZ_W_FF;
constexpr size_t OFF_ROPE = OFF_MODV + (size_t)DEPTH * 5 * 6144 * 4;
constexpr size_t OFF_LAM = OFF_ROPE + 8192;
constexpr size_t OFF_H = OFF_LAM + 256;
constexpr size_t OFF_ABUF = OFF_H + (size_t)NTOK * D * 4;
constexpr size_t OFF_R1 = OFF_ABUF + (size_t)NTOK * D * 2;
constexpr size_t SZ_HEADBUF = (size_t)NB * 8 * POS * 64 * 2;
constexpr size_t OFF_QD = OFF_R1;
constexpr size_t OFF_KD = OFF_QD + SZ_HEADBUF;
constexpr size_t OFF_VDT = OFF_KD + SZ_HEADBUF;
constexpr size_t OFF_SU = OFF_VDT + SZ_HEADBUF;
constexpr size_t OFF_QW = OFF_SU + (size_t)NTOK * 512 * 2;
constexpr size_t OFF_KW = OFF_QW + SZ_HEADBUF;
constexpr size_t OFF_VWT = OFF_KW + SZ_HEADBUF / 4;
constexpr size_t OFF_GATES = OFF_VWT + SZ_HEADBUF / 4;
constexpr size_t OFF_YD = OFF_GATES + (size_t)NTOK * 3072 * 2;
constexpr size_t OFF_YS = OFF_YD + (size_t)NTOK * 512 * 2;
constexpr size_t OFF_YW = OFF_YS + (size_t)NTOK * 512 * 2;
constexpr size_t OFF_GB = OFF_YW + (size_t)NTOK * 512 * 2;
constexpr size_t OFF_EB = OFF_GB + (size_t)NTOK * 512 * 2;
constexpr size_t OFF_END = OFF_EB + (size_t)NB * 32 * 2 * (NCH + 8) * 64 * 8;
constexpr size_t OFF_BAR = OFF_END;
constexpr size_t BAR_BYTES = 16384;
constexpr size_t WS_NEED = OFF_BAR + BAR_BYTES;
constexpr size_t OFF_M = OFF_QD;
constexpr size_t OFF_U = OFF_R1;
static_assert((size_t)NTOK * DFF * 2 <= OFF_END - OFF_R1, "u alias");

struct Params {
  const float *x, *c, *ctx, *c_ctx, *w_mod, *b_mod, *norm1_g, *norm2_g, *w_in;
  const float *dq_g, *dk_g, *lq1, *lk1, *lq2, *lk2, *dout_g;
  const float *s5_lre, *s5_lim, *s5_ldt, *s5_bre, *s5_bim, *s5_cre, *s5_cim, *s5_d, *s5_wglu;
  const float *wq_g, *wk_g, *w_sink;
  const float *w_pd, *w_ps, *w_pw, *w_out, *w_ff1, *w_ff2;
  float* out;
  unsigned char* ws;
};

DI int get_tid() { int t = threadIdx.x; asm volatile("" : "+v"(t)); return t; }
DI int get_bid() { int b = blockIdx.x; asm volatile("" : "+s"(b)); return b; }
DI unsigned pack2(float lo, float hi) { f32x2 v = {lo, hi}; bf2_t r = __builtin_convertvector(v, bf2_t); return __builtin_bit_cast(unsigned, r); }
DI float sigmoidf_(float x) { return __builtin_amdgcn_rcpf(1.0f + __expf(-x)); }
DI float gelu_tanh(float x) { const float z = 0.7978845608028654f * (x + 0.044715f * x * x * x); const float e = __expf(2.0f * z); const float t = 1.0f - 2.0f * __builtin_amdgcn_rcpf(e + 1.0f); return 0.5f * x * (1.0f + t); }
DI f32x4 ld_bf4(const bf16_t* p_) { const u32x2 r = *(const u32x2*)p_; f32x4 v; v[0] = __uint_as_float(r[0] << 16); v[1] = __uint_as_float(r[0] & 0xffff0000u); v[2] = __uint_as_float(r[1] << 16); v[3] = __uint_as_float(r[1] & 0xffff0000u); return v; }
DI float xshfl(float v, int m) { return __shfl_xor(v, m, 64); }

constexpr int SMEM_BYTES = 65552;
constexpr int LDT = 72;

DI u32x4 gload_async(const void* ptr) { u32x4 r; asm volatile("global_load_dwordx4 %0, %1, off" : "=v"(r) : "v"(ptr) : "memory"); return r; }
DI u32x4 gload_async_s(const void* sbase, unsigned voff) { u32x4 r; asm volatile("global_load_dwordx4 %0, %1, %2" : "=v"(r) : "v"(voff), "s"(sbase) : "memory"); return r; }
#define VM_WAIT8(N, R, Q) asm volatile("s_waitcnt vmcnt(" #N ")" : "+v"(R[0]), "+v"(R[1]), "+v"(R[2]), "+v"(R[3]), "+v"(Q[0]), "+v"(Q[1]), "+v"(Q[2]), "+v"(Q[3]) :: "memory")
template <bool PERM = false, bool SWAP = false>
DI void gemm_mainloop(f32x4 (&acc)[4][4], const bf16_t* __restrict__ A, int lda, const bf16_t* __restrict__ B, int ldb, int K, bf16_t* As, bf16_t* Bs) {
  const int tid = get_tid(), lane = tid & 63, wid = tid >> 6, wr = wid >> 1, wc = wid & 1, lr = lane & 15, lg = lane >> 4;
  const int crow = tid >> 3, ckc = (tid & 7) * 8;
  constexpr int TB = 128 * 64;
  const int swc = (((tid & 7) ^ (crow & 7)) * 8);
  const int swcB = PERM ? (((tid & 7) ^ ((((crow >> 3) & 3) * 2 + ((crow & 7) >> 1)) & 7)) * 8) : swc;
  u32x4 ra0[4], rb0[4], ra1[4], rb1[4];
  unsigned aoff[4], boff[4];
#pragma unroll
  for (int i = 0; i < 4; ++i) { aoff[i] = (unsigned)(((crow + i * 32) * lda + ckc) * 2); boff[i] = (unsigned)(((crow + i * 32) * ldb + ckc) * 2); }
#define GM_LOAD(RA, RB, KOFF) do { const char* ab_ = (const char*)A + (size_t)(KOFF) * 2; const char* bb_ = (const char*)B + (size_t)(KOFF) * 2; \
    _Pragma("unroll") for (int i = 0; i < 4; ++i) { RA[i] = gload_async_s(ab_, aoff[i]); RB[i] = gload_async_s(bb_, boff[i]); } } while (0)
#define GM_STORE(RA, RB, BUF) do { _Pragma("unroll") for (int i = 0; i < 4; ++i) { *(u32x4*)(As + (BUF) * 2 * TB + (crow + i * 32) * 64 + swc) = RA[i]; *(u32x4*)(As + (BUF) * 2 * TB + TB + (crow + i * 32) * 64 + swcB) = RB[i]; } } while (0)
#define GM_COMPUTE(BUF) do { const bf16_t* as_ = As + (BUF) * 2 * TB; const bf16_t* bs_ = as_ + TB; \
    bf16x8 af[2][4], bfr[2][4];     \
    _Pragma("unroll") for (int ks = 0; ks < 2; ++ks) { const int co_ = ((ks * 4 + lg) ^ (lr & 7)) * 8; \
      _Pragma("unroll") for (int mi = 0; mi < 4; ++mi) af[ks][mi] = *(const bf16x8*)(as_ + (wr * 64 + mi * 16 + lr) * 64 + co_); \
      _Pragma("unroll") for (int ni = 0; ni < 4; ++ni) { \
        if (PERM) { const int rw_ = (ni & 1) * 4 + (lr & 3); const int key_ = ((lr >> 2) * 2 + (rw_ >> 1)) & 7; bfr[ks][ni] = *(const bf16x8*)(bs_ + (wc * 64 + (ni >> 1) * 32 + (lr >> 2) * 8 + rw_) * 64 + (((ks * 4 + lg) ^ key_) * 8)); } \
        else bfr[ks][ni] = *(const bf16x8*)(bs_ + (wc * 64 + ni * 16 + lr) * 64 + co_); } } \
    __builtin_amdgcn_sched_barrier(0); \
    __builtin_amdgcn_s_setprio(1); \
    _Pragma("unroll") for (int ks = 0; ks < 2; ++ks) _Pragma("unroll") for (int mi = 0; mi < 4; ++mi) _Pragma("unroll") for (int ni = 0; ni < 4; ++ni) acc[mi][ni] = SWAP ? MFMA16(af[ks][mi], bfr[ks][ni], acc[mi][ni]) : MFMA16(bfr[ks][ni], af[ks][mi], acc[mi][ni]); \
    __builtin_amdgcn_s_setprio(0); \
    __builtin_amdgcn_sched_barrier(0); } while (0)
  asm volatile("s_waitcnt vmcnt(0)" ::: "memory");
  GM_LOAD(ra0, rb0, 0); GM_LOAD(ra1, rb1, 64);
  __syncthreads();
  VM_WAIT8(8, ra0, rb0); GM_STORE(ra0, rb0, 0); GM_LOAD(ra0, rb0, (128 < K ? 128 : 0));
  __syncthreads();
  for (int k0 = 0; k0 < K; k0 += 128) {
    const int kn1 = k0 + 192 < K ? k0 + 192 : 0, kn0 = k0 + 256 < K ? k0 + 256 : 0;
    VM_WAIT8(8, ra1, rb1); GM_STORE(ra1, rb1, 1); GM_LOAD(ra1, rb1, kn1);
    GM_COMPUTE(0); __syncthreads();
    VM_WAIT8(8, ra0, rb0); GM_STORE(ra0, rb0, 0); GM_LOAD(ra0, rb0, kn0);
    GM_COMPUTE(1); __syncthreads();
  }
  VM_WAIT8(0, ra0, rb0); VM_WAIT8(0, ra1, rb1);
#undef GM_LOAD
#undef GM_STORE
#undef GM_COMPUTE
}
DI void zero_acc(f32x4 (&acc)[4][4]) {
#pragma unroll
  for (int mi = 0; mi < 4; ++mi)
#pragma unroll
    for (int ni = 0; ni < 4; ++ni) acc[mi][ni] = (f32x4){0.f, 0.f, 0.f, 0.f};
}

template <int KC, bool PERM, class Epi>
DI void gemm_stream(const bf16_t* __restrict__ A, const bf16_t* __restrict__ W, int ntiles, int NT, bf16_t* As, const Epi& epi) {
  const int G = gridDim.x, bid = get_bid();
  if (bid >= ntiles) return;
  constexpr int KT = KC / 64;
  const int T = (ntiles - bid + G - 1) / G, total = T * KT;
  const int tid = get_tid(), lane = tid & 63, wid = tid >> 6, wr = wid >> 1, wc = wid & 1, lr = lane & 15, lg = lane >> 4;
  const int crow = tid >> 3, ckc = (tid & 7) * 8;
  constexpr int TB = 128 * 64;
  const int swc = (((tid & 7) ^ (crow & 7)) * 8);
  const int swcB = PERM ? (((tid & 7) ^ ((((crow >> 3) & 3) * 2 + ((crow & 7) >> 1)) & 7)) * 8) : swc;
  unsigned aoff[4];
#pragma unroll
  for (int i = 0; i < 4; ++i) aoff[i] = (unsigned)(((crow + i * 32) * KC + ckc) * 2);
  u32x4 ra0[4], rb0[4], ra1[4], rb1[4];
  bf16x8 af[2][4], bfr[2][4];
  f32x4 acc[4][4]; zero_acc(acc);
#define GS_LOAD(RA, RB, I) do { int i_ = (I); int ti_ = i_ / KT; const int ko_ = (i_ - ti_ * KT) * 64; ti_ = ti_ < T ? ti_ : T - 1; const int t_ = bid + ti_ * G; const int mt_ = t_ / NT, nt_ = t_ - mt_ * NT; \
    const char* ab_ = (const char*)(A + (size_t)mt_ * 128 * KC + ko_); const char* bb_ = (const char*)(W + (size_t)nt_ * 128 * KC + ko_); \
    _Pragma("unroll") for (int i = 0; i < 4; ++i) { RA[i] = gload_async_s(ab_, aoff[i]); RB[i] = gload_async_s(bb_, aoff[i]); } } while (0)
#define GS_STORE(RA, RB, BUF) do { _Pragma("unroll") for (int i = 0; i < 4; ++i) { *(u32x4*)(As + (BUF) * 2 * TB + (crow + i * 32) * 64 + swc) = RA[i]; *(u32x4*)(As + (BUF) * 2 * TB + TB + (crow + i * 32) * 64 + swcB) = RB[i]; } } while (0)
#define GS_COMPUTE(BUF) do { const bf16_t* as_ = As + (BUF) * 2 * TB; const bf16_t* bs_ = as_ + TB; \
    _Pragma("unroll") for (int ks = 0; ks < 2; ++ks) { const int co_ = ((ks * 4 + lg) ^ (lr & 7)) * 8; \
      _Pragma("unroll") for (int mi = 0; mi < 4; ++mi) af[ks][mi] = *(const bf16x8*)(as_ + (wr * 64 + mi * 16 + lr) * 64 + co_); \
      _Pragma("unroll") for (int ni = 0; ni < 4; ++ni) { \
        if (PERM) { const int rw_ = (ni & 1) * 4 + (lr & 3); const int key_ = ((lr >> 2) * 2 + (rw_ >> 1)) & 7; bfr[ks][ni] = *(const bf16x8*)(bs_ + (wc * 64 + (ni >> 1) * 32 + (lr >> 2) * 8 + rw_) * 64 + (((ks * 4 + lg) ^ key_) * 8)); } \
        else bfr[ks][ni] = *(const bf16x8*)(bs_ + (wc * 64 + ni * 16 + lr) * 64 + co_); } } \
    __builtin_amdgcn_sched_barrier(0); __builtin_amdgcn_s_setprio(1); \
    _Pragma("unroll") for (int ks = 0; ks < 2; ++ks) _Pragma("unroll") for (int mi = 0; mi < 4; ++mi) _Pragma("unroll") for (int ni = 0; ni < 4; ++ni) acc[mi][ni] = MFMA16(bfr[ks][ni], af[ks][mi], acc[mi][ni]); \
    __builtin_amdgcn_s_setprio(0); __builtin_amdgcn_sched_barrier(0); } while (0)
  asm volatile("s_waitcnt vmcnt(0)" ::: "memory");
  GS_LOAD(ra0, rb0, 0); GS_LOAD(ra1, rb1, 1);
  __syncthreads();
  VM_WAIT8(8, ra0, rb0); GS_STORE(ra0, rb0, 0); GS_LOAD(ra0, rb0, 2);
  __syncthreads();
  for (int sidx = 0; sidx < total; sidx += 2) {
    VM_WAIT8(8, ra1, rb1); GS_STORE(ra1, rb1, 1); GS_LOAD(ra1, rb1, sidx + 3);
    GS_COMPUTE(0); __syncthreads();
    VM_WAIT8(8, ra0, rb0); GS_STORE(ra0, rb0, 0); GS_LOAD(ra0, rb0, sidx + 4);
    GS_COMPUTE(1); __syncthreads();
    if (((sidx + 2) & (KT - 1)) == 0) {
      const int t_ = bid + (sidx / KT) * G; const int mt_ = t_ / NT, nt_ = t_ - mt_ * NT;
      epi(acc, mt_ * 128, nt_ * 128);
      zero_acc(acc);
    }
  }
  VM_WAIT8(0, ra0, rb0); VM_WAIT8(0, ra1, rb1);
#undef GS_LOAD
#undef GS_STORE
#undef GS_COMPUTE
}

DI void convert_tile(const float* __restrict__ src, int K, int N, bf16_t* __restrict__ dst, int kt, int nt, float* tile) {
  const int tid = get_tid();
  { const int r = tid >> 4, c4 = (tid & 15) * 4;
#pragma unroll
    for (int i = 0; i < 4; ++i) { const int k = r + i * 16; const f32x4 v = *(const f32x4*)(src + (size_t)(kt * 64 + k) * N + nt * 64 + c4);
      tile[k * 65 + c4 + 0] = v[0]; tile[k * 65 + c4 + 1] = v[1]; tile[k * 65 + c4 + 2] = v[2]; tile[k * 65 + c4 + 3] = v[3]; } }
  __syncthreads();
  { const int n = tid >> 2, kc = (tid & 3) * 16; u32x4 o0, o1;
#pragma unroll
    for (int q = 0; q < 4; ++q) { o0[q] = pack2(tile[(kc + 2 * q) * 65 + n], tile[(kc + 2 * q + 1) * 65 + n]); o1[q] = pack2(tile[(kc + 8 + 2 * q) * 65 + n], tile[(kc + 8 + 2 * q + 1) * 65 + n]); }
    bf16_t* d = dst + (size_t)(nt * 64 + n) * K + kt * 64 + kc; *(u32x4*)d = o0; *(u32x4*)(d + 8) = o1; }
  __syncthreads();
}
DI void convert_item(const Params& p, int l, int t, float* tile) {
  unsigned char* ws = p.ws;
  const float* src; bf16_t* dst; int K, N, idx;
  if (t < 1472) { idx = t; src = p.w_in + (size_t)l * D * DIN; K = D; N = DIN; dst = (bf16_t*)(ws + OFF_W_IN); }
  else if (t < 1536) { idx = t - 1472; src = p.s5_wglu + (size_t)l * 512 * 512; K = 512; N = 512; dst = (bf16_t*)(ws + OFF_W_GLU); }
  else if (t < 1664) { idx = t - 1536; src = p.w_pd + (size_t)l * 512 * D; K = 512; N = D; dst = (bf16_t*)(ws + OFF_W_PD); }
  else if (t < 1792) { idx = t - 1664; src = p.w_ps + (size_t)l * 512 * D; K = 512; N = D; dst = (bf16_t*)(ws + OFF_W_PS); }
  else if (t < 1920) { idx = t - 1792; src = p.w_pw + (size_t)l * 512 * D; K = 512; N = D; dst = (bf16_t*)(ws + OFF_W_PW); }
  else if (t < 2176) { idx = t - 1920; src = p.w_out + (size_t)l * D * D; K = D; N = D; dst = (bf16_t*)(ws + OFF_W_OUT); }
  else if (t < 3200) { idx = t - 2176; src = p.w_ff1 + (size_t)l * D * DFF; K = D; N = DFF; dst = (bf16_t*)(ws + OFF_W_FF1); }
  else { idx = t - 3200; src = p.w_ff2 + (size_t)l * DFF * D; K = DFF; N = D; dst = (bf16_t*)(ws + OFF_W_FF2); }
  const int nts = N / 64; convert_tile(src, K, N, dst, idx / nts, idx % nts, tile);
}
constexpr int CONV_EARLY = 3200, CONV_ALL = 4224;
DI void convert_layer(const Params& p, int l, int t_begin, unsigned char* smem) {
  float* tile = (float*)smem;
  for (int t = t_begin + get_bid(); t < CONV_ALL; t += gridDim.x) convert_item(p, l, t, tile);
}
DI void convert_steal(const Params& p, int l, unsigned char* smem) {
  float* tile = (float*)smem;
  volatile int* smw = (volatile int*)(smem + SMEM_BYTES - 16);
  unsigned* ctr = (unsigned*)(p.ws + OFF_LAM) + 48 + l;
  for (;;) {
    __syncthreads();
    if (get_tid() == 0) *smw = (int)atomicAdd(ctr, 1u);
    __syncthreads();
    int t = *smw; t = __builtin_amdgcn_readfirstlane(t);
    if (t >= CONV_EARLY) break;
    convert_item(p, l, t, tile);
  }
}

DI void phase0_misc(const Params& p, unsigned char* smem) {
  unsigned char* ws = p.ws;
  const int tid = get_tid();
  if (get_bid() == 0) {
    float* rope = (float*)(ws + OFF_ROPE);
    for (int i = tid; i < 1024; i += 256) { const int pos = i >> 4, f = i & 15; const float inv = powf(10000.0f, -(float)f / 16.0f); const float ang = (float)pos * inv; rope[i] = cosf(ang); rope[1024 + i] = sinf(ang); }
    if (tid < DEPTH) { const int l = tid; float s1 = 0.f, s2 = 0.f;
      for (int i = 0; i < 64; ++i) { s1 += p.lq1[l * 64 + i] * p.lk1[l * 64 + i]; s2 += p.lq2[l * 64 + i] * p.lk2[l * 64 + i]; }
      const float lam_init = 0.8f - 0.6f * expf(-0.3f * (float)l);
      ((float*)(ws + OFF_LAM))[l] = expf(s1) - expf(s2) + lam_init; }
    if (tid >= 64 && tid < 64 + DEPTH) { const int l = tid - 64; float a = 0.f, b2 = 0.f, c2 = 0.f, d2 = 0.f;
      for (int i = 0; i < 64; ++i) { a = fmaxf(a, fabsf(p.dq_g[l * 64 + i])); b2 = fmaxf(b2, fabsf(p.dk_g[l * 64 + i])); c2 = fmaxf(c2, fabsf(p.wq_g[l * 64 + i])); d2 = fmaxf(d2, fabsf(p.wk_g[l * 64 + i])); }
      ((float*)(ws + OFF_LAM))[4 + l] = 8.0f * LOG2E * 1.02f * a * b2;
      ((float*)(ws + OFF_LAM))[8 + l] = 8.0f * LOG2E * 1.02f * c2 * d2;
      for (int i = 0; i < 8; ++i) ((unsigned*)(ws + OFF_LAM))[16 + l * 8 + i] = 0u;
      ((unsigned*)(ws + OFF_LAM))[48 + l] = 0u; }
  }
  float* sc = (float*)smem;
  float* red = sc + 5 * 1024;
  for (int i = tid; i < 5 * 1024; i += 256) { const int bb = i >> 10, k = i & 1023; const float v = bb < 4 ? p.c[bb * 1024 + k] : p.c_ctx[k]; sc[i] = v / (1.0f + __expf(-v)); }
  __syncthreads();
  float* modv = (float*)(ws + OFF_MODV);
  for (int t = get_bid(); t < DEPTH * 96; t += gridDim.x) {
    const int l = t / 96, cb = t % 96, kq = tid >> 6, cl = tid & 63, col = cb * 64 + cl;
    const float* w = p.w_mod + (size_t)l * D * 6144 + col;
    float s[5] = {0.f, 0.f, 0.f, 0.f, 0.f};
    for (int k = kq * 256; k < kq * 256 + 256; ++k) { const float wv = w[(size_t)k * 6144];
#pragma unroll
      for (int bb = 0; bb < 5; ++bb) s[bb] += sc[bb * 1024 + k] * wv; }
#pragma unroll
    for (int bb = 0; bb < 5; ++bb) red[(kq * 5 + bb) * 64 + cl] = s[bb];
    __syncthreads();
    for (int i = tid; i < 5 * 64; i += 256) { const int bb = i >> 6, c2 = i & 63; const float v = red[(0 * 5 + bb) * 64 + c2] + red[(1 * 5 + bb) * 64 + c2] + red[(2 * 5 + bb) * 64 + c2] + red[(3 * 5 + bb) * 64 + c2];
      modv[((size_t)l * 5 + bb) * 6144 + cb * 64 + c2] = v + p.b_mod[l * 6144 + cb * 64 + c2]; }
    __syncthreads();
  }
}

DI void norm_phase(const Params& p, int l, const float* gvec, int sh_off, int sc_off, int nrows, bool first = false) {
  const int tid = get_tid(), lane = tid & 63, wid = tid >> 6;
  const float* h = (const float*)(p.ws + OFF_H); bf16_t* out = (bf16_t*)(p.ws + OFF_ABUF);
  const float* modv = (const float*)(p.ws + OFF_MODV) + (size_t)l * 5 * 6144;
  constexpr int RPW = 4;
  for (int t = get_bid(); t < nrows / (4 * RPW); t += gridDim.x) {
    const int row0 = t * (4 * RPW) + wid * RPW;
    const int bb = row0 < NLAT ? row0 / SEQ : 4;
    const float* mv = modv + bb * 6144;
    f32x4 v[RPW][4];
#pragma unroll
    for (int r = 0; r < RPW; ++r) { const int row = row0 + r;
      const float* hr = first ? (row < NLAT ? p.x + (size_t)row * D : p.ctx + (size_t)(row - NLAT) * D) : h + (size_t)row * D;
#pragma unroll
      for (int it = 0; it < 4; ++it) v[r][it] = *(const f32x4*)(hr + it * 256 + lane * 4); }
    f32x4 gm[4], s0[4];
#pragma unroll
    for (int it = 0; it < 4; ++it) { const int idx = it * 256 + lane * 4;
      const f32x4 g = *(const f32x4*)(gvec + idx), s1 = *(const f32x4*)(mv + sc_off + idx); s0[it] = *(const f32x4*)(mv + sh_off + idx);
      gm[it] = g * (1.0f + s1); }
    float ss[RPW];
#pragma unroll
    for (int r = 0; r < RPW; ++r) { float a = 0.f;
#pragma unroll
      for (int it = 0; it < 4; ++it) a += v[r][it][0] * v[r][it][0] + v[r][it][1] * v[r][it][1] + v[r][it][2] * v[r][it][2] + v[r][it][3] * v[r][it][3];
      ss[r] = a; }
#pragma unroll
    for (int m = 1; m < 64; m <<= 1)
#pragma unroll
      for (int r = 0; r < RPW; ++r) ss[r] += xshfl(ss[r], m);
#pragma unroll
    for (int r = 0; r < RPW; ++r) { const float rstd = rsqrtf(ss[r] * (1.0f / 1024.0f) + EPS);
#pragma unroll
      for (int it = 0; it < 4; ++it) { const int idx = it * 256 + lane * 4;
        const f32x4 y = v[r][it] * rstd * gm[it] + s0[it];
        u32x2 o; o[0] = pack2(y[0], y[1]); o[1] = pack2(y[2], y[3]); *(u32x2*)(out + (size_t)(row0 + r) * D + idx) = o; } }
  }
}

DI void inproj_epilogue(const Params& p, int l, const f32x4 (&acc)[4][4], int m0, int n0) {
  unsigned char* ws = p.ws;
  const int tid = get_tid(), lane = tid & 63, wid = tid >> 6, wr = wid >> 1, wc = wid & 1, lr = lane & 15, lg = lane >> 4;
  const bool is_lat = m0 < NLAT;
  int b, i0; if (is_lat) { b = m0 / SEQ; i0 = m0 % SEQ; } else { const int c0 = m0 - NLAT; b = c0 / CTX; i0 = c0 % CTX; }
  const int pos0 = is_lat ? CTX + i0 : i0;
  const int hc = n0 + wc * 64;
  int seg;
  if (n0 < 512) seg = 0; else if (n0 < 1024) seg = 1; else if (n0 < 1536) seg = 2; else if (n0 < 2048) seg = 3; else if (n0 < 2560) seg = 4; else if (n0 < 2688) seg = 5; else if (n0 < 2816) seg = 6; else seg = 7;
  if (seg == 0 || seg == 1 || seg == 4 || seg == 5) {
    const float* gv; bf16_t* dst; float qs = 1.0f;
    if (seg == 0) { const int c = hc; gv = p.dq_g + l * 64; dst = (bf16_t*)(ws + OFF_QD) + ((size_t)((b * 2 + c / 256) * 4 + (c % 256) / 64) * POS) * 64; qs = 0.125f * LOG2E; }
    else if (seg == 1) { const int c = hc - 512; gv = p.dk_g + l * 64; dst = (bf16_t*)(ws + OFF_KD) + ((size_t)((b * 2 + c / 256) * 4 + (c % 256) / 64) * POS) * 64; }
    else if (seg == 4) { const int c = hc - 2048; gv = p.wq_g + l * 64; dst = (bf16_t*)(ws + OFF_QW) + ((size_t)(b * 8 + c / 64) * POS) * 64; qs = 0.125f * LOG2E; }
    else { const int c = hc - 2560; gv = p.wk_g + l * 64; dst = (bf16_t*)(ws + OFF_KW) + ((size_t)(b * 2 + c / 64) * POS) * 64; }
    const float* rope = (const float*)(ws + OFF_ROPE);
    f32x4 gq[4];
#pragma unroll
    for (int ni = 0; ni < 4; ++ni) gq[ni] = *(const f32x4*)(gv + ni * 16 + lg * 4);
#pragma unroll
    for (int mi = 0; mi < 4; ++mi) {
      const int r = wr * 64 + mi * 16 + lr;
      float ss = 0.f;
#pragma unroll
      for (int ni = 0; ni < 4; ++ni)
#pragma unroll
        for (int j = 0; j < 4; ++j) ss += acc[mi][ni][j] * acc[mi][ni][j];
      ss += xshfl(ss, 16); ss += xshfl(ss, 32);
      const float rstd = rsqrtf(ss * (1.0f / 64.0f) + EPS);
      f32x4 v[4];
#pragma unroll
      for (int ni = 0; ni < 4; ++ni) v[ni] = acc[mi][ni] * rstd * gq[ni];
      if (is_lat) {
        const int li = i0 + r, gr = li >> 6, gc = li & 63;
#pragma unroll
        for (int ni = 0; ni < 2; ++ni) {
          const int pi = ni == 0 ? gr : gc;
          const f32x4 cs = *(const f32x4*)(rope + pi * 16 + lg * 4), sn = *(const f32x4*)(rope + 1024 + pi * 16 + lg * 4);
          const f32x4 x1 = v[ni], x2 = v[ni + 2];
          v[ni] = x1 * cs - x2 * sn; v[ni + 2] = x2 * cs + x1 * sn;
        }
      }
      bf16_t* drow = dst + (size_t)(pos0 + r) * 64 + lg * 4;
#pragma unroll
      for (int ni = 0; ni < 4; ++ni) { u32x2 o; o[0] = pack2(v[ni][0] * qs, v[ni][1] * qs); o[1] = pack2(v[ni][2] * qs, v[ni][3] * qs); *(u32x2*)(drow + ni * 16) = o; }
    }
  } else if (seg == 2 || seg == 6) {
#pragma unroll
    for (int mi = 0; mi < 4; ++mi) {
      const int pos = pos0 + wr * 64 + mi * 16 + lr;
#pragma unroll
      for (int ni = 0; ni < 4; ++ni)
#pragma unroll
        for (int j = 0; j < 4; ++j) {
          const int col = hc + ni * 16 + lg * 4 + j; bf16_t* dst;
          if (seg == 2) { const int c = col - 1024; dst = (bf16_t*)(ws + OFF_VDT) + ((size_t)(b * 4 + c / 128) * 128 + (c % 128)) * POS + pos; }
          else { const int c = col - 2688; dst = (bf16_t*)(ws + OFF_VWT) + ((size_t)(b * 2 + c / 64) * 64 + (c % 64)) * POS + pos; }
          *dst = (bf16_t)(pack2(acc[mi][ni][j], 0.f) & 0xffffu);
        }
    }
  } else if (seg == 3) {
    bf16_t* su = (bf16_t*)(ws + OFF_SU);
#pragma unroll
    for (int mi = 0; mi < 4; ++mi) { const int pos = pos0 + wr * 64 + mi * 16 + lr;
#pragma unroll
      for (int ni = 0; ni < 4; ++ni) { u32x2 o; o[0] = pack2(acc[mi][ni][0], acc[mi][ni][1]); o[1] = pack2(acc[mi][ni][2], acc[mi][ni][3]);
        *(u32x2*)(su + ((size_t)(b * 32 + (hc - 1536) / 16 + ni) * POS + pos) * 16 + lg * 4) = o; } }
  } else {
    bf16_t* gt = (bf16_t*)(ws + OFF_GATES);
#pragma unroll
    for (int mi = 0; mi < 4; ++mi) { const int row = m0 + wr * 64 + mi * 16 + lr;
#pragma unroll
      for (int ni = 0; ni < 4; ++ni) { u32x2 o; o[0] = pack2(sigmoidf_(acc[mi][ni][0]), sigmoidf_(acc[mi][ni][1])); o[1] = pack2(sigmoidf_(acc[mi][ni][2]), sigmoidf_(acc[mi][ni][3]));
        *(u32x2*)(gt + (size_t)row * 3072 + (hc - 2816) + ni * 16 + lg * 4) = o; } }
  }
}
DI void inproj_phase(const Params& p, int l, unsigned char* smem) {
  const bf16_t* A = (const bf16_t*)(p.ws + OFF_ABUF); const bf16_t* W = (const bf16_t*)(p.ws + OFF_W_IN);
  constexpr int NT = DIN / 128, MT = NTOK / 128;
  gemm_stream<D, false>(A, W, MT * NT, NT, (bf16_t*)smem, [&](const f32x4 (&acc)[4][4], int m0, int n0) { inproj_epilogue(p, l, acc, m0, n0); });
}

constexpr int NW = 4;
constexpr int NTHR = NW * 64;
constexpr int QU = NW * 32;
template <int DV, bool TWOK>
DI void attn_core_d1(f32x4 (&O)[2][DV / 16], float (&lsum)[2], const bf16x8 (&Qf)[2][2], float negm,
                  const bf16_t* __restrict__ Kp0, const bf16_t* __restrict__ Kp1, const bf16_t* __restrict__ Vt, int t0, int t1, int tm0, int tm1, int qlat0, unsigned char* smem) {
  constexpr int KB = TWOK ? 16384 : 8192, BUFB = KB + DV * 128;
  constexpr int NKL = (TWOK ? 16 : 8) / NW, NVL = DV / 8 / NW;
  const int tid = get_tid(), lane = tid & 63, wid = __builtin_amdgcn_readfirstlane(tid >> 6), lr = lane & 15, lg = lane >> 4;
  const int rl = lane >> 3, lc = (lane & 7) ^ rl;
  const int n0 = t1 - t0, ntl = n0 + (tm1 - tm0);
  u32x4 rk[NKL], rv[NVL];
#define ATTN_GLOAD(KEY0) do { const int key0_ = (KEY0); \
    _Pragma("unroll") for (int i = 0; i < NKL; ++i) { const int L = wid + i * NW; const bf16_t* kp_ = (i * NW >= 8) ? Kp1 : Kp0; rk[i] = *(const u32x4*)(kp_ + (size_t)(key0_ + (L & 7) * 8 + rl) * 64 + (((lane & 7) ^ ((((L & 3) * 2) + (rl >> 1)) & 7)) * 8)); } \
    _Pragma("unroll") for (int i = 0; i < NVL; ++i) { const int L = wid + i * NW; rv[i] = *(const u32x4*)(Vt + (size_t)(L * 8 + rl) * POS + key0_ + lc * 8); } } while (0)
#define ATTN_LSTORE(BUF) do { unsigned char* buf_ = (BUF); \
    _Pragma("unroll") for (int i = 0; i < NKL; ++i) *(u32x4*)(buf_ + (wid + i * NW) * 1024 + lane * 16) = rk[i]; \
    _Pragma("unroll") for (int i = 0; i < NVL; ++i) *(u32x4*)(buf_ + KB + (wid + i * NW) * 1024 + lane * 16) = rv[i]; } while (0)
  ATTN_GLOAD((n0 > 0 ? t0 : tm0) * 64);
  __syncthreads();
  ATTN_LSTORE(smem);
  const int sw = lr & 7;
  for (int it = 0; it < ntl; ++it) {
    const bool masked = it >= n0;
    const int key0 = (masked ? tm0 + (it - n0) : t0 + it) * 64;
    const unsigned char* Kb = smem + (it & 1) * BUFB; const unsigned char* Vb = Kb + KB;
    __syncthreads();
    if (it + 1 < ntl) ATTN_GLOAD(((it + 1) >= n0 ? tm0 + (it + 1 - n0) : t0 + it + 1) * 64);
    f32x4 s[4][2];
#pragma unroll
    for (int kt = 0; kt < 4; ++kt) {
      const unsigned char* kr = Kb + ((kt >> 1) * 32 + (lr >> 2) * 8 + (kt & 1) * 4 + (lr & 3)) * 128; const int kkey = ((lr >> 2) * 2 + (kt & 1) * 2 + ((lr & 3) >> 1)) & 7;
      if (!TWOK) {
        const bf16x8 k0f = *(const bf16x8*)(kr + ((lg ^ kkey) << 4)), k1f = *(const bf16x8*)(kr + (((4 + lg) ^ kkey) << 4));
#pragma unroll
        for (int qt = 0; qt < 2; ++qt) { f32x4 z = {negm, negm, negm, negm}; z = MFMA16(k0f, Qf[qt][0], z); s[kt][qt] = MFMA16(k1f, Qf[qt][1], z); }
      } else {
#pragma unroll
        for (int qt = 0; qt < 2; ++qt) {
          const bf16x8 k0f = *(const bf16x8*)(kr + qt * 8192 + ((lg ^ kkey) << 4)), k1f = *(const bf16x8*)(kr + qt * 8192 + (((4 + lg) ^ kkey) << 4));
          f32x4 z = {negm, negm, negm, negm}; z = MFMA16(k0f, Qf[qt][0], z); s[kt][qt] = MFMA16(k1f, Qf[qt][1], z); }
      }
    }
    if (masked) {
#pragma unroll
      for (int kt = 0; kt < 4; ++kt)
#pragma unroll
        for (int qt = 0; qt < 2; ++qt)
#pragma unroll
          for (int j = 0; j < 4; ++j) { const int kl = key0 - CTX + (kt >> 1) * 32 + lg * 8 + (kt & 1) * 4 + j, ql = qlat0 + qt * 16 + lr; const int rel = kl - ql; if (rel > 128 || rel < -128) s[kt][qt][j] = -INFINITY; }
    }
    bf16x8 pf[2][2];
#pragma unroll
    for (int qt = 0; qt < 2; ++qt) {
      float rs = 0.f;
#pragma unroll
      for (int kt = 0; kt < 4; ++kt)
#pragma unroll
        for (int j = 0; j < 4; ++j) { const float e = __builtin_amdgcn_exp2f(s[kt][qt][j]); s[kt][qt][j] = e; rs += e; }
      lsum[qt] += rs;
#pragma unroll
      for (int kk = 0; kk < 2; ++kk) {
        u32x4 w; w[0] = pack2(s[2 * kk][qt][0], s[2 * kk][qt][1]); w[1] = pack2(s[2 * kk][qt][2], s[2 * kk][qt][3]);
        w[2] = pack2(s[2 * kk + 1][qt][0], s[2 * kk + 1][qt][1]); w[3] = pack2(s[2 * kk + 1][qt][2], s[2 * kk + 1][qt][3]);
        pf[qt][kk] = __builtin_bit_cast(bf16x8, w);
      }
    }
#pragma unroll
    for (int et = 0; et < DV / 16; ++et)
#pragma unroll
      for (int kk = 0; kk < 2; ++kk) {
        const bf16x8 vf = *(const bf16x8*)(Vb + (et * 16 + lr) * 128 + (((kk * 4 + lg) ^ sw) << 4));
        O[0][et] = MFMA16(vf, pf[0][kk], O[0][et]);
        O[1][et] = MFMA16(vf, pf[1][kk], O[1][et]);
      }
    if (it + 1 < ntl) ATTN_LSTORE(smem + ((it + 1) & 1) * BUFB);
  }
#undef ATTN_GLOAD
#undef ATTN_LSTORE
}

#define VM_WAIT4(N, R, Q) asm volatile("s_waitcnt vmcnt(" #N ")" : "+v"(R[0]), "+v"(R[1]), "+v"(Q[0]), "+v"(Q[1]) :: "memory")
template <int DV, bool TWOK>
DI void attn_core(f32x4 (&O)[2][DV / 16], float (&lsum)[2], const bf16x8 (&Qf)[2][2], float negm,
                  const bf16_t* __restrict__ Kp0, const bf16_t* __restrict__ Kp1, const bf16_t* __restrict__ Vt, int t0, int t1, int tm0, int tm1, int qlat0, unsigned char* smem) {
  constexpr int KB = TWOK ? 16384 : 8192, BUFB = KB + DV * 128;
  constexpr int NKL = (TWOK ? 16 : 8) / NW, NVL = DV / 8 / NW;
  static_assert((NKL == 4 && NVL == 4) || (NKL == 2 && NVL == 2), "wait macros are written for 8 or 4 loads per set");
  const int tid = get_tid(), lane = tid & 63, wid = __builtin_amdgcn_readfirstlane(tid >> 6), lr = lane & 15, lg = lane >> 4;
  const int rl = lane >> 3, lc = (lane & 7) ^ rl;
  const int n0 = t1 - t0, ntl = n0 + (tm1 - tm0);
  u32x4 rk0[NKL], rv0[NVL], rk1[NKL], rv1[NVL];
#define ATTN_TILE(I) ({ int i_ = (I); i_ = i_ < ntl ? i_ : ntl - 1; (i_ < n0 ? t0 + i_ : tm0 + (i_ - n0)) * 64; })
#define ATTN_GLOAD(RK, RV, KEY0) do { const int key0_ = (KEY0); \
    _Pragma("unroll") for (int i = 0; i < NKL; ++i) { const int L = wid + i * NW; const bf16_t* kp_ = (i * NW >= 8) ? Kp1 : Kp0; RK[i] = gload_async(kp_ + (size_t)(key0_ + (L & 7) * 8 + rl) * 64 + (((lane & 7) ^ ((((L & 3) * 2) + (rl >> 1)) & 7)) * 8)); } \
    _Pragma("unroll") for (int i = 0; i < NVL; ++i) { const int L = wid + i * NW; RV[i] = gload_async(Vt + (size_t)(L * 8 + rl) * POS + key0_ + lc * 8); } } while (0)
#define ATTN_LSTORE(RK, RV, BUF) do { unsigned char* buf_ = (BUF); \
    _Pragma("unroll") for (int i = 0; i < NKL; ++i) *(u32x4*)(buf_ + (wid + i * NW) * 1024 + lane * 16) = RK[i]; \
    _Pragma("unroll") for (int i = 0; i < NVL; ++i) *(u32x4*)(buf_ + KB + (wid + i * NW) * 1024 + lane * 16) = RV[i]; } while (0)
#define ATTN_WAIT(RK, RV) do { if constexpr (NKL == 4) VM_WAIT8(8, RK, RV); else VM_WAIT4(4, RK, RV); } while (0)
#define ATTN_DRAIN(RK, RV) do { if constexpr (NKL == 4) VM_WAIT8(0, RK, RV); else VM_WAIT4(0, RK, RV); } while (0)
  const int sw = lr & 7;
#define ATTN_COMPUTE(IT, BUFP) do { const int it_ = (IT); const bool masked = it_ >= n0; const int key0 = (masked ? tm0 + (it_ - n0) : t0 + it_) * 64; \
    const unsigned char* Kb = (BUFP); const unsigned char* Vb = Kb + KB; \
    bf16x8 pf[2][2]; \
    _Pragma("unroll") for (int qt = 0; qt < 2; ++qt) { f32x4 s4[4]; \
      _Pragma("unroll") for (int kt = 0; kt < 4; ++kt) { const unsigned char* kq = Kb + ((kt >> 1) * 32 + (lr >> 2) * 8 + (kt & 1) * 4 + (lr & 3)) * 128 + (TWOK ? qt * 8192 : 0); const int kkey = ((lr >> 2) * 2 + (kt & 1) * 2 + ((lr & 3) >> 1)) & 7; \
        const bf16x8 k0f = *(const bf16x8*)(kq + ((lg ^ kkey) << 4)), k1f = *(const bf16x8*)(kq + (((4 + lg) ^ kkey) << 4)); \
        f32x4 z = {negm, negm, negm, negm}; z = MFMA16(k0f, Qf[qt][0], z); s4[kt] = MFMA16(k1f, Qf[qt][1], z); } \
      if (masked) { \
        _Pragma("unroll") for (int kt = 0; kt < 4; ++kt) _Pragma("unroll") for (int j = 0; j < 4; ++j) { \
          const int kl = key0 - CTX + (kt >> 1) * 32 + lg * 8 + (kt & 1) * 4 + j, ql = qlat0 + qt * 16 + lr; const int rel = kl - ql; if (rel > 128 || rel < -128) s4[kt][j] = -INFINITY; } } \
      float rs = 0.f; \
      _Pragma("unroll") for (int kt = 0; kt < 4; ++kt) _Pragma("unroll") for (int j = 0; j < 4; ++j) { const float e = __builtin_amdgcn_exp2f(s4[kt][j]); s4[kt][j] = e; rs += e; } \
      lsum[qt] += rs; \
      _Pragma("unroll") for (int kk = 0; kk < 2; ++kk) { u32x4 w; w[0] = pack2(s4[2 * kk][0], s4[2 * kk][1]); w[1] = pack2(s4[2 * kk][2], s4[2 * kk][3]); \
        w[2] = pack2(s4[2 * kk + 1][0], s4[2 * kk + 1][1]); w[3] = pack2(s4[2 * kk + 1][2], s4[2 * kk + 1][3]); pf[qt][kk] = __builtin_bit_cast(bf16x8, w); } } \
    _Pragma("unroll") for (int et = 0; et < DV / 16; ++et) _Pragma("unroll") for (int kk = 0; kk < 2; ++kk) { \
        const bf16x8 vf = *(const bf16x8*)(Vb + (et * 16 + lr) * 128 + (((kk * 4 + lg) ^ sw) << 4)); \
        O[0][et] = MFMA16(vf, pf[0][kk], O[0][et]); O[1][et] = MFMA16(vf, pf[1][kk], O[1][et]); } } while (0)
  asm volatile("s_waitcnt vmcnt(0)" ::: "memory");
  ATTN_GLOAD(rk0, rv0, ATTN_TILE(0)); ATTN_GLOAD(rk1, rv1, ATTN_TILE(1));
  __syncthreads();
  ATTN_WAIT(rk0, rv0); ATTN_LSTORE(rk0, rv0, smem); ATTN_GLOAD(rk0, rv0, ATTN_TILE(2));
  for (int it = 0; it < ntl; it += 2) {
    __syncthreads();
    ATTN_COMPUTE(it, smem);
    ATTN_WAIT(rk1, rv1); ATTN_LSTORE(rk1, rv1, smem + BUFB); ATTN_GLOAD(rk1, rv1, ATTN_TILE(it + 3));
    __syncthreads();
    ATTN_COMPUTE(it + 1, smem + BUFB);
    ATTN_WAIT(rk0, rv0); ATTN_LSTORE(rk0, rv0, smem); ATTN_GLOAD(rk0, rv0, ATTN_TILE(it + 4));
  }
  ATTN_DRAIN(rk0, rv0); ATTN_DRAIN(rk1, rv1);
#undef ATTN_TILE
#undef ATTN_GLOAD
#undef ATTN_LSTORE
#undef ATTN_WAIT
#undef ATTN_DRAIN
#undef ATTN_COMPUTE
}

constexpr int QUD = NW * 16;
DI void diff_unit(const Params& p, int l, int b, int hd, bool is_lat, int qi, unsigned char* smem) {
  unsigned char* ws = p.ws;
  const int tid = get_tid(), lane = tid & 63, wid = __builtin_amdgcn_readfirstlane(tid >> 6), lr = lane & 15, lg = lane >> 4;
  const int qpos0 = (is_lat ? CTX + qi * QUD : qi * QUD) + wid * 16;
  const int ntile = is_lat ? POS / 64 : CTX / 64;
  const float lam = ((const float*)(ws + OFF_LAM))[l];
  const float negm = -((const float*)(ws + OFF_LAM))[4 + l];
  const float lam_init = 0.8f - 0.6f * expf(-0.3f * (float)l);
  const size_t hoff0 = (size_t)((b * 2 + 0) * 4 + hd) * POS * 64, hoff1 = (size_t)((b * 2 + 1) * 4 + hd) * POS * 64;
  const bf16_t* Qd = (const bf16_t*)(ws + OFF_QD); const bf16_t* Kd = (const bf16_t*)(ws + OFF_KD);
  bf16x8 Qf[2][2];
#pragma unroll
  for (int ks = 0; ks < 2; ++ks) { Qf[0][ks] = *(const bf16x8*)(Qd + hoff0 + (size_t)(qpos0 + lr) * 64 + ks * 32 + lg * 8); Qf[1][ks] = *(const bf16x8*)(Qd + hoff1 + (size_t)(qpos0 + lr) * 64 + ks * 32 + lg * 8); }
  float lsum[2] = {0.f, 0.f};
  f32x4 O[2][8];
#pragma unroll
  for (int m = 0; m < 2; ++m)
#pragma unroll
    for (int et = 0; et < 8; ++et) O[m][et] = (f32x4){0.f, 0.f, 0.f, 0.f};
  attn_core_d1<128, true>(O, lsum, Qf, negm, Kd + hoff0, Kd + hoff1, (const bf16_t*)(ws + OFF_VDT) + (size_t)(b * 4 + hd) * 128 * POS, 0, ntile, 0, 0, 0, smem);
  float l0 = lsum[0], l1 = lsum[1];
  l0 += xshfl(l0, 16); l0 += xshfl(l0, 32); l1 += xshfl(l1, 16); l1 += xshfl(l1, 32);
  const float i0 = 1.0f / l0, i1 = lam / l1;
  float ss = 0.f;
#pragma unroll
  for (int et = 0; et < 8; ++et) { O[0][et] = O[0][et] * i0 - O[1][et] * i1;
#pragma unroll
    for (int j = 0; j < 4; ++j) ss += O[0][et][j] * O[0][et][j]; }
  ss += xshfl(ss, 16); ss += xshfl(ss, 32);
  const float rs = rsqrtf(ss * (1.0f / 128.0f) + EPS) * (1.0f - lam_init);
  const float* og = p.dout_g + l * 128; bf16_t* yd = (bf16_t*)(ws + OFF_YD);
  const int qpos = qpos0 + lr;
  const int row = is_lat ? b * SEQ + (qpos - CTX) : NLAT + b * CTX + qpos;
#pragma unroll
  for (int et = 0; et < 8; ++et) { const f32x4 g = *(const f32x4*)(og + et * 16 + lg * 4); const f32x4 y = O[0][et] * rs * g;
    u32x2 o; o[0] = pack2(y[0], y[1]); o[1] = pack2(y[2], y[3]); *(u32x2*)(yd + (size_t)row * 512 + hd * 128 + et * 16 + lg * 4) = o; }
}

DI void win_unit(const Params& p, int l, int b, int qh, bool is_lat, int qi, unsigned char* smem) {
  unsigned char* ws = p.ws;
  const int tid = get_tid(), lane = tid & 63, wid = __builtin_amdgcn_readfirstlane(tid >> 6), lr = lane & 15, lg = lane >> 4;
  const int qpos0 = (is_lat ? CTX + qi * QU : qi * QU) + wid * 32;
  const int kv = qh >> 2;
  const bf16_t* Qp = (const bf16_t*)(ws + OFF_QW) + ((size_t)(b * 8 + qh) * POS + qpos0) * 64;
  bf16x8 Qf[2][2];
#pragma unroll
  for (int qt = 0; qt < 2; ++qt)
#pragma unroll
    for (int ks = 0; ks < 2; ++ks) Qf[qt][ks] = *(const bf16x8*)(Qp + (qt * 16 + lr) * 64 + ks * 32 + lg * 8);
  const float sk = p.w_sink[l * 8 + qh] * LOG2E;
  const float mfix = fmaxf(((const float*)(ws + OFF_LAM))[8 + l], sk);
  const float l0 = lg == 0 ? __builtin_amdgcn_exp2f(sk - mfix) : 0.f;
  float lsum[2] = {l0, l0};
  f32x4 O[2][4];
#pragma unroll
  for (int qt = 0; qt < 2; ++qt)
#pragma unroll
    for (int et = 0; et < 4; ++et) O[qt][et] = (f32x4){0.f, 0.f, 0.f, 0.f};
  int tm0 = 0, tm1 = 0;
  if (is_lat) { const int q0 = qi * QU; tm0 = (q0 + 128) / 64; if (tm0 < 4) tm0 = 4; tm1 = (q0 + QU + 384) / 64; if (tm1 > POS / 64) tm1 = POS / 64; }
  attn_core<64, false>(O, lsum, Qf, -mfix, (const bf16_t*)(ws + OFF_KW) + (size_t)(b * 2 + kv) * POS * 64, nullptr, (const bf16_t*)(ws + OFF_VWT) + (size_t)(b * 2 + kv) * 64 * POS, 0, 4, tm0, tm1, qpos0 - CTX, smem);
  bf16_t* yw = (bf16_t*)(ws + OFF_YW);
#pragma unroll
  for (int qt = 0; qt < 2; ++qt) {
    float ls = lsum[qt]; ls += xshfl(ls, 16); ls += xshfl(ls, 32);
    const float inv = 1.0f / ls;
    const int qpos = qpos0 + qt * 16 + lr;
    const int row = is_lat ? b * SEQ + (qpos - CTX) : NLAT + b * CTX + qpos;
#pragma unroll
    for (int et = 0; et < 4; ++et) { const f32x4 y = O[qt][et] * inv; u32x2 o; o[0] = pack2(y[0], y[1]); o[1] = pack2(y[2], y[3]);
      *(u32x2*)(yw + (size_t)row * 512 + qh * 64 + et * 16 + lg * 4) = o; }
  }
}

constexpr int NR = NW / 2, CR = NCH / NR;
constexpr int BST = 20, SST = 136;
constexpr int S5_WAVE_LDS = 128 * BST * 4 + 16 * SST * 2;
constexpr int EB_PER_UNIT = 2 * (NCH + 8) * 64 * 2;
DI int s5_row(int b, int k, int t) { return k < 8 ? NLAT + b * CTX + k * 32 + t : b * SEQ + (k - 8) * 32 + t; }
DI int s5_cmap(int d, int k) { return d == 0 ? k : (k < 8 ? 7 - k : 143 - k); }
DI void s5_make_bf(const Params& p, int l, int d, int g, float fre, float fim, bf16x8 (&Bf)[8], int lr, int lg) {
#pragma unroll
  for (int q = 0; q < 8; ++q) {
    const int pp = 16 * (q & 3) + lr;
    const float fr = __shfl(fre, pp, 64), fi = __shfl(fim, pp, 64);
    u32x4 w = {0u, 0u, 0u, 0u};
    if (lg < 2) {
      const size_t bo = ((size_t)((l * 2 + d) * 32 + g) * 64 + pp) * 16 + lg * 8;
      const f32x4 br0 = *(const f32x4*)(p.s5_bre + bo), br1 = *(const f32x4*)(p.s5_bre + bo + 4), bi0 = *(const f32x4*)(p.s5_bim + bo), bi1 = *(const f32x4*)(p.s5_bim + bo + 4);
      f32x4 v0, v1;
      if (q < 4) { v0 = fr * br0 - fi * bi0; v1 = fr * br1 - fi * bi1; } else { v0 = fr * bi0 + fi * br0; v1 = fr * bi1 + fi * br1; }
      w[0] = pack2(v0[0], v0[1]); w[1] = pack2(v0[2], v0[3]); w[2] = pack2(v1[0], v1[1]); w[3] = pack2(v1[2], v1[3]);
    }
    Bf[q] = __builtin_bit_cast(bf16x8, w);
  }
}
DI u32x4 s5_load_uf(const bf16_t* sug, int k, int tt, int lr, int lg) { u32x4 uw = {0u, 0u, 0u, 0u}; if (lg < 2) uw = *(const u32x4*)(sug + (size_t)(k * 32 + tt * 16 + lr) * 16 + lg * 8); return uw; }
DI void s5_bu_tile(u32x4 uw, const bf16x8 (&Bf)[8], float* Bsm, int lr, int lg) {
  const bf16x8 uf = __builtin_bit_cast(bf16x8, uw);
#pragma unroll
  for (int q = 0; q < 8; ++q) { f32x4 z = {0.f, 0.f, 0.f, 0.f}; z = MFMA16(Bf[q], uf, z);
#pragma unroll
    for (int jj = 0; jj < 4; ++jj) Bsm[(q * 16 + lg * 4 + jj) * BST + lr] = z[jj]; }
}
#define S5_SCAN(D, AR, AI, WRITE) do { \
    _Pragma("unroll") for (int hb = 0; hb < 2; ++hb) { const int cb = ((D) ? 1 - hb : hb) * 2;     \
      const f32x4 br0_ = *(const f32x4*)(Bsm + lane * BST + cb * 4), br1_ = *(const f32x4*)(Bsm + lane * BST + cb * 4 + 4); \
      const f32x4 bi0_ = *(const f32x4*)(Bsm + (64 + lane) * BST + cb * 4), bi1_ = *(const f32x4*)(Bsm + (64 + lane) * BST + cb * 4 + 4); \
      _Pragma("unroll") for (int st = 0; st < 8; ++st) { const int t8 = (D) ? 7 - st : st; const int tl = cb * 4 + t8; \
        const float br = t8 < 4 ? br0_[t8 & 3] : br1_[t8 & 3], bi = t8 < 4 ? bi0_[t8 & 3] : bi1_[t8 & 3]; \
        const float nr = (AR) * sr - (AI) * si + br, ni = (AR) * si + (AI) * sr + bi; sr = nr; si = ni; \
        if (WRITE) { const unsigned pk = pack2(sr, si); Ssm[tl * SST + lane] = (bf16_t)(pk & 0xffffu); Ssm[tl * SST + 64 + lane] = (bf16_t)(pk >> 16); } } } } while (0)
DI void s5_unit(const Params& p, int l, int b, int g, unsigned char* smem) {
  unsigned char* ws = p.ws;
  const int tid = get_tid(), lane = tid & 63, wid = __builtin_amdgcn_readfirstlane(tid >> 6), lr = lane & 15, lg = lane >> 4;
  float* Bsm = (float*)(smem + wid * S5_WAVE_LDS);
  bf16_t* Ssm = (bf16_t*)(smem + wid * S5_WAVE_LDS + 128 * BST * 4);
  const bf16_t* sug = (const bf16_t*)(ws + OFF_SU) + (size_t)(b * 32 + g) * POS * 16;
  float* Eb = (float*)(ws + OFF_EB) + (size_t)(b * 32 + g) * EB_PER_UNIT;
  float are[2], aim[2], fre[2], fim[2];
#pragma unroll
  for (int d = 0; d < 2; ++d) {
    const int pi = ((l * 2 + d) * 32 + g) * 64 + lane;
    const float lre = p.s5_lre[pi], lim = p.s5_lim[pi], dt = expf(p.s5_ldt[(l * 2 + d) * 32 + g]);
    const float mag = expf(lre * dt), ang = lim * dt;
    are[d] = mag * cosf(ang); aim[d] = mag * sinf(ang);
    const float den = lre * lre + lim * lim, nre = are[d] - 1.0f;
    fre[d] = (nre * lre + aim[d] * lim) / den; fim[d] = (aim[d] * lre - nre * lim) / den;
  }
  bf16x8 Bf[2][8];
  s5_make_bf(p, l, 0, g, fre[0], fim[0], Bf[0], lr, lg);
  s5_make_bf(p, l, 1, g, fre[1], fim[1], Bf[1], lr, lg);
  {
    const int d = wid & 1, r = wid >> 1;
    const float ar = d ? are[1] : are[0], ai = d ? aim[1] : aim[0];
    float sr = 0.f, si = 0.f;
    for (int ci = 0; ci < CR; ++ci) {
      const int c = r * CR + ci, k = s5_cmap(d, c);
      { float* e_ = Eb + ((size_t)(d * (NCH + 8) + c) * 64 + lane) * 2; __hip_atomic_store(e_, sr, __ATOMIC_RELAXED, __HIP_MEMORY_SCOPE_AGENT); __hip_atomic_store(e_ + 1, si, __ATOMIC_RELAXED, __HIP_MEMORY_SCOPE_AGENT); }
      const u32x4 ua = s5_load_uf(sug, k, d ? 1 : 0, lr, lg), ub = s5_load_uf(sug, k, d ? 0 : 1, lr, lg);
#pragma unroll
      for (int hh = 0; hh < 2; ++hh) {
        const u32x4 uw = hh ? ub : ua;
        __builtin_amdgcn_wave_barrier();
        if (d) s5_bu_tile(uw, Bf[1], Bsm, lr, lg); else s5_bu_tile(uw, Bf[0], Bsm, lr, lg);
        __builtin_amdgcn_wave_barrier();
        if (d) S5_SCAN(1, ar, ai, false); else S5_SCAN(0, ar, ai, false);
      }
    }
    { float* e_ = Eb + ((size_t)(d * (NCH + 8) + NCH + r) * 64 + lane) * 2; __hip_atomic_store(e_, sr, __ATOMIC_RELAXED, __HIP_MEMORY_SCOPE_AGENT); __hip_atomic_store(e_ + 1, si, __ATOMIC_RELAXED, __HIP_MEMORY_SCOPE_AGENT); }
  }
  asm volatile("s_waitcnt vmcnt(0)" ::: "memory"); __syncthreads();
  bf16x8 Cf[2][4];
  float a32r[2], a32i[2], aCRr[2], aCRi[2];
#pragma unroll
  for (int d = 0; d < 2; ++d) {
#pragma unroll
    for (int ks = 0; ks < 4; ++ks) {
      const float* src = (ks < 2 ? p.s5_cre : p.s5_cim) + ((size_t)((l * 2 + d) * 32 + g) * 16 + lr) * 64 + (ks & 1) * 32 + lg * 8;
      const f32x4 v0 = *(const f32x4*)src, v1 = *(const f32x4*)(src + 4); const float sg = ks < 2 ? 1.0f : -1.0f;
      u32x4 w; w[0] = pack2(sg * v0[0], sg * v0[1]); w[1] = pack2(sg * v0[2], sg * v0[3]); w[2] = pack2(sg * v1[0], sg * v1[1]); w[3] = pack2(sg * v1[2], sg * v1[3]);
      Cf[d][ks] = __builtin_bit_cast(bf16x8, w);
    }
    float pr = are[d], pi_ = aim[d];
#pragma unroll
    for (int q = 0; q < 5; ++q) { const float nr = pr * pr - pi_ * pi_, ni = 2.0f * pr * pi_; pr = nr; pi_ = ni; }
    a32r[d] = pr; a32i[d] = pi_;
    float rr = 1.f, ri = 0.f, br_ = pr, bi_ = pi_;
#pragma unroll
    for (int bit = 0; bit < 7; ++bit) { if ((CR >> bit) & 1) { const float nr = rr * br_ - ri * bi_, ni = rr * bi_ + ri * br_; rr = nr; ri = ni; } const float nr = br_ * br_ - bi_ * bi_, ni = 2.0f * br_ * bi_; br_ = nr; bi_ = ni; }
    aCRr[d] = rr; aCRi[d] = ri;
  }
  const f32x4 dsk = *(const f32x4*)(p.s5_d + l * 512 + g * 16 + lg * 4);
  bf16_t* gb = (bf16_t*)(ws + OFF_GB);
  for (int k = wid; k < NCH; k += NW) {
    f32x4 acc[2] = {{0.f, 0.f, 0.f, 0.f}, {0.f, 0.f, 0.f, 0.f}};
    u32x4 uq[2]; uq[0] = s5_load_uf(sug, k, 0, lr, lg); uq[1] = s5_load_uf(sug, k, 1, lr, lg);
    u32x2 us[2]; us[0] = *(const u32x2*)(sug + (size_t)(k * 32 + lr) * 16 + lg * 4); us[1] = *(const u32x2*)(sug + (size_t)(k * 32 + 16 + lr) * 16 + lg * 4);
    float s0[2][2];
#pragma unroll
    for (int d = 0; d < 2; ++d) { const float* e_ = Eb + ((size_t)(d * (NCH + 8) + s5_cmap(d, k)) * 64 + lane) * 2;
      s0[d][0] = __hip_atomic_load(e_, __ATOMIC_RELAXED, __HIP_MEMORY_SCOPE_AGENT); s0[d][1] = __hip_atomic_load(e_ + 1, __ATOMIC_RELAXED, __HIP_MEMORY_SCOPE_AGENT); }
#pragma unroll
    for (int d = 0; d < 2; ++d) {
      const int c = s5_cmap(d, k), r = c / CR, j = c - r * CR;
      const float* Ed = Eb + (size_t)d * (NCH + 8) * 128 + lane * 2;
      float tr = 0.f, ti = 0.f;
#pragma unroll
      for (int r2 = 0; r2 < NR - 1; ++r2) if (r2 < r) {
        const float er = __hip_atomic_load(Ed + (size_t)(NCH + r2) * 128, __ATOMIC_RELAXED, __HIP_MEMORY_SCOPE_AGENT), ei = __hip_atomic_load(Ed + (size_t)(NCH + r2) * 128 + 1, __ATOMIC_RELAXED, __HIP_MEMORY_SCOPE_AGENT);
        const float nr = aCRr[d] * tr - aCRi[d] * ti + er, ni = aCRr[d] * ti + aCRi[d] * tr + ei; tr = nr; ti = ni; }
      float pr = 1.f, pi_ = 0.f, br_ = a32r[d], bi_ = a32i[d];
      for (int bit = 0; bit < 7; ++bit) { if ((j >> bit) & 1) { const float nr = pr * br_ - pi_ * bi_, ni = pr * bi_ + pi_ * br_; pr = nr; pi_ = ni; } const float nr = br_ * br_ - bi_ * bi_, ni = 2.0f * br_ * bi_; br_ = nr; bi_ = ni; }
      float sr = s0[d][0] + (pr * tr - pi_ * ti), si = s0[d][1] + (pr * ti + pi_ * tr);
#pragma unroll
      for (int hh = 0; hh < 2; ++hh) {
        const int tt = d ? 1 - hh : hh;
        __builtin_amdgcn_wave_barrier();
        s5_bu_tile(uq[tt], Bf[d], Bsm, lr, lg);
        __builtin_amdgcn_wave_barrier();
        if (d) S5_SCAN(1, are[1], aim[1], true); else S5_SCAN(0, are[0], aim[0], true);
        __builtin_amdgcn_wave_barrier();
#pragma unroll
        for (int ks = 0; ks < 4; ++ks) { const bf16x8 sf = *(const bf16x8*)(Ssm + lr * SST + ks * 32 + lg * 8); acc[tt] = MFMA16(Cf[d][ks], sf, acc[tt]); }
      }
    }
#pragma unroll
    for (int tt = 0; tt < 2; ++tt) { const int row = s5_row(b, k, tt * 16 + lr);
      f32x4 u; u[0] = __uint_as_float(us[tt][0] << 16); u[1] = __uint_as_float(us[tt][0] & 0xffff0000u); u[2] = __uint_as_float(us[tt][1] << 16); u[3] = __uint_as_float(us[tt][1] & 0xffff0000u);
      float y[4];
#pragma unroll
      for (int j = 0; j < 4; ++j) y[j] = gelu_tanh(acc[tt][j] + u[j] * dsk[j]);
      u32x2 o; o[0] = pack2(y[0], y[1]); o[1] = pack2(y[2], y[3]); *(u32x2*)(gb + (size_t)row * 512 + g * 16 + lg * 4) = o; }
  }
}

DI void mixer_phase(const Params& p, int l, unsigned char* smem) {
  const bool need_ctx = l < DEPTH - 1;
  volatile int* smw = (volatile int*)(smem + SMEM_BYTES - 16);
  constexpr int QL = SEQ / QU, QC = CTX / QU, QLD = SEQ / QUD, QCD = CTX / QUD;
  const int n_s5 = 16, n_dl = 2 * QLD, n_dc = need_ctx ? 2 * QCD : 0, n_wl = 4 * QL, n_wc = need_ctx ? 4 * QC : 0;
  const int total = n_dl + n_s5 + n_dc + n_wl + n_wc;
  const int x0 = get_bid() & 7;
  for (int dx = 0; dx < 8; ++dx) {
    const int xq = (x0 + dx) & 7;
    unsigned* ctr = (unsigned*)(p.ws + OFF_LAM) + 16 + l * 8 + xq;
    for (;;) {
      __syncthreads();
      if (get_tid() == 0) *smw = (int)atomicAdd(ctr, 1u);
      __syncthreads();
      int u = *smw;
      u = __builtin_amdgcn_readfirstlane(u);
      if (u >= total) break;
      int type, bq, hd, qi; bool is_lat = true;
      if (u < n_s5) { const int idx = xq * 16 + u; type = 1; bq = idx >> 5; hd = idx & 31; qi = 0; }
      else if ((u -= n_s5) < n_dl) { const int gidx = xq + 8 * (u / QLD); type = 0; bq = gidx >> 2; hd = gidx & 3; qi = u % QLD; }
      else if ((u -= n_dl) < n_dc) { const int gidx = xq + 8 * (u / QCD); type = 0; is_lat = false; bq = gidx >> 2; hd = gidx & 3; qi = u % QCD; }
      else if ((u -= n_dc) < n_wl) { type = 2; bq = xq >> 1; hd = (xq & 1) * 4 + (u & 3); qi = u >> 2; }
      else { u -= n_wl; type = 2; is_lat = false; bq = xq >> 1; hd = (xq & 1) * 4 + (u & 3); qi = u >> 2; }
      if (type == 0) diff_unit(p, l, bq, hd, is_lat, qi, smem);
      else if (type == 1) s5_unit(p, l, bq, hd, smem);
      else win_unit(p, l, bq, hd, is_lat, qi, smem);
    }
  }
}

#define EPI_LOOP_BEGIN { const int tid_ = get_tid(), lane_ = tid_ & 63, wid_ = tid_ >> 6, wr_ = wid_ >> 1, wc_ = wid_ & 1, lr_ = lane_ & 15, lg_ = lane_ >> 4; \
  _Pragma("unroll") for (int mi = 0; mi < 4; ++mi) { const int row = m0 + wr_ * 64 + mi * 16 + lr_; \
  _Pragma("unroll") for (int ni = 0; ni < 4; ++ni) { const int col = n0 + wc_ * 64 + ni * 16 + lg_ * 4;
#define EPI_LOOP_END } } }

DI void glu_phase(const Params& p, int MT, unsigned char* smem) {
  bf16_t* As = (bf16_t*)smem; bf16_t* Bs = As + 128 * LDT;
  const bf16_t* G = (const bf16_t*)(p.ws + OFF_GB); const bf16_t* W = (const bf16_t*)(p.ws + OFF_W_GLU); bf16_t* ys = (bf16_t*)(p.ws + OFF_YS);
  constexpr int NT = 4;
  for (int t = get_bid(); t < MT * NT; t += gridDim.x) {
    const int m0 = (t / NT) * 128, n0 = (t % NT) * 128;
    f32x4 acc[4][4]; zero_acc(acc);
    gemm_mainloop(acc, G + (size_t)m0 * 512, 512, W + (size_t)n0 * 512, 512, 512, As, Bs);
    EPI_LOOP_BEGIN
      const u32x2 gr = *(const u32x2*)(G + (size_t)row * 512 + col);
      const float g0 = __uint_as_float(gr[0] << 16), g1 = __uint_as_float(gr[0] & 0xffff0000u), g2 = __uint_as_float(gr[1] << 16), g3 = __uint_as_float(gr[1] & 0xffff0000u);
      u32x2 o; o[0] = pack2(g0 * sigmoidf_(acc[mi][ni][0]), g1 * sigmoidf_(acc[mi][ni][1])); o[1] = pack2(g2 * sigmoidf_(acc[mi][ni][2]), g3 * sigmoidf_(acc[mi][ni][3]));
      *(u32x2*)(ys + (size_t)row * 512 + col) = o;
    EPI_LOOP_END
  }
}
DI void merge_phase(const Params& p, int MT, unsigned char* smem) {
  bf16_t* As = (bf16_t*)smem; bf16_t* Bs = As + 128 * LDT;
  const bf16_t* gt = (const bf16_t*)(p.ws + OFF_GATES); bf16_t* mo = (bf16_t*)(p.ws + OFF_M);
  constexpr int NT = 8;
  for (int t = get_bid(); t < MT * NT; t += gridDim.x) {
    const int m0 = (t / NT) * 128, n0 = (t % NT) * 128;
    f32x4 acc[4][4]; zero_acc(acc);
#pragma unroll 1
    for (int br = 0; br < 3; ++br) {
      const bf16_t* Y = (const bf16_t*)(p.ws + (br == 0 ? OFF_YD : br == 1 ? OFF_YS : OFF_YW));
      const bf16_t* W = (const bf16_t*)(p.ws + (br == 0 ? OFF_W_PD : br == 1 ? OFF_W_PS : OFF_W_PW));
      gemm_mainloop(acc, Y + (size_t)m0 * 512, 512, W + (size_t)n0 * 512, 512, 512, As, Bs);
      if (br < 2) {
        EPI_LOOP_BEGIN
          const f32x4 g0 = ld_bf4(gt + (size_t)row * 3072 + br * 1024 + col), g1 = ld_bf4(gt + (size_t)row * 3072 + (br + 1) * 1024 + col);
#pragma unroll
          for (int j = 0; j < 4; ++j) acc[mi][ni][j] *= fmaxf(g0[j], 1e-30f) * __builtin_amdgcn_rcpf(fmaxf(g1[j], 1e-30f));
        EPI_LOOP_END
      } else {
        EPI_LOOP_BEGIN
          const f32x4 g2 = ld_bf4(gt + (size_t)row * 3072 + 2048 + col);
          u32x2 o; o[0] = pack2(acc[mi][ni][0] * fmaxf(g2[0], 1e-30f), acc[mi][ni][1] * fmaxf(g2[1], 1e-30f)); o[1] = pack2(acc[mi][ni][2] * fmaxf(g2[2], 1e-30f), acc[mi][ni][3] * fmaxf(g2[3], 1e-30f));
          *(u32x2*)(mo + (size_t)row * D + col) = o;
        EPI_LOOP_END
      }
    }
  }
}
DI void resid_phase(const Params& p, int l, const bf16_t* A, int K, const bf16_t* W, int gate_off, float* dst, int MT, unsigned char* smem, bool first = false) {
  bf16_t* As = (bf16_t*)smem; bf16_t* Bs = As + 128 * LDT;
  const float* h = (const float*)(p.ws + OFF_H);
  const float* modv = (const float*)(p.ws + OFF_MODV) + (size_t)l * 5 * 6144;
  constexpr int NT = 8;
  for (int t = get_bid(); t < MT * NT; t += gridDim.x) {
    const int m0 = (t / NT) * 128, n0 = (t % NT) * 128;
    f32x4 acc[4][4]; zero_acc(acc);
    gemm_mainloop(acc, A + (size_t)m0 * K, K, W + (size_t)n0 * K, K, K, As, Bs);
    const int bb = m0 < NLAT ? m0 / SEQ : 4;
    EPI_LOOP_BEGIN
      const f32x4 gv = *(const f32x4*)(modv + bb * 6144 + gate_off + col);
      const f32x4 hv = *(const f32x4*)((first ? (row < NLAT ? p.x + (size_t)row * D : p.ctx + (size_t)(row - NLAT) * D) : h + (size_t)row * D) + col);
      *(f32x4*)(dst + (size_t)row * D + col) = hv + gv * acc[mi][ni];
    EPI_LOOP_END
  }
}
DI void ff1_phase(const Params& p, int MT, unsigned char* smem) {
  const bf16_t* A = (const bf16_t*)(p.ws + OFF_ABUF); const bf16_t* W = (const bf16_t*)(p.ws + OFF_W_FF1); bf16_t* uo = (bf16_t*)(p.ws + OFF_U);
  constexpr int NT = DFF / 128;
  gemm_stream<D, true>(A, W, MT * NT, NT, (bf16_t*)smem, [&](const f32x4 (&acc)[4][4], int m0, int n0) {
    const int tid_ = get_tid(), lane_ = tid_ & 63, wid_ = tid_ >> 6, wr_ = wid_ >> 1, wc_ = wid_ & 1, lr_ = lane_ & 15, lg_ = lane_ >> 4;
#pragma unroll
    for (int mi = 0; mi < 4; ++mi) { const int row = m0 + wr_ * 64 + mi * 16 + lr_;
#pragma unroll
      for (int q = 0; q < 2; ++q) { const int col = n0 + wc_ * 64 + q * 32 + lg_ * 8;
        float r[8];
#pragma unroll
        for (int j = 0; j < 4; ++j) { const float v0 = fmaxf(acc[mi][2 * q][j], 0.f), v1 = fmaxf(acc[mi][2 * q + 1][j], 0.f); r[j] = v0 * v0; r[4 + j] = v1 * v1; }
        u32x4 o; o[0] = pack2(r[0], r[1]); o[1] = pack2(r[2], r[3]); o[2] = pack2(r[4], r[5]); o[3] = pack2(r[6], r[7]);
        *(u32x4*)(uo + (size_t)row * DFF + col) = o; } }
  });
}

#define XB_TMO      128
#define XB_XCNT(j)  (256  + 64 * (j))
#define XB_XSUB(j)  (1280 + 64 * (j))
#define XB_XGEN(j)  (2304 + 64 * (j))
#define XB_TOP      3328
#define XB_TOPGEN   3392
#define XCD_BAR_WORDS 3456
#define XB_SPIN_CAP (1u << 18)
#define XLAS __attribute__((address_space(3)))

__device__ __forceinline__ unsigned xb_ld(unsigned* p)              { return __hip_atomic_load(p, __ATOMIC_RELAXED, __HIP_MEMORY_SCOPE_AGENT); }
__device__ __forceinline__ unsigned xb_add(unsigned* p, unsigned v) { return __hip_atomic_fetch_add(p, v, __ATOMIC_RELAXED, __HIP_MEMORY_SCOPE_AGENT); }
__device__ __forceinline__ unsigned xb_xcc_id() { return (unsigned)__builtin_amdgcn_s_getreg((3 << 11) | 20) & 0xFu; }
#define XB_SPIN(cond, bar) do { unsigned _sp = 0; while (cond) { __builtin_amdgcn_s_sleep(1); \
    if ((++_sp & 255u) == 0u) { if (xb_ld(&(bar)[XB_TMO])) break; if (_sp > XB_SPIN_CAP) { atomicAdd(&(bar)[XB_TMO], 1u); break; } } } } while (0)

struct XcdBarrier {
    unsigned* bar; unsigned x;
    volatile XLAS unsigned* st;
};

__device__ __forceinline__ XcdBarrier xcd_barrier_post(unsigned* bar, volatile XLAS unsigned* st) {
    XcdBarrier b; b.bar = bar; b.x = xb_xcc_id(); b.st = st;
    if (threadIdx.x == 0) (void)xb_add(&bar[XB_XCNT(b.x)], 1u);
    return b;
}
__device__ __forceinline__ void xcd_barrier_complete(unsigned* bar, unsigned x, unsigned& nloc, unsigned& nx) {
    const unsigned G = gridDim.x * gridDim.y * gridDim.z;
    unsigned sum, cnt, mine, sp = 0u;
    for (;;) {
        sum = 0u; cnt = 0u; mine = 0u;
#pragma unroll
        for (unsigned j = 0; j < 16; ++j) { const unsigned c = xb_ld(&bar[XB_XCNT(j)]); sum += c; cnt += (c > 0u) ? 1u : 0u; mine = (j == x) ? c : mine; }
        if (sum == G) break;
        __builtin_amdgcn_s_sleep(1);
        if ((++sp & 255u) == 0u) { if (xb_ld(&bar[XB_TMO])) break; if (sp > XB_SPIN_CAP) { atomicAdd(&bar[XB_TMO], 1u); break; } }
    }
    nloc = mine > 0u ? mine : 1u; nx = cnt > 0u ? cnt : 1u;
}

__device__ __forceinline__ void xcd_barrier(const XcdBarrier& b) {
    asm volatile("s_waitcnt vmcnt(0)" ::: "memory");
    __syncthreads();
    if (threadIdx.x == 0) {
        unsigned* bar = b.bar;
        __builtin_amdgcn_s_waitcnt(0);
        unsigned nloc = b.st[0], nx = b.st[1];
        if (nloc == 0u) { xcd_barrier_complete(bar, b.x, nloc, nx); b.st[0] = nloc; b.st[1] = nx; }
        const unsigned old = xb_add(&bar[XB_XSUB(b.x)], 1u);
        const unsigned gen = old / nloc;
        if (old + 1u == (gen + 1u) * nloc) {
            __builtin_amdgcn_fence(__ATOMIC_RELEASE, "agent");
            asm volatile("s_waitcnt vmcnt(0)" ::: "memory");
            const unsigned og = xb_add(&bar[XB_TOP], 1u);
            const unsigned tg = og / nx;
            if (og + 1u == (tg + 1u) * nx) xb_add(&bar[XB_TOPGEN], 1u);
            else XB_SPIN(xb_ld(&bar[XB_TOPGEN]) == tg, bar);
            __builtin_amdgcn_fence(__ATOMIC_ACQUIRE, "agent");
            xb_add(&bar[XB_XGEN(b.x)], 1u);
            asm volatile("s_waitcnt vmcnt(0)" ::: "memory");
        } else {
            XB_SPIN(xb_ld(&bar[XB_XGEN(b.x)]) == gen, bar);
            __builtin_amdgcn_fence(__ATOMIC_ACQUIRE, "agent");
            asm volatile("s_waitcnt vmcnt(0)" ::: "memory");
        }
    }
    __syncthreads();
}


__global__ void __launch_bounds__(256, 2) fwd_megakernel(Params p) {
  __shared__ __attribute__((aligned(16))) unsigned char smem[SMEM_BYTES];
  __shared__ uint4 xb_words;
  cg::grid_group grid = cg::this_grid();
  unsigned char* ws = p.ws;
  if (threadIdx.x == 0) xb_words = make_uint4(0u, 0u, 0u, 0u);
  __syncthreads();
  const XcdBarrier xb = xcd_barrier_post((unsigned*)(ws + OFF_BAR), (volatile XLAS unsigned*)&xb_words);
  phase0_misc(p, smem);
  __syncthreads();
  convert_layer(p, 0, 0, smem);
  if (p.ws == nullptr) grid.sync();
  for (int l = 0; l < DEPTH; ++l) {
    const bool need_ctx = l < DEPTH - 1;
    const int MT = need_ctx ? NTOK / 128 : NLAT / 128;
    xcd_barrier(xb);
    if (l > 0) convert_layer(p, l, CONV_EARLY, smem);
    norm_phase(p, l, p.norm1_g + l * D, 0, 1024, NTOK, l == 0);
    xcd_barrier(xb);
    inproj_phase(p, l, smem);
    xcd_barrier(xb);
    mixer_phase(p, l, smem);
    xcd_barrier(xb);
    glu_phase(p, MT, smem);
    xcd_barrier(xb);
    merge_phase(p, MT, smem);
    xcd_barrier(xb);
    resid_phase(p, l, (const bf16_t*)(ws + OFF_M), D, (const bf16_t*)(ws + OFF_W_OUT), 2048, (float*)(ws + OFF_H), MT, smem, l == 0);
    xcd_barrier(xb);
    norm_phase(p, l, p.norm2_g + l * D, 3072, 4096, MT * 128);
    xcd_barrier(xb);
    ff1_phase(p, MT, smem);
    xcd_barrier(xb);
    resid_phase(p, l, (const bf16_t*)(ws + OFF_U), DFF, (const bf16_t*)(ws + OFF_W_FF2), 5120, need_ctx ? (float*)(ws + OFF_H) : p.out, MT, smem);
    if (need_ctx) convert_steal(p, l + 1, smem);
  }
}

extern "C" void kernel_launch(void* const* d_in, const int* in_sizes, int n_in, void* d_out, int out_size, void* d_ws, size_t ws_size, hipStream_t stream) {
  static int grid_blocks = 0;
  if (!grid_blocks) {
    int dev = 0, cus = 0, per_cu = 0;
    (void)hipGetDevice(&dev);
    (void)hipDeviceGetAttribute(&cus, hipDeviceAttributeMultiprocessorCount, dev);
    (void)hipOccupancyMaxActiveBlocksPerMultiprocessor(&per_cu, fwd_megakernel, 256, 0);
    if (per_cu > 2) per_cu = 2;
    if (per_cu < 1) per_cu = 1;
    grid_blocks = cus * per_cu;
  }
  if (ws_size < WS_NEED) { fprintf(stderr, "workspace too small: %zu < %zu\n", ws_size, (size_t)WS_NEED); return; }
  (void)hipMemsetAsync((unsigned char*)d_ws + OFF_BAR, 0, BAR_BYTES, stream);
  Params p{};
  const float* const* in = (const float* const*)d_in;
  p.x = in[0]; p.c = in[1]; p.ctx = in[2]; p.c_ctx = in[3]; p.w_mod = in[4]; p.b_mod = in[5]; p.norm1_g = in[6]; p.norm2_g = in[7]; p.w_in = in[8];
  p.dq_g = in[9]; p.dk_g = in[10]; p.lq1 = in[11]; p.lk1 = in[12]; p.lq2 = in[13]; p.lk2 = in[14]; p.dout_g = in[15];
  p.s5_lre = in[16]; p.s5_lim = in[17]; p.s5_ldt = in[18]; p.s5_bre = in[19]; p.s5_bim = in[20]; p.s5_cre = in[21]; p.s5_cim = in[22]; p.s5_d = in[23]; p.s5_wglu = in[24];
  p.wq_g = in[25]; p.wk_g = in[26]; p.w_sink = in[27];
  p.w_pd = in[28]; p.w_ps = in[29]; p.w_pw = in[30]; p.w_out = in[31]; p.w_ff1 = in[32]; p.w_ff2 = in[33];
  p.out = (float*)d_out; p.ws = (unsigned char*)d_ws;
  void* args[] = {&p};
  hipError_t e = hipLaunchCooperativeKernel((void*)fwd_megakernel, dim3(grid_blocks), dim3(256), args, 0, stream);
  if (e != hipSuccess) fprintf(stderr, "cooperative launch failed: %s (grid %d)\n", hipGetErrorString(e), grid_blocks);
}
```
